# Optimizing an MI355X kernel written in HIP

```python
import math
import jax, jax.numpy as jnp
from jax import lax
import numpy as np

D_MODEL = 1024
BATCH = 8
SEQ = 2048
DEPTH = 1
DEC_BATCH = 128
DEC_SEQ = 1
PAST_LEN = 16384
PAGE_SIZE = 128

N_META = 16
D_LRU = D_MODEL
LRU_BLOCKS = 8
LRU_BLOCK = D_LRU // LRU_BLOCKS
LRU_CONV = 4
LRU_C = 8.0
D_SSM = D_MODEL // 2
SSM_GROUP = 16
SSM_GROUPS = D_SSM // SSM_GROUP
SSM_STATE = 64
D_FF = 3 * D_MODEL
FFN_CONV = 3
D_IN = D_LRU + D_SSM + 2 * D_MODEL
ALPHA = (2.0 * DEPTH) ** 0.25
BETA = (8.0 * DEPTH) ** -0.25
LN_EPS = 1e-5

kernel_name = 'hawk_s5_convffn_deepnorm_step'


def layer_norm(x, g, b):
    xf = x.astype(jnp.float32)
    mu = jnp.mean(xf, axis=-1, keepdims=True)
    var = jnp.mean(jnp.square(xf - mu), axis=-1, keepdims=True)
    return ((xf - mu) * lax.rsqrt(var + LN_EPS)).astype(x.dtype) * g + b


def causal_dwconv(x, buf, w, b):
    k = w.shape[0]
    t = x.shape[1]
    xp = jnp.concatenate([buf.astype(x.dtype), x], axis=1)
    y = b + sum(xp[:, j:j + t] * w[j] for j in range(k))
    return y, xp[:, t:]


def linear_scan(a, bx, h0):
    bx = bx.at[:, 0].add(a[:, 0] * h0)

    def comb(l, r):
        return r[0] * l[0], r[0] * l[1] + r[1]

    _, h = lax.associative_scan(comb, (a, bx), axis=1)
    return h


def complex_linear_scan(a_re, a_im, b_re, b_im, h0_re, h0_im):
    b_re = b_re.at[:, 0].add(a_re[:, 0] * h0_re - a_im[:, 0] * h0_im)
    b_im = b_im.at[:, 0].add(a_re[:, 0] * h0_im + a_im[:, 0] * h0_re)

    def comb(l, r):
        lar, lai, lbr, lbi = l
        rar, rai, rbr, rbi = r
        return (rar * lar - rai * lai, rar * lai + rai * lar,
                rar * lbr - rai * lbi + rbr, rar * lbi + rai * lbr + rbi)

    _, _, h_re, h_im = lax.associative_scan(comb, (a_re, a_im, b_re, b_im), axis=1)
    return h_re, h_im


def rg_lru(x, h0, w_r, b_r, w_i, b_i, lam):
    nb, t, _ = x.shape
    xb = x.reshape(nb, t, LRU_BLOCKS, LRU_BLOCK)
    r = jax.nn.sigmoid(jnp.einsum('btnc,ncd->btnd', xb, w_r).reshape(nb, t, D_LRU) + b_r)
    i = jax.nn.sigmoid(jnp.einsum('btnc,ncd->btnd', xb, w_i).reshape(nb, t, D_LRU) + b_i)
    log_a = (-LRU_C * r.astype(jnp.float32)) * jax.nn.softplus(-lam.astype(jnp.float32))
    a = jnp.exp(log_a)
    mult = jnp.sqrt(-jnp.expm1(2.0 * log_a))
    bx = mult * (i * x).astype(jnp.float32)
    h = linear_scan(a, bx, h0.astype(jnp.float32))
    return h.astype(x.dtype), h[:, -1]


def s5_ssm(u, h0_re, h0_im, lam_re, lam_im, log_dt, b_re, b_im, c_re, c_im, d):
    f32 = jnp.float32
    nb, t, _ = u.shape
    dt = jnp.exp(log_dt.astype(f32))[:, None]
    lre = lam_re.astype(f32)
    lim = lam_im.astype(f32)
    mag = jnp.exp(lre * dt)
    ab_re = mag * jnp.cos(lim * dt)
    ab_im = mag * jnp.sin(lim * dt)
    den = lre * lre + lim * lim
    nr = ab_re - 1.0
    ni = ab_im
    f_re = (nr * lre + ni * lim) / den
    f_im = (ni * lre - nr * lim) / den
    br = b_re.astype(f32)
    bi = b_im.astype(f32)
    bb_re = f_re[..., None] * br - f_im[..., None] * bi
    bb_im = f_re[..., None] * bi + f_im[..., None] * br
    ug = u.reshape(nb, t, SSM_GROUPS, SSM_GROUP).astype(f32)
    bu_re = jnp.einsum('btgc,gpc->btgp', ug, bb_re)
    bu_im = jnp.einsum('btgc,gpc->btgp', ug, bb_im)
    a_re = jnp.broadcast_to(ab_re, bu_re.shape)
    a_im = jnp.broadcast_to(ab_im, bu_re.shape)
    h_re, h_im = complex_linear_scan(a_re, a_im, bu_re, bu_im,
                                     h0_re.astype(f32), h0_im.astype(f32))
    y = (jnp.einsum('btgp,gcp->btgc', h_re, c_re.astype(f32))
         - jnp.einsum('btgp,gcp->btgc', h_im, c_im.astype(f32)))
    y = y.reshape(nb, t, D_SSM).astype(u.dtype) + d * u
    return y, h_re[:, -1], h_im[:, -1]


def hybrid_layer(x, conv_buf, h_lru, s_re, s_im, ffn_buf,
                 w_in, b_in, conv_lru_w, conv_lru_b, lru_w_r, lru_b_r, lru_w_i, lru_b_i, lru_lambda,
                 ssm_lambda_re, ssm_lambda_im, ssm_log_dt, ssm_b_re, ssm_b_im, ssm_c_re, ssm_c_im, ssm_d,
                 w_glu, b_glu, w_out, b_out, ln1_g, ln1_b,
                 w_up, b_up, ffn_conv_w, ffn_conv_b, w_down, b_down, ln2_g, ln2_b):
    proj = x @ w_in + b_in
    xa, us, ga, gb = jnp.split(proj, [D_LRU, D_LRU + D_SSM, D_LRU + D_SSM + D_MODEL], axis=-1)
    xa_c, new_conv = causal_dwconv(xa, conv_buf, conv_lru_w, conv_lru_b)
    ya, new_h = rg_lru(xa_c, h_lru, lru_w_r, lru_b_r, lru_w_i, lru_b_i, lru_lambda)
    ys, new_re, new_im = s5_ssm(us, s_re, s_im, ssm_lambda_re, ssm_lambda_im, ssm_log_dt,
                                ssm_b_re, ssm_b_im, ssm_c_re, ssm_c_im, ssm_d)
    glu = jax.nn.gelu(ys) @ w_glu + b_glu
    yb = glu[..., :D_MODEL] * jax.nn.sigmoid(glu[..., D_MODEL:])
    mix = jax.nn.sigmoid(ga) * ya + jax.nn.sigmoid(gb) * yb
    x = layer_norm(ALPHA * x + (mix @ w_out + b_out), ln1_g, ln1_b)
    up = x @ w_up + b_up
    g, v = up[..., :D_FF], up[..., D_FF:]
    g_c, new_ffn = causal_dwconv(g, ffn_buf, ffn_conv_w, ffn_conv_b)
    h = jax.nn.gelu(g_c) * v
    x = layer_norm(ALPHA * x + (h @ w_down + b_down), ln2_g, ln2_b)
    return x, (new_conv, new_h, new_re, new_im, new_ffn)


def setup_inputs(seed: int = 0) -> dict:
    key = jax.random.key(seed)
    ks = iter(jax.random.split(key, 48))

    def nrm(shape, scale):
        return jax.random.normal(next(ks), shape, jnp.float32) * scale

    u_a = jax.random.uniform(next(ks), (DEPTH, D_LRU), jnp.float32, 0.9, 0.999)
    a0 = u_a ** (1.0 / LRU_C)
    lru_lambda = jnp.log(a0) - jnp.log1p(-a0)
    n_idx = jnp.arange(SSM_STATE, dtype=jnp.float32)
    return {
        'x_prompt': nrm((BATCH, SEQ, D_MODEL), 1.0),
        'x_sample': nrm((DEC_BATCH, DEC_SEQ, D_MODEL), 1.0),
        'cache_conv_lru': nrm((DEPTH, DEC_BATCH, LRU_CONV - 1, D_LRU), 1.0),
        'state_lru': nrm((DEPTH, DEC_BATCH, D_LRU), 0.5),
        'state_ssm_re': nrm((DEPTH, DEC_BATCH, SSM_GROUPS, SSM_STATE), 0.1),
        'state_ssm_im': nrm((DEPTH, DEC_BATCH, SSM_GROUPS, SSM_STATE), 0.1),
        'cache_conv_ffn': nrm((DEPTH, DEC_BATCH, FFN_CONV - 1, D_FF), 1.0),
        'meta_tokens': nrm((N_META, D_MODEL), 1.0),
        'emb_ln_g': 1.0 + nrm((D_MODEL,), 0.01),
        'emb_ln_b': nrm((D_MODEL,), 0.01),
        'w_in': nrm((DEPTH, D_MODEL, D_IN), D_MODEL ** -0.5),
        'b_in': nrm((DEPTH, D_IN), 0.01),
        'conv_lru_w': nrm((DEPTH, LRU_CONV, D_LRU), LRU_CONV ** -0.5),
        'conv_lru_b': nrm((DEPTH, D_LRU), 0.01),
        'lru_w_r': nrm((DEPTH, LRU_BLOCKS, LRU_BLOCK, LRU_BLOCK), LRU_BLOCK ** -0.5),
        'lru_b_r': nrm((DEPTH, D_LRU), 0.01),
        'lru_w_i': nrm((DEPTH, LRU_BLOCKS, LRU_BLOCK, LRU_BLOCK), LRU_BLOCK ** -0.5),
        'lru_b_i': nrm((DEPTH, D_LRU), 0.01),
        'lru_lambda': lru_lambda,
        'ssm_lambda_re': -0.5 * (1.0 + nrm((DEPTH, SSM_GROUPS, SSM_STATE), 0.02)),
        'ssm_lambda_im': math.pi * n_idx + nrm((DEPTH, SSM_GROUPS, SSM_STATE), 0.01),
        'ssm_log_dt': jax.random.uniform(next(ks), (DEPTH, SSM_GROUPS), jnp.float32,
                                         math.log(0.001), math.log(0.1)),
        'ssm_b_re': nrm((DEPTH, SSM_GROUPS, SSM_STATE, SSM_GROUP), (2.0 * SSM_GROUP) ** -0.5),
        'ssm_b_im': nrm((DEPTH, SSM_GROUPS, SSM_STATE, SSM_GROUP), (2.0 * SSM_GROUP) ** -0.5),
        'ssm_c_re': nrm((DEPTH, SSM_GROUPS, SSM_GROUP, SSM_STATE), (2.0 * SSM_STATE) ** -0.5),
        'ssm_c_im': nrm((DEPTH, SSM_GROUPS, SSM_GROUP, SSM_STATE), (2.0 * SSM_STATE) ** -0.5),
        'ssm_d': nrm((DEPTH, D_SSM), 1.0),
        'w_glu': nrm((DEPTH, D_SSM, 2 * D_MODEL), D_SSM ** -0.5),
        'b_glu': nrm((DEPTH, 2 * D_MODEL), 0.01),
        'w_out': nrm((DEPTH, D_MODEL, D_MODEL), BETA * D_MODEL ** -0.5),
        'b_out': nrm((DEPTH, D_MODEL), 0.01),
        'ln1_g': 1.0 + nrm((DEPTH, D_MODEL), 0.01),
        'ln1_b': nrm((DEPTH, D_MODEL), 0.01),
        'w_up': nrm((DEPTH, D_MODEL, 2 * D_FF), D_MODEL ** -0.5),
        'b_up': nrm((DEPTH, 2 * D_FF), 0.01),
        'ffn_conv_w': nrm((DEPTH, FFN_CONV, D_FF), FFN_CONV ** -0.5),
        'ffn_conv_b': nrm((DEPTH, D_FF), 0.01),
        'w_down': nrm((DEPTH, D_FF, D_MODEL), BETA * D_FF ** -0.5),
        'b_down': nrm((DEPTH, D_MODEL), 0.01),
        'ln2_g': 1.0 + nrm((DEPTH, D_MODEL), 0.01),
        'ln2_b': nrm((DEPTH, D_MODEL), 0.01),
    }


def reference(x_prompt, x_sample, cache_conv_lru, state_lru, state_ssm_re, state_ssm_im, cache_conv_ffn,
              meta_tokens, emb_ln_g, emb_ln_b, w_in, b_in, conv_lru_w, conv_lru_b,
              lru_w_r, lru_b_r, lru_w_i, lru_b_i, lru_lambda,
              ssm_lambda_re, ssm_lambda_im, ssm_log_dt, ssm_b_re, ssm_b_im, ssm_c_re, ssm_c_im, ssm_d,
              w_glu, b_glu, w_out, b_out, ln1_g, ln1_b,
              w_up, b_up, ffn_conv_w, ffn_conv_b, w_down, b_down, ln2_g, ln2_b):
    nbp = x_prompt.shape[0]
    meta = jnp.broadcast_to(meta_tokens[None].astype(x_prompt.dtype), (nbp, N_META, D_MODEL))
    xp = layer_norm(jnp.concatenate([meta, x_prompt], axis=1), emb_ln_g, emb_ln_b)
    xs = layer_norm(x_sample, emb_ln_g, emb_ln_b)
    f32 = jnp.float32
    p_new = ([], [], [], [], [])
    s_new = ([], [], [], [], [])
    for l in range(DEPTH):
        lw = (w_in[l], b_in[l], conv_lru_w[l], conv_lru_b[l], lru_w_r[l], lru_b_r[l], lru_w_i[l], lru_b_i[l],
              lru_lambda[l], ssm_lambda_re[l], ssm_lambda_im[l], ssm_log_dt[l], ssm_b_re[l], ssm_b_im[l],
              ssm_c_re[l], ssm_c_im[l], ssm_d[l], w_glu[l], b_glu[l], w_out[l], b_out[l], ln1_g[l], ln1_b[l],
              w_up[l], b_up[l], ffn_conv_w[l], ffn_conv_b[l], w_down[l], b_down[l], ln2_g[l], ln2_b[l])
        xp, st_p = hybrid_layer(xp,
                                jnp.zeros((nbp, LRU_CONV - 1, D_LRU), xp.dtype),
                                jnp.zeros((nbp, D_LRU), f32),
                                jnp.zeros((nbp, SSM_GROUPS, SSM_STATE), f32),
                                jnp.zeros((nbp, SSM_GROUPS, SSM_STATE), f32),
                                jnp.zeros((nbp, FFN_CONV - 1, D_FF), xp.dtype),
                                *lw)
        xs, st_s = hybrid_layer(xs, cache_conv_lru[l], state_lru[l], state_ssm_re[l], state_ssm_im[l],
                                cache_conv_ffn[l], *lw)
        for lst, val in zip(p_new, st_p):
            lst.append(val)
        for lst, val in zip(s_new, st_s):
            lst.append(val)
    y_prompt = xp[:, N_META:]
    y_sample = xs
    return (y_prompt, y_sample,
            jnp.stack(p_new[0]), jnp.stack(p_new[1]), jnp.stack(p_new[2]), jnp.stack(p_new[3]),
            jnp.stack(p_new[4]),
            jnp.stack(s_new[0]), jnp.stack(s_new[1]), jnp.stack(s_new[2]), jnp.stack(s_new[3]),
            jnp.stack(s_new[4]))
```

```cpp
#include <hip/hip_runtime.h>
#include <hip/hip_cooperative_groups.h>
#include <cstdio>
#include <cstdint>
namespace cg = cooperative_groups;
namespace pg8 {
#define PG8_LAS __attribute__((address_space(3)))
typedef unsigned short bf16_t;
typedef short bf16x8 __attribute__((ext_vector_type(8)));
typedef float f32x4 __attribute__((ext_vector_type(4)));
typedef unsigned u32x4 __attribute__((ext_vector_type(4)));
constexpr int BM = 256, BK = 64, HALF = 128, HTB = HALF * BK * 2  , STAGE_BYTES = 8 * HTB, NXCD = 8, WGM = 8;

__host__ __device__ __forceinline__ int lds_byte(int r, int c) { const int st = (r >> 4) * 2 + (c >> 5), rr = r & 15, cc = c & 31, ob = rr * 64 + cc * 2; return st * 1024 + (ob ^ (((ob >> 9) & 1) << 5)); }
__host__ __device__ __forceinline__ void stage_rc(int b, int& R, int& C) { const int st = b / 1024, sb = b % 1024, swz = sb ^ (((sb >> 9) & 1) << 5); R = (st >> 1) * 16 + swz / 64; C = (st & 1) * 32 + (swz % 64) / 2; }
__host__ __device__ __forceinline__ int perm32(int rho) { const int n = rho >> 4, i = rho & 15; return 8 * (i >> 2) + 4 * n + (i & 3); }

struct Unit { int pm, pn; };
struct Gemm { const bf16_t* A; const bf16_t* Bt; int M, N, K; };

struct StaticOrder {
    int nM, nN, nwg, G, c;
    __host__ __device__ void init(int M, int N, int G_, int c_) { nM = M / BM; nN = N / BM; nwg = nM * nN; G = G_; c = c_; }
    __host__ __device__ bool next(int i, Unit& u) const {
        const long L = (long)i * G + c; if (L >= nwg) return false;
        int wgid = (int)L; { const int q = nwg / NXCD, r = nwg % NXCD, xcd = wgid % NXCD, off = wgid / NXCD; wgid = (xcd < r ? xcd * (q + 1) : r * (q + 1) + (xcd - r) * q) + off; }
        const int nig = WGM * nN, gid = wgid / nig, fm = gid * WGM, gsz = (nM - fm) < WGM ? (nM - fm) : WGM;
        u.pm = fm + ((wgid % nig) % gsz); u.pn = (wgid % nig) / gsz; return true;
    }
    __device__ __forceinline__ void a_ready(const Unit&) const {}
    __device__ __forceinline__ void done(const Unit&) const {}
};
__device__ __forceinline__ unsigned cvt_pk_bf16(float lo, float hi) { unsigned r; asm volatile("v_cvt_pk_bf16_f32 %0, %1, %2" : "=v"(r) : "v"(lo), "v"(hi)); return r; }
template <class Epi, class Sched, bool STAMP = false>
__device__ __forceinline__ void gemm_phase(PG8_LAS unsigned char* lds, const Gemm g, const Sched& S, const Epi& E, unsigned long long* stamps) {
    const int tid = threadIdx.x, wid = __builtin_amdgcn_readfirstlane(tid >> 6), lane = tid & 63, wr = wid >> 2, wc = wid & 3, fr = lane & 15, fq = lane >> 4;
    const int K = g.K, nt = K / BK;
    int ts_lo = 0, ts_hi = 0, nts = 0; const unsigned long long rt_entry = STAMP ? (unsigned long long)wall_clock64() : 0ull;
#define PG8_STAMP() do { if (STAMP && wid == 0 && nts < 64) { const unsigned long long _c = (unsigned long long)clock64(); \
        ts_lo = (lane == nts) ? (int)(unsigned)_c : ts_lo; ts_hi = (lane == nts) ? (int)(unsigned)(_c >> 32) : ts_hi; ++nts; } } while (0)
    PG8_STAMP();
    unsigned voffA[2], voffB[2];
#pragma unroll
    for (int i = 0; i < 2; ++i) { int R, C; stage_rc(tid * 16 + i * 8192, R, C); const int Rb = Epi::PERM ? ((R & ~31) + perm32(R & 31)) : R;
        voffA[i] = (unsigned)(R * K + C) * 2u; voffB[i] = (unsigned)(Rb * K + C) * 2u; }
    const size_t kstep = (size_t)(BK * 2);
    const size_t hstep = (size_t)HALF * K * 2;
    const size_t tstep = 2 * hstep;
    const unsigned ldsw = (unsigned)wid * 1024u;
    const int aoff = lds_byte(wr * 64 + fr, fq * 8), boff = lds_byte(wc * 32 + fr, fq * 8);
#define PG8_SA(b, h) (((b) * 2 + (h)) * HTB)
#define PG8_SB(b, h) ((4 + (b) * 2 + (h)) * HTB)
#define PG8_STAGE(bufoff, gbase, voff) do { _Pragma("unroll") for (int _i = 0; _i < 2; ++_i) \
        __builtin_amdgcn_global_load_lds((const unsigned*)((const char*)(gbase) + (voff)[_i]), (PG8_LAS unsigned*)(lds + (bufoff) + ldsw + _i * 8192), 16, 0, 0); } while (0)
#define PG8_LDA(dst, b, h) do { _Pragma("unroll") for (int m = 0; m < 4; ++m) _Pragma("unroll") for (int k = 0; k < 2; ++k) dst[m][k] = *(const PG8_LAS bf16x8*)(lds + PG8_SA(b, h) + aoff + m * 2048 + k * 1024); } while (0)
#define PG8_LDB(dst, b, h) do { _Pragma("unroll") for (int n = 0; n < 2; ++n) _Pragma("unroll") for (int k = 0; k < 2; ++k) dst[n][k] = *(const PG8_LAS bf16x8*)(lds + PG8_SB(b, h) + boff + n * 2048 + k * 1024); } while (0)
#define PG8_MMA(ai, bj, At, Bt) do { __builtin_amdgcn_s_setprio(1); _Pragma("unroll") for (int m = 0; m < 4; ++m) _Pragma("unroll") for (int n = 0; n < 2; ++n) _Pragma("unroll") for (int k = 0; k < 2; ++k) \
        acc[ai][bj][m][n] = __builtin_amdgcn_mfma_f32_16x16x32_bf16(Bt[n][k], At[m][k], acc[ai][bj][m][n], 0, 0, 0); __builtin_amdgcn_s_setprio(0); } while (0)
#define PG8_WAIT_V(n) asm volatile("s_waitcnt vmcnt(" #n ")" ::: "memory")
#define PG8_WAIT_L(n) asm volatile("s_waitcnt lgkmcnt(" #n ")" ::: "memory")
#define PG8_BAR __builtin_amdgcn_s_barrier()
#define PG8_SCHED __builtin_amdgcn_sched_barrier(0)
    Unit cur, nxt; int ui = 0;
    if (!S.next(0, cur)) return;
    f32x4 acc[2][2][4][2];
#pragma unroll
    for (int a = 0; a < 2; ++a)
#pragma unroll
        for (int b = 0; b < 2; ++b)
#pragma unroll
            for (int m = 0; m < 4; ++m)
#pragma unroll
                for (int n = 0; n < 2; ++n) acc[a][b][m][n] = (f32x4){0.f, 0.f, 0.f, 0.f};
    bf16x8 At[4][2], B0[2][2], B1[2][2];
    const char* cA = (const char*)g.A + (size_t)cur.pm * tstep; const char* cB = (const char*)g.Bt + (size_t)cur.pn * tstep;
    S.a_ready(cur);
    PG8_STAGE(PG8_SB(0, 0), cB, voffB); PG8_STAGE(PG8_SA(0, 0), cA, voffA); PG8_STAGE(PG8_SB(0, 1), cB + hstep, voffB); PG8_STAGE(PG8_SA(0, 1), cA + hstep, voffA);
    if (wr == 1) PG8_BAR;
    PG8_WAIT_V(4); PG8_BAR;
    PG8_STAGE(PG8_SB(1, 0), cB + kstep, voffB); PG8_STAGE(PG8_SA(1, 0), cA + kstep, voffA); PG8_STAGE(PG8_SB(1, 1), cB + hstep + kstep, voffB);
    PG8_WAIT_V(6); PG8_BAR;
    PG8_STAMP();
    for (;;) {
        const bool has_next = S.next(ui + 1, nxt);
        const char* nA = has_next ? (const char*)g.A + (size_t)nxt.pm * tstep : cA; const char* nB = has_next ? (const char*)g.Bt + (size_t)nxt.pn * tstep : cB;
        for (int t = 0; t < nt; t += 2) {
            const bool last = (t == nt - 2);
            const char* a1 = cA + (size_t)(t + 1) * kstep;
            const char* a2 = last ? nA : cA + (size_t)(t + 2) * kstep; const char* b2 = last ? nB : cB + (size_t)(t + 2) * kstep;
            const char* a3 = a2 + kstep; const char* b3 = b2 + kstep;
            if (last && has_next) S.a_ready(nxt);
            PG8_LDB(B0, 0, 0); PG8_SCHED; PG8_LDA(At, 0, 0); PG8_STAGE(PG8_SA(1, 1), a1 + hstep, voffA);
            PG8_WAIT_L(8); PG8_BAR; PG8_WAIT_L(0); PG8_MMA(0, 0, At, B0); PG8_BAR; PG8_SCHED;
            PG8_LDB(B1, 0, 1); PG8_STAGE(PG8_SB(0, 0), b2, voffB);
            PG8_BAR; PG8_WAIT_L(0); PG8_MMA(0, 1, At, B1); PG8_BAR;
            PG8_LDA(At, 0, 1); PG8_STAGE(PG8_SA(0, 0), a2, voffA);
            PG8_BAR; PG8_WAIT_L(0); PG8_MMA(1, 0, At, B0); PG8_BAR; PG8_SCHED;
            PG8_STAGE(PG8_SB(0, 1), b2 + hstep, voffB);
            PG8_WAIT_V(6); PG8_BAR; PG8_MMA(1, 1, At, B1); PG8_BAR;
            PG8_LDB(B0, 1, 0); PG8_SCHED; PG8_LDA(At, 1, 0); PG8_STAGE(PG8_SA(0, 1), a2 + hstep, voffA);
            PG8_WAIT_L(8); PG8_BAR; PG8_WAIT_L(0); PG8_MMA(0, 0, At, B0); PG8_BAR; PG8_SCHED;
            PG8_LDB(B1, 1, 1); PG8_STAGE(PG8_SB(1, 0), b3, voffB);
            PG8_BAR; PG8_WAIT_L(0); PG8_MMA(0, 1, At, B1); PG8_BAR;
            PG8_LDA(At, 1, 1); PG8_STAGE(PG8_SA(1, 0), a3, voffA);
            PG8_BAR; PG8_WAIT_L(0); PG8_MMA(1, 0, At, B0); PG8_BAR; PG8_SCHED;
            PG8_STAGE(PG8_SB(1, 1), b3 + hstep, voffB);
            PG8_WAIT_V(6); PG8_BAR; PG8_MMA(1, 1, At, B1); PG8_BAR;
        }
        PG8_STAMP();
        if constexpr (!Epi::AFTER_DRAIN) { E(acc, cur, wr, wc, fr, fq); S.done(cur); }
        PG8_STAMP();
        if (!has_next) break;
#pragma unroll
        for (int a = 0; a < 2; ++a)
#pragma unroll
            for (int b = 0; b < 2; ++b)
#pragma unroll
                for (int m = 0; m < 4; ++m)
#pragma unroll
                    for (int n = 0; n < 2; ++n) acc[a][b][m][n] = (f32x4){0.f, 0.f, 0.f, 0.f};
        cur = nxt; cA = nA; cB = nB; ++ui;
    }
    PG8_WAIT_V(0);
    if (wr == 0) PG8_BAR;
    PG8_BAR;
    if constexpr (Epi::AFTER_DRAIN) { E.fused(acc, cur, wr, wc, fr, fq, lds, wid, lane); S.done(cur); }
    PG8_STAMP();
    if (STAMP && wid == 0) { stamps[lane] = lane < nts ? (((unsigned long long)(unsigned)ts_hi << 32) | (unsigned)ts_lo) : 0ull;
        if (lane == 62) stamps[62] = rt_entry; if (lane == 63) stamps[63] = (unsigned long long)wall_clock64(); }
#undef PG8_STAMP
#undef PG8_SA
#undef PG8_SB
#undef PG8_STAGE
#undef PG8_LDA
#undef PG8_LDB
#undef PG8_MMA
#undef PG8_WAIT_V
#undef PG8_WAIT_L
#undef PG8_BAR
#undef PG8_SCHED
}
}
using pg8::bf16_t; using pg8::bf16x8; using pg8::f32x4; using pg8::u32x4; using pg8::Unit; using pg8::cvt_pk_bf16;
#define LAS __attribute__((address_space(3)))
typedef unsigned u32x2 __attribute__((ext_vector_type(2)));

constexpr int DM = 1024, NBATCH = 8, TT = 2064, NSAMP = 128, MP = NBATCH * TT  , MTOK = MP + NSAMP  ;
constexpr int DIN = 3584, DSSM = 512, DFF = 3072, NG = 32, NCHUNK = 129, NR = NBATCH * NCHUNK  ;
constexpr int C_US = 1024, C_GA = 1536, C_GB = 2560;
constexpr float ALPHA = 1.189207115002721f, LN_EPS = 1e-5f;
enum { I_XP = 0, I_XS, I_CCL, I_SL, I_SSR, I_SSI, I_CCF, I_META, I_EG, I_EB, I_WIN, I_BIN, I_CLW, I_CLB, I_WR, I_BR, I_WI, I_BI, I_LAM,
       I_SLRE, I_SLIM, I_SLDT, I_SBRE, I_SBIM, I_SCRE, I_SCIM, I_SD, I_WGLU, I_BGLU, I_WOUT, I_BOUT, I_L1G, I_L1B, I_WUP, I_BUP, I_FCW, I_FCB,
       I_WDOWN, I_BDOWN, I_L2G, I_L2B, N_IN };
constexpr size_t O_YP = 0, O_YS = 16777216, O_PCL = O_YS + 131072, O_PL = O_PCL + 24576, O_PSR = O_PL + 8192, O_PSI = O_PSR + 16384, O_PCF = O_PSI + 16384,
                 O_SCL = O_PCF + 49152, O_SL = O_SCL + 393216, O_SSR = O_SL + 131072, O_SSI = O_SSR + 262144, O_SCF = O_SSI + 262144, O_END = O_SCF + 786432;
constexpr size_t W_WTUP = 0, W_WTDOWN = W_WTUP + (size_t)6144 * 1024 * 2, W_XN = W_WTDOWN + (size_t)1024 * 3072 * 2, W_C = W_XN + (size_t)MTOK * 1024 * 2;
constexpr size_t W_PROJ = W_C, W_MIX = W_PROJ + (size_t)MTOK * DIN * 2, W_YSG = W_MIX + (size_t)MTOK * 1024 * 2, W_D = W_YSG + (size_t)MTOK * 512 * 2;
constexpr size_t W_WTGLU = W_D, W_WTOUT = W_WTGLU + (size_t)2048 * 512 * 2, W_WTR = W_WTOUT + (size_t)1024 * 1024 * 2, W_WTI = W_WTR + 262144, W_W1 = W_WTI + 262144,
                 W_W2 = W_W1 + (size_t)NG * 128 * 256 * 2, W_HPREV = W_W2 + (size_t)NG * 256 * 384 * 2, W_A1 = W_HPREV + (size_t)NR * NG * 128 * 2, W_A16 = W_A1 + 16384,
                 W_BBAR = W_A16 + 16384, W_LRUA = W_BBAR + 262144, W_LRUH = W_LRUA + 262144, W_LRUC = W_LRUH + 262144, W_S = W_LRUC + 262144, W_WTIN = W_S,
                 W_S_END = W_S + (size_t)NR * NG * 128 * 4;
constexpr size_t W_R1 = W_C, W_G = W_C, W_V = W_G + (size_t)MTOK * DFF * 2, W_V_END = W_V + (size_t)MTOK * DFF * 2, W_R2 = W_C;
static_assert(W_S_END <= 268435456 && W_V_END <= 268435456, "workspace map exceeds 256 MiB");
static_assert(W_R1 + (size_t)MTOK * 1024 * 4 <= W_MIX, "r1 overlaps mix");

struct P { const float* in[N_IN]; float* out; unsigned char* ws; };

__device__ __forceinline__ float bf2f(unsigned short b) { return __uint_as_float(((unsigned)b) << 16); }
__device__ __forceinline__ float bflo(unsigned u) { return __uint_as_float(u << 16); }
__device__ __forceinline__ float bfhi(unsigned u) { return __uint_as_float(u & 0xffff0000u); }
__device__ __forceinline__ unsigned short f2bf(float f) { return (unsigned short)(cvt_pk_bf16(f, 0.f) & 0xffffu); }
__device__ __forceinline__ float sigm(float x) { return __builtin_amdgcn_rcpf(1.f + __expf(-x)); }
__device__ __forceinline__ float gelu_tanh(float x) { return x * sigm(1.5957691216057308f * (x + 0.044715f * x * x * x)); }
__device__ __forceinline__ float wave_sum(float v) {
#pragma unroll
    for (int o = 1; o < 64; o <<= 1) v += __shfl_xor(v, o);
    return v;
}
#define LDS_WAIT() asm volatile("s_waitcnt lgkmcnt(0)" ::: "memory")

struct EpiProj {
    static constexpr bool PERM = false, AFTER_DRAIN = false;
    bf16_t* O; const float* bias;
    __device__ __forceinline__ void operator()(const f32x4 (&acc)[2][2][4][2], const Unit& u, int wr, int wc, int fr, int fq) const {
        const int row0 = u.pm * 256 + wr * 64 + fr, col0 = u.pn * 256 + wc * 32 + 4 * fq;
#pragma unroll
        for (int bj = 0; bj < 2; ++bj)
#pragma unroll
            for (int n = 0; n < 2; ++n) { const int col = col0 + bj * 128 + n * 16; const f32x4 bv = *(const f32x4*)(bias + col);
#pragma unroll
                for (int ai = 0; ai < 2; ++ai)
#pragma unroll
                    for (int m = 0; m < 4; ++m) { const f32x4 v = acc[ai][bj][m][n] + bv; u32x2 w; w.x = cvt_pk_bf16(v[0], v[1]); w.y = cvt_pk_bf16(v[2], v[3]);
                        *(u32x2*)(O + (size_t)(row0 + ai * 128 + m * 16) * DIN + col) = w; } }
    }
};
struct EpiGlu {
    static constexpr bool PERM = false, AFTER_DRAIN = false;
    bf16_t* mix; const bf16_t* proj; const float* bias;
    __device__ __forceinline__ void operator()(const f32x4 (&acc)[2][2][4][2], const Unit& u, int wr, int wc, int fr, int fq) const {
        const int row0 = u.pm * 256 + wr * 64 + fr, j0 = u.pn * 128 + wc * 32 + 4 * fq;
#pragma unroll
        for (int n = 0; n < 2; ++n) { const int j = j0 + n * 16; const f32x4 bv = *(const f32x4*)(bias + j), bg = *(const f32x4*)(bias + 1024 + j);
#pragma unroll
            for (int ai = 0; ai < 2; ++ai)
#pragma unroll
                for (int m = 0; m < 4; ++m) { const size_t row = (size_t)(row0 + ai * 128 + m * 16);
                    const f32x4 val = acc[ai][0][m][n] + bv, gate = acc[ai][1][m][n] + bg;
                    const u32x2 gbw = *(const u32x2*)(proj + row * DIN + C_GB + j); const u32x2 mw = *(const u32x2*)(mix + row * 1024 + j);
                    const float o0 = bflo(mw.x) + sigm(bflo(gbw.x)) * val[0] * sigm(gate[0]), o1 = bfhi(mw.x) + sigm(bfhi(gbw.x)) * val[1] * sigm(gate[1]);
                    const float o2 = bflo(mw.y) + sigm(bflo(gbw.y)) * val[2] * sigm(gate[2]), o3 = bfhi(mw.y) + sigm(bfhi(gbw.y)) * val[3] * sigm(gate[3]);
                    u32x2 w; w.x = cvt_pk_bf16(o0, o1); w.y = cvt_pk_bf16(o2, o3); *(u32x2*)(mix + row * 1024 + j) = w; } }
    }
};
struct EpiRes {
    static constexpr bool PERM = false, AFTER_DRAIN = false;
    float* R; const bf16_t* X; const float* bias;
    __device__ __forceinline__ void operator()(const f32x4 (&acc)[2][2][4][2], const Unit& u, int wr, int wc, int fr, int fq) const {
        const int row0 = u.pm * 256 + wr * 64 + fr, col0 = u.pn * 256 + wc * 32 + 4 * fq;
#pragma unroll
        for (int bj = 0; bj < 2; ++bj)
#pragma unroll
            for (int n = 0; n < 2; ++n) { const int col = col0 + bj * 128 + n * 16; const f32x4 bv = *(const f32x4*)(bias + col);
#pragma unroll
                for (int ai = 0; ai < 2; ++ai)
#pragma unroll
                    for (int m = 0; m < 4; ++m) { const size_t off = (size_t)(row0 + ai * 128 + m * 16) * 1024 + col; const u32x2 xw = *(const u32x2*)(X + off);
                        f32x4 v = acc[ai][bj][m][n] + bv; v[0] += ALPHA * bflo(xw.x); v[1] += ALPHA * bfhi(xw.x); v[2] += ALPHA * bflo(xw.y); v[3] += ALPHA * bfhi(xw.y);
                        *(f32x4*)(R + off) = v; } }
    }
};
struct EpiUp {
    static constexpr bool PERM = false, AFTER_DRAIN = false;
    bf16_t* G; bf16_t* V; const float* bias; float* out;
    __device__ __forceinline__ void operator()(const f32x4 (&acc)[2][2][4][2], const Unit& u, int wr, int wc, int fr, int fq) const {
        const int row0 = u.pm * 256 + wr * 64 + fr, c0 = u.pn * 128 + wc * 32 + 4 * fq;
#pragma unroll
        for (int n = 0; n < 2; ++n) { const int ch = c0 + n * 16; const f32x4 bg = *(const f32x4*)(bias + ch), bv = *(const f32x4*)(bias + DFF + ch);
#pragma unroll
            for (int ai = 0; ai < 2; ++ai)
#pragma unroll
                for (int m = 0; m < 4; ++m) { const int row = row0 + ai * 128 + m * 16; const f32x4 g = acc[ai][0][m][n] + bg, v = acc[ai][1][m][n] + bv;
                    u32x2 w; w.x = cvt_pk_bf16(g[0], g[1]); w.y = cvt_pk_bf16(g[2], g[3]); *(u32x2*)(G + (size_t)row * DFF + ch) = w;
                    w.x = cvt_pk_bf16(v[0], v[1]); w.y = cvt_pk_bf16(v[2], v[3]); *(u32x2*)(V + (size_t)row * DFF + ch) = w;
                    if (row >= MP) { *(f32x4*)(out + O_SCF + ((size_t)(row - MP) * 2 + 1) * DFF + ch) = g; }
                    else { const int b = row / TT, t = row - b * TT; if (t >= TT - 2) *(f32x4*)(out + O_PCF + ((size_t)b * 2 + (t - (TT - 2))) * DFF + ch) = g; } } }
    }
};
template <class Epi> __device__ __forceinline__ void run_gemm(LAS unsigned char* lds, const bf16_t* A, const bf16_t* Bt, int N, int K, const Epi& E) {
    pg8::Gemm g; g.A = A; g.Bt = Bt; g.M = MTOK; g.N = N; g.K = K;
    pg8::StaticOrder S; S.init(MTOK, N, (int)gridDim.x, (int)blockIdx.x);
    pg8::gemm_phase<Epi, pg8::StaticOrder, false>(lds, g, S, E, nullptr);
}

__device__ __forceinline__ void transpose_item(const float* W, int N, bf16_t* WT, int K, int k0, int srcn0, int dstn0, LAS float* scr, int lane) {
#pragma unroll 8
    for (int i = 0; i < 32; ++i) { const int kk = 2 * i + (lane >> 5); scr[kk * 33 + (lane & 31)] = W[(size_t)(k0 + kk) * N + srcn0 + (lane & 31)]; }
    LDS_WAIT();
    const int c = lane & 7;
#pragma unroll
    for (int j = 0; j < 4; ++j) { const int n = (lane >> 3) + 8 * j; const LAS float* s = scr + (8 * c) * 33 + n;
        u32x4 o; o.x = cvt_pk_bf16(s[0 * 33], s[1 * 33]); o.y = cvt_pk_bf16(s[2 * 33], s[3 * 33]); o.z = cvt_pk_bf16(s[4 * 33], s[5 * 33]); o.w = cvt_pk_bf16(s[6 * 33], s[7 * 33]);
        *(u32x4*)(WT + (size_t)(dstn0 + n) * K + k0 + 8 * c) = o; }
    LDS_WAIT();
}
__device__ __forceinline__ const float* src_row(const P& p, int r) {
    if (r < MP) { const int b = r / TT, t = r - b * TT; return t < 16 ? p.in[I_META] + (size_t)t * DM : p.in[I_XP] + ((size_t)b * 2048 + (t - 16)) * DM; }
    return p.in[I_XS] + (size_t)(r - MP) * DM;
}
template <bool OUT_BF16> __device__ __forceinline__ void ln_row(const float* xrow, const float* g, const float* bta, void* orow, int lane) {
    f32x4 v[4]; float s = 0.f;
#pragma unroll
    for (int j = 0; j < 4; ++j) { v[j] = *(const f32x4*)(xrow + 4 * lane + 256 * j); s += (v[j][0] + v[j][1]) + (v[j][2] + v[j][3]); }
    const float mean = wave_sum(s) * (1.f / DM); float s2 = 0.f;
#pragma unroll
    for (int j = 0; j < 4; ++j) { v[j] = v[j] - mean; s2 += (v[j][0] * v[j][0] + v[j][1] * v[j][1]) + (v[j][2] * v[j][2] + v[j][3] * v[j][3]); }
    const float rstd = 1.f / sqrtf(wave_sum(s2) * (1.f / DM) + LN_EPS);
#pragma unroll
    for (int j = 0; j < 4; ++j) { const f32x4 gg = *(const f32x4*)(g + 4 * lane + 256 * j), bb = *(const f32x4*)(bta + 4 * lane + 256 * j);
        const f32x4 o = (v[j] * rstd) * gg + bb;
        if (OUT_BF16) { u32x2 w; w.x = cvt_pk_bf16(o[0], o[1]); w.y = cvt_pk_bf16(o[2], o[3]); *(u32x2*)((bf16_t*)orow + 4 * lane + 256 * j) = w; }
        else *(f32x4*)((float*)orow + 4 * lane + 256 * j) = o; }
}
__device__ __forceinline__ void s5_precompute(const P& p, LAS unsigned char* lds, int g) {
    LAS float* apr = (LAS float*)lds;
    LAS float* api = apr + 17 * 64;
    LAS float* bbr = api + 17 * 64;
    LAS float* bbi = bbr + 1024;
    LAS float* cr = bbi + 1024;
    LAS float* ci = cr + 1024;
    LAS float* Kl = ci + 1024;
    const int tid = threadIdx.x;
    if (tid < 64) { const int pp = tid;
        const float dt = expf(p.in[I_SLDT][g]); const float lre = p.in[I_SLRE][g * 64 + pp], lim = p.in[I_SLIM][g * 64 + pp];
        const float mag = expf(lre * dt); const float ang = lim * dt; const float abr = mag * cosf(ang), abi = mag * sinf(ang);
        const float den = lre * lre + lim * lim, nr = abr - 1.0f, ni = abi; const float fre = (nr * lre + ni * lim) / den, fim = (ni * lre - nr * lim) / den;
        float pr = 1.f, pi = 0.f;
        for (int j = 0; j <= 16; ++j) { apr[j * 64 + pp] = pr; api[j * 64 + pp] = pi; const float nr2 = pr * abr - pi * abi, ni2 = pr * abi + pi * abr; pr = nr2; pi = ni2; }
        float* a1 = (float*)(p.ws + W_A1); float* a16 = (float*)(p.ws + W_A16); float* bbar = (float*)(p.ws + W_BBAR);
        a1[(g * 64 + pp) * 2] = abr; a1[(g * 64 + pp) * 2 + 1] = abi; a16[(g * 64 + pp) * 2] = apr[16 * 64 + pp]; a16[(g * 64 + pp) * 2 + 1] = api[16 * 64 + pp];
        for (int c = 0; c < 16; ++c) { const float br = p.in[I_SBRE][(g * 64 + pp) * 16 + c], bi = p.in[I_SBIM][(g * 64 + pp) * 16 + c];
            const float xr = fre * br - fim * bi, xi = fre * bi + fim * br; bbr[pp * 16 + c] = xr; bbi[pp * 16 + c] = xi;
            bbar[((g * 64 + pp) * 16 + c) * 2] = xr; bbar[((g * 64 + pp) * 16 + c) * 2 + 1] = xi; }
    }
    for (int i = tid; i < 1024; i += 512) { cr[i] = p.in[I_SCRE][g * 1024 + i]; ci[i] = p.in[I_SCIM][g * 1024 + i]; }
    __syncthreads();
    for (int i = 0; i < 8; ++i) { const int idx = tid + 512 * i, j = idx >> 8, c1 = (idx >> 4) & 15, c = idx & 15; float s = 0.f;
        for (int pp = 0; pp < 64; ++pp) { const float car = cr[c1 * 64 + pp] * apr[j * 64 + pp] - ci[c1 * 64 + pp] * api[j * 64 + pp], cai = cr[c1 * 64 + pp] * api[j * 64 + pp] + ci[c1 * 64 + pp] * apr[j * 64 + pp];
            s += car * bbr[pp * 16 + c] - cai * bbi[pp * 16 + c]; }
        if (j == 0 && c1 == c) s += p.in[I_SD][g * 16 + c1];
        Kl[idx] = s; }
    __syncthreads();
    bf16_t* W1 = (bf16_t*)(p.ws + W_W1) + (size_t)g * 128 * 256; bf16_t* W2 = (bf16_t*)(p.ws + W_W2) + (size_t)g * 256 * 384;
    for (int i = tid; i < 128 * 32; i += 512) { const int n = i >> 5, ch = i & 31, s = ch >> 1, c0 = 8 * (ch & 1), pp = n & 63; const bool im = n >= 64; float v[8];
        const float ar = apr[(15 - s) * 64 + pp], ai = api[(15 - s) * 64 + pp];
#pragma unroll
        for (int e = 0; e < 8; ++e) { const float xr = bbr[pp * 16 + c0 + e], xi = bbi[pp * 16 + c0 + e]; v[e] = im ? (ar * xi + ai * xr) : (ar * xr - ai * xi); }
        u32x4 o; o.x = cvt_pk_bf16(v[0], v[1]); o.y = cvt_pk_bf16(v[2], v[3]); o.z = cvt_pk_bf16(v[4], v[5]); o.w = cvt_pk_bf16(v[6], v[7]);
        *(u32x4*)(W1 + (size_t)n * 256 + 8 * ch) = o; }
    for (int i = tid; i < 256 * 48; i += 512) { const int n = i / 48, ch = i - n * 48, t = n >> 4, c1 = n & 15; float v[8];
        if (ch < 32) { const int s = ch >> 1, c0 = 8 * (ch & 1);
#pragma unroll
            for (int e = 0; e < 8; ++e) v[e] = (s <= t) ? Kl[((t - s) * 16 + c1) * 16 + c0 + e] : 0.f; }
        else { const bool im = ch >= 40; const int p0 = 8 * (ch - (im ? 40 : 32));
#pragma unroll
            for (int e = 0; e < 8; ++e) { const int pp = p0 + e; const float ar = apr[(t + 1) * 64 + pp], ai = api[(t + 1) * 64 + pp], xr = cr[c1 * 64 + pp], xi = ci[c1 * 64 + pp];
                v[e] = im ? -(xr * ai + xi * ar) : (xr * ar - xi * ai); } }
        u32x4 o; o.x = cvt_pk_bf16(v[0], v[1]); o.y = cvt_pk_bf16(v[2], v[3]); o.z = cvt_pk_bf16(v[4], v[5]); o.w = cvt_pk_bf16(v[6], v[7]);
        *(u32x4*)(W2 + (size_t)n * 384 + 8 * ch) = o; }
    __syncthreads();
}
__device__ __forceinline__ void phase0(const P& p, LAS unsigned char* lds) {
    const int tid = threadIdx.x, lane = tid & 63, wid = tid >> 6;
    for (int g = blockIdx.x; g < NG; g += gridDim.x) s5_precompute(p, lds, g);
    LAS float* scr = (LAS float*)(lds + wid * 8704);
    const int gw = blockIdx.x * 8 + wid, NGW = gridDim.x * 8;
    constexpr int I_UP = 16 * 192, I_DN = 48 * 32, I_IN = 16 * 112, I_GL = 8 * 64, I_OU = 16 * 32, I_LR = 16 * 8, NITEMS = I_UP + I_DN + I_IN + I_GL + I_OU + I_LR;
    for (int it = gw; it < NITEMS; it += NGW) { int r = it;
        if (r < I_UP) { const int kb = r / 192, nb = r % 192, d0 = 32 * nb, s0 = ((d0 >> 7) & 1) * DFF + (d0 >> 8) * 128 + (d0 & 127);
            transpose_item(p.in[I_WUP], 6144, (bf16_t*)(p.ws + W_WTUP), 1024, 64 * kb, s0, d0, scr, lane); continue; } r -= I_UP;
        if (r < I_DN) { const int kb = r / 32, nb = r % 32; transpose_item(p.in[I_WDOWN], 1024, (bf16_t*)(p.ws + W_WTDOWN), 3072, 64 * kb, 32 * nb, 32 * nb, scr, lane); continue; } r -= I_DN;
        if (r < I_IN) { const int kb = r / 112, nb = r % 112; transpose_item(p.in[I_WIN], DIN, (bf16_t*)(p.ws + W_WTIN), 1024, 64 * kb, 32 * nb, 32 * nb, scr, lane); continue; } r -= I_IN;
        if (r < I_GL) { const int kb = r / 64, nb = r % 64, d0 = 32 * nb, s0 = ((d0 >> 7) & 1) * 1024 + (d0 >> 8) * 128 + (d0 & 127);
            transpose_item(p.in[I_WGLU], 2048, (bf16_t*)(p.ws + W_WTGLU), 512, 64 * kb, s0, d0, scr, lane); continue; } r -= I_GL;
        if (r < I_OU) { const int kb = r / 32, nb = r % 32; transpose_item(p.in[I_WOUT], 1024, (bf16_t*)(p.ws + W_WTOUT), 1024, 64 * kb, 32 * nb, 32 * nb, scr, lane); continue; } r -= I_OU;
        { const int which = r >> 6, blk = (r >> 3) & 7, kb = (r >> 2) & 1, nb = r & 3;
          transpose_item(p.in[which ? I_WI : I_WR] + blk * 16384, 128, (bf16_t*)(p.ws + (which ? W_WTI : W_WTR)) + blk * 16384, 128, 64 * kb, 32 * nb, 32 * nb, scr, lane); }
    }
    for (int r = gw; r < MTOK; r += NGW) ln_row<true>(src_row(p, r), p.in[I_EG], p.in[I_EB], (bf16_t*)(p.ws + W_XN) + (size_t)r * DM, lane);
}

template <int MODE> __device__ __forceinline__ void lru_unit(const P& p, LAS unsigned char* lds, int b, int kc, int nb) {
    const int tid = threadIdx.x, lane = tid & 63, wid = tid >> 6, q = lane >> 4, n = lane & 15;
    int mt0, nmt, rowbase;
    if (MODE == 2) { mt0 = 0; nmt = 8; rowbase = MP; } else { mt0 = (NCHUNK * kc) >> 3; nmt = ((NCHUNK * (kc + 1)) >> 3) - mt0; rowbase = b * TT; }
    const int t0 = 16 * mt0, ntok = 16 * nmt;
    const bf16_t* proj = (const bf16_t*)(p.ws + W_PROJ);
    LAS bf16_t* xcs = (LAS bf16_t*)lds;
    for (int it = tid; it < ntok * 16; it += 512) { const int i = it >> 4, cg8 = it & 15, c0 = nb * 128 + cg8 * 8; float a[8];
        { const f32x4 b0 = *(const f32x4*)(p.in[I_CLB] + c0), b1 = *(const f32x4*)(p.in[I_CLB] + c0 + 4); a[0] = b0[0]; a[1] = b0[1]; a[2] = b0[2]; a[3] = b0[3]; a[4] = b1[0]; a[5] = b1[1]; a[6] = b1[2]; a[7] = b1[3]; }
#pragma unroll
        for (int j = 0; j < 4; ++j) { const f32x4 w0 = *(const f32x4*)(p.in[I_CLW] + j * 1024 + c0), w1 = *(const f32x4*)(p.in[I_CLW] + j * 1024 + c0 + 4); float x[8];
            if (MODE == 2 && j < 3) { const float* cp = p.in[I_CCL] + ((size_t)i * 3 + j) * 1024 + c0; const f32x4 x0 = *(const f32x4*)cp, x1 = *(const f32x4*)(cp + 4);
                x[0] = x0[0]; x[1] = x0[1]; x[2] = x0[2]; x[3] = x0[3]; x[4] = x1[0]; x[5] = x1[1]; x[6] = x1[2]; x[7] = x1[3]; }
            else { const int t = (MODE == 2) ? i : (t0 + i - 3 + j); u32x4 xv = {0u, 0u, 0u, 0u}; if (t >= 0) xv = *(const u32x4*)(proj + (size_t)(rowbase + t) * DIN + c0);
                x[0] = bflo(xv.x); x[1] = bfhi(xv.x); x[2] = bflo(xv.y); x[3] = bfhi(xv.y); x[4] = bflo(xv.z); x[5] = bfhi(xv.z); x[6] = bflo(xv.w); x[7] = bfhi(xv.w); }
            a[0] += w0[0] * x[0]; a[1] += w0[1] * x[1]; a[2] += w0[2] * x[2]; a[3] += w0[3] * x[3]; a[4] += w1[0] * x[4]; a[5] += w1[1] * x[5]; a[6] += w1[2] * x[6]; a[7] += w1[3] * x[7]; }
        u32x4 o; o.x = cvt_pk_bf16(a[0], a[1]); o.y = cvt_pk_bf16(a[2], a[3]); o.z = cvt_pk_bf16(a[4], a[5]); o.w = cvt_pk_bf16(a[6], a[7]);
        *(LAS u32x4*)(xcs + i * 136 + cg8 * 8) = o; }
    __syncthreads();
    const int c = nb * 128 + wid * 16 + n;
    bf16x8 Br[4], Bi[4];
    { const bf16_t* wr_ = (const bf16_t*)(p.ws + W_WTR) + (size_t)c * 128 + q * 8; const bf16_t* wi_ = (const bf16_t*)(p.ws + W_WTI) + (size_t)c * 128 + q * 8;
#pragma unroll
      for (int kk = 0; kk < 4; ++kk) { Br[kk] = *(const bf16x8*)(wr_ + 32 * kk); Bi[kk] = *(const bf16x8*)(wi_ + 32 * kk); } }
    const float br = p.in[I_BR][c], bi = p.in[I_BI][c]; const float c8 = -8.0f * log1pf(expf(-p.in[I_LAM][c]));
    float h_run = 0.f, A_run = 1.f;
    if (MODE == 1) h_run = ((const float*)(p.ws + W_LRUC))[(size_t)(b * 8 + kc) * 1024 + c];
    for (int mt = 0; mt < nmt; ++mt) {
        f32x4 accr = {0.f, 0.f, 0.f, 0.f}, acci = {0.f, 0.f, 0.f, 0.f};
#pragma unroll
        for (int kk = 0; kk < 4; ++kk) { const bf16x8 Af = *(const LAS bf16x8*)(xcs + (16 * mt + n) * 136 + 32 * kk + 8 * q);
            accr = __builtin_amdgcn_mfma_f32_16x16x32_bf16(Af, Br[kk], accr, 0, 0, 0); acci = __builtin_amdgcn_mfma_f32_16x16x32_bf16(Af, Bi[kk], acci, 0, 0, 0); }
        float a[4], bx[4];
#pragma unroll
        for (int j = 0; j < 4; ++j) { const int tok = 16 * mt + 4 * q + j; const float xcv = bf2f(xcs[tok * 136 + wid * 16 + n]);
            const float r = sigm(accr[j] + br), ig = sigm(acci[j] + bi), la = c8 * r; a[j] = __expf(la); bx[j] = sqrtf(-expm1f(2.0f * la)) * (ig * xcv); }
        float h[4];
        if (MODE == 2) {
#pragma unroll
            for (int j = 0; j < 4; ++j) { const int s = 16 * mt + 4 * q + j; h[j] = a[j] * p.in[I_SL][(size_t)s * 1024 + c] + bx[j]; p.out[O_SL + (size_t)s * 1024 + c] = h[j]; }
        } else {
            float Ap[4]; h[0] = bx[0]; Ap[0] = a[0];
#pragma unroll
            for (int j = 1; j < 4; ++j) { h[j] = a[j] * h[j - 1] + bx[j]; Ap[j] = a[j] * Ap[j - 1]; }
            float PA = Ap[3], PH = h[3];
            float tA = __shfl_up(PA, 16), tH = __shfl_up(PH, 16); if (q >= 1) { PH = PA * tH + PH; PA = PA * tA; }
            tA = __shfl_up(PA, 32); tH = __shfl_up(PH, 32); if (q >= 2) { PH = PA * tH + PH; PA = PA * tA; }
            const float h_end = PA * h_run + PH; const float hin_s = __shfl_up(h_end, 16); const float h_in = (q == 0) ? h_run : hin_s;
#pragma unroll
            for (int j = 0; j < 4; ++j) h[j] += Ap[j] * h_in;
            h_run = __shfl(h_end, 48 + n); if (MODE == 0) A_run *= __shfl(PA, 48 + n);
        }
        if (MODE != 0) {
#pragma unroll
            for (int j = 0; j < 4; ++j) { const size_t row = (size_t)(rowbase + t0 + 16 * mt + 4 * q + j); const float ga = bf2f(proj[row * DIN + C_GA + c]);
                ((bf16_t*)(p.ws + W_MIX))[row * 1024 + c] = f2bf(sigm(ga) * h[j]); }
        }
    }
    if (MODE == 0 && q == 0) { ((float*)(p.ws + W_LRUA))[(size_t)(b * 8 + kc) * 1024 + c] = A_run; ((float*)(p.ws + W_LRUH))[(size_t)(b * 8 + kc) * 1024 + c] = h_run; }
    __syncthreads();
}

template <int PASS> __device__ __forceinline__ void s5_tile(const P& p, int g, int rt, int lane) {
    constexpr int KS = (PASS == 1) ? 8 : 12, NT = (PASS == 1) ? 8 : 16, LDW = (PASS == 1) ? 256 : 384;
    const int n = lane & 15, q = lane >> 4; const int R = 16 * rt + n; const bool valid = R < NR; const int Rc = valid ? R : 0; const int b = Rc / NCHUNK, k = Rc - b * NCHUNK;
    const bf16_t* proj = (const bf16_t*)(p.ws + W_PROJ);
    bf16x8 Af[KS]; const bf16x8 zero = {0, 0, 0, 0, 0, 0, 0, 0};
    { const bf16_t* ub = proj + (size_t)(b * TT + 16 * k) * DIN + C_US + 16 * g + 8 * (q & 1);
#pragma unroll
      for (int kk = 0; kk < 8; ++kk) { const int s = 2 * kk + (q >> 1); Af[kk] = valid ? *(const bf16x8*)(ub + (size_t)s * DIN) : zero; } }
    if (PASS == 3) { const bf16_t* hb = (const bf16_t*)(p.ws + W_HPREV) + ((size_t)Rc * NG + g) * 128 + 8 * q;
#pragma unroll
      for (int kk = 8; kk < KS; ++kk) Af[kk] = valid ? *(const bf16x8*)(hb + 32 * (kk - 8)) : zero; }
    const bf16_t* W = (PASS == 1) ? (const bf16_t*)(p.ws + W_W1) + (size_t)g * 128 * 256 : (const bf16_t*)(p.ws + W_W2) + (size_t)g * 256 * 384;
    f32x4 acc[NT];
#pragma unroll
    for (int nt = 0; nt < NT; ++nt) { acc[nt] = (f32x4){0.f, 0.f, 0.f, 0.f};
#pragma unroll
        for (int kk = 0; kk < KS; ++kk) { const bf16x8 Bf = *(const bf16x8*)(W + (size_t)(16 * nt + n) * LDW + 32 * kk + 8 * q);
            acc[nt] = __builtin_amdgcn_mfma_f32_16x16x32_bf16(Af[kk], Bf, acc[nt], 0, 0, 0); } }
#pragma unroll
    for (int j = 0; j < 4; ++j) { const int R2 = 16 * rt + 4 * q + j; if (R2 < NR) {
        if (PASS == 1) { float* S = (float*)(p.ws + W_S) + ((size_t)R2 * NG + g) * 128;
#pragma unroll
            for (int nt = 0; nt < NT; ++nt) S[16 * nt + n] = acc[nt][j]; }
        else { const int b2 = R2 / NCHUNK, k2 = R2 - b2 * NCHUNK; bf16_t* Y = (bf16_t*)(p.ws + W_YSG) + (size_t)(b2 * TT + 16 * k2) * DSSM + 16 * g + n;
#pragma unroll
            for (int nt = 0; nt < NT; ++nt) Y[(size_t)nt * DSSM] = f2bf(gelu_tanh(acc[nt][j])); } } }
}
__device__ __forceinline__ void s5_sample(const P& p, int s, int g, int lane) {
    const bf16_t* proj = (const bf16_t*)(p.ws + W_PROJ); const bf16_t* up = proj + (size_t)(MP + s) * DIN + C_US + 16 * g;
    const u32x4 u0 = *(const u32x4*)up, u1 = *(const u32x4*)(up + 8); float u[16];
    u[0] = bflo(u0.x); u[1] = bfhi(u0.x); u[2] = bflo(u0.y); u[3] = bfhi(u0.y); u[4] = bflo(u0.z); u[5] = bfhi(u0.z); u[6] = bflo(u0.w); u[7] = bfhi(u0.w);
    u[8] = bflo(u1.x); u[9] = bfhi(u1.x); u[10] = bflo(u1.y); u[11] = bfhi(u1.y); u[12] = bflo(u1.z); u[13] = bfhi(u1.z); u[14] = bflo(u1.w); u[15] = bfhi(u1.w);
    const float* a1 = (const float*)(p.ws + W_A1) + (g * 64 + lane) * 2; const float ar = a1[0], ai = a1[1];
    const float* bb = (const float*)(p.ws + W_BBAR) + (size_t)(g * 64 + lane) * 32; float bur = 0.f, bui = 0.f;
#pragma unroll
    for (int c = 0; c < 16; ++c) { bur += bb[2 * c] * u[c]; bui += bb[2 * c + 1] * u[c]; }
    const size_t si = ((size_t)s * NG + g) * 64 + lane; const float h0r = p.in[I_SSR][si], h0i = p.in[I_SSI][si];
    const float hr = ar * h0r - ai * h0i + bur, hi = ar * h0i + ai * h0r + bui;
    p.out[O_SSR + si] = hr; p.out[O_SSI + si] = hi;
    float yv = 0.f;
#pragma unroll
    for (int c1 = 0; c1 < 16; ++c1) { const float v = p.in[I_SCRE][(g * 16 + c1) * 64 + lane] * hr - p.in[I_SCIM][(g * 16 + c1) * 64 + lane] * hi; const float tot = wave_sum(v);
        if (lane == c1) yv = tot + p.in[I_SD][g * 16 + c1] * u[c1]; }
    if (lane < 16) ((bf16_t*)(p.ws + W_YSG))[(size_t)(MP + s) * DSSM + 16 * g + lane] = f2bf(gelu_tanh(yv));
}
__device__ __forceinline__ void phase2a(const P& p, LAS unsigned char* lds) {
    for (int u = blockIdx.x; u < 512; u += gridDim.x) lru_unit<0>(p, lds, (u >> 3) & 7, u >> 6, u & 7);
    const int lane = threadIdx.x & 63, wid = threadIdx.x >> 6;
    for (int t = blockIdx.x * 8 + wid; t < NG * 65; t += gridDim.x * 8) s5_tile<1>(p, t / 65, t % 65, lane);
}
__device__ __forceinline__ void phase2b(const P& p, LAS unsigned char* lds) {
    const int tid = threadIdx.x, lane = tid & 63, wid = tid >> 6;
    const size_t gt = (size_t)blockIdx.x * 512 + tid, GT = (size_t)gridDim.x * 512;
    for (int it = wid * gridDim.x + blockIdx.x; it < NBATCH * NG; it += 8 * gridDim.x) { const int b = it >> 5, g = it & 31;
        const float* a16 = (const float*)(p.ws + W_A16) + (g * 64 + lane) * 2; const float ar = a16[0], ai = a16[1]; float hr = 0.f, hi = 0.f;
        const float* S = (const float*)(p.ws + W_S) + ((size_t)(b * NCHUNK) * NG + g) * 128; bf16_t* H = (bf16_t*)(p.ws + W_HPREV) + ((size_t)(b * NCHUNK) * NG + g) * 128;
        for (int k = 0; k < NCHUNK; ++k) { const float sr = S[(size_t)k * NG * 128 + lane], si = S[(size_t)k * NG * 128 + 64 + lane];
            H[(size_t)k * NG * 128 + lane] = f2bf(hr); H[(size_t)k * NG * 128 + 64 + lane] = f2bf(hi);
            const float nr = ar * hr - ai * hi + sr, ni = ar * hi + ai * hr + si; hr = nr; hi = ni; }
        p.out[O_PSR + ((size_t)b * NG + g) * 64 + lane] = hr; p.out[O_PSI + ((size_t)b * NG + g) * 64 + lane] = hi; }
    for (size_t i = gt; i < (size_t)NBATCH * 1024; i += GT) { const int b = (int)(i >> 10), c = (int)(i & 1023); float h = 0.f;
        const float* A = (const float*)(p.ws + W_LRUA); const float* Hh = (const float*)(p.ws + W_LRUH); float* Cc = (float*)(p.ws + W_LRUC);
        for (int kc = 0; kc < 8; ++kc) { const size_t o = (size_t)(b * 8 + kc) * 1024 + c; Cc[o] = h; h = A[o] * h + Hh[o]; }
        p.out[O_PL + i] = h; }
    for (int u = (int)gridDim.x - 1 - (int)blockIdx.x; u < 8; u += gridDim.x) lru_unit<2>(p, lds, 0, 0, u);
    for (int it = blockIdx.x * 8 + wid; it < NSAMP * NG; it += gridDim.x * 8) s5_sample(p, it >> 5, it & 31, lane);
    const bf16_t* proj = (const bf16_t*)(p.ws + W_PROJ);
    for (size_t i = gt; i < (size_t)NBATCH * 3 * 1024; i += GT) { const int c = (int)(i & 1023), j = (int)((i >> 10) % 3), b = (int)(i / 3072);
        p.out[O_PCL + i] = bf2f(proj[(size_t)(b * TT + TT - 3 + j) * DIN + c]); }
    for (size_t i = gt; i < (size_t)NSAMP * 3 * 1024; i += GT) { const int c = (int)(i & 1023), j = (int)((i >> 10) % 3), s = (int)(i / 3072);
        p.out[O_SCL + i] = (j < 2) ? p.in[I_CCL][((size_t)s * 3 + j + 1) * 1024 + c] : bf2f(proj[(size_t)(MP + s) * DIN + c]); }
    for (size_t i = gt; i < (size_t)NSAMP * DFF; i += GT) { const int ch = (int)(i % DFF), s = (int)(i / DFF);
        p.out[O_SCF + ((size_t)s * 2) * DFF + ch] = p.in[I_CCF][((size_t)s * 2 + 1) * DFF + ch]; }
}
__device__ __forceinline__ void phase2c(const P& p, LAS unsigned char* lds) {
    for (int u = blockIdx.x; u < 512; u += gridDim.x) lru_unit<1>(p, lds, (u >> 3) & 7, u >> 6, u & 7);
    const int lane = threadIdx.x & 63, wid = threadIdx.x >> 6;
    for (int t = blockIdx.x * 8 + wid; t < NG * 65; t += gridDim.x * 8) s5_tile<3>(p, t / 65, t % 65, lane);
}
__device__ __forceinline__ void phase_ln1(const P& p) {
    const int lane = threadIdx.x & 63, wid = threadIdx.x >> 6;
    for (int r = blockIdx.x * 8 + wid; r < MTOK; r += gridDim.x * 8)
        ln_row<true>((const float*)(p.ws + W_R1) + (size_t)r * DM, p.in[I_L1G], p.in[I_L1B], (bf16_t*)(p.ws + W_XN) + (size_t)r * DM, lane);
}
__device__ __forceinline__ void phase_ffnconv(const P& p) {
    const size_t gt = (size_t)blockIdx.x * 512 + threadIdx.x, GT = (size_t)gridDim.x * 512;
    const bf16_t* G = (const bf16_t*)(p.ws + W_G); bf16_t* V = (bf16_t*)(p.ws + W_V);
    for (size_t it = gt; it < (size_t)MTOK * 384; it += GT) { const int row = (int)(it / 384), ch = (int)(it - (size_t)row * 384) * 8; float gm[3][8];
        { const u32x4 x = *(const u32x4*)(G + (size_t)row * DFF + ch);
          gm[2][0] = bflo(x.x); gm[2][1] = bfhi(x.x); gm[2][2] = bflo(x.y); gm[2][3] = bfhi(x.y); gm[2][4] = bflo(x.z); gm[2][5] = bfhi(x.z); gm[2][6] = bflo(x.w); gm[2][7] = bfhi(x.w); }
        if (row >= MP) { const int s = row - MP;
#pragma unroll
            for (int j = 0; j < 2; ++j) { const float* cp = p.in[I_CCF] + ((size_t)s * 2 + j) * DFF + ch; const f32x4 x0 = *(const f32x4*)cp, x1 = *(const f32x4*)(cp + 4);
                gm[j][0] = x0[0]; gm[j][1] = x0[1]; gm[j][2] = x0[2]; gm[j][3] = x0[3]; gm[j][4] = x1[0]; gm[j][5] = x1[1]; gm[j][6] = x1[2]; gm[j][7] = x1[3]; } }
        else { const int t = row % TT;
#pragma unroll
            for (int j = 0; j < 2; ++j) { u32x4 x = {0u, 0u, 0u, 0u}; if (t - 2 + j >= 0) x = *(const u32x4*)(G + (size_t)(row - 2 + j) * DFF + ch);
                gm[j][0] = bflo(x.x); gm[j][1] = bfhi(x.x); gm[j][2] = bflo(x.y); gm[j][3] = bfhi(x.y); gm[j][4] = bflo(x.z); gm[j][5] = bfhi(x.z); gm[j][6] = bflo(x.w); gm[j][7] = bfhi(x.w); } }
        const u32x4 vv = *(const u32x4*)(V + (size_t)row * DFF + ch); float v[8];
        v[0] = bflo(vv.x); v[1] = bfhi(vv.x); v[2] = bflo(vv.y); v[3] = bfhi(vv.y); v[4] = bflo(vv.z); v[5] = bfhi(vv.z); v[6] = bflo(vv.w); v[7] = bfhi(vv.w);
        float o[8];
#pragma unroll
        for (int e = 0; e < 8; ++e) { const float y = p.in[I_FCB][ch + e] + p.in[I_FCW][ch + e] * gm[0][e] + p.in[I_FCW][DFF + ch + e] * gm[1][e] + p.in[I_FCW][2 * DFF + ch + e] * gm[2][e];
            o[e] = gelu_tanh(y) * v[e]; }
        u32x4 w; w.x = cvt_pk_bf16(o[0], o[1]); w.y = cvt_pk_bf16(o[2], o[3]); w.z = cvt_pk_bf16(o[4], o[5]); w.w = cvt_pk_bf16(o[6], o[7]);
        *(u32x4*)(V + (size_t)row * DFF + ch) = w; }
}
__device__ __forceinline__ void phase_ln2(const P& p) {
    const int lane = threadIdx.x & 63, wid = threadIdx.x >> 6;
    for (int r = blockIdx.x * 8 + wid; r < MTOK; r += gridDim.x * 8) { float* o;
        if (r >= MP) o = p.out + O_YS + (size_t)(r - MP) * DM; else { const int b = r / TT, t = r - b * TT; if (t < 16) continue; o = p.out + O_YP + ((size_t)b * 2048 + (t - 16)) * DM; }
        ln_row<false>((const float*)(p.ws + W_R2) + (size_t)r * DM, p.in[I_L2G], p.in[I_L2B], o, lane); }
}

__global__ __launch_bounds__(512, 2) void hawk_fwd(P p) {
    extern __shared__ __attribute__((aligned(16))) unsigned char shm[];
    LAS unsigned char* lds = (LAS unsigned char*)shm;
    cg::grid_group grid = cg::this_grid();
    phase0(p, lds);
    grid.sync();
    { EpiProj E; E.O = (bf16_t*)(p.ws + W_PROJ); E.bias = p.in[I_BIN]; run_gemm(lds, (const bf16_t*)(p.ws + W_XN), (const bf16_t*)(p.ws + W_WTIN), DIN, 1024, E); }
    grid.sync();
    phase2a(p, lds);
    grid.sync();
    phase2b(p, lds);
    grid.sync();
    phase2c(p, lds);
    grid.sync();
    { EpiGlu E; E.mix = (bf16_t*)(p.ws + W_MIX); E.proj = (const bf16_t*)(p.ws + W_PROJ); E.bias = p.in[I_BGLU]; run_gemm(lds, (const bf16_t*)(p.ws + W_YSG), (const bf16_t*)(p.ws + W_WTGLU), 2048, 512, E); }
    grid.sync();
    { EpiRes E; E.R = (float*)(p.ws + W_R1); E.X = (const bf16_t*)(p.ws + W_XN); E.bias = p.in[I_BOUT]; run_gemm(lds, (const bf16_t*)(p.ws + W_MIX), (const bf16_t*)(p.ws + W_WTOUT), 1024, 1024, E); }
    grid.sync();
    phase_ln1(p);
    grid.sync();
    { EpiUp E; E.G = (bf16_t*)(p.ws + W_G); E.V = (bf16_t*)(p.ws + W_V); E.bias = p.in[I_BUP]; E.out = p.out; run_gemm(lds, (const bf16_t*)(p.ws + W_XN), (const bf16_t*)(p.ws + W_WTUP), 6144, 1024, E); }
    grid.sync();
    phase_ffnconv(p);
    grid.sync();
    { EpiRes E; E.R = (float*)(p.ws + W_R2); E.X = (const bf16_t*)(p.ws + W_XN); E.bias = p.in[I_BDOWN]; run_gemm(lds, (const bf16_t*)(p.ws + W_V), (const bf16_t*)(p.ws + W_WTDOWN), 1024, 3072, E); }
    grid.sync();
    phase_ln2(p);
}

extern "C" void kernel_launch(void* const* d_in, const int* in_sizes, int n_in, void* d_out, int out_size, void* d_ws, size_t ws_size, hipStream_t stream) {
    constexpr int LDS_BYTES = pg8::STAGE_BYTES;
    static int grid = 0;
    if (grid == 0) {
        if (n_in != N_IN || (size_t)out_size != O_END || ws_size < 268435456ull) { fprintf(stderr, "kernel_launch: unexpected shapes (n_in %d out %d ws %zu)\n", n_in, out_size, ws_size); grid = -1; return; }
        int dev = 0, cus = 0, per_cu = 0;
        if (hipGetDevice(&dev) != hipSuccess || hipDeviceGetAttribute(&cus, hipDeviceAttributeMultiprocessorCount, dev) != hipSuccess) { grid = -1; return; }
        if (hipFuncSetAttribute((const void*)hawk_fwd, hipFuncAttributeMaxDynamicSharedMemorySize, LDS_BYTES) != hipSuccess) { fprintf(stderr, "kernel_launch: hipFuncSetAttribute failed\n"); grid = -1; return; }
        if (hipOccupancyMaxActiveBlocksPerMultiprocessor(&per_cu, (const void*)hawk_fwd, 512, LDS_BYTES) != hipSuccess || per_cu < 1) { fprintf(stderr, "kernel_launch: occupancy query failed (%d)\n", per_cu); grid = -1; (void)hipGetLastError(); return; }
        grid = cus * per_cu;
    }
    if (grid < 0) return;
    P p{};
    for (int i = 0; i < N_IN; ++i) p.in[i] = (const float*)d_in[i];
    p.out = (float*)d_out; p.ws = (unsigned char*)d_ws;
    void* args[] = {&p};
    hipError_t e = hipLaunchCooperativeKernel((const void*)hawk_fwd, dim3(grid), dim3(512), args, LDS_BYTES, stream);
    if (e != hipSuccess) fprintf(stderr, "cooperative launch failed: %s (grid %d)\n", hipGetErrorString(e), grid);
}
```

```cpp
#include <hip/hip_runtime.h>
#include <hip/hip_cooperative_groups.h>
#include <cstdio>
#include <cstdint>
namespace cg = cooperative_groups;
#define REP_P0 1
#define REP_P0A 1
#define REP_P0B 1
#define REP_P0C 1
#define REP_P1 1
#define REP_P2A 1
#define REP_P2B 1
#define REP_P2C 1
#define REP_P4 1
#define REP_P5 1
#define REP_P6 1
#define REP_P8 1
#define REP_P9 1
namespace pg8 {
#define PG8_LAS __attribute__((address_space(3)))
typedef unsigned short bf16_t;
typedef short bf16x8 __attribute__((ext_vector_type(8)));
typedef float f32x4 __attribute__((ext_vector_type(4)));
typedef unsigned u32x4 __attribute__((ext_vector_type(4)));
constexpr int BM = 256, BK = 64, HALF = 128, HTB = HALF * BK * 2  , STAGE_BYTES = 8 * HTB, NXCD = 8, WGM = 8;

__host__ __device__ __forceinline__ int lds_byte(int r, int c) { const int st = (r >> 4) * 2 + (c >> 5), rr = r & 15, cc = c & 31, ob = rr * 64 + cc * 2; return st * 1024 + (ob ^ (((ob >> 9) & 1) << 5)); }
__host__ __device__ __forceinline__ void stage_rc(int b, int& R, int& C) { const int st = b / 1024, sb = b % 1024, swz = sb ^ (((sb >> 9) & 1) << 5); R = (st >> 1) * 16 + swz / 64; C = (st & 1) * 32 + (swz % 64) / 2; }
__host__ __device__ __forceinline__ int perm32(int rho) { const int n = rho >> 4, i = rho & 15; return 8 * (i >> 2) + 4 * n + (i & 3); }

struct Unit { int pm, pn, k0, nt, ks; };
struct Gemm { const bf16_t* A; const bf16_t* Bt; int M, N, K; };

struct StaticOrder {
    int nM, nN, nwg, G, c, ntk;
    __host__ __device__ void init(int M, int N, int K, int G_, int c_) { nM = M / BM; nN = N / BM; nwg = nM * nN; G = G_; c = c_; ntk = K / BK; }
    __host__ __device__ bool next(int i, Unit& u) const {
        const long L = (long)i * G + c; if (L >= nwg) return false;
        int wgid = (int)L; { const int q = nwg / NXCD, r = nwg % NXCD, xcd = wgid % NXCD, off = wgid / NXCD; wgid = (xcd < r ? xcd * (q + 1) : r * (q + 1) + (xcd - r) * q) + off; }
        const int nig = WGM * nN, gid = wgid / nig, fm = gid * WGM, gsz = (nM - fm) < WGM ? (nM - fm) : WGM;
        u.pm = fm + ((wgid % nig) % gsz); u.pn = (wgid % nig) / gsz; u.k0 = 0; u.nt = ntk; u.ks = -1; return true;
    }
    __device__ __forceinline__ void a_ready(const Unit&) const {}
    __device__ __forceinline__ void done(const Unit&) const {}
};
struct SplitOrder {
    StaticOrder base; int nsplit;
    __host__ __device__ void init(int N, int K, int nsplit_, int G_, int c_) { base.init(64 * BM, N, K, G_, c_); nsplit = nsplit_; }
    __host__ __device__ bool next(int i, Unit& u) const {
        Unit t; t.pm = 0; t.pn = 0; t.k0 = 0; t.nt = base.ntk; t.ks = -1;
        const bool ok = base.next(i, t);
        const long L = (long)i * base.G + base.c - base.nwg; const bool sp = (!ok) && L >= 0 && L < (long)base.nN * nsplit;
        const int ks = (int)(L / base.nN), pn = (int)(L % base.nN), ntp = base.ntk / nsplit;
        u.pm = sp ? 64 : t.pm; u.pn = sp ? pn : t.pn; u.ks = sp ? ks : -1; u.nt = sp ? ntp : t.nt; u.k0 = sp ? ks * ntp * BK : 0;
        return ok || sp;
    }
    __device__ __forceinline__ void a_ready(const Unit&) const {}
    __device__ __forceinline__ void done(const Unit&) const {}
};
__device__ __forceinline__ unsigned cvt_pk_bf16(float lo, float hi) { unsigned r; asm volatile("v_cvt_pk_bf16_f32 %0, %1, %2" : "=v"(r) : "v"(lo), "v"(hi)); return r; }
template <class Epi, class Sched, bool STAMP = false>
__device__ __forceinline__ void gemm_phase(PG8_LAS unsigned char* lds, const Gemm g, const Sched& S, const Epi& E, unsigned long long* stamps) {
    const int tid = threadIdx.x, wid = __builtin_amdgcn_readfirstlane(tid >> 6), lane = tid & 63, wr = wid >> 2, wc = wid & 3, fr = lane & 15, fq = lane >> 4;
    const int K = g.K;
    int ts_lo = 0, ts_hi = 0, nts = 0; const unsigned long long rt_entry = STAMP ? (unsigned long long)wall_clock64() : 0ull;
#define PG8_STAMP() do { if (STAMP && wid == 0 && nts < 64) { const unsigned long long _c = (unsigned long long)clock64(); \
        ts_lo = (lane == nts) ? (int)(unsigned)_c : ts_lo; ts_hi = (lane == nts) ? (int)(unsigned)(_c >> 32) : ts_hi; ++nts; } } while (0)
    PG8_STAMP();
    unsigned voffA[2], voffB[2];
#pragma unroll
    for (int i = 0; i < 2; ++i) { int R, C; stage_rc(tid * 16 + i * 8192, R, C); const int Rb = Epi::PERM ? ((R & ~31) + perm32(R & 31)) : R;
        voffA[i] = (unsigned)(R * K + C) * 2u; voffB[i] = (unsigned)(Rb * K + C) * 2u; }
    const size_t kstep = (size_t)(BK * 2);
    const size_t hstep = (size_t)HALF * K * 2;
    const size_t tstep = 2 * hstep;
    const unsigned ldsw = (unsigned)wid * 1024u;
    const int aoff = lds_byte(wr * 64 + fr, fq * 8), boff = lds_byte(wc * 32 + fr, fq * 8);
#define PG8_SA(b, h) (((b) * 2 + (h)) * HTB)
#define PG8_SB(b, h) ((4 + (b) * 2 + (h)) * HTB)
#define PG8_STAGE(bufoff, gbase, voff) do { _Pragma("unroll") for (int _i = 0; _i < 2; ++_i) \
        __builtin_amdgcn_global_load_lds((const unsigned*)((const char*)(gbase) + (voff)[_i]), (PG8_LAS unsigned*)(lds + (bufoff) + ldsw + _i * 8192), 16, 0, 0); } while (0)
#define PG8_LDA(dst, b, h) do { _Pragma("unroll") for (int m = 0; m < 4; ++m) _Pragma("unroll") for (int k = 0; k < 2; ++k) dst[m][k] = *(const PG8_LAS bf16x8*)(lds + PG8_SA(b, h) + aoff + m * 2048 + k * 1024); } while (0)
#define PG8_LDB(dst, b, h) do { _Pragma("unroll") for (int n = 0; n < 2; ++n) _Pragma("unroll") for (int k = 0; k < 2; ++k) dst[n][k] = *(const PG8_LAS bf16x8*)(lds + PG8_SB(b, h) + boff + n * 2048 + k * 1024); } while (0)
#define PG8_MMA(ai, bj, At, Bt) do { __builtin_amdgcn_s_setprio(1); _Pragma("unroll") for (int m = 0; m < 4; ++m) _Pragma("unroll") for (int n = 0; n < 2; ++n) _Pragma("unroll") for (int k = 0; k < 2; ++k) \
        acc[ai][bj][m][n] = __builtin_amdgcn_mfma_f32_16x16x32_bf16(Bt[n][k], At[m][k], acc[ai][bj][m][n], 0, 0, 0); __builtin_amdgcn_s_setprio(0); } while (0)
#define PG8_WAIT_V(n) asm volatile("s_waitcnt vmcnt(" #n ")" ::: "memory")
#define PG8_WAIT_L(n) asm volatile("s_waitcnt lgkmcnt(" #n ")" ::: "memory")
#define PG8_BAR __builtin_amdgcn_s_barrier()
#define PG8_SCHED __builtin_amdgcn_sched_barrier(0)
    Unit cur, nxt; int ui = 0;
    if (!S.next(0, cur)) return;
    f32x4 acc[2][2][4][2];
#pragma unroll
    for (int a = 0; a < 2; ++a)
#pragma unroll
        for (int b = 0; b < 2; ++b)
#pragma unroll
            for (int m = 0; m < 4; ++m)
#pragma unroll
                for (int n = 0; n < 2; ++n) acc[a][b][m][n] = (f32x4){0.f, 0.f, 0.f, 0.f};
    bf16x8 At[4][2], B0[2][2], B1[2][2];
    const char* cA = (const char*)g.A + (size_t)cur.pm * tstep + (size_t)cur.k0 * 2; const char* cB = (const char*)g.Bt + (size_t)cur.pn * tstep + (size_t)cur.k0 * 2;
    S.a_ready(cur);
    PG8_STAGE(PG8_SB(0, 0), cB, voffB); PG8_STAGE(PG8_SA(0, 0), cA, voffA); PG8_STAGE(PG8_SB(0, 1), cB + hstep, voffB); PG8_STAGE(PG8_SA(0, 1), cA + hstep, voffA);
    if (wr == 1) PG8_BAR;
    PG8_WAIT_V(4); PG8_BAR;
    PG8_STAGE(PG8_SB(1, 0), cB + kstep, voffB); PG8_STAGE(PG8_SA(1, 0), cA + kstep, voffA); PG8_STAGE(PG8_SB(1, 1), cB + hstep + kstep, voffB);
    PG8_WAIT_V(6); PG8_BAR;
    PG8_STAMP();
    for (;;) {
        const bool has_next = S.next(ui + 1, nxt);
        const char* nA = has_next ? (const char*)g.A + (size_t)nxt.pm * tstep + (size_t)nxt.k0 * 2 : cA; const char* nB = has_next ? (const char*)g.Bt + (size_t)nxt.pn * tstep + (size_t)nxt.k0 * 2 : cB;
        const int nt = cur.nt;
        for (int t = 0; t < nt; t += 2) {
            const bool last = (t == nt - 2);
            const char* a1 = cA + (size_t)(t + 1) * kstep;
            const char* a2 = last ? nA : cA + (size_t)(t + 2) * kstep; const char* b2 = last ? nB : cB + (size_t)(t + 2) * kstep;
            const char* a3 = a2 + kstep; const char* b3 = b2 + kstep;
            if (last && has_next) S.a_ready(nxt);
            PG8_LDB(B0, 0, 0); PG8_SCHED; PG8_LDA(At, 0, 0); PG8_STAGE(PG8_SA(1, 1), a1 + hstep, voffA);
            PG8_WAIT_L(8); PG8_BAR; PG8_WAIT_L(0); PG8_MMA(0, 0, At, B0); PG8_BAR; PG8_SCHED;
            PG8_LDB(B1, 0, 1); PG8_STAGE(PG8_SB(0, 0), b2, voffB);
            PG8_BAR; PG8_WAIT_L(0); PG8_MMA(0, 1, At, B1); PG8_BAR;
            PG8_LDA(At, 0, 1); PG8_STAGE(PG8_SA(0, 0), a2, voffA);
            PG8_BAR; PG8_WAIT_L(0); PG8_MMA(1, 0, At, B0); PG8_BAR; PG8_SCHED;
            PG8_STAGE(PG8_SB(0, 1), b2 + hstep, voffB);
            PG8_WAIT_V(6); PG8_BAR; PG8_MMA(1, 1, At, B1); PG8_BAR;
            PG8_LDB(B0, 1, 0); PG8_SCHED; PG8_LDA(At, 1, 0); PG8_STAGE(PG8_SA(0, 1), a2 + hstep, voffA);
            PG8_WAIT_L(8); PG8_BAR; PG8_WAIT_L(0); PG8_MMA(0, 0, At, B0); PG8_BAR; PG8_SCHED;
            PG8_LDB(B1, 1, 1); PG8_STAGE(PG8_SB(1, 0), b3, voffB);
            PG8_BAR; PG8_WAIT_L(0); PG8_MMA(0, 1, At, B1); PG8_BAR;
            PG8_LDA(At, 1, 1); PG8_STAGE(PG8_SA(1, 0), a3, voffA);
            PG8_BAR; PG8_WAIT_L(0); PG8_MMA(1, 0, At, B0); PG8_BAR; PG8_SCHED;
            PG8_STAGE(PG8_SB(1, 1), b3 + hstep, voffB);
            PG8_WAIT_V(6); PG8_BAR; PG8_MMA(1, 1, At, B1); PG8_BAR;
        }
        PG8_STAMP();
        if constexpr (!Epi::AFTER_DRAIN) { E(acc, cur, wr, wc, fr, fq); S.done(cur); }
        PG8_STAMP();
        if (!has_next) break;
#pragma unroll
        for (int a = 0; a < 2; ++a)
#pragma unroll
            for (int b = 0; b < 2; ++b)
#pragma unroll
                for (int m = 0; m < 4; ++m)
#pragma unroll
                    for (int n = 0; n < 2; ++n) acc[a][b][m][n] = (f32x4){0.f, 0.f, 0.f, 0.f};
        cur = nxt; cA = nA; cB = nB; ++ui;
    }
    PG8_WAIT_V(0);
    if (wr == 0) PG8_BAR;
    PG8_BAR;
    if constexpr (Epi::AFTER_DRAIN) { E.fused(acc, cur, wr, wc, fr, fq, lds, wid, lane); S.done(cur); }
    PG8_STAMP();
    if (STAMP && wid == 0) { stamps[lane] = lane < nts ? (((unsigned long long)(unsigned)ts_hi << 32) | (unsigned)ts_lo) : 0ull;
        if (lane == 62) stamps[62] = rt_entry; if (lane == 63) stamps[63] = (unsigned long long)wall_clock64(); }
#undef PG8_STAMP
#undef PG8_SA
#undef PG8_SB
#undef PG8_STAGE
#undef PG8_LDA
#undef PG8_LDB
#undef PG8_MMA
#undef PG8_WAIT_V
#undef PG8_WAIT_L
#undef PG8_BAR
#undef PG8_SCHED
}
}
using pg8::bf16_t; using pg8::bf16x8; using pg8::f32x4; using pg8::u32x4; using pg8::Unit; using pg8::cvt_pk_bf16;
#define LAS __attribute__((address_space(3)))
typedef unsigned u32x2 __attribute__((ext_vector_type(2)));
#define XB_TMO      128
#define XB_XCNT(j)  (256  + 64 * (j))
#define XB_XSUB(j)  (1280 + 64 * (j))
#define XB_XGEN(j)  (2304 + 64 * (j))
#define XB_TOP      3328
#define XB_TOPGEN   3392
#define XCD_BAR_WORDS 3456
#define XB_SPIN_CAP (1u << 18)

__device__ __forceinline__ unsigned xb_ld(unsigned* p)              { return __hip_atomic_load(p, __ATOMIC_RELAXED, __HIP_MEMORY_SCOPE_AGENT); }
__device__ __forceinline__ unsigned xb_add(unsigned* p, unsigned v) { return __hip_atomic_fetch_add(p, v, __ATOMIC_RELAXED, __HIP_MEMORY_SCOPE_AGENT); }
__device__ __forceinline__ unsigned xb_xcc_id() { return (unsigned)__builtin_amdgcn_s_getreg((3 << 11) | 20) & 0xFu; }
#define XB_SPIN(cond, bar) do { unsigned _sp = 0; while (cond) { __builtin_amdgcn_s_sleep(1); \
    if ((++_sp & 255u) == 0u) { if (xb_ld(&(bar)[XB_TMO])) break; if (_sp > XB_SPIN_CAP) { atomicAdd(&(bar)[XB_TMO], 1u); break; } } } } while (0)

struct XcdBarrier {
    unsigned* bar; unsigned x;
    volatile LAS unsigned* st;
};

__device__ __forceinline__ XcdBarrier xcd_barrier_post(unsigned* bar, volatile LAS unsigned* st) {
    XcdBarrier b; b.bar = bar; b.x = xb_xcc_id(); b.st = st;
    if (threadIdx.x == 0) (void)xb_add(&bar[XB_XCNT(b.x)], 1u);
    return b;
}
__device__ __forceinline__ void xcd_barrier_complete(unsigned* bar, unsigned x, unsigned& nloc, unsigned& nx) {
    const unsigned G = gridDim.x * gridDim.y * gridDim.z;
    unsigned sum, cnt, mine, sp = 0u;
    for (;;) {
        sum = 0u; cnt = 0u; mine = 0u;
#pragma unroll
        for (unsigned j = 0; j < 16; ++j) { const unsigned c = xb_ld(&bar[XB_XCNT(j)]); sum += c; cnt += (c > 0u) ? 1u : 0u; mine = (j == x) ? c : mine; }
        if (sum == G) break;
        __builtin_amdgcn_s_sleep(1);
        if ((++sp & 255u) == 0u) { if (xb_ld(&bar[XB_TMO])) break; if (sp > XB_SPIN_CAP) { atomicAdd(&bar[XB_TMO], 1u); break; } }
    }
    nloc = mine > 0u ? mine : 1u; nx = cnt > 0u ? cnt : 1u;
}

__device__ __forceinline__ void xcd_barrier(const XcdBarrier& b) {
    asm volatile("s_waitcnt vmcnt(0)" ::: "memory");
    __syncthreads();
    if (threadIdx.x == 0) {
        unsigned* bar = b.bar;
        __builtin_amdgcn_s_waitcnt(0);
        unsigned nloc = b.st[0], nx = b.st[1];
        if (nloc == 0u) { xcd_barrier_complete(bar, b.x, nloc, nx); b.st[0] = nloc; b.st[1] = nx; }
        const unsigned old = xb_add(&bar[XB_XSUB(b.x)], 1u);
        const unsigned gen = old / nloc;
        if (old + 1u == (gen + 1u) * nloc) {
            __builtin_amdgcn_fence(__ATOMIC_RELEASE, "agent");
            asm volatile("s_waitcnt vmcnt(0)" ::: "memory");
            const unsigned og = xb_add(&bar[XB_TOP], 1u);
            const unsigned tg = og / nx;
            if (og + 1u == (tg + 1u) * nx) xb_add(&bar[XB_TOPGEN], 1u);
            else XB_SPIN(xb_ld(&bar[XB_TOPGEN]) == tg, bar);
            __builtin_amdgcn_fence(__ATOMIC_ACQUIRE, "agent");
            xb_add(&bar[XB_XGEN(b.x)], 1u);
            asm volatile("s_waitcnt vmcnt(0)" ::: "memory");
        } else {
            XB_SPIN(xb_ld(&bar[XB_XGEN(b.x)]) == gen, bar);
            __builtin_amdgcn_fence(__ATOMIC_ACQUIRE, "agent");
            asm volatile("s_waitcnt vmcnt(0)" ::: "memory");
        }
    }
    __syncthreads();
}


constexpr int DM = 1024, NBATCH = 8, TT = 2064, NSAMP = 128, MP = NBATCH * TT  , MTOK = MP + NSAMP  ;
constexpr int DIN = 3584, DSSM = 512, DFF = 3072, NG = 32, NCHUNK = 129, NR = NBATCH * NCHUNK  ;
constexpr int C_US = 1024, C_GA = 1536, C_GB = 2560;
constexpr float ALPHA = 1.189207115002721f, LN_EPS = 1e-5f;
enum { I_XP = 0, I_XS, I_CCL, I_SL, I_SSR, I_SSI, I_CCF, I_META, I_EG, I_EB, I_WIN, I_BIN, I_CLW, I_CLB, I_WR, I_BR, I_WI, I_BI, I_LAM,
       I_SLRE, I_SLIM, I_SLDT, I_SBRE, I_SBIM, I_SCRE, I_SCIM, I_SD, I_WGLU, I_BGLU, I_WOUT, I_BOUT, I_L1G, I_L1B, I_WUP, I_BUP, I_FCW, I_FCB,
       I_WDOWN, I_BDOWN, I_L2G, I_L2B, N_IN };
constexpr size_t O_YP = 0, O_YS = 16777216, O_PCL = O_YS + 131072, O_PL = O_PCL + 24576, O_PSR = O_PL + 8192, O_PSI = O_PSR + 16384, O_PCF = O_PSI + 16384,
                 O_SCL = O_PCF + 49152, O_SL = O_SCL + 393216, O_SSR = O_SL + 131072, O_SSI = O_SSR + 262144, O_SCF = O_SSI + 262144, O_END = O_SCF + 786432;
constexpr size_t W_WTUP = 0, W_WTDOWN = W_WTUP + (size_t)6144 * 1024 * 2, W_XN = W_WTDOWN + (size_t)1024 * 3072 * 2, W_C = W_XN + (size_t)MTOK * 1024 * 2;
constexpr size_t W_PROJ = W_C, W_MIX = W_PROJ + (size_t)MTOK * DIN * 2, W_YSG = W_MIX + (size_t)MTOK * 1024 * 2, W_D = W_YSG + (size_t)MTOK * 512 * 2;
constexpr size_t W_WTGLU = W_D, W_WTOUT = W_WTGLU + (size_t)2048 * 512 * 2, W_WTR = W_WTOUT + (size_t)1024 * 1024 * 2, W_WTI = W_WTR + 262144, W_W1 = W_WTI + 262144,
                 W_W2 = W_W1 + (size_t)NG * 128 * 256 * 2, W_HPREV = W_W2 + (size_t)NG * 256 * 384 * 2, W_A1 = W_HPREV + (size_t)NR * NG * 128 * 2, W_A16 = W_A1 + 16384,
                 W_BBAR = W_A16 + 16384, W_LRUA = W_BBAR + 262144, W_LRUH = W_LRUA + 262144, W_LRUC = W_LRUH + 262144, W_S = W_LRUC + 262144, W_WTIN = W_S,
                 W_S_END = W_S + (size_t)NR * NG * 128 * 4;
constexpr size_t W_BAR = (W_S_END + 4095) / 4096 * 4096;
static_assert(W_BAR + 16384 <= 268435456, "barrier words");
constexpr size_t W_PART = W_C + (size_t)MTOK * 1024 * 4;
constexpr size_t W_SBG = W_C, W_SBV = W_SBG + (size_t)260 * 4 * DFF * 4, W_SB_END = W_SBV + (size_t)260 * 2 * DFF * 4;
constexpr size_t W_R1 = W_C, W_G = W_C, W_V = W_G + (size_t)MTOK * DFF * 2, W_V_END = W_V + (size_t)MTOK * DFF * 2, W_R2 = W_C;
static_assert(W_S_END <= 268435456 && W_V_END <= 268435456, "workspace map exceeds 256 MiB");
static_assert(W_SB_END <= W_V, "side buffers overlap H");
static_assert(W_PART + (size_t)12 * 256 * 1024 * 4 <= W_MIX && W_PART + (size_t)12 * 256 * 1024 * 4 <= W_V, "r1 / partials overlap mix or v");

constexpr int LDS_TOTAL = 147456;
struct P { const float* in[N_IN]; float* out; unsigned char* ws; };

__device__ __forceinline__ float bf2f(unsigned short b) { return __uint_as_float(((unsigned)b) << 16); }
__device__ __forceinline__ float bflo(unsigned u) { return __uint_as_float(u << 16); }
__device__ __forceinline__ float bfhi(unsigned u) { return __uint_as_float(u & 0xffff0000u); }
__device__ __forceinline__ unsigned short f2bf(float f) { return (unsigned short)(cvt_pk_bf16(f, 0.f) & 0xffffu); }
__device__ __forceinline__ float sigm(float x) { return __builtin_amdgcn_rcpf(1.f + __expf(-x)); }
__device__ __forceinline__ float gelu_tanh(float x) { return x * sigm(1.5957691216057308f * (x + 0.044715f * x * x * x)); }
__device__ __forceinline__ float wave_sum(float v) {
#pragma unroll
    for (int o = 1; o < 64; o <<= 1) v += __shfl_xor(v, o);
    return v;
}
#define LDS_WAIT() asm volatile("s_waitcnt lgkmcnt(0)" ::: "memory")
#define REPEAT(N) for (int rep_ = 0; rep_ < (N); ++rep_)

struct EpiProj {
    static constexpr bool PERM = true, AFTER_DRAIN = false;
    bf16_t* O; const float* bias;
    __device__ __forceinline__ void operator()(const f32x4 (&acc)[2][2][4][2], const Unit& u, int wr, int wc, int fr, int fq) const {
        const int row0 = u.pm * 256 + wr * 64 + fr, col0 = u.pn * 256 + wc * 32 + 8 * fq;
#pragma unroll
        for (int bj = 0; bj < 2; ++bj) { const int col = col0 + bj * 128; const f32x4 b0 = *(const f32x4*)(bias + col), b1 = *(const f32x4*)(bias + col + 4);
#pragma unroll
            for (int ai = 0; ai < 2; ++ai)
#pragma unroll
                for (int m = 0; m < 4; ++m) { const f32x4 v0 = acc[ai][bj][m][0] + b0, v1 = acc[ai][bj][m][1] + b1; u32x4 w;
                    w.x = cvt_pk_bf16(v0[0], v0[1]); w.y = cvt_pk_bf16(v0[2], v0[3]); w.z = cvt_pk_bf16(v1[0], v1[1]); w.w = cvt_pk_bf16(v1[2], v1[3]);
                    *(u32x4*)(O + (size_t)(row0 + ai * 128 + m * 16) * DIN + col) = w; } }
    }
};
struct EpiGlu {
    static constexpr bool PERM = false, AFTER_DRAIN = false;
    bf16_t* mix; const bf16_t* m2; const float* carry; const bf16_t* proj; const float* bias;
    __device__ __forceinline__ void operator()(const f32x4 (&acc)[2][2][4][2], const Unit& u, int wr, int wc, int fr, int fq) const {
        const int row0 = u.pm * 256 + wr * 64 + fr, j0 = u.pn * 128 + wc * 32 + 4 * fq;
#pragma unroll
        for (int ai = 0; ai < 2; ++ai)
#pragma unroll
            for (int m = 0; m < 4; ++m) { const int rowi = row0 + ai * 128 + m * 16; const size_t row = (size_t)rowi; int cidx = 0;
                if (rowi < MP) { const int b = rowi / TT, t = rowi - b * TT; int kc = t >> 8; kc = kc > 7 ? 7 : kc; cidx = (b * 8 + kc) * 1024; }
#pragma unroll
                for (int n = 0; n < 2; ++n) { const int j = j0 + n * 16; const f32x4 bv = *(const f32x4*)(bias + j), bg = *(const f32x4*)(bias + 1024 + j);
                    const f32x4 val = acc[ai][0][m][n] + bv, gate = acc[ai][1][m][n] + bg; const f32x4 cv = *(const f32x4*)(carry + cidx + j);
                    const u32x2 gbw = *(const u32x2*)(proj + row * DIN + C_GB + j); const u32x2 mw = *(const u32x2*)(mix + row * 1024 + j); const u32x2 m2w = *(const u32x2*)(m2 + row * 1024 + j);
                    const float o0 = bflo(mw.x) + bflo(m2w.x) * cv[0] + sigm(bflo(gbw.x)) * val[0] * sigm(gate[0]), o1 = bfhi(mw.x) + bfhi(m2w.x) * cv[1] + sigm(bfhi(gbw.x)) * val[1] * sigm(gate[1]);
                    const float o2 = bflo(mw.y) + bflo(m2w.y) * cv[2] + sigm(bflo(gbw.y)) * val[2] * sigm(gate[2]), o3 = bfhi(mw.y) + bfhi(m2w.y) * cv[3] + sigm(bfhi(gbw.y)) * val[3] * sigm(gate[3]);
                    u32x2 w; w.x = cvt_pk_bf16(o0, o1); w.y = cvt_pk_bf16(o2, o3); *(u32x2*)(mix + row * 1024 + j) = w; } }
    }
};
struct EpiRes {
    static constexpr bool PERM = false, AFTER_DRAIN = false;
    float* R; const bf16_t* X; const float* bias; float* part;
    __device__ __forceinline__ void operator()(const f32x4 (&acc)[2][2][4][2], const Unit& u, int wr, int wc, int fr, int fq) const {
        const int row0 = u.pm * 256 + wr * 64 + fr, col0 = u.pn * 256 + wc * 32 + 4 * fq;
        const bool sp = u.ks >= 0; const float al = sp ? 0.f : ALPHA, bsc = sp ? 0.f : 1.f;
        float* Rb = sp ? part + ((size_t)u.ks * 256 - 16384) * 1024 : R;
#pragma unroll
        for (int bj = 0; bj < 2; ++bj)
#pragma unroll
            for (int n = 0; n < 2; ++n) { const int col = col0 + bj * 128 + n * 16; const f32x4 bv = *(const f32x4*)(bias + col) * bsc;
#pragma unroll
                for (int ai = 0; ai < 2; ++ai)
#pragma unroll
                    for (int m = 0; m < 4; ++m) { const size_t off = (size_t)(row0 + ai * 128 + m * 16) * 1024 + col; const u32x2 xw = *(const u32x2*)(X + off);
                        f32x4 v = acc[ai][bj][m][n] + bv; v[0] += al * bflo(xw.x); v[1] += al * bfhi(xw.x); v[2] += al * bflo(xw.y); v[3] += al * bfhi(xw.y);
                        *(f32x4*)(Rb + off) = v; } }
    }
};
__device__ __forceinline__ float rot1(float x) { return __int_as_float(__builtin_amdgcn_update_dpp(0, __float_as_int(x), 0x121, 0xf, 0xf, false)); }
__device__ __forceinline__ float rot2(float x) { return __int_as_float(__builtin_amdgcn_update_dpp(0, __float_as_int(x), 0x122, 0xf, 0xf, false)); }
struct EpiUp {
    static constexpr bool PERM = false, AFTER_DRAIN = false;
    bf16_t* H; const float* bias; float* out; const float* cw; const float* cb; const float* cache; float* sbg; float* sbv;
    __device__ __forceinline__ void operator()(const f32x4 (&acc)[2][2][4][2], const Unit& u, int wr, int wc, int fr, int fq) const {
        const int c0 = u.pn * 128 + wc * 32 + 4 * fq;
#pragma unroll
        for (int n = 0; n < 2; ++n) { const int ch = c0 + n * 16; const f32x4 bg = *(const f32x4*)(bias + ch), bv = *(const f32x4*)(bias + DFF + ch);
            const f32x4 w0 = *(const f32x4*)(cw + ch), w1 = *(const f32x4*)(cw + DFF + ch), w2 = *(const f32x4*)(cw + 2 * DFF + ch), cbv = *(const f32x4*)(cb + ch);
#pragma unroll
            for (int ai = 0; ai < 2; ++ai) { const int blk = u.pm * 4 + ai * 2 + wr, r0 = blk * 64; const bool samp = blk >= 258;
                f32x4 gp = {0.f, 0.f, 0.f, 0.f}, gp1 = {0.f, 0.f, 0.f, 0.f}, gp2 = {0.f, 0.f, 0.f, 0.f};
#pragma unroll
                for (int m = 0; m < 4; ++m) { const int row = r0 + 16 * m + fr; const f32x4 g = acc[ai][0][m][n] + bg, v = acc[ai][1][m][n] + bv;
                    f32x4 a1, a2; a1[0] = rot1(g[0]); a1[1] = rot1(g[1]); a1[2] = rot1(g[2]); a1[3] = rot1(g[3]); a2[0] = rot2(g[0]); a2[1] = rot2(g[1]); a2[2] = rot2(g[2]); a2[3] = rot2(g[3]);
                    f32x4 g1, g2;
                    if (samp) { const int s = row - MP; g2 = *(const f32x4*)(cache + ((size_t)s * 2) * DFF + ch); g1 = *(const f32x4*)(cache + ((size_t)s * 2 + 1) * DFF + ch);
                        *(f32x4*)(out + O_SCF + ((size_t)s * 2 + 1) * DFF + ch) = g; }
                    else { g1 = (fr >= 1) ? a1 : gp1; g2 = (fr >= 2) ? a2 : gp2; const int b = row / TT, t = row - b * TT;
                        if (t == 0) g1 = (f32x4){0.f, 0.f, 0.f, 0.f}; if (t <= 1) g2 = (f32x4){0.f, 0.f, 0.f, 0.f};
                        if (t >= TT - 2) *(f32x4*)(out + O_PCF + ((size_t)b * 2 + (t - (TT - 2))) * DFF + ch) = g;
                        if (m == 0 && fr < 2) { *(f32x4*)(sbg + ((size_t)blk * 4 + fr) * DFF + ch) = g; *(f32x4*)(sbv + ((size_t)blk * 2 + fr) * DFF + ch) = v; }
                        if (m == 3 && fr >= 14) *(f32x4*)(sbg + ((size_t)blk * 4 + fr - 12) * DFF + ch) = g; }
                    const f32x4 y = cbv + w0 * g2 + w1 * g1 + w2 * g;
                    const float h0 = gelu_tanh(y[0]) * v[0], h1 = gelu_tanh(y[1]) * v[1], h2 = gelu_tanh(y[2]) * v[2], h3 = gelu_tanh(y[3]) * v[3];
                    u32x2 w; w.x = cvt_pk_bf16(h0, h1); w.y = cvt_pk_bf16(h2, h3); *(u32x2*)(H + (size_t)row * DFF + ch) = w;
                    gp = g; gp1 = a1; gp2 = a2; } } }
    }
};
template <class Epi> __device__ __forceinline__ void run_gemm(LAS unsigned char* lds, const bf16_t* A, const bf16_t* Bt, int N, int K, const Epi& E) {
    pg8::Gemm g; g.A = A; g.Bt = Bt; g.M = MTOK; g.N = N; g.K = K;
    pg8::StaticOrder S; S.init(MTOK, N, K, (int)gridDim.x, (int)blockIdx.x);
    pg8::gemm_phase<Epi, pg8::StaticOrder, false>(lds, g, S, E, nullptr);
}

template <class Epi> __device__ __forceinline__ void run_gemm_split(LAS unsigned char* lds, const bf16_t* A, const bf16_t* Bt, int K, int nsplit, const Epi& E) {
    pg8::Gemm g; g.A = A; g.Bt = Bt; g.M = MTOK; g.N = 1024; g.K = K;
    pg8::SplitOrder S; S.init(1024, K, nsplit, (int)gridDim.x, (int)blockIdx.x);
    pg8::gemm_phase<Epi, pg8::SplitOrder, false>(lds, g, S, E, nullptr);
}

__device__ __forceinline__ void transpose_item(const float* W, int N, bf16_t* WT, int K, int k0, int srcn0, int dstn0, LAS float* scr, int lane) {
    float tv[32];
#pragma unroll
    for (int i = 0; i < 32; ++i) tv[i] = W[(size_t)(k0 + 2 * i + (lane >> 5)) * N + srcn0 + (lane & 31)];
#pragma unroll
    for (int i = 0; i < 32; ++i) scr[(2 * i + (lane >> 5)) * 33 + (lane & 31)] = tv[i];
    LDS_WAIT();
    const int c = lane & 7;
#pragma unroll
    for (int j = 0; j < 4; ++j) { const int n = (lane >> 3) + 8 * j; const LAS float* s = scr + (8 * c) * 33 + n;
        u32x4 o; o.x = cvt_pk_bf16(s[0 * 33], s[1 * 33]); o.y = cvt_pk_bf16(s[2 * 33], s[3 * 33]); o.z = cvt_pk_bf16(s[4 * 33], s[5 * 33]); o.w = cvt_pk_bf16(s[6 * 33], s[7 * 33]);
        *(u32x4*)(WT + (size_t)(dstn0 + n) * K + k0 + 8 * c) = o; }
    LDS_WAIT();
}
__device__ __forceinline__ const float* src_row(const P& p, int r) {
    if (r < MP) { const int b = r / TT, t = r - b * TT; return t < 16 ? p.in[I_META] + (size_t)t * DM : p.in[I_XP] + ((size_t)b * 2048 + (t - 16)) * DM; }
    return p.in[I_XS] + (size_t)(r - MP) * DM;
}
template <bool OUT_BF16> __device__ __forceinline__ void ln_row(const float* xrow, const float* g, const float* bta, void* orow, int lane, int nsplit = 0, const bf16_t* xres = nullptr, const float* rbias = nullptr) {
    f32x4 v[4]; float s = 0.f;
#pragma unroll
    for (int j = 0; j < 4; ++j) { v[j] = *(const f32x4*)(xrow + 4 * lane + 256 * j);
        if (nsplit > 0) { for (int k = 1; k < nsplit; ++k) v[j] += *(const f32x4*)(xrow + (size_t)k * 256 * 1024 + 4 * lane + 256 * j);
            const u32x2 xw = *(const u32x2*)(xres + 4 * lane + 256 * j); const f32x4 bv = *(const f32x4*)(rbias + 4 * lane + 256 * j);
            v[j][0] += ALPHA * bflo(xw.x) + bv[0]; v[j][1] += ALPHA * bfhi(xw.x) + bv[1]; v[j][2] += ALPHA * bflo(xw.y) + bv[2]; v[j][3] += ALPHA * bfhi(xw.y) + bv[3]; }
        s += (v[j][0] + v[j][1]) + (v[j][2] + v[j][3]); }
    const float mean = wave_sum(s) * (1.f / DM); float s2 = 0.f;
#pragma unroll
    for (int j = 0; j < 4; ++j) { v[j] = v[j] - mean; s2 += (v[j][0] * v[j][0] + v[j][1] * v[j][1]) + (v[j][2] * v[j][2] + v[j][3] * v[j][3]); }
    const float rstd = 1.f / sqrtf(wave_sum(s2) * (1.f / DM) + LN_EPS);
#pragma unroll
    for (int j = 0; j < 4; ++j) { const f32x4 gg = *(const f32x4*)(g + 4 * lane + 256 * j), bb = *(const f32x4*)(bta + 4 * lane + 256 * j);
        const f32x4 o = (v[j] * rstd) * gg + bb;
        if (OUT_BF16) { u32x2 w; w.x = cvt_pk_bf16(o[0], o[1]); w.y = cvt_pk_bf16(o[2], o[3]); *(u32x2*)((bf16_t*)orow + 4 * lane + 256 * j) = w; }
        else *(f32x4*)((float*)orow + 4 * lane + 256 * j) = o; }
}
template <bool OUT_BF16> __device__ __forceinline__ void ln_rows2(const float* xa, const float* xb, const float* g, const float* bta, void* oa, void* ob, int lane, bool vb) {
    f32x4 va[4], vbv[4]; float sa = 0.f, sb = 0.f;
#pragma unroll
    for (int j = 0; j < 4; ++j) { va[j] = *(const f32x4*)(xa + 4 * lane + 256 * j); vbv[j] = *(const f32x4*)(xb + 4 * lane + 256 * j); }
#pragma unroll
    for (int j = 0; j < 4; ++j) { sa += (va[j][0] + va[j][1]) + (va[j][2] + va[j][3]); sb += (vbv[j][0] + vbv[j][1]) + (vbv[j][2] + vbv[j][3]); }
#pragma unroll
    for (int o = 1; o < 64; o <<= 1) { sa += __shfl_xor(sa, o); sb += __shfl_xor(sb, o); }
    const float ma = sa * (1.f / DM), mb = sb * (1.f / DM); float qa = 0.f, qb = 0.f;
#pragma unroll
    for (int j = 0; j < 4; ++j) { va[j] = va[j] - ma; vbv[j] = vbv[j] - mb; qa += (va[j][0] * va[j][0] + va[j][1] * va[j][1]) + (va[j][2] * va[j][2] + va[j][3] * va[j][3]);
        qb += (vbv[j][0] * vbv[j][0] + vbv[j][1] * vbv[j][1]) + (vbv[j][2] * vbv[j][2] + vbv[j][3] * vbv[j][3]); }
#pragma unroll
    for (int o = 1; o < 64; o <<= 1) { qa += __shfl_xor(qa, o); qb += __shfl_xor(qb, o); }
    const float ra = 1.f / sqrtf(qa * (1.f / DM) + LN_EPS), rb = 1.f / sqrtf(qb * (1.f / DM) + LN_EPS);
#pragma unroll
    for (int j = 0; j < 4; ++j) { const f32x4 gg = *(const f32x4*)(g + 4 * lane + 256 * j), bb = *(const f32x4*)(bta + 4 * lane + 256 * j);
        const f32x4 o1 = (va[j] * ra) * gg + bb, o2 = (vbv[j] * rb) * gg + bb;
        if (OUT_BF16) { u32x2 w; w.x = cvt_pk_bf16(o1[0], o1[1]); w.y = cvt_pk_bf16(o1[2], o1[3]); *(u32x2*)((bf16_t*)oa + 4 * lane + 256 * j) = w;
            if (vb) { w.x = cvt_pk_bf16(o2[0], o2[1]); w.y = cvt_pk_bf16(o2[2], o2[3]); *(u32x2*)((bf16_t*)ob + 4 * lane + 256 * j) = w; } }
        else { *(f32x4*)((float*)oa + 4 * lane + 256 * j) = o1; if (vb) *(f32x4*)((float*)ob + 4 * lane + 256 * j) = o2; } }
}
__device__ __forceinline__ void s5_precompute(const P& p, LAS unsigned char* lds, int g) {
    LAS float* apr = (LAS float*)lds;
    LAS float* api = apr + 17 * 64;
    LAS float* bbr = api + 17 * 64;
    LAS float* bbi = bbr + 1024;
    LAS float* cr = bbi + 1024;
    LAS float* ci = cr + 1024;
    LAS float* Kl = ci + 1024;
    const int tid = threadIdx.x;
    if (tid < 64) { const int pp = tid;
        const float dt = expf(p.in[I_SLDT][g]); const float lre = p.in[I_SLRE][g * 64 + pp], lim = p.in[I_SLIM][g * 64 + pp];
        const float mag = expf(lre * dt); const float ang = lim * dt; const float abr = mag * cosf(ang), abi = mag * sinf(ang);
        const float den = lre * lre + lim * lim, nr = abr - 1.0f, ni = abi; const float fre = (nr * lre + ni * lim) / den, fim = (ni * lre - nr * lim) / den;
        float pr = 1.f, pi = 0.f;
        for (int j = 0; j <= 16; ++j) { apr[j * 64 + pp] = pr; api[j * 64 + pp] = pi; const float nr2 = pr * abr - pi * abi, ni2 = pr * abi + pi * abr; pr = nr2; pi = ni2; }
        float* a1 = (float*)(p.ws + W_A1); float* a16 = (float*)(p.ws + W_A16); float* bbar = (float*)(p.ws + W_BBAR);
        a1[(g * 64 + pp) * 2] = abr; a1[(g * 64 + pp) * 2 + 1] = abi; a16[(g * 64 + pp) * 2] = apr[16 * 64 + pp]; a16[(g * 64 + pp) * 2 + 1] = api[16 * 64 + pp];
        for (int c = 0; c < 16; ++c) { const float br = p.in[I_SBRE][(g * 64 + pp) * 16 + c], bi = p.in[I_SBIM][(g * 64 + pp) * 16 + c];
            const float xr = fre * br - fim * bi, xi = fre * bi + fim * br; bbr[pp * 16 + c] = xr; bbi[pp * 16 + c] = xi;
            bbar[((g * 64 + pp) * 16 + c) * 2] = xr; bbar[((g * 64 + pp) * 16 + c) * 2 + 1] = xi; }
    }
    for (int i = tid; i < 1024; i += 512) { cr[i] = p.in[I_SCRE][g * 1024 + i]; ci[i] = p.in[I_SCIM][g * 1024 + i]; }
    __syncthreads();
    { const int j = tid >> 5, c1 = (tid >> 1) & 15, c0 = 8 * (tid & 1); float acc8[8];
#pragma unroll
      for (int e = 0; e < 8; ++e) acc8[e] = 0.f;
      for (int pp = 0; pp < 64; ++pp) { const float xr = cr[c1 * 64 + pp], xi = ci[c1 * 64 + pp], ar = apr[j * 64 + pp], ai = api[j * 64 + pp]; const float car = xr * ar - xi * ai, cai = xr * ai + xi * ar;
          const f32x4 r0 = *(const LAS f32x4*)(bbr + pp * 16 + c0), r1 = *(const LAS f32x4*)(bbr + pp * 16 + c0 + 4), i0 = *(const LAS f32x4*)(bbi + pp * 16 + c0), i1 = *(const LAS f32x4*)(bbi + pp * 16 + c0 + 4);
          acc8[0] += car * r0[0] - cai * i0[0]; acc8[1] += car * r0[1] - cai * i0[1]; acc8[2] += car * r0[2] - cai * i0[2]; acc8[3] += car * r0[3] - cai * i0[3];
          acc8[4] += car * r1[0] - cai * i1[0]; acc8[5] += car * r1[1] - cai * i1[1]; acc8[6] += car * r1[2] - cai * i1[2]; acc8[7] += car * r1[3] - cai * i1[3]; }
#pragma unroll
      for (int e = 0; e < 8; ++e) { float v = acc8[e]; if (j == 0 && c1 == c0 + e) v += p.in[I_SD][g * 16 + c1]; Kl[(j * 16 + c1) * 16 + c0 + e] = v; } }
    __syncthreads();
    bf16_t* W1 = (bf16_t*)(p.ws + W_W1) + (size_t)g * 128 * 256; bf16_t* W2 = (bf16_t*)(p.ws + W_W2) + (size_t)g * 256 * 384;
    for (int i = tid; i < 128 * 32; i += 512) { const int n = i >> 5, ch = i & 31, s = ch >> 1, c0 = 8 * (ch & 1), pp = n & 63; const bool im = n >= 64; float v[8];
        const float ar = apr[(15 - s) * 64 + pp], ai = api[(15 - s) * 64 + pp];
#pragma unroll
        for (int e = 0; e < 8; ++e) { const float xr = bbr[pp * 16 + c0 + e], xi = bbi[pp * 16 + c0 + e]; v[e] = im ? (ar * xi + ai * xr) : (ar * xr - ai * xi); }
        u32x4 o; o.x = cvt_pk_bf16(v[0], v[1]); o.y = cvt_pk_bf16(v[2], v[3]); o.z = cvt_pk_bf16(v[4], v[5]); o.w = cvt_pk_bf16(v[6], v[7]);
        *(u32x4*)(W1 + (size_t)n * 256 + 8 * ch) = o; }
    for (int i = tid; i < 256 * 48; i += 512) { const int n = i / 48, ch = i - n * 48, t = n >> 4, c1 = n & 15; float v[8];
        if (ch < 32) { const int s = ch >> 1, c0 = 8 * (ch & 1);
#pragma unroll
            for (int e = 0; e < 8; ++e) v[e] = (s <= t) ? Kl[((t - s) * 16 + c1) * 16 + c0 + e] : 0.f; }
        else { const bool im = ch >= 40; const int p0 = 8 * (ch - (im ? 40 : 32));
#pragma unroll
            for (int e = 0; e < 8; ++e) { const int pp = p0 + e; const float ar = apr[(t + 1) * 64 + pp], ai = api[(t + 1) * 64 + pp], xr = cr[c1 * 64 + pp], xi = ci[c1 * 64 + pp];
                v[e] = im ? -(xr * ai + xi * ar) : (xr * ar - xi * ai); } }
        u32x4 o; o.x = cvt_pk_bf16(v[0], v[1]); o.y = cvt_pk_bf16(v[2], v[3]); o.z = cvt_pk_bf16(v[4], v[5]); o.w = cvt_pk_bf16(v[6], v[7]);
        *(u32x4*)(W2 + (size_t)n * 384 + 8 * ch) = o; }
    __syncthreads();
}
template <int CLS> __device__ __forceinline__ void transposes(const P& p, LAS float* scr, int lane, int gw, int NGW) {
    constexpr int I_UP = 16 * 192, I_DN = 48 * 32, I_IN = 16 * 112, I_GL = 8 * 64, I_OU = 16 * 32, I_LR = 16 * 8;
    constexpr int NITEMS = CLS == 0 ? I_IN + I_LR : I_UP + I_DN + I_GL + I_OU;
    for (int it = gw; it < NITEMS; it += NGW) { int r = it;
        if (CLS == 0) {
            if (r < I_IN) { const int kb = r / 112, nb = r % 112; transpose_item(p.in[I_WIN], DIN, (bf16_t*)(p.ws + W_WTIN), 1024, 64 * kb, 32 * nb, 32 * nb, scr, lane); continue; } r -= I_IN;
            { const int which = r >> 6, blk = (r >> 3) & 7, kb = (r >> 2) & 1, nb = r & 3;
              transpose_item(p.in[which ? I_WI : I_WR] + blk * 16384, 128, (bf16_t*)(p.ws + (which ? W_WTI : W_WTR)) + blk * 16384, 128, 64 * kb, 32 * nb, 32 * nb, scr, lane); }
        } else {
            if (r < I_UP) { const int kb = r / 192, nb = r % 192, d0 = 32 * nb, s0 = ((d0 >> 7) & 1) * DFF + (d0 >> 8) * 128 + (d0 & 127);
                transpose_item(p.in[I_WUP], 6144, (bf16_t*)(p.ws + W_WTUP), 1024, 64 * kb, s0, d0, scr, lane); continue; } r -= I_UP;
            if (r < I_DN) { const int kb = r / 32, nb = r % 32; transpose_item(p.in[I_WDOWN], 1024, (bf16_t*)(p.ws + W_WTDOWN), 3072, 64 * kb, 32 * nb, 32 * nb, scr, lane); continue; } r -= I_DN;
            if (r < I_GL) { const int kb = r / 64, nb = r % 64, d0 = 32 * nb, s0 = ((d0 >> 7) & 1) * 1024 + (d0 >> 8) * 128 + (d0 & 127);
                transpose_item(p.in[I_WGLU], 2048, (bf16_t*)(p.ws + W_WTGLU), 512, 64 * kb, s0, d0, scr, lane); continue; } r -= I_GL;
            { const int kb = r / 32, nb = r % 32; transpose_item(p.in[I_WOUT], 1024, (bf16_t*)(p.ws + W_WTOUT), 1024, 64 * kb, 32 * nb, 32 * nb, scr, lane); }
        }
    }
}
__device__ __forceinline__ void phase0(const P& p, LAS unsigned char* lds) {
    const int tid = threadIdx.x, lane = tid & 63, wid = tid >> 6;
    REPEAT(REP_P0A) for (int g = blockIdx.x; g < NG; g += gridDim.x) s5_precompute(p, lds, g);
    LAS float* scr = (LAS float*)(lds + wid * 8704);
    const int gw = blockIdx.x * 8 + wid, NGW = gridDim.x * 8;
    { const int skip = ((int)gridDim.x >= 64) ? NG : 0;
      if ((int)blockIdx.x >= skip) REPEAT(REP_P0B) transposes<0>(p, scr, lane, ((int)blockIdx.x - skip) * 8 + wid, ((int)gridDim.x - skip) * 8); }
    REPEAT(REP_P0C) for (int r = gw; r < MTOK; r += 2 * NGW) { const int r2 = r + NGW; const bool vb = r2 < MTOK; const int rb = vb ? r2 : r;
        ln_rows2<true>(src_row(p, r), src_row(p, rb), p.in[I_EG], p.in[I_EB], (bf16_t*)(p.ws + W_XN) + (size_t)r * DM, (bf16_t*)(p.ws + W_XN) + (size_t)rb * DM, lane, vb); }
}

template <int MODE> __device__ __forceinline__ void lru_unit(const P& p, LAS unsigned char* lds, int b, int kc, int nb) {
    const int tid = threadIdx.x, lane = tid & 63, wid = tid >> 6, q = lane >> 4, n = lane & 15;
    int mt0, nmt, rowbase;
    if (MODE == 2) { mt0 = kc; nmt = 1; rowbase = MP; } else { mt0 = (NCHUNK * kc) >> 3; nmt = ((NCHUNK * (kc + 1)) >> 3) - mt0; rowbase = b * TT; }
    const int t0 = 16 * mt0, ntok = 16 * nmt;
    const bf16_t* proj = (const bf16_t*)(p.ws + W_PROJ);
    LAS bf16_t* xcs = (LAS bf16_t*)lds;
    LAS bf16_t* gas = (LAS bf16_t*)(lds + 73984);
    if (MODE == 2) {
        for (int it = tid; it < ntok * 16; it += 512) { const int i = it >> 4, cg8 = it & 15, c0 = nb * 128 + cg8 * 8; float a[8];
            { const f32x4 b0 = *(const f32x4*)(p.in[I_CLB] + c0), b1 = *(const f32x4*)(p.in[I_CLB] + c0 + 4); a[0] = b0[0]; a[1] = b0[1]; a[2] = b0[2]; a[3] = b0[3]; a[4] = b1[0]; a[5] = b1[1]; a[6] = b1[2]; a[7] = b1[3]; }
#pragma unroll
            for (int j = 0; j < 4; ++j) { const f32x4 w0 = *(const f32x4*)(p.in[I_CLW] + j * 1024 + c0), w1 = *(const f32x4*)(p.in[I_CLW] + j * 1024 + c0 + 4); float x[8];
                if (j < 3) { const float* cp = p.in[I_CCL] + ((size_t)(t0 + i) * 3 + j) * 1024 + c0; const f32x4 x0 = *(const f32x4*)cp, x1 = *(const f32x4*)(cp + 4);
                    x[0] = x0[0]; x[1] = x0[1]; x[2] = x0[2]; x[3] = x0[3]; x[4] = x1[0]; x[5] = x1[1]; x[6] = x1[2]; x[7] = x1[3]; }
                else { const u32x4 xv = *(const u32x4*)(proj + (size_t)(rowbase + t0 + i) * DIN + c0);
                    x[0] = bflo(xv.x); x[1] = bfhi(xv.x); x[2] = bflo(xv.y); x[3] = bfhi(xv.y); x[4] = bflo(xv.z); x[5] = bfhi(xv.z); x[6] = bflo(xv.w); x[7] = bfhi(xv.w); }
                a[0] += w0[0] * x[0]; a[1] += w0[1] * x[1]; a[2] += w0[2] * x[2]; a[3] += w0[3] * x[3]; a[4] += w1[0] * x[4]; a[5] += w1[1] * x[5]; a[6] += w1[2] * x[6]; a[7] += w1[3] * x[7]; }
            u32x4 o; o.x = cvt_pk_bf16(a[0], a[1]); o.y = cvt_pk_bf16(a[2], a[3]); o.z = cvt_pk_bf16(a[4], a[5]); o.w = cvt_pk_bf16(a[6], a[7]);
            *(LAS u32x4*)(xcs + i * 136 + cg8 * 8) = o;
            *(LAS u32x4*)(gas + i * 128 + cg8 * 8) = *(const u32x4*)(proj + (size_t)(rowbase + t0 + i) * DIN + C_GA + c0); }
    } else {
        const int cg8 = tid & 15, tr = tid >> 4, c0 = nb * 128 + cg8 * 8; float w[4][8], bs[8];
        { const f32x4 b0 = *(const f32x4*)(p.in[I_CLB] + c0), b1 = *(const f32x4*)(p.in[I_CLB] + c0 + 4); bs[0] = b0[0]; bs[1] = b0[1]; bs[2] = b0[2]; bs[3] = b0[3]; bs[4] = b1[0]; bs[5] = b1[1]; bs[6] = b1[2]; bs[7] = b1[3]; }
#pragma unroll
        for (int j = 0; j < 4; ++j) { const f32x4 w0 = *(const f32x4*)(p.in[I_CLW] + j * 1024 + c0), w1 = *(const f32x4*)(p.in[I_CLW] + j * 1024 + c0 + 4);
            w[j][0] = w0[0]; w[j][1] = w0[1]; w[j][2] = w0[2]; w[j][3] = w0[3]; w[j][4] = w1[0]; w[j][5] = w1[1]; w[j][6] = w1[2]; w[j][7] = w1[3]; }
        const int i0 = tr * 9; int i1 = i0 + 9; if (i1 > ntok) i1 = ntok;
        u32x4 xr[12], gr[9];
#pragma unroll
        for (int k = 0; k < 12; ++k) { const int i = i0 - 3 + k, t = t0 + i; xr[k] = (u32x4){0u, 0u, 0u, 0u}; if (t >= 0 && i < i1) xr[k] = *(const u32x4*)(proj + (size_t)(rowbase + t) * DIN + c0); }
#pragma unroll
        for (int k = 0; k < 9; ++k) { gr[k] = (u32x4){0u, 0u, 0u, 0u}; if (i0 + k < i1) gr[k] = *(const u32x4*)(proj + (size_t)(rowbase + t0 + i0 + k) * DIN + C_GA + c0); }
#pragma unroll
        for (int k = 0; k < 9; ++k) { if (i0 + k < i1) { float a[8];
#pragma unroll
            for (int e = 0; e < 8; ++e) a[e] = bs[e];
#pragma unroll
            for (int j = 0; j < 4; ++j) { const u32x4 xv = xr[k + j];
                a[0] += w[j][0] * bflo(xv.x); a[1] += w[j][1] * bfhi(xv.x); a[2] += w[j][2] * bflo(xv.y); a[3] += w[j][3] * bfhi(xv.y);
                a[4] += w[j][4] * bflo(xv.z); a[5] += w[j][5] * bfhi(xv.z); a[6] += w[j][6] * bflo(xv.w); a[7] += w[j][7] * bfhi(xv.w); }
            u32x4 o; o.x = cvt_pk_bf16(a[0], a[1]); o.y = cvt_pk_bf16(a[2], a[3]); o.z = cvt_pk_bf16(a[4], a[5]); o.w = cvt_pk_bf16(a[6], a[7]);
            *(LAS u32x4*)(xcs + (i0 + k) * 136 + cg8 * 8) = o; *(LAS u32x4*)(gas + (i0 + k) * 128 + cg8 * 8) = gr[k]; } }
    }
    __syncthreads();
    const int c = nb * 128 + wid * 16 + n;
    bf16x8 Br[4], Bi[4];
    { const bf16_t* wr_ = (const bf16_t*)(p.ws + W_WTR) + (size_t)c * 128 + q * 8; const bf16_t* wi_ = (const bf16_t*)(p.ws + W_WTI) + (size_t)c * 128 + q * 8;
#pragma unroll
      for (int kk = 0; kk < 4; ++kk) { Br[kk] = *(const bf16x8*)(wr_ + 32 * kk); Bi[kk] = *(const bf16x8*)(wi_ + 32 * kk); } }
    const float br = p.in[I_BR][c], bi = p.in[I_BI][c]; const float c8 = -8.0f * log1pf(expf(-p.in[I_LAM][c]));
    bf16_t* M1 = (bf16_t*)(p.ws + W_MIX); bf16_t* M2 = (bf16_t*)(p.out + O_YP);
    float h_run = 0.f, A_run = 1.f;
    for (int mt = 0; mt < nmt; ++mt) {
        f32x4 accr = {0.f, 0.f, 0.f, 0.f}, acci = {0.f, 0.f, 0.f, 0.f};
#pragma unroll
        for (int kk = 0; kk < 4; ++kk) { const bf16x8 Af = *(const LAS bf16x8*)(xcs + (16 * mt + n) * 136 + 32 * kk + 8 * q);
            accr = __builtin_amdgcn_mfma_f32_16x16x32_bf16(Af, Br[kk], accr, 0, 0, 0); acci = __builtin_amdgcn_mfma_f32_16x16x32_bf16(Af, Bi[kk], acci, 0, 0, 0); }
        float a[4], bx[4], ga[4];
#pragma unroll
        for (int j = 0; j < 4; ++j) { const int tok = 16 * mt + 4 * q + j; const float xcv = bf2f(xcs[tok * 136 + wid * 16 + n]);
            ga[j] = bf2f(gas[tok * 128 + wid * 16 + n]);
            const float r = sigm(accr[j] + br), ig = sigm(acci[j] + bi), la = c8 * r; a[j] = __expf(la); bx[j] = __builtin_amdgcn_sqrtf(fmaf(-a[j], a[j], 1.0f)) * (ig * xcv); }
        float h[4], Ac[4];
        if (MODE == 2) {
#pragma unroll
            for (int j = 0; j < 4; ++j) { const int s = t0 + 16 * mt + 4 * q + j; h[j] = a[j] * p.in[I_SL][(size_t)s * 1024 + c] + bx[j]; p.out[O_SL + (size_t)s * 1024 + c] = h[j]; Ac[j] = 0.f; }
        } else {
            float Ap[4]; h[0] = bx[0]; Ap[0] = a[0];
#pragma unroll
            for (int j = 1; j < 4; ++j) { h[j] = a[j] * h[j - 1] + bx[j]; Ap[j] = a[j] * Ap[j - 1]; }
            float PA = Ap[3], PH = h[3];
            float tA = __shfl_up(PA, 16), tH = __shfl_up(PH, 16); if (q >= 1) { PH = PA * tH + PH; PA = PA * tA; }
            tA = __shfl_up(PA, 32); tH = __shfl_up(PH, 32); if (q >= 2) { PH = PA * tH + PH; PA = PA * tA; }
            const float h_end = PA * h_run + PH; const float hin_s = __shfl_up(h_end, 16), pae_s = __shfl_up(PA, 16);
            const float h_in = (q == 0) ? h_run : hin_s; const float a_in = A_run * ((q == 0) ? 1.0f : pae_s);
#pragma unroll
            for (int j = 0; j < 4; ++j) { h[j] += Ap[j] * h_in; Ac[j] = Ap[j] * a_in; }
            h_run = __shfl(h_end, 48 + n); A_run *= __shfl(PA, 48 + n);
        }
#pragma unroll
        for (int j = 0; j < 4; ++j) { const size_t row = (size_t)(rowbase + t0 + 16 * mt + 4 * q + j); const float sg = sigm(ga[j]);
            M1[row * 1024 + c] = f2bf(sg * h[j]); M2[row * 1024 + c] = f2bf(sg * Ac[j]); }
    }
    if (MODE == 0 && q == 0) { ((float*)(p.ws + W_LRUA))[(size_t)(b * 8 + kc) * 1024 + c] = A_run; ((float*)(p.ws + W_LRUH))[(size_t)(b * 8 + kc) * 1024 + c] = h_run; }
    __syncthreads();
}

template <int PASS> __device__ __forceinline__ void s5_item(const P& p, int g, int sub, int lane, int wid) {
    constexpr int KS = (PASS == 1) ? 8 : 12, NTW = (PASS == 1) ? 1 : 2, LDW = (PASS == 1) ? 256 : 384;
    const int n = lane & 15, q = lane >> 4;
    const bf16_t* proj = (const bf16_t*)(p.ws + W_PROJ);
    const bf16_t* W = (PASS == 1) ? (const bf16_t*)(p.ws + W_W1) + (size_t)g * 128 * 256 : (const bf16_t*)(p.ws + W_W2) + (size_t)g * 256 * 384;
    bf16x8 Bf[NTW][KS];
#pragma unroll
    for (int i = 0; i < NTW; ++i)
#pragma unroll
        for (int kk = 0; kk < KS; ++kk) Bf[i][kk] = *(const bf16x8*)(W + (size_t)(16 * (NTW * wid + i) + n) * LDW + 32 * kk + 8 * q);
    const int rt0 = (65 * sub) >> 3, rt1 = (65 * (sub + 1)) >> 3; const bf16x8 zero = {0, 0, 0, 0, 0, 0, 0, 0};
    for (int rt = rt0; rt < rt1; ++rt) {
        const int R = 16 * rt + n; const bool valid = R < NR; const int Rc = valid ? R : 0; const int b = Rc / NCHUNK, k = Rc - b * NCHUNK;
        bf16x8 Af[KS];
        { const bf16_t* ub = proj + (size_t)(b * TT + 16 * k) * DIN + C_US + 16 * g + 8 * (q & 1);
#pragma unroll
          for (int kk = 0; kk < 8; ++kk) { const int s = 2 * kk + (q >> 1); Af[kk] = valid ? *(const bf16x8*)(ub + (size_t)s * DIN) : zero; } }
        if (PASS == 3) { const bf16_t* hb = (const bf16_t*)(p.ws + W_HPREV) + ((size_t)Rc * NG + g) * 128 + 8 * q;
#pragma unroll
          for (int kk = 8; kk < KS; ++kk) Af[kk] = valid ? *(const bf16x8*)(hb + 32 * (kk - 8)) : zero; }
        f32x4 acc[NTW];
#pragma unroll
        for (int i = 0; i < NTW; ++i) { acc[i] = (f32x4){0.f, 0.f, 0.f, 0.f};
#pragma unroll
            for (int kk = 0; kk < KS; ++kk) acc[i] = __builtin_amdgcn_mfma_f32_16x16x32_bf16(Af[kk], Bf[i][kk], acc[i], 0, 0, 0); }
#pragma unroll
        for (int j = 0; j < 4; ++j) { const int R2 = 16 * rt + 4 * q + j; if (R2 < NR) {
            if (PASS == 1) { ((float*)(p.ws + W_S))[((size_t)R2 * NG + g) * 128 + 16 * wid + n] = acc[0][j]; }
            else { const int b2 = R2 / NCHUNK, k2 = R2 - b2 * NCHUNK; bf16_t* Y = (bf16_t*)(p.ws + W_YSG) + (size_t)(b2 * TT + 16 * k2) * DSSM + 16 * g + n;
#pragma unroll
                for (int i = 0; i < NTW; ++i) Y[(size_t)(NTW * wid + i) * DSSM] = f2bf(gelu_tanh(acc[i][j])); } } }
    }
}
__device__ __forceinline__ void s5_fused(const P& p, LAS unsigned char* lds, int g, int b) {
    const int tid = threadIdx.x, lane = tid & 63, wid = tid >> 6, n = lane & 15, q = lane >> 4;
    LAS bf16_t* Us = (LAS bf16_t*)lds;
    LAS float* Ssm = (LAS float*)(lds + 68112);
    LAS bf16_t* Hs = (LAS bf16_t*)(lds + 68112);
    const bf16_t* proj = (const bf16_t*)(p.ws + W_PROJ); const bf16x8 zero = {0, 0, 0, 0, 0, 0, 0, 0};
    { const bf16_t* ub = proj + (size_t)(b * TT) * DIN + C_US + 16 * g;
      u32x4 tv[9];
#pragma unroll
      for (int i = 0; i < 9; ++i) { const int it = tid + 512 * i; tv[i] = (u32x4){0u, 0u, 0u, 0u}; if (it < TT * 2) tv[i] = *(const u32x4*)(ub + (size_t)(it >> 1) * DIN + 8 * (it & 1)); }
#pragma unroll
      for (int i = 0; i < 9; ++i) { const int it = tid + 512 * i; if (it < TT * 2) { const int t = it >> 1; *(LAS u32x4*)(Us + (t >> 4) * 264 + (t & 15) * 16 + 8 * (it & 1)) = tv[i]; } } }
    __syncthreads();
    { const bf16_t* W = (const bf16_t*)(p.ws + W_W1) + (size_t)g * 128 * 256; bf16x8 Bf[8];
#pragma unroll
      for (int kk = 0; kk < 8; ++kk) Bf[kk] = *(const bf16x8*)(W + (size_t)(16 * wid + n) * 256 + 32 * kk + 8 * q);
#pragma unroll 1
      for (int rt = 0; rt < 9; ++rt) { const int k = 16 * rt + n; const bool valid = k < NCHUNK; const int kc = valid ? k : 0; f32x4 acc = {0.f, 0.f, 0.f, 0.f};
#pragma unroll
          for (int kk = 0; kk < 8; ++kk) { const bf16x8 uv = *(const LAS bf16x8*)(Us + kc * 264 + 32 * kk + 8 * q); const bf16x8 Af = valid ? uv : zero;
              acc = __builtin_amdgcn_mfma_f32_16x16x32_bf16(Af, Bf[kk], acc, 0, 0, 0); }
#pragma unroll
          for (int j = 0; j < 4; ++j) Ssm[(16 * rt + 4 * q + j) * 128 + 16 * wid + n] = acc[j]; } }
    __syncthreads();
    if (wid == 0) { const float* a16 = (const float*)(p.ws + W_A16) + (g * 64 + lane) * 2; const float ar = a16[0], ai = a16[1]; float hr = 0.f, hi = 0.f;
#pragma unroll 1
        for (int kb = 0; kb < 132; kb += 4) { float sr[4], si[4];
#pragma unroll
            for (int u = 0; u < 4; ++u) { sr[u] = Ssm[(kb + u) * 128 + lane]; si[u] = Ssm[(kb + u) * 128 + 64 + lane]; }
            LDS_WAIT();
#pragma unroll
            for (int u = 0; u < 4; ++u) { const int k = kb + u; if (k < NCHUNK) { Hs[k * 136 + lane] = f2bf(hr); Hs[k * 136 + 64 + lane] = f2bf(hi);
                const float nr = ar * hr - ai * hi + sr[u], ni = ar * hi + ai * hr + si[u]; hr = nr; hi = ni; } } }
        p.out[O_PSR + ((size_t)b * NG + g) * 64 + lane] = hr; p.out[O_PSI + ((size_t)b * NG + g) * 64 + lane] = hi; }
    __syncthreads();
#pragma unroll 1
    for (int i = 0; i < 2; ++i) { const bf16_t* W = (const bf16_t*)(p.ws + W_W2) + (size_t)g * 256 * 384; bf16x8 Bf[12];
#pragma unroll
      for (int kk = 0; kk < 12; ++kk) Bf[kk] = *(const bf16x8*)(W + (size_t)(16 * (2 * wid + i) + n) * 384 + 32 * kk + 8 * q);
#pragma unroll 1
      for (int rt = 0; rt < 9; ++rt) { const int k = 16 * rt + n; const bool valid = k < NCHUNK; const int kc = valid ? k : 0; f32x4 acc = {0.f, 0.f, 0.f, 0.f};
#pragma unroll
          for (int kk = 0; kk < 8; ++kk) { const bf16x8 uv = *(const LAS bf16x8*)(Us + kc * 264 + 32 * kk + 8 * q); acc = __builtin_amdgcn_mfma_f32_16x16x32_bf16(valid ? uv : zero, Bf[kk], acc, 0, 0, 0); }
#pragma unroll
          for (int kk = 8; kk < 12; ++kk) { const bf16x8 hv = *(const LAS bf16x8*)(Hs + kc * 136 + 32 * (kk - 8) + 8 * q); acc = __builtin_amdgcn_mfma_f32_16x16x32_bf16(valid ? hv : zero, Bf[kk], acc, 0, 0, 0); }
#pragma unroll
          for (int j = 0; j < 4; ++j) { const int k2 = 16 * rt + 4 * q + j; if (k2 < NCHUNK) ((bf16_t*)(p.ws + W_YSG))[(size_t)(b * TT + 16 * k2 + 2 * wid + i) * DSSM + 16 * g + n] = f2bf(gelu_tanh(acc[j])); } } }
    __syncthreads();
}
__device__ __forceinline__ void s5_sample(const P& p, int s, int g, int lane) {
    const bf16_t* proj = (const bf16_t*)(p.ws + W_PROJ); const bf16_t* up = proj + (size_t)(MP + s) * DIN + C_US + 16 * g;
    const u32x4 u0 = *(const u32x4*)up, u1 = *(const u32x4*)(up + 8); float u[16];
    u[0] = bflo(u0.x); u[1] = bfhi(u0.x); u[2] = bflo(u0.y); u[3] = bfhi(u0.y); u[4] = bflo(u0.z); u[5] = bfhi(u0.z); u[6] = bflo(u0.w); u[7] = bfhi(u0.w);
    u[8] = bflo(u1.x); u[9] = bfhi(u1.x); u[10] = bflo(u1.y); u[11] = bfhi(u1.y); u[12] = bflo(u1.z); u[13] = bfhi(u1.z); u[14] = bflo(u1.w); u[15] = bfhi(u1.w);
    const float* a1 = (const float*)(p.ws + W_A1) + (g * 64 + lane) * 2; const float ar = a1[0], ai = a1[1];
    const float* bb = (const float*)(p.ws + W_BBAR) + (size_t)(g * 64 + lane) * 32; float bur = 0.f, bui = 0.f;
#pragma unroll
    for (int c = 0; c < 16; ++c) { bur += bb[2 * c] * u[c]; bui += bb[2 * c + 1] * u[c]; }
    const size_t si = ((size_t)s * NG + g) * 64 + lane; const float h0r = p.in[I_SSR][si], h0i = p.in[I_SSI][si];
    const float hr = ar * h0r - ai * h0i + bur, hi = ar * h0i + ai * h0r + bui;
    p.out[O_SSR + si] = hr; p.out[O_SSI + si] = hi;
    float v16[16];
#pragma unroll
    for (int c1 = 0; c1 < 16; ++c1) v16[c1] = p.in[I_SCRE][(g * 16 + c1) * 64 + lane] * hr - p.in[I_SCIM][(g * 16 + c1) * 64 + lane] * hi;
    float v8[8], v4[4], v2[2], v1;
    { const bool hi32 = (lane & 32) != 0;
#pragma unroll
      for (int i = 0; i < 8; ++i) { const float keep = hi32 ? v16[i + 8] : v16[i], send = hi32 ? v16[i] : v16[i + 8]; v8[i] = keep + __shfl_xor(send, 32); } }
    { const bool hb = (lane & 16) != 0;
#pragma unroll
      for (int i = 0; i < 4; ++i) { const float keep = hb ? v8[i + 4] : v8[i], send = hb ? v8[i] : v8[i + 4]; v4[i] = keep + __shfl_xor(send, 16); } }
    { const bool hb = (lane & 8) != 0;
#pragma unroll
      for (int i = 0; i < 2; ++i) { const float keep = hb ? v4[i + 2] : v4[i], send = hb ? v4[i] : v4[i + 2]; v2[i] = keep + __shfl_xor(send, 8); } }
    { const bool hb = (lane & 4) != 0; const float keep = hb ? v2[1] : v2[0], send = hb ? v2[0] : v2[1]; v1 = keep + __shfl_xor(send, 4); }
    v1 += __shfl_xor(v1, 1); v1 += __shfl_xor(v1, 2);
    const int c1 = ((lane >> 5) & 1) * 8 + ((lane >> 4) & 1) * 4 + ((lane >> 3) & 1) * 2 + ((lane >> 2) & 1);
    if ((lane & 3) == 0) { const float uc = bf2f(up[c1]); const float yv = v1 + p.in[I_SD][g * 16 + c1] * uc;
        ((bf16_t*)(p.ws + W_YSG))[(size_t)(MP + s) * DSSM + 16 * g + c1] = f2bf(gelu_tanh(yv)); }
}
__device__ __forceinline__ void phase2a(const P& p, LAS unsigned char* lds) {
    for (int u = blockIdx.x; u < 512; u += gridDim.x) lru_unit<0>(p, lds, (u >> 3) & 7, u >> 6, u & 7);
    const int lane = threadIdx.x & 63, wid = threadIdx.x >> 6;
    for (int it = blockIdx.x; it < NG * NBATCH; it += gridDim.x) s5_fused(p, lds, it & 31, it >> 5);
}
__device__ __forceinline__ void phase2b(const P& p, LAS unsigned char* lds) {
    const int tid = threadIdx.x, lane = tid & 63, wid = tid >> 6;
    const size_t gt = (size_t)blockIdx.x * 512 + tid, GT = (size_t)gridDim.x * 512;
    for (size_t i = gt; i < (size_t)NBATCH * 1024; i += GT) { const int b = (int)(i >> 10), c = (int)(i & 1023); float h = 0.f;
        const float* A = (const float*)(p.ws + W_LRUA); const float* Hh = (const float*)(p.ws + W_LRUH); float* Cc = (float*)(p.ws + W_LRUC);
        for (int kc = 0; kc < 8; ++kc) { const size_t o = (size_t)(b * 8 + kc) * 1024 + c; Cc[o] = h; h = A[o] * h + Hh[o]; }
        p.out[O_PL + i] = h; }
    for (int u = (int)gridDim.x - 1 - (int)blockIdx.x; u < 64; u += gridDim.x) lru_unit<2>(p, lds, 0, u >> 3, u & 7);
    for (int it = blockIdx.x * 8 + wid; it < NSAMP * NG; it += gridDim.x * 8) s5_sample(p, it >> 5, it & 31, lane);
    const bf16_t* proj = (const bf16_t*)(p.ws + W_PROJ);
    for (size_t i = gt; i < (size_t)NBATCH * 3 * 1024; i += GT) { const int c = (int)(i & 1023), j = (int)((i >> 10) % 3), b = (int)(i / 3072);
        p.out[O_PCL + i] = bf2f(proj[(size_t)(b * TT + TT - 3 + j) * DIN + c]); }
    for (size_t i = gt; i < (size_t)NSAMP * 3 * 1024; i += GT) { const int c = (int)(i & 1023), j = (int)((i >> 10) % 3), s = (int)(i / 3072);
        p.out[O_SCL + i] = (j < 2) ? p.in[I_CCL][((size_t)s * 3 + j + 1) * 1024 + c] : bf2f(proj[(size_t)(MP + s) * DIN + c]); }
    for (size_t i = gt; i < (size_t)NSAMP * DFF; i += GT) { const int ch = (int)(i % DFF), s = (int)(i / DFF);
        p.out[O_SCF + ((size_t)s * 2) * DFF + ch] = p.in[I_CCF][((size_t)s * 2 + 1) * DFF + ch]; }
}
__device__ __forceinline__ void phase2c(const P& p, LAS unsigned char* lds) {
    const int lane = threadIdx.x & 63, wid = threadIdx.x >> 6;
    for (int it = blockIdx.x; it < NG * 8; it += gridDim.x) s5_item<3>(p, it >> 3, it & 7, lane, wid);
}
__device__ __forceinline__ void phase_ln1(const P& p) {
    const int lane = threadIdx.x & 63, wid = threadIdx.x >> 6; const int gw = blockIdx.x * 8 + wid, NGW = gridDim.x * 8;
    const float* R = (const float*)(p.ws + W_R1); bf16_t* X = (bf16_t*)(p.ws + W_XN);
    for (int r = gw; r < 16384; r += 2 * NGW) { const int r2 = r + NGW; const bool vb = r2 < 16384; const int rb = vb ? r2 : r;
        ln_rows2<true>(R + (size_t)r * DM, R + (size_t)rb * DM, p.in[I_L1G], p.in[I_L1B], X + (size_t)r * DM, X + (size_t)rb * DM, lane, vb); }
    for (int r = 16384 + gw; r < MTOK; r += NGW) { bf16_t* xr = X + (size_t)r * DM;
        ln_row<true>((const float*)(p.ws + W_PART) + (size_t)(r - 16384) * DM, p.in[I_L1G], p.in[I_L1B], xr, lane, 4, xr, p.in[I_BOUT]); }
}
__device__ __forceinline__ void phase_ffnfix(const P& p) {
    const size_t gt = (size_t)blockIdx.x * 512 + threadIdx.x, GT = (size_t)gridDim.x * 512;
    const float* sbg = (const float*)(p.ws + W_SBG); const float* sbv = (const float*)(p.ws + W_SBV); bf16_t* H = (bf16_t*)(p.ws + W_V);
    for (size_t it = gt; it < (size_t)258 * 2 * 384; it += GT) { const int cg8 = (int)(it % 384), rr = (int)((it / 384) & 1), blk = (int)(it / 768), ch = cg8 * 8, row = blk * 64 + rr; const int t = row % TT;
        float o[8];
#pragma unroll
        for (int hh = 0; hh < 2; ++hh) { const int c = ch + 4 * hh; const f32x4 z = {0.f, 0.f, 0.f, 0.f};
            const f32x4 g0 = *(const f32x4*)(sbg + ((size_t)blk * 4 + rr) * DFF + c), v = *(const f32x4*)(sbv + ((size_t)blk * 2 + rr) * DFF + c);
            f32x4 g1, g2;
            if (rr == 0) { g1 = (blk > 0 && t >= 1) ? *(const f32x4*)(sbg + ((size_t)(blk - 1) * 4 + 3) * DFF + c) : z; g2 = (blk > 0 && t >= 2) ? *(const f32x4*)(sbg + ((size_t)(blk - 1) * 4 + 2) * DFF + c) : z; }
            else { g1 = (t >= 1) ? *(const f32x4*)(sbg + ((size_t)blk * 4) * DFF + c) : z; g2 = (blk > 0 && t >= 2) ? *(const f32x4*)(sbg + ((size_t)(blk - 1) * 4 + 3) * DFF + c) : z; }
            const f32x4 w0 = *(const f32x4*)(p.in[I_FCW] + c), w1 = *(const f32x4*)(p.in[I_FCW] + DFF + c), w2 = *(const f32x4*)(p.in[I_FCW] + 2 * DFF + c), cbv = *(const f32x4*)(p.in[I_FCB] + c);
            const f32x4 y = cbv + w0 * g2 + w1 * g1 + w2 * g0;
            o[4 * hh] = gelu_tanh(y[0]) * v[0]; o[4 * hh + 1] = gelu_tanh(y[1]) * v[1]; o[4 * hh + 2] = gelu_tanh(y[2]) * v[2]; o[4 * hh + 3] = gelu_tanh(y[3]) * v[3]; }
        u32x4 w; w.x = cvt_pk_bf16(o[0], o[1]); w.y = cvt_pk_bf16(o[2], o[3]); w.z = cvt_pk_bf16(o[4], o[5]); w.w = cvt_pk_bf16(o[6], o[7]);
        *(u32x4*)(H + (size_t)row * DFF + ch) = w; }
}
__device__ __forceinline__ float* y_row(const P& p, int r) {
    if (r >= MP) return p.out + O_YS + (size_t)(r - MP) * DM;
    const int b = r / TT, t = r - b * TT; return t < 16 ? nullptr : p.out + O_YP + ((size_t)b * 2048 + (t - 16)) * DM;
}
__device__ __forceinline__ void phase_ln2(const P& p) {
    const int lane = threadIdx.x & 63, wid = threadIdx.x >> 6; const int gw = blockIdx.x * 8 + wid, NGW = gridDim.x * 8;
    const float* R = (const float*)(p.ws + W_R2);
    for (int r = gw; r < 16384; r += 2 * NGW) { const int r2 = r + NGW; float* oa = y_row(p, r); float* ob = (r2 < 16384) ? y_row(p, r2) : nullptr;
        if (oa && ob) ln_rows2<false>(R + (size_t)r * DM, R + (size_t)r2 * DM, p.in[I_L2G], p.in[I_L2B], oa, ob, lane, true);
        else if (oa) ln_row<false>(R + (size_t)r * DM, p.in[I_L2G], p.in[I_L2B], oa, lane);
        else if (ob) ln_row<false>(R + (size_t)r2 * DM, p.in[I_L2G], p.in[I_L2B], ob, lane); }
    for (int r = 16384 + gw; r < MTOK; r += NGW) { float* o = y_row(p, r);
        if (o) ln_row<false>((const float*)(p.ws + W_PART) + (size_t)(r - 16384) * DM, p.in[I_L2G], p.in[I_L2B], o, lane, 12, (const bf16_t*)(p.ws + W_XN) + (size_t)r * DM, p.in[I_BDOWN]); }
}

__global__ __launch_bounds__(512, 2) void hawk_fwd(P p) {
    extern __shared__ __attribute__((aligned(16))) unsigned char shm[];
    LAS unsigned char* lds = (LAS unsigned char*)shm;
    cg::grid_group grid = cg::this_grid();
    volatile LAS unsigned* xst = (volatile LAS unsigned*)(lds + LDS_TOTAL - 16);
    if (threadIdx.x < 4) xst[threadIdx.x] = 0u;
    __syncthreads();
    XcdBarrier xb = xcd_barrier_post((unsigned*)(p.ws + W_BAR), xst);
#define GSYNC() xcd_barrier(xb)
    if (p.ws == nullptr) grid.sync();
    REPEAT(REP_P0) { phase0(p, lds); GSYNC(); }
    REPEAT(REP_P1) { EpiProj E; E.O = (bf16_t*)(p.ws + W_PROJ); E.bias = p.in[I_BIN]; run_gemm(lds, (const bf16_t*)(p.ws + W_XN), (const bf16_t*)(p.ws + W_WTIN), DIN, 1024, E);
        { const int G = (int)gridDim.x, nun = (MTOK / 256) * (DIN / 256), rem = nun % G; const int c = (int)blockIdx.x;
          if (c >= rem) transposes<1>(p, (LAS float*)(lds + (threadIdx.x >> 6) * 8704), threadIdx.x & 63, (c - rem) * 8 + (int)(threadIdx.x >> 6), (G - rem) * 8); }
        GSYNC(); }
    REPEAT(REP_P2A) { phase2a(p, lds); GSYNC(); }
    REPEAT(REP_P2B) { phase2b(p, lds); GSYNC(); }
    { EpiGlu E; E.mix = (bf16_t*)(p.ws + W_MIX); E.m2 = (const bf16_t*)(p.out + O_YP); E.carry = (const float*)(p.ws + W_LRUC); E.proj = (const bf16_t*)(p.ws + W_PROJ); E.bias = p.in[I_BGLU]; run_gemm(lds, (const bf16_t*)(p.ws + W_YSG), (const bf16_t*)(p.ws + W_WTGLU), 2048, 512, E); }
    GSYNC();
    REPEAT(REP_P4) { EpiRes E; E.R = (float*)(p.ws + W_R1); E.X = (const bf16_t*)(p.ws + W_XN); E.bias = p.in[I_BOUT]; E.part = (float*)(p.ws + W_PART); run_gemm_split(lds, (const bf16_t*)(p.ws + W_MIX), (const bf16_t*)(p.ws + W_WTOUT), 1024, 4, E); GSYNC(); }
    REPEAT(REP_P5) { phase_ln1(p); GSYNC(); }
    REPEAT(REP_P6) { EpiUp E; E.H = (bf16_t*)(p.ws + W_V); E.bias = p.in[I_BUP]; E.out = p.out; E.cw = p.in[I_FCW]; E.cb = p.in[I_FCB]; E.cache = p.in[I_CCF]; E.sbg = (float*)(p.ws + W_SBG); E.sbv = (float*)(p.ws + W_SBV); run_gemm(lds, (const bf16_t*)(p.ws + W_XN), (const bf16_t*)(p.ws + W_WTUP), 6144, 1024, E); GSYNC(); }
    phase_ffnfix(p);
    GSYNC();
    REPEAT(REP_P8) { EpiRes E; E.R = (float*)(p.ws + W_R2); E.X = (const bf16_t*)(p.ws + W_XN); E.bias = p.in[I_BDOWN]; E.part = (float*)(p.ws + W_PART); run_gemm_split(lds, (const bf16_t*)(p.ws + W_V), (const bf16_t*)(p.ws + W_WTDOWN), 3072, 12, E); GSYNC(); }
    REPEAT(REP_P9) phase_ln2(p);
}

extern "C" void kernel_launch(void* const* d_in, const int* in_sizes, int n_in, void* d_out, int out_size, void* d_ws, size_t ws_size, hipStream_t stream) {
    constexpr int LDS_BYTES = LDS_TOTAL;
    static int grid = 0;
    if (grid == 0) {
        if (n_in != N_IN || (size_t)out_size != O_END || ws_size < 268435456ull) { fprintf(stderr, "kernel_launch: unexpected shapes (n_in %d out %d ws %zu)\n", n_in, out_size, ws_size); grid = -1; return; }
        int dev = 0, cus = 0, per_cu = 0;
        if (hipGetDevice(&dev) != hipSuccess || hipDeviceGetAttribute(&cus, hipDeviceAttributeMultiprocessorCount, dev) != hipSuccess) { grid = -1; return; }
        if (hipFuncSetAttribute((const void*)hawk_fwd, hipFuncAttributeMaxDynamicSharedMemorySize, LDS_BYTES) != hipSuccess) { fprintf(stderr, "kernel_launch: hipFuncSetAttribute failed\n"); grid = -1; return; }
        if (hipOccupancyMaxActiveBlocksPerMultiprocessor(&per_cu, (const void*)hawk_fwd, 512, LDS_BYTES) != hipSuccess || per_cu < 1) { fprintf(stderr, "kernel_launch: occupancy query failed (%d)\n", per_cu); grid = -1; (void)hipGetLastError(); return; }
        grid = cus * per_cu;
    }
    if (grid < 0) return;
    if (hipMemsetAsync((char*)d_ws + W_BAR, 0, XCD_BAR_WORDS * 4, stream) != hipSuccess) { fprintf(stderr, "kernel_launch: memset failed\n"); return; }
    P p{};
    for (int i = 0; i < N_IN; ++i) p.in[i] = (const float*)d_in[i];
    p.out = (float*)d_out; p.ws = (unsigned char*)d_ws;
    void* args[] = {&p};
    hipError_t e = hipLaunchCooperativeKernel((const void*)hawk_fwd, dim3(grid), dim3(512), args, LDS_BYTES, stream);
    if (e != hipSuccess) fprintf(stderr, "cooperative launch failed: %s (grid %d)\n", hipGetErrorString(e), grid);
}
```

```cpp
#include <hip/hip_runtime.h>
#include <hip/hip_cooperative_groups.h>
#include <cstdio>
#include <cstdint>
namespace cg = cooperative_groups;
#define REP_P0 1
#define REP_P0A 1
#define REP_P0B 1
#define REP_P0C 1
#define REP_P1 1
#define REP_P3 1
#define REP_P2A 1
#define REP_P2B 1
#define REP_P2C 1
#define REP_P4 1
#define REP_P5 1
#define REP_P6 1
#define REP_P8 1
#define REP_P9 1
#define PROBE_PHASE -1
namespace pg8 {
#define PG8_LAS __attribute__((address_space(3)))
typedef unsigned short bf16_t;
typedef short bf16x8 __attribute__((ext_vector_type(8)));
typedef float f32x4 __attribute__((ext_vector_type(4)));
typedef unsigned u32x4 __attribute__((ext_vector_type(4)));
constexpr int BM = 256, BK = 64, HALF = 128, HTB = HALF * BK * 2  , STAGE_BYTES = 8 * HTB, NXCD = 8, WGM = 8;

__host__ __device__ __forceinline__ int lds_byte(int r, int c) { const int st = (r >> 4) * 2 + (c >> 5), rr = r & 15, cc = c & 31, ob = rr * 64 + cc * 2; return st * 1024 + (ob ^ (((ob >> 9) & 1) << 5)); }
__host__ __device__ __forceinline__ void stage_rc(int b, int& R, int& C) { const int st = b / 1024, sb = b % 1024, swz = sb ^ (((sb >> 9) & 1) << 5); R = (st >> 1) * 16 + swz / 64; C = (st & 1) * 32 + (swz % 64) / 2; }
__host__ __device__ __forceinline__ int perm32(int rho) { const int n = rho >> 4, i = rho & 15; return 8 * (i >> 2) + 4 * n + (i & 3); }

struct Unit { int pm, pn, k0, nt, ks; };
struct Gemm { const bf16_t* A; const bf16_t* Bt; int M, N, K; };

struct StaticOrder {
    int nM, nN, nwg, G, c, ntk;
    __host__ __device__ void init(int M, int N, int K, int G_, int c_) { nM = M / BM; nN = N / BM; nwg = nM * nN; G = G_; c = c_; ntk = K / BK; }
    __host__ __device__ bool next(int i, Unit& u) const {
        const long L = (long)i * G + c; if (L >= nwg) return false;
        int wgid = (int)L; { const int q = nwg / NXCD, r = nwg % NXCD, xcd = wgid % NXCD, off = wgid / NXCD; wgid = (xcd < r ? xcd * (q + 1) : r * (q + 1) + (xcd - r) * q) + off; }
        const int nig = WGM * nN, gid = wgid / nig, fm = gid * WGM, gsz = (nM - fm) < WGM ? (nM - fm) : WGM;
        u.pm = fm + ((wgid % nig) % gsz); u.pn = (wgid % nig) / gsz; u.k0 = 0; u.nt = ntk; u.ks = -1; return true;
    }
    __device__ __forceinline__ void a_ready(const Unit&) const {}
    __device__ __forceinline__ void done(const Unit&) const {}
};
struct TailOrder {
    int nN, ntk, nsplit, G, c;
    __host__ __device__ void init(int N, int K, int nsplit_, int G_, int c_) { nN = N / BM; ntk = K / BK; nsplit = nsplit_; G = G_; c = c_; }
    __host__ __device__ bool next(int i, Unit& u) const {
        const long L = (long)i * G + c; const bool ok = L < (long)nN * nsplit; const int ks = (int)(L / nN), ntp = ntk / nsplit;
        u.pm = 64; u.pn = (int)(L % nN); u.ks = ks; u.nt = ntp; u.k0 = ks * ntp * BK; return ok;
    }
    __device__ __forceinline__ void a_ready(const Unit&) const {}
    __device__ __forceinline__ void done(const Unit&) const {}
};
struct SplitOrder {
    StaticOrder base; int nsplit;
    __host__ __device__ void init(int N, int K, int nsplit_, int G_, int c_) { base.init(64 * BM, N, K, G_, c_); nsplit = nsplit_; }
    __host__ __device__ bool next(int i, Unit& u) const {
        Unit t; t.pm = 0; t.pn = 0; t.k0 = 0; t.nt = base.ntk; t.ks = -1;
        const bool ok = base.next(i, t);
        const long L = (long)i * base.G + base.c - base.nwg; const bool sp = (!ok) && L >= 0 && L < (long)base.nN * nsplit;
        const int ks = (int)(L / base.nN), pn = (int)(L % base.nN), ntp = base.ntk / nsplit;
        u.pm = sp ? 64 : t.pm; u.pn = sp ? pn : t.pn; u.ks = sp ? ks : -1; u.nt = sp ? ntp : t.nt; u.k0 = sp ? ks * ntp * BK : 0;
        return ok || sp;
    }
    __device__ __forceinline__ void a_ready(const Unit&) const {}
    __device__ __forceinline__ void done(const Unit&) const {}
};
__device__ __forceinline__ unsigned cvt_pk_bf16(float lo, float hi) { unsigned r; asm volatile("v_cvt_pk_bf16_f32 %0, %1, %2" : "=v"(r) : "v"(lo), "v"(hi)); return r; }
template <class Epi, class Sched, bool STAMP = false>
__device__ __forceinline__ void gemm_phase(PG8_LAS unsigned char* lds, const Gemm g, const Sched& S, const Epi& E, unsigned long long* stamps) {
    int tid_ = threadIdx.x; asm volatile("" : "+v"(tid_)); const int tid = tid_, wid = __builtin_amdgcn_readfirstlane(tid >> 6), lane = tid & 63, wr = wid >> 2, wc = wid & 3, fr = lane & 15, fq = lane >> 4;
    const int K = g.K;
    int ts_lo = 0, ts_hi = 0, nts = 0; const unsigned long long rt_entry = STAMP ? (unsigned long long)wall_clock64() : 0ull;
#define PG8_STAMP() do { if (STAMP && wid == 0 && nts < 64) { const unsigned long long _c = (unsigned long long)clock64(); \
        ts_lo = (lane == nts) ? (int)(unsigned)_c : ts_lo; ts_hi = (lane == nts) ? (int)(unsigned)(_c >> 32) : ts_hi; ++nts; } } while (0)
    PG8_STAMP();
    unsigned voffA[2], voffB[2];
#pragma unroll
    for (int i = 0; i < 2; ++i) { int R, C; stage_rc(tid * 16 + i * 8192, R, C); const int Rb = Epi::PERM ? ((R & ~31) + perm32(R & 31)) : R;
        voffA[i] = (unsigned)(R * K + C) * 2u; voffB[i] = (unsigned)(Rb * K + C) * 2u; }
    const size_t kstep = (size_t)(BK * 2);
    const size_t hstep = (size_t)HALF * K * 2;
    const size_t tstep = 2 * hstep;
    const unsigned ldsw = (unsigned)wid * 1024u;
    const int aoff = lds_byte(wr * 64 + fr, fq * 8), boff = lds_byte(wc * 32 + fr, fq * 8);
#define PG8_SA(b, h) (((b) * 2 + (h)) * HTB)
#define PG8_SB(b, h) ((4 + (b) * 2 + (h)) * HTB)
#define PG8_STAGE(bufoff, gbase, voff) do { _Pragma("unroll") for (int _i = 0; _i < 2; ++_i) \
        __builtin_amdgcn_global_load_lds((const unsigned*)((const char*)(gbase) + (voff)[_i]), (PG8_LAS unsigned*)(lds + (bufoff) + ldsw + _i * 8192), 16, 0, 0); } while (0)
#define PG8_LDA(dst, b, h) do { _Pragma("unroll") for (int m = 0; m < 4; ++m) _Pragma("unroll") for (int k = 0; k < 2; ++k) dst[m][k] = *(const PG8_LAS bf16x8*)(lds + PG8_SA(b, h) + aoff + m * 2048 + k * 1024); } while (0)
#define PG8_LDB(dst, b, h) do { _Pragma("unroll") for (int n = 0; n < 2; ++n) _Pragma("unroll") for (int k = 0; k < 2; ++k) dst[n][k] = *(const PG8_LAS bf16x8*)(lds + PG8_SB(b, h) + boff + n * 2048 + k * 1024); } while (0)
#define PG8_MMA(ai, bj, At, Bt) do { __builtin_amdgcn_s_setprio(1); _Pragma("unroll") for (int m = 0; m < 4; ++m) _Pragma("unroll") for (int n = 0; n < 2; ++n) _Pragma("unroll") for (int k = 0; k < 2; ++k) \
        acc[ai][bj][m][n] = __builtin_amdgcn_mfma_f32_16x16x32_bf16(Bt[n][k], At[m][k], acc[ai][bj][m][n], 0, 0, 0); __builtin_amdgcn_s_setprio(0); } while (0)
#define PG8_WAIT_V(n) asm volatile("s_waitcnt vmcnt(" #n ")" ::: "memory")
#define PG8_WAIT_L(n) asm volatile("s_waitcnt lgkmcnt(" #n ")" ::: "memory")
#define PG8_BAR __builtin_amdgcn_s_barrier()
#define PG8_SCHED __builtin_amdgcn_sched_barrier(0)
    Unit cur, nxt; int ui = 0;
    if (!S.next(0, cur)) return;
    f32x4 acc[2][2][4][2];
#pragma unroll
    for (int a = 0; a < 2; ++a)
#pragma unroll
        for (int b = 0; b < 2; ++b)
#pragma unroll
            for (int m = 0; m < 4; ++m)
#pragma unroll
                for (int n = 0; n < 2; ++n) acc[a][b][m][n] = (f32x4){0.f, 0.f, 0.f, 0.f};
    bf16x8 At[4][2], B0[2][2], B1[2][2];
    const char* cA = (const char*)g.A + (size_t)cur.pm * tstep + (size_t)cur.k0 * 2; const char* cB = (const char*)g.Bt + (size_t)cur.pn * tstep + (size_t)cur.k0 * 2;
    S.a_ready(cur);
    PG8_STAGE(PG8_SB(0, 0), cB, voffB); PG8_STAGE(PG8_SA(0, 0), cA, voffA); PG8_STAGE(PG8_SB(0, 1), cB + hstep, voffB); PG8_STAGE(PG8_SA(0, 1), cA + hstep, voffA);
    if (wr == 1) PG8_BAR;
    PG8_WAIT_V(4); PG8_BAR;
    PG8_STAGE(PG8_SB(1, 0), cB + kstep, voffB); PG8_STAGE(PG8_SA(1, 0), cA + kstep, voffA); PG8_STAGE(PG8_SB(1, 1), cB + hstep + kstep, voffB);
    PG8_WAIT_V(6); PG8_BAR;
    PG8_STAMP();
    for (;;) {
        const bool has_next = S.next(ui + 1, nxt);
        const char* nA = has_next ? (const char*)g.A + (size_t)nxt.pm * tstep + (size_t)nxt.k0 * 2 : cA; const char* nB = has_next ? (const char*)g.Bt + (size_t)nxt.pn * tstep + (size_t)nxt.k0 * 2 : cB;
        const int nt = cur.nt;
        for (int t = 0; t < nt; t += 2) {
            const bool last = (t == nt - 2);
            const char* a1 = cA + (size_t)(t + 1) * kstep;
            const char* a2 = last ? nA : cA + (size_t)(t + 2) * kstep; const char* b2 = last ? nB : cB + (size_t)(t + 2) * kstep;
            const char* a3 = a2 + kstep; const char* b3 = b2 + kstep;
            if (last && has_next) S.a_ready(nxt);
            PG8_LDB(B0, 0, 0); PG8_SCHED; PG8_LDA(At, 0, 0); PG8_STAGE(PG8_SA(1, 1), a1 + hstep, voffA);
            PG8_WAIT_L(8); PG8_BAR; PG8_WAIT_L(0); PG8_MMA(0, 0, At, B0); PG8_BAR; PG8_SCHED;
            PG8_LDB(B1, 0, 1); PG8_STAGE(PG8_SB(0, 0), b2, voffB);
            PG8_BAR; PG8_WAIT_L(0); PG8_MMA(0, 1, At, B1); PG8_BAR;
            PG8_LDA(At, 0, 1); PG8_STAGE(PG8_SA(0, 0), a2, voffA);
            PG8_BAR; PG8_WAIT_L(0); PG8_MMA(1, 0, At, B0); PG8_BAR; PG8_SCHED;
            PG8_STAGE(PG8_SB(0, 1), b2 + hstep, voffB);
            PG8_WAIT_V(6); PG8_BAR; PG8_MMA(1, 1, At, B1); PG8_BAR;
            PG8_LDB(B0, 1, 0); PG8_SCHED; PG8_LDA(At, 1, 0); PG8_STAGE(PG8_SA(0, 1), a2 + hstep, voffA);
            PG8_WAIT_L(8); PG8_BAR; PG8_WAIT_L(0); PG8_MMA(0, 0, At, B0); PG8_BAR; PG8_SCHED;
            PG8_LDB(B1, 1, 1); PG8_STAGE(PG8_SB(1, 0), b3, voffB);
            PG8_BAR; PG8_WAIT_L(0); PG8_MMA(0, 1, At, B1); PG8_BAR;
            PG8_LDA(At, 1, 1); PG8_STAGE(PG8_SA(1, 0), a3, voffA);
            PG8_BAR; PG8_WAIT_L(0); PG8_MMA(1, 0, At, B0); PG8_BAR; PG8_SCHED;
            PG8_STAGE(PG8_SB(1, 1), b3 + hstep, voffB);
            PG8_WAIT_V(6); PG8_BAR; PG8_MMA(1, 1, At, B1); PG8_BAR;
        }
        PG8_STAMP();
        if constexpr (!Epi::AFTER_DRAIN) { E(acc, cur, wr, wc, fr, fq); S.done(cur); }
        PG8_STAMP();
        if (!has_next) break;
#pragma unroll
        for (int a = 0; a < 2; ++a)
#pragma unroll
            for (int b = 0; b < 2; ++b)
#pragma unroll
                for (int m = 0; m < 4; ++m)
#pragma unroll
                    for (int n = 0; n < 2; ++n) acc[a][b][m][n] = (f32x4){0.f, 0.f, 0.f, 0.f};
        cur = nxt; cA = nA; cB = nB; ++ui;
    }
    PG8_WAIT_V(0);
    if (wr == 0) PG8_BAR;
    PG8_BAR;
    if constexpr (Epi::AFTER_DRAIN) { E.fused(acc, cur, wr, wc, fr, fq, lds, wid, lane); S.done(cur); }
    PG8_STAMP();
    if (STAMP && wid == 0) { stamps[lane] = lane < nts ? (((unsigned long long)(unsigned)ts_hi << 32) | (unsigned)ts_lo) : 0ull;
        if (lane == 62) stamps[62] = rt_entry; if (lane == 63) stamps[63] = (unsigned long long)wall_clock64(); }
#undef PG8_STAMP
#undef PG8_SA
#undef PG8_SB
#undef PG8_STAGE
#undef PG8_LDA
#undef PG8_LDB
#undef PG8_MMA
#undef PG8_WAIT_V
#undef PG8_WAIT_L
#undef PG8_BAR
#undef PG8_SCHED
}
}
using pg8::bf16_t; using pg8::bf16x8; using pg8::f32x4; using pg8::u32x4; using pg8::Unit; using pg8::cvt_pk_bf16;
#define LAS __attribute__((address_space(3)))
typedef unsigned u32x2 __attribute__((ext_vector_type(2)));
#define XB_TMO      128
#define XB_XCNT(j)  (256  + 64 * (j))
#define XB_XSUB(j)  (1280 + 64 * (j))
#define XB_XGEN(j)  (2304 + 64 * (j))
#define XB_TOP      3328
#define XB_TOPGEN   3392
#define XCD_BAR_WORDS 3456
#define XB_SPIN_CAP (1u << 18)

__device__ __forceinline__ unsigned xb_ld(unsigned* p)              { return __hip_atomic_load(p, __ATOMIC_RELAXED, __HIP_MEMORY_SCOPE_AGENT); }
__device__ __forceinline__ unsigned xb_add(unsigned* p, unsigned v) { return __hip_atomic_fetch_add(p, v, __ATOMIC_RELAXED, __HIP_MEMORY_SCOPE_AGENT); }
__device__ __forceinline__ unsigned xb_xcc_id() { return (unsigned)__builtin_amdgcn_s_getreg((3 << 11) | 20) & 0xFu; }
#define XB_SPIN(cond, bar) do { unsigned _sp = 0; while (cond) { __builtin_amdgcn_s_sleep(1); \
    if ((++_sp & 255u) == 0u) { if (xb_ld(&(bar)[XB_TMO])) break; if (_sp > XB_SPIN_CAP) { atomicAdd(&(bar)[XB_TMO], 1u); break; } } } } while (0)

struct XcdBarrier {
    unsigned* bar; unsigned x;
    volatile LAS unsigned* st;
};

__device__ __forceinline__ XcdBarrier xcd_barrier_post(unsigned* bar, volatile LAS unsigned* st) {
    XcdBarrier b; b.bar = bar; b.x = xb_xcc_id(); b.st = st;
    if (threadIdx.x == 0) (void)xb_add(&bar[XB_XCNT(b.x)], 1u);
    return b;
}
__device__ __forceinline__ void xcd_barrier_complete(unsigned* bar, unsigned x, unsigned& nloc, unsigned& nx) {
    const unsigned G = gridDim.x * gridDim.y * gridDim.z;
    unsigned sum, cnt, mine, sp = 0u;
    for (;;) {
        sum = 0u; cnt = 0u; mine = 0u;
#pragma unroll
        for (unsigned j = 0; j < 16; ++j) { const unsigned c = xb_ld(&bar[XB_XCNT(j)]); sum += c; cnt += (c > 0u) ? 1u : 0u; mine = (j == x) ? c : mine; }
        if (sum == G) break;
        __builtin_amdgcn_s_sleep(1);
        if ((++sp & 255u) == 0u) { if (xb_ld(&bar[XB_TMO])) break; if (sp > XB_SPIN_CAP) { atomicAdd(&bar[XB_TMO], 1u); break; } }
    }
    nloc = mine > 0u ? mine : 1u; nx = cnt > 0u ? cnt : 1u;
}

__device__ __forceinline__ void xcd_barrier(const XcdBarrier& b) {
    asm volatile("s_waitcnt vmcnt(0)" ::: "memory");
    __syncthreads();
    if (threadIdx.x == 0) {
        unsigned* bar = b.bar;
        __builtin_amdgcn_s_waitcnt(0);
        unsigned nloc = b.st[0], nx = b.st[1];
        if (nloc == 0u) { xcd_barrier_complete(bar, b.x, nloc, nx); b.st[0] = nloc; b.st[1] = nx; }
        const unsigned old = xb_add(&bar[XB_XSUB(b.x)], 1u);
        const unsigned gen = old / nloc;
        if (old + 1u == (gen + 1u) * nloc) {
            __builtin_amdgcn_fence(__ATOMIC_RELEASE, "agent");
            asm volatile("s_waitcnt vmcnt(0)" ::: "memory");
            const unsigned og = xb_add(&bar[XB_TOP], 1u);
            const unsigned tg = og / nx;
            if (og + 1u == (tg + 1u) * nx) xb_add(&bar[XB_TOPGEN], 1u);
            else XB_SPIN(xb_ld(&bar[XB_TOPGEN]) == tg, bar);
            __builtin_amdgcn_fence(__ATOMIC_ACQUIRE, "agent");
            xb_add(&bar[XB_XGEN(b.x)], 1u);
            asm volatile("s_waitcnt vmcnt(0)" ::: "memory");
        } else {
            XB_SPIN(xb_ld(&bar[XB_XGEN(b.x)]) == gen, bar);
            __builtin_amdgcn_fence(__ATOMIC_ACQUIRE, "agent");
            asm volatile("s_waitcnt vmcnt(0)" ::: "memory");
        }
    }
    __syncthreads();
}


constexpr int DM = 1024, NBATCH = 8, TT = 2064, NSAMP = 128, MP = NBATCH * TT  , MTOK = MP + NSAMP  ;
constexpr int DIN = 3584, DSSM = 512, DFF = 3072, NG = 32, NCHUNK = 129, NR = NBATCH * NCHUNK  ;
constexpr int C_US = 1024, C_GA = 1536, C_GB = 2560;
constexpr float ALPHA = 1.189207115002721f, LN_EPS = 1e-5f;
enum { I_XP = 0, I_XS, I_CCL, I_SL, I_SSR, I_SSI, I_CCF, I_META, I_EG, I_EB, I_WIN, I_BIN, I_CLW, I_CLB, I_WR, I_BR, I_WI, I_BI, I_LAM,
       I_SLRE, I_SLIM, I_SLDT, I_SBRE, I_SBIM, I_SCRE, I_SCIM, I_SD, I_WGLU, I_BGLU, I_WOUT, I_BOUT, I_L1G, I_L1B, I_WUP, I_BUP, I_FCW, I_FCB,
       I_WDOWN, I_BDOWN, I_L2G, I_L2B, N_IN };
constexpr size_t O_YP = 0, O_YS = 16777216, O_PCL = O_YS + 131072, O_PL = O_PCL + 24576, O_PSR = O_PL + 8192, O_PSI = O_PSR + 16384, O_PCF = O_PSI + 16384,
                 O_SCL = O_PCF + 49152, O_SL = O_SCL + 393216, O_SSR = O_SL + 131072, O_SSI = O_SSR + 262144, O_SCF = O_SSI + 262144, O_END = O_SCF + 786432;
constexpr size_t W_WTUP = 0, W_WTDOWN = W_WTUP + (size_t)6144 * 1024 * 2, W_XN = W_WTDOWN + (size_t)1024 * 3072 * 2, W_C = W_XN + (size_t)MTOK * 1024 * 2;
constexpr size_t W_PROJ = W_C, W_MIX = W_PROJ + (size_t)MTOK * DIN * 2, W_YSG = W_MIX + (size_t)MTOK * 1024 * 2, W_D = W_YSG + (size_t)MTOK * 512 * 2;
constexpr size_t W_WTGLU = W_D, W_WTOUT = W_WTGLU + (size_t)2048 * 512 * 2, W_WTR = W_WTOUT + (size_t)1024 * 1024 * 2, W_WTI = W_WTR + 262144, W_W1 = W_WTI + 262144,
                 W_W2 = W_W1 + (size_t)NG * 128 * 256 * 2, W_HPREV = W_W2 + (size_t)NG * 256 * 384 * 2, W_A1 = W_HPREV + (size_t)NR * NG * 128 * 2, W_A16 = W_A1 + 16384,
                 W_BBAR = W_A16 + 16384, W_LRUA = W_BBAR + 262144, W_LRUH = W_LRUA + 262144, W_LRUC = W_LRUH + 262144, W_S = W_LRUC + 262144, W_WTIN = W_S,
                 W_S_END = W_S + (size_t)NR * NG * 128 * 4;
constexpr size_t W_BAR = (W_S_END + 4095) / 4096 * 4096;
static_assert(W_BAR + (XCD_BAR_WORDS + 64 * 16) * 4 <= 268435456, "barrier words");
constexpr size_t W_PART = W_C + (size_t)MTOK * 1024 * 4;
constexpr size_t W_SBG = W_C, W_SBV = W_SBG + (size_t)260 * 4 * DFF * 4, W_SB_END = W_SBV + (size_t)260 * 2 * DFF * 4;
constexpr size_t W_PU = W_SB_END, W_PU_END = W_PU + (size_t)4 * 256 * 6144 * 4;
constexpr size_t W_R1 = W_C, W_G = W_C, W_V = W_G + (size_t)MTOK * DFF * 2, W_V_END = W_V + (size_t)MTOK * DFF * 2, W_R2 = W_C;
static_assert(W_S_END <= 268435456 && W_V_END <= 268435456, "workspace map exceeds 256 MiB");
static_assert(W_SB_END <= W_V && W_PU_END <= W_V, "side buffers / up partials overlap H");
static_assert(W_PART + (size_t)12 * 256 * 1024 * 4 <= W_MIX && W_PART + (size_t)12 * 256 * 1024 * 4 <= W_V, "r1 / partials overlap mix or v");

constexpr int LDS_TOTAL = 147456;
struct P { const float* in[N_IN]; float* out; unsigned char* ws; };

__device__ __forceinline__ float bf2f(unsigned short b) { return __uint_as_float(((unsigned)b) << 16); }
__device__ __forceinline__ float bflo(unsigned u) { return __uint_as_float(u << 16); }
__device__ __forceinline__ float bfhi(unsigned u) { return __uint_as_float(u & 0xffff0000u); }
__device__ __forceinline__ unsigned short f2bf(float f) { return (unsigned short)(cvt_pk_bf16(f, 0.f) & 0xffffu); }
__device__ __forceinline__ float sigm(float x) { return __builtin_amdgcn_rcpf(1.f + __expf(-x)); }
__device__ __forceinline__ float gelu_tanh(float x) { return x * sigm(1.5957691216057308f * (x + 0.044715f * x * x * x)); }
__device__ __forceinline__ float wave_sum(float v) {
#pragma unroll
    for (int o = 1; o < 64; o <<= 1) v += __shfl_xor(v, o);
    return v;
}
#define LDS_WAIT() asm volatile("s_waitcnt lgkmcnt(0)" ::: "memory")
#define REPEAT(N) for (int rep_ = 0; rep_ < (N); ++rep_)
#define TIMED(N) const unsigned long long tq0_##N = (PROBE_PHASE == (N)) ? __builtin_amdgcn_s_memrealtime() : 0ull;
#define TIMED_END(N) if (PROBE_PHASE == (N)) { const unsigned long long tq1 = __builtin_amdgcn_s_memrealtime(); while (__builtin_amdgcn_s_memrealtime() - tq1 < tq1 - tq0_##N) __builtin_amdgcn_s_sleep(4); }

struct EpiProj {
    static constexpr bool PERM = true, AFTER_DRAIN = false;
    bf16_t* O; const float* bias;
    __device__ __forceinline__ void operator()(const f32x4 (&acc)[2][2][4][2], const Unit& u, int wr, int wc, int fr, int fq) const {
        const int row0 = u.pm * 256 + wr * 64 + fr, col0 = u.pn * 256 + wc * 32 + 8 * fq;
#pragma unroll
        for (int bj = 0; bj < 2; ++bj) { const int col = col0 + bj * 128; const f32x4 b0 = *(const f32x4*)(bias + col), b1 = *(const f32x4*)(bias + col + 4);
#pragma unroll
            for (int ai = 0; ai < 2; ++ai)
#pragma unroll
                for (int m = 0; m < 4; ++m) { const f32x4 v0 = acc[ai][bj][m][0] + b0, v1 = acc[ai][bj][m][1] + b1; u32x4 w;
                    w.x = cvt_pk_bf16(v0[0], v0[1]); w.y = cvt_pk_bf16(v0[2], v0[3]); w.z = cvt_pk_bf16(v1[0], v1[1]); w.w = cvt_pk_bf16(v1[2], v1[3]);
                    *(u32x4*)(O + (size_t)(row0 + ai * 128 + m * 16) * DIN + col) = w; } }
    }
};
struct EpiGlu {
    static constexpr bool PERM = false, AFTER_DRAIN = false;
    bf16_t* mix; const bf16_t* m2; const float* carry; const bf16_t* proj; const float* bias;
    __device__ __forceinline__ void operator()(const f32x4 (&acc)[2][2][4][2], const Unit& u, int wr, int wc, int fr, int fq) const {
        const int row0 = u.pm * 256 + wr * 64 + fr, j0 = u.pn * 128 + wc * 32 + 4 * fq;
#pragma unroll
        for (int n = 0; n < 2; ++n) { const int j = j0 + n * 16; const f32x4 bv = *(const f32x4*)(bias + j), bg = *(const f32x4*)(bias + 1024 + j);
#pragma unroll
            for (int ai = 0; ai < 2; ++ai) { u32x2 gbw[4], mw[4], m2w[4]; f32x4 cv[4];
#pragma unroll
                for (int m = 0; m < 4; ++m) { const int rowi = row0 + ai * 128 + m * 16; const size_t row = (size_t)rowi; int cidx = 0;
                    if (rowi < MP) { const int b = rowi / TT, t = rowi - b * TT; int kc = t >> 8; kc = kc > 7 ? 7 : kc; cidx = (b * 8 + kc) * 1024; }
                    cv[m] = *(const f32x4*)(carry + cidx + j); gbw[m] = *(const u32x2*)(proj + row * DIN + C_GB + j); mw[m] = *(const u32x2*)(mix + row * 1024 + j); m2w[m] = *(const u32x2*)(m2 + row * 1024 + j); }
#pragma unroll
                for (int m = 0; m < 4; ++m) { const size_t row = (size_t)(row0 + ai * 128 + m * 16); const f32x4 val = acc[ai][0][m][n] + bv, gate = acc[ai][1][m][n] + bg;
                    const float o0 = bflo(mw[m].x) + bflo(m2w[m].x) * cv[m][0] + sigm(bflo(gbw[m].x)) * val[0] * sigm(gate[0]), o1 = bfhi(mw[m].x) + bfhi(m2w[m].x) * cv[m][1] + sigm(bfhi(gbw[m].x)) * val[1] * sigm(gate[1]);
                    const float o2 = bflo(mw[m].y) + bflo(m2w[m].y) * cv[m][2] + sigm(bflo(gbw[m].y)) * val[2] * sigm(gate[2]), o3 = bfhi(mw[m].y) + bfhi(m2w[m].y) * cv[m][3] + sigm(bfhi(gbw[m].y)) * val[3] * sigm(gate[3]);
                    u32x2 w; w.x = cvt_pk_bf16(o0, o1); w.y = cvt_pk_bf16(o2, o3); *(u32x2*)(mix + row * 1024 + j) = w; } } }
    }
};
struct EpiRes {
    static constexpr bool PERM = false, AFTER_DRAIN = false;
    float* R; const bf16_t* X; const float* bias; float* part;
    __device__ __forceinline__ void operator()(const f32x4 (&acc)[2][2][4][2], const Unit& u, int wr, int wc, int fr, int fq) const {
        const int row0 = u.pm * 256 + wr * 64 + fr, col0 = u.pn * 256 + wc * 32 + 4 * fq;
        const bool sp = u.ks >= 0; const float al = sp ? 0.f : ALPHA, bsc = sp ? 0.f : 1.f;
        float* Rb = sp ? part + ((size_t)u.ks * 256 - 16384) * 1024 : R;
#pragma unroll
        for (int bj = 0; bj < 2; ++bj)
#pragma unroll
            for (int n = 0; n < 2; ++n) { const int col = col0 + bj * 128 + n * 16; const f32x4 bv = *(const f32x4*)(bias + col) * bsc;
#pragma unroll
                for (int ai = 0; ai < 2; ++ai) { u32x2 xw[4];
#pragma unroll
                    for (int m = 0; m < 4; ++m) xw[m] = *(const u32x2*)(X + (size_t)(row0 + ai * 128 + m * 16) * 1024 + col);
#pragma unroll
                    for (int m = 0; m < 4; ++m) { const size_t off = (size_t)(row0 + ai * 128 + m * 16) * 1024 + col;
                        f32x4 v = acc[ai][bj][m][n] + bv; v[0] += al * bflo(xw[m].x); v[1] += al * bfhi(xw[m].x); v[2] += al * bflo(xw[m].y); v[3] += al * bfhi(xw[m].y);
                        *(f32x4*)(Rb + off) = v; } } }
    }
};
__device__ __forceinline__ float rot1(float x) { return __int_as_float(__builtin_amdgcn_update_dpp(0, __float_as_int(x), 0x121, 0xf, 0xf, false)); }
__device__ __forceinline__ float rot2(float x) { return __int_as_float(__builtin_amdgcn_update_dpp(0, __float_as_int(x), 0x122, 0xf, 0xf, false)); }
struct EpiUp {
    static constexpr bool PERM = false, AFTER_DRAIN = false;
    bf16_t* H; const float* bias; float* out; const float* cw; const float* cb; const float* cache; float* sbg; float* sbv;
    __device__ __forceinline__ void operator()(const f32x4 (&acc)[2][2][4][2], const Unit& u, int wr, int wc, int fr, int fq) const {
        const int c0 = u.pn * 128 + wc * 32 + 4 * fq;
#pragma unroll
        for (int n = 0; n < 2; ++n) { const int ch = c0 + n * 16; const f32x4 bg = *(const f32x4*)(bias + ch), bv = *(const f32x4*)(bias + DFF + ch);
            const f32x4 w0 = *(const f32x4*)(cw + ch), w1 = *(const f32x4*)(cw + DFF + ch), w2 = *(const f32x4*)(cw + 2 * DFF + ch), cbv = *(const f32x4*)(cb + ch);
#pragma unroll
            for (int ai = 0; ai < 2; ++ai) { const int blk = u.pm * 4 + ai * 2 + wr, r0 = blk * 64; const bool samp = blk >= 258;
                f32x4 gp = {0.f, 0.f, 0.f, 0.f}, gp1 = {0.f, 0.f, 0.f, 0.f}, gp2 = {0.f, 0.f, 0.f, 0.f};
#pragma unroll
                for (int m = 0; m < 4; ++m) { const int row = r0 + 16 * m + fr; const f32x4 g = acc[ai][0][m][n] + bg, v = acc[ai][1][m][n] + bv;
                    f32x4 a1, a2; a1[0] = rot1(g[0]); a1[1] = rot1(g[1]); a1[2] = rot1(g[2]); a1[3] = rot1(g[3]); a2[0] = rot2(g[0]); a2[1] = rot2(g[1]); a2[2] = rot2(g[2]); a2[3] = rot2(g[3]);
                    f32x4 g1, g2;
                    if (samp) { const int s = row - MP; g2 = *(const f32x4*)(cache + ((size_t)s * 2) * DFF + ch); g1 = *(const f32x4*)(cache + ((size_t)s * 2 + 1) * DFF + ch);
                        *(f32x4*)(out + O_SCF + ((size_t)s * 2 + 1) * DFF + ch) = g; }
                    else { g1 = (fr >= 1) ? a1 : gp1; g2 = (fr >= 2) ? a2 : gp2; const int b = row / TT, t = row - b * TT;
                        if (t == 0) g1 = (f32x4){0.f, 0.f, 0.f, 0.f}; if (t <= 1) g2 = (f32x4){0.f, 0.f, 0.f, 0.f};
                        if (t >= TT - 2) *(f32x4*)(out + O_PCF + ((size_t)b * 2 + (t - (TT - 2))) * DFF + ch) = g;
                        if (m == 0 && fr < 2) { *(f32x4*)(sbg + ((size_t)blk * 4 + fr) * DFF + ch) = g; *(f32x4*)(sbv + ((size_t)blk * 2 + fr) * DFF + ch) = v; }
                        if (m == 3 && fr >= 14) *(f32x4*)(sbg + ((size_t)blk * 4 + fr - 12) * DFF + ch) = g; }
                    const f32x4 y = cbv + w0 * g2 + w1 * g1 + w2 * g;
                    const float h0 = gelu_tanh(y[0]) * v[0], h1 = gelu_tanh(y[1]) * v[1], h2 = gelu_tanh(y[2]) * v[2], h3 = gelu_tanh(y[3]) * v[3];
                    u32x2 w; w.x = cvt_pk_bf16(h0, h1); w.y = cvt_pk_bf16(h2, h3); *(u32x2*)(H + (size_t)row * DFF + ch) = w;
                    gp = g; gp1 = a1; gp2 = a2; } } }
    }
};
struct EpiRaw {
    static constexpr bool PERM = false, AFTER_DRAIN = false;
    float* pu; int ld;
    __device__ __forceinline__ void operator()(const f32x4 (&acc)[2][2][4][2], const Unit& u, int wr, int wc, int fr, int fq) const {
        float* pp = pu + (size_t)u.ks * 256 * ld + (size_t)(wr * 64 + fr) * ld + u.pn * 256 + wc * 32 + 4 * fq;
#pragma unroll
        for (int ai = 0; ai < 2; ++ai)
#pragma unroll
            for (int m = 0; m < 4; ++m)
#pragma unroll
                for (int bj = 0; bj < 2; ++bj)
#pragma unroll
                    for (int n = 0; n < 2; ++n) *(f32x4*)(pp + (size_t)(ai * 128 + m * 16) * ld + bj * 128 + n * 16) = acc[ai][bj][m][n];
    }
};
template <class Epi> __device__ __forceinline__ void run_gemm(LAS unsigned char* lds, int vc, const bf16_t* A, const bf16_t* Bt, int N, int K, const Epi& E) {
    pg8::Gemm g; g.A = A; g.Bt = Bt; g.M = MTOK; g.N = N; g.K = K;
    pg8::StaticOrder S; S.init(MTOK, N, K, (int)gridDim.x, vc);
    pg8::gemm_phase<Epi, pg8::StaticOrder, false>(lds, g, S, E, nullptr);
}

template <class Epi> __device__ __forceinline__ void run_gemm_split(LAS unsigned char* lds, int vc, const bf16_t* A, const bf16_t* Bt, int N, int K, int nsplit, const Epi& E) {
    pg8::Gemm g; g.A = A; g.Bt = Bt; g.M = MTOK; g.N = N; g.K = K;
    pg8::SplitOrder S; S.init(N, K, nsplit, (int)gridDim.x, vc);
    pg8::gemm_phase<Epi, pg8::SplitOrder, false>(lds, g, S, E, nullptr);
}

template <class Epi> __device__ __forceinline__ void run_gemm_main64(LAS unsigned char* lds, int vc, const bf16_t* A, const bf16_t* Bt, int N, int K, const Epi& E) {
    pg8::Gemm g; g.A = A; g.Bt = Bt; g.M = 16384; g.N = N; g.K = K;
    pg8::StaticOrder S; S.init(16384, N, K, (int)gridDim.x, vc);
    pg8::gemm_phase<Epi, pg8::StaticOrder, false>(lds, g, S, E, nullptr);
}
__device__ __forceinline__ void run_gemm_tail(LAS unsigned char* lds, int vc, const bf16_t* A, const bf16_t* Bt, int N, int K, int nsplit, float* pu) {
    pg8::Gemm g; g.A = A; g.Bt = Bt; g.M = MTOK; g.N = N; g.K = K;
    pg8::TailOrder S; S.init(N, K, nsplit, (int)gridDim.x, vc);
    EpiRaw E; E.pu = pu; E.ld = N;
    pg8::gemm_phase<EpiRaw, pg8::TailOrder, false>(lds, g, S, E, nullptr);
}

__device__ __forceinline__ void transpose_item(const float* W, int N, bf16_t* WT, int K, int k0, int srcn0, int dstn0, LAS float* scr, int lane) {
    float tv[32];
#pragma unroll
    for (int i = 0; i < 32; ++i) tv[i] = W[(size_t)(k0 + 2 * i + (lane >> 5)) * N + srcn0 + (lane & 31)];
#pragma unroll
    for (int i = 0; i < 32; ++i) scr[(2 * i + (lane >> 5)) * 33 + (lane & 31)] = tv[i];
    LDS_WAIT();
    const int c = lane & 7;
#pragma unroll
    for (int j = 0; j < 4; ++j) { const int n = (lane >> 3) + 8 * j; const LAS float* s = scr + (8 * c) * 33 + n;
        u32x4 o; o.x = cvt_pk_bf16(s[0 * 33], s[1 * 33]); o.y = cvt_pk_bf16(s[2 * 33], s[3 * 33]); o.z = cvt_pk_bf16(s[4 * 33], s[5 * 33]); o.w = cvt_pk_bf16(s[6 * 33], s[7 * 33]);
        *(u32x4*)(WT + (size_t)(dstn0 + n) * K + k0 + 8 * c) = o; }
    LDS_WAIT();
}
__device__ __forceinline__ const float* src_row(const P& p, int r) {
    if (r < MP) { const int b = r / TT, t = r - b * TT; return t < 16 ? p.in[I_META] + (size_t)t * DM : p.in[I_XP] + ((size_t)b * 2048 + (t - 16)) * DM; }
    return p.in[I_XS] + (size_t)(r - MP) * DM;
}
template <bool OUT_BF16> __device__ __forceinline__ void ln_row(const float* xrow, const float* g, const float* bta, void* orow, int lane, int nsplit = 0, const bf16_t* xres = nullptr, const float* rbias = nullptr) {
    f32x4 v[4]; float s = 0.f;
#pragma unroll
    for (int j = 0; j < 4; ++j) { v[j] = *(const f32x4*)(xrow + 4 * lane + 256 * j);
        if (nsplit > 0) { for (int k = 1; k < nsplit; ++k) v[j] += *(const f32x4*)(xrow + (size_t)k * 256 * 1024 + 4 * lane + 256 * j);
            const u32x2 xw = *(const u32x2*)(xres + 4 * lane + 256 * j); const f32x4 bv = *(const f32x4*)(rbias + 4 * lane + 256 * j);
            v[j][0] += ALPHA * bflo(xw.x) + bv[0]; v[j][1] += ALPHA * bfhi(xw.x) + bv[1]; v[j][2] += ALPHA * bflo(xw.y) + bv[2]; v[j][3] += ALPHA * bfhi(xw.y) + bv[3]; }
        s += (v[j][0] + v[j][1]) + (v[j][2] + v[j][3]); }
    const float mean = wave_sum(s) * (1.f / DM); float s2 = 0.f;
#pragma unroll
    for (int j = 0; j < 4; ++j) { v[j] = v[j] - mean; s2 += (v[j][0] * v[j][0] + v[j][1] * v[j][1]) + (v[j][2] * v[j][2] + v[j][3] * v[j][3]); }
    const float rstd = 1.f / sqrtf(wave_sum(s2) * (1.f / DM) + LN_EPS);
#pragma unroll
    for (int j = 0; j < 4; ++j) { const f32x4 gg = *(const f32x4*)(g + 4 * lane + 256 * j), bb = *(const f32x4*)(bta + 4 * lane + 256 * j);
        const f32x4 o = (v[j] * rstd) * gg + bb;
        if (OUT_BF16) { u32x2 w; w.x = cvt_pk_bf16(o[0], o[1]); w.y = cvt_pk_bf16(o[2], o[3]); *(u32x2*)((bf16_t*)orow + 4 * lane + 256 * j) = w; }
        else *(f32x4*)((float*)orow + 4 * lane + 256 * j) = o; }
}
template <bool OUT_BF16> __device__ __forceinline__ void ln_rows2(const float* xa, const float* xb, const float* g, const float* bta, void* oa, void* ob, int lane, bool vb) {
    f32x4 va[4], vbv[4]; float sa = 0.f, sb = 0.f;
#pragma unroll
    for (int j = 0; j < 4; ++j) { va[j] = *(const f32x4*)(xa + 4 * lane + 256 * j); vbv[j] = *(const f32x4*)(xb + 4 * lane + 256 * j); }
#pragma unroll
    for (int j = 0; j < 4; ++j) { sa += (va[j][0] + va[j][1]) + (va[j][2] + va[j][3]); sb += (vbv[j][0] + vbv[j][1]) + (vbv[j][2] + vbv[j][3]); }
#pragma unroll
    for (int o = 1; o < 64; o <<= 1) { sa += __shfl_xor(sa, o); sb += __shfl_xor(sb, o); }
    const float ma = sa * (1.f / DM), mb = sb * (1.f / DM); float qa = 0.f, qb = 0.f;
#pragma unroll
    for (int j = 0; j < 4; ++j) { va[j] = va[j] - ma; vbv[j] = vbv[j] - mb; qa += (va[j][0] * va[j][0] + va[j][1] * va[j][1]) + (va[j][2] * va[j][2] + va[j][3] * va[j][3]);
        qb += (vbv[j][0] * vbv[j][0] + vbv[j][1] * vbv[j][1]) + (vbv[j][2] * vbv[j][2] + vbv[j][3] * vbv[j][3]); }
#pragma unroll
    for (int o = 1; o < 64; o <<= 1) { qa += __shfl_xor(qa, o); qb += __shfl_xor(qb, o); }
    const float ra = 1.f / sqrtf(qa * (1.f / DM) + LN_EPS), rb = 1.f / sqrtf(qb * (1.f / DM) + LN_EPS);
#pragma unroll
    for (int j = 0; j < 4; ++j) { const f32x4 gg = *(const f32x4*)(g + 4 * lane + 256 * j), bb = *(const f32x4*)(bta + 4 * lane + 256 * j);
        const f32x4 o1 = (va[j] * ra) * gg + bb, o2 = (vbv[j] * rb) * gg + bb;
        if (OUT_BF16) { u32x2 w; w.x = cvt_pk_bf16(o1[0], o1[1]); w.y = cvt_pk_bf16(o1[2], o1[3]); *(u32x2*)((bf16_t*)oa + 4 * lane + 256 * j) = w;
            if (vb) { w.x = cvt_pk_bf16(o2[0], o2[1]); w.y = cvt_pk_bf16(o2[2], o2[3]); *(u32x2*)((bf16_t*)ob + 4 * lane + 256 * j) = w; } }
        else { *(f32x4*)((float*)oa + 4 * lane + 256 * j) = o1; if (vb) *(f32x4*)((float*)ob + 4 * lane + 256 * j) = o2; } }
}
__device__ __forceinline__ void s5_precompute(const P& p, LAS unsigned char* lds, int g) {
    LAS float* apr = (LAS float*)lds;
    LAS float* api = apr + 17 * 64;
    LAS float* bbr = api + 17 * 64;
    LAS float* bbi = bbr + 1024;
    LAS float* cr = bbi + 1024;
    LAS float* ci = cr + 1024;
    LAS float* Kl = ci + 1024;
    int tid_ = threadIdx.x; asm volatile("" : "+v"(tid_)); const int tid = tid_;
    if (tid < 64) { const int pp = tid;
        const float dt = expf(p.in[I_SLDT][g]); const float lre = p.in[I_SLRE][g * 64 + pp], lim = p.in[I_SLIM][g * 64 + pp];
        const float mag = expf(lre * dt); const float ang = lim * dt; const float abr = mag * cosf(ang), abi = mag * sinf(ang);
        const float den = lre * lre + lim * lim, nr = abr - 1.0f, ni = abi; const float fre = (nr * lre + ni * lim) / den, fim = (ni * lre - nr * lim) / den;
        float pr = 1.f, pi = 0.f;
        for (int j = 0; j <= 16; ++j) { apr[j * 64 + pp] = pr; api[j * 64 + pp] = pi; const float nr2 = pr * abr - pi * abi, ni2 = pr * abi + pi * abr; pr = nr2; pi = ni2; }
        float* a1 = (float*)(p.ws + W_A1); float* a16 = (float*)(p.ws + W_A16); float* bbar = (float*)(p.ws + W_BBAR);
        a1[(g * 64 + pp) * 2] = abr; a1[(g * 64 + pp) * 2 + 1] = abi; a16[(g * 64 + pp) * 2] = apr[16 * 64 + pp]; a16[(g * 64 + pp) * 2 + 1] = api[16 * 64 + pp];
        for (int c = 0; c < 16; ++c) { const float br = p.in[I_SBRE][(g * 64 + pp) * 16 + c], bi = p.in[I_SBIM][(g * 64 + pp) * 16 + c];
            const float xr = fre * br - fim * bi, xi = fre * bi + fim * br; bbr[pp * 16 + c] = xr; bbi[pp * 16 + c] = xi;
            bbar[((g * 64 + pp) * 16 + c) * 2] = xr; bbar[((g * 64 + pp) * 16 + c) * 2 + 1] = xi; }
    }
    for (int i = tid; i < 1024; i += 512) { cr[i] = p.in[I_SCRE][g * 1024 + i]; ci[i] = p.in[I_SCIM][g * 1024 + i]; }
    __syncthreads();
    { const int j = tid >> 5, c1 = (tid >> 1) & 15, c0 = 8 * (tid & 1); float acc8[8];
#pragma unroll
      for (int e = 0; e < 8; ++e) acc8[e] = 0.f;
      for (int pp = 0; pp < 64; ++pp) { const float xr = cr[c1 * 64 + pp], xi = ci[c1 * 64 + pp], ar = apr[j * 64 + pp], ai = api[j * 64 + pp]; const float car = xr * ar - xi * ai, cai = xr * ai + xi * ar;
          const f32x4 r0 = *(const LAS f32x4*)(bbr + pp * 16 + c0), r1 = *(const LAS f32x4*)(bbr + pp * 16 + c0 + 4), i0 = *(const LAS f32x4*)(bbi + pp * 16 + c0), i1 = *(const LAS f32x4*)(bbi + pp * 16 + c0 + 4);
          acc8[0] += car * r0[0] - cai * i0[0]; acc8[1] += car * r0[1] - cai * i0[1]; acc8[2] += car * r0[2] - cai * i0[2]; acc8[3] += car * r0[3] - cai * i0[3];
          acc8[4] += car * r1[0] - cai * i1[0]; acc8[5] += car * r1[1] - cai * i1[1]; acc8[6] += car * r1[2] - cai * i1[2]; acc8[7] += car * r1[3] - cai * i1[3]; }
#pragma unroll
      for (int e = 0; e < 8; ++e) { float v = acc8[e]; if (j == 0 && c1 == c0 + e) v += p.in[I_SD][g * 16 + c1]; Kl[(j * 16 + c1) * 16 + c0 + e] = v; } }
    __syncthreads();
    bf16_t* W1 = (bf16_t*)(p.ws + W_W1) + (size_t)g * 128 * 256; bf16_t* W2 = (bf16_t*)(p.ws + W_W2) + (size_t)g * 256 * 384;
    for (int i = tid; i < 128 * 32; i += 512) { const int n = i >> 5, ch = i & 31, s = ch >> 1, c0 = 8 * (ch & 1), pp = n & 63; const bool im = n >= 64; float v[8];
        const float ar = apr[(15 - s) * 64 + pp], ai = api[(15 - s) * 64 + pp];
#pragma unroll
        for (int e = 0; e < 8; ++e) { const float xr = bbr[pp * 16 + c0 + e], xi = bbi[pp * 16 + c0 + e]; v[e] = im ? (ar * xi + ai * xr) : (ar * xr - ai * xi); }
        u32x4 o; o.x = cvt_pk_bf16(v[0], v[1]); o.y = cvt_pk_bf16(v[2], v[3]); o.z = cvt_pk_bf16(v[4], v[5]); o.w = cvt_pk_bf16(v[6], v[7]);
        *(u32x4*)(W1 + (size_t)n * 256 + 8 * ch) = o; }
    for (int i = tid; i < 256 * 48; i += 512) { const int n = i / 48, ch = i - n * 48, t = n >> 4, c1 = n & 15; float v[8];
        if (ch < 32) { const int s = ch >> 1, c0 = 8 * (ch & 1);
#pragma unroll
            for (int e = 0; e < 8; ++e) v[e] = (s <= t) ? Kl[((t - s) * 16 + c1) * 16 + c0 + e] : 0.f; }
        else { const bool im = ch >= 40; const int p0 = 8 * (ch - (im ? 40 : 32));
#pragma unroll
            for (int e = 0; e < 8; ++e) { const int pp = p0 + e; const float ar = apr[(t + 1) * 64 + pp], ai = api[(t + 1) * 64 + pp], xr = cr[c1 * 64 + pp], xi = ci[c1 * 64 + pp];
                v[e] = im ? -(xr * ai + xi * ar) : (xr * ar - xi * ai); } }
        u32x4 o; o.x = cvt_pk_bf16(v[0], v[1]); o.y = cvt_pk_bf16(v[2], v[3]); o.z = cvt_pk_bf16(v[4], v[5]); o.w = cvt_pk_bf16(v[6], v[7]);
        *(u32x4*)(W2 + (size_t)n * 384 + 8 * ch) = o; }
    __syncthreads();
}
template <int CLS> __device__ __forceinline__ void transposes(const P& p, LAS float* scr, int lane, int gw, int NGW) {
    constexpr int I_UP = 16 * 192, I_DN = 48 * 32, I_IN = 16 * 112, I_GL = 8 * 64, I_OU = 16 * 32, I_LR = 16 * 8;
    constexpr int NITEMS = CLS == 0 ? I_IN + I_LR : I_UP + I_DN + I_GL + I_OU;
    for (int it = gw; it < NITEMS; it += NGW) { int r = it;
        if (CLS == 0) {
            if (r < I_IN) { const int kb = r / 112, nb = r % 112; transpose_item(p.in[I_WIN], DIN, (bf16_t*)(p.ws + W_WTIN), 1024, 64 * kb, 32 * nb, 32 * nb, scr, lane); continue; } r -= I_IN;
            { const int which = r >> 6, blk = (r >> 3) & 7, kb = (r >> 2) & 1, nb = r & 3;
              transpose_item(p.in[which ? I_WI : I_WR] + blk * 16384, 128, (bf16_t*)(p.ws + (which ? W_WTI : W_WTR)) + blk * 16384, 128, 64 * kb, 32 * nb, 32 * nb, scr, lane); }
        } else {
            if (r < I_UP) { const int kb = r / 192, nb = r % 192, d0 = 32 * nb, s0 = ((d0 >> 7) & 1) * DFF + (d0 >> 8) * 128 + (d0 & 127);
                transpose_item(p.in[I_WUP], 6144, (bf16_t*)(p.ws + W_WTUP), 1024, 64 * kb, s0, d0, scr, lane); continue; } r -= I_UP;
            if (r < I_DN) { const int kb = r / 32, nb = r % 32; transpose_item(p.in[I_WDOWN], 1024, (bf16_t*)(p.ws + W_WTDOWN), 3072, 64 * kb, 32 * nb, 32 * nb, scr, lane); continue; } r -= I_DN;
            if (r < I_GL) { const int kb = r / 64, nb = r % 64, d0 = 32 * nb, s0 = ((d0 >> 7) & 1) * 1024 + (d0 >> 8) * 128 + (d0 & 127);
                transpose_item(p.in[I_WGLU], 2048, (bf16_t*)(p.ws + W_WTGLU), 512, 64 * kb, s0, d0, scr, lane); continue; } r -= I_GL;
            { const int kb = r / 32, nb = r % 32; transpose_item(p.in[I_WOUT], 1024, (bf16_t*)(p.ws + W_WTOUT), 1024, 64 * kb, 32 * nb, 32 * nb, scr, lane); }
        }
    }
}
__device__ __forceinline__ void phase0(const P& p, LAS unsigned char* lds) {
    int tid_ = threadIdx.x; asm volatile("" : "+v"(tid_)); const int tid = tid_, lane = tid & 63, wid = tid >> 6;
    REPEAT(REP_P0A) for (int g = blockIdx.x; g < NG; g += gridDim.x) s5_precompute(p, lds, g);
    LAS float* scr = (LAS float*)(lds + wid * 8704);
    const int gw = blockIdx.x * 8 + wid, NGW = gridDim.x * 8;
    { const int skip = ((int)gridDim.x >= 64) ? NG : 0;
      if ((int)blockIdx.x >= skip) REPEAT(REP_P0B) transposes<0>(p, scr, lane, ((int)blockIdx.x - skip) * 8 + wid, ((int)gridDim.x - skip) * 8); }
    { const int skip = ((int)gridDim.x >= 64) ? NG : 0;
      if ((int)blockIdx.x >= skip) { const int gw2 = ((int)blockIdx.x - skip) * 8 + wid, NGW2 = ((int)gridDim.x - skip) * 8;
        REPEAT(REP_P0C) for (int r = gw2; r < MTOK; r += 2 * NGW2) { const int r2 = r + NGW2; const bool vb = r2 < MTOK; const int rb = vb ? r2 : r;
          ln_rows2<true>(src_row(p, r), src_row(p, rb), p.in[I_EG], p.in[I_EB], (bf16_t*)(p.ws + W_XN) + (size_t)r * DM, (bf16_t*)(p.ws + W_XN) + (size_t)rb * DM, lane, vb); } } }
}

template <int MODE> __device__ __forceinline__ void lru_unit(const P& p, LAS unsigned char* lds, int b, int kc, int nb) {
    int tid_ = threadIdx.x; asm volatile("" : "+v"(tid_)); const int tid = tid_, lane = tid & 63, wid = tid >> 6, q = lane >> 4, n = lane & 15;
    int mt0, nmt, rowbase;
    if (MODE == 2) { mt0 = kc; nmt = 1; rowbase = MP; } else { mt0 = (NCHUNK * kc) >> 3; nmt = ((NCHUNK * (kc + 1)) >> 3) - mt0; rowbase = b * TT; }
    const int t0 = 16 * mt0, ntok = 16 * nmt;
    const bf16_t* proj = (const bf16_t*)(p.ws + W_PROJ);
    LAS bf16_t* xcs = (LAS bf16_t*)lds;
    LAS bf16_t* gas = (LAS bf16_t*)(lds + 73984);
    if (MODE == 2) {
        for (int it = tid; it < ntok * 16; it += 512) { const int i = it >> 4, cg8 = it & 15, c0 = nb * 128 + cg8 * 8; float a[8];
            { const f32x4 b0 = *(const f32x4*)(p.in[I_CLB] + c0), b1 = *(const f32x4*)(p.in[I_CLB] + c0 + 4); a[0] = b0[0]; a[1] = b0[1]; a[2] = b0[2]; a[3] = b0[3]; a[4] = b1[0]; a[5] = b1[1]; a[6] = b1[2]; a[7] = b1[3]; }
#pragma unroll
            for (int j = 0; j < 4; ++j) { const f32x4 w0 = *(const f32x4*)(p.in[I_CLW] + j * 1024 + c0), w1 = *(const f32x4*)(p.in[I_CLW] + j * 1024 + c0 + 4); float x[8];
                if (j < 3) { const float* cp = p.in[I_CCL] + ((size_t)(t0 + i) * 3 + j) * 1024 + c0; const f32x4 x0 = *(const f32x4*)cp, x1 = *(const f32x4*)(cp + 4);
                    x[0] = x0[0]; x[1] = x0[1]; x[2] = x0[2]; x[3] = x0[3]; x[4] = x1[0]; x[5] = x1[1]; x[6] = x1[2]; x[7] = x1[3]; }
                else { const u32x4 xv = *(const u32x4*)(proj + (size_t)(rowbase + t0 + i) * DIN + c0);
                    x[0] = bflo(xv.x); x[1] = bfhi(xv.x); x[2] = bflo(xv.y); x[3] = bfhi(xv.y); x[4] = bflo(xv.z); x[5] = bfhi(xv.z); x[6] = bflo(xv.w); x[7] = bfhi(xv.w); }
                a[0] += w0[0] * x[0]; a[1] += w0[1] * x[1]; a[2] += w0[2] * x[2]; a[3] += w0[3] * x[3]; a[4] += w1[0] * x[4]; a[5] += w1[1] * x[5]; a[6] += w1[2] * x[6]; a[7] += w1[3] * x[7]; }
            u32x4 o; o.x = cvt_pk_bf16(a[0], a[1]); o.y = cvt_pk_bf16(a[2], a[3]); o.z = cvt_pk_bf16(a[4], a[5]); o.w = cvt_pk_bf16(a[6], a[7]);
            *(LAS u32x4*)(xcs + i * 136 + cg8 * 8) = o;
            *(LAS u32x4*)(gas + i * 128 + cg8 * 8) = *(const u32x4*)(proj + (size_t)(rowbase + t0 + i) * DIN + C_GA + c0); }
    } else {
        const int cg8 = tid & 15, tr = tid >> 4, c0 = nb * 128 + cg8 * 8; float w[4][8], bs[8];
        { const f32x4 b0 = *(const f32x4*)(p.in[I_CLB] + c0), b1 = *(const f32x4*)(p.in[I_CLB] + c0 + 4); bs[0] = b0[0]; bs[1] = b0[1]; bs[2] = b0[2]; bs[3] = b0[3]; bs[4] = b1[0]; bs[5] = b1[1]; bs[6] = b1[2]; bs[7] = b1[3]; }
#pragma unroll
        for (int j = 0; j < 4; ++j) { const f32x4 w0 = *(const f32x4*)(p.in[I_CLW] + j * 1024 + c0), w1 = *(const f32x4*)(p.in[I_CLW] + j * 1024 + c0 + 4);
            w[j][0] = w0[0]; w[j][1] = w0[1]; w[j][2] = w0[2]; w[j][3] = w0[3]; w[j][4] = w1[0]; w[j][5] = w1[1]; w[j][6] = w1[2]; w[j][7] = w1[3]; }
        const int i0 = tr * 9; int i1 = i0 + 9; if (i1 > ntok) i1 = ntok;
        u32x4 xr[12], gr[9];
#pragma unroll
        for (int k = 0; k < 12; ++k) { const int i = i0 - 3 + k, t = t0 + i; xr[k] = (u32x4){0u, 0u, 0u, 0u}; if (t >= 0 && i < i1) xr[k] = *(const u32x4*)(proj + (size_t)(rowbase + t) * DIN + c0); }
#pragma unroll
        for (int k = 0; k < 9; ++k) { gr[k] = (u32x4){0u, 0u, 0u, 0u}; if (i0 + k < i1) gr[k] = *(const u32x4*)(proj + (size_t)(rowbase + t0 + i0 + k) * DIN + C_GA + c0); }
#pragma unroll
        for (int k = 0; k < 9; ++k) { if (i0 + k < i1) { float a[8];
#pragma unroll
            for (int e = 0; e < 8; ++e) a[e] = bs[e];
#pragma unroll
            for (int j = 0; j < 4; ++j) { const u32x4 xv = xr[k + j];
                a[0] += w[j][0] * bflo(xv.x); a[1] += w[j][1] * bfhi(xv.x); a[2] += w[j][2] * bflo(xv.y); a[3] += w[j][3] * bfhi(xv.y);
                a[4] += w[j][4] * bflo(xv.z); a[5] += w[j][5] * bfhi(xv.z); a[6] += w[j][6] * bflo(xv.w); a[7] += w[j][7] * bfhi(xv.w); }
            u32x4 o; o.x = cvt_pk_bf16(a[0], a[1]); o.y = cvt_pk_bf16(a[2], a[3]); o.z = cvt_pk_bf16(a[4], a[5]); o.w = cvt_pk_bf16(a[6], a[7]);
            *(LAS u32x4*)(xcs + (i0 + k) * 136 + cg8 * 8) = o; *(LAS u32x4*)(gas + (i0 + k) * 128 + cg8 * 8) = gr[k]; } }
    }
    __syncthreads();
    const int c = nb * 128 + wid * 16 + n;
    bf16x8 Br[4], Bi[4];
    { const bf16_t* wr_ = (const bf16_t*)(p.ws + W_WTR) + (size_t)c * 128 + q * 8; const bf16_t* wi_ = (const bf16_t*)(p.ws + W_WTI) + (size_t)c * 128 + q * 8;
#pragma unroll
      for (int kk = 0; kk < 4; ++kk) { Br[kk] = *(const bf16x8*)(wr_ + 32 * kk); Bi[kk] = *(const bf16x8*)(wi_ + 32 * kk); } }
    const float br = p.in[I_BR][c], bi = p.in[I_BI][c]; const float c8 = -8.0f * log1pf(expf(-p.in[I_LAM][c]));
    bf16_t* M1 = (bf16_t*)(p.ws + W_MIX); bf16_t* M2 = (bf16_t*)(p.out + O_YP);
    float h_run = 0.f, A_run = 1.f;
    for (int mt = 0; mt < nmt; ++mt) {
        f32x4 accr = {0.f, 0.f, 0.f, 0.f}, acci = {0.f, 0.f, 0.f, 0.f};
#pragma unroll
        for (int kk = 0; kk < 4; ++kk) { const bf16x8 Af = *(const LAS bf16x8*)(xcs + (16 * mt + n) * 136 + 32 * kk + 8 * q);
            accr = __builtin_amdgcn_mfma_f32_16x16x32_bf16(Af, Br[kk], accr, 0, 0, 0); acci = __builtin_amdgcn_mfma_f32_16x16x32_bf16(Af, Bi[kk], acci, 0, 0, 0); }
        float a[4], bx[4], ga[4];
#pragma unroll
        for (int j = 0; j < 4; ++j) { const int tok = 16 * mt + 4 * q + j; const float xcv = bf2f(xcs[tok * 136 + wid * 16 + n]);
            ga[j] = bf2f(gas[tok * 128 + wid * 16 + n]);
            const float r = sigm(accr[j] + br), ig = sigm(acci[j] + bi), la = c8 * r; a[j] = __expf(la); bx[j] = __builtin_amdgcn_sqrtf(fmaf(-a[j], a[j], 1.0f)) * (ig * xcv); }
        float h[4], Ac[4];
        if (MODE == 2) {
#pragma unroll
            for (int j = 0; j < 4; ++j) { const int s = t0 + 16 * mt + 4 * q + j; h[j] = a[j] * p.in[I_SL][(size_t)s * 1024 + c] + bx[j]; p.out[O_SL + (size_t)s * 1024 + c] = h[j]; Ac[j] = 0.f; }
        } else {
            float Ap[4]; h[0] = bx[0]; Ap[0] = a[0];
#pragma unroll
            for (int j = 1; j < 4; ++j) { h[j] = a[j] * h[j - 1] + bx[j]; Ap[j] = a[j] * Ap[j - 1]; }
            float PA = Ap[3], PH = h[3];
            float tA = __shfl_up(PA, 16), tH = __shfl_up(PH, 16); if (q >= 1) { PH = PA * tH + PH; PA = PA * tA; }
            tA = __shfl_up(PA, 32); tH = __shfl_up(PH, 32); if (q >= 2) { PH = PA * tH + PH; PA = PA * tA; }
            const float h_end = PA * h_run + PH; const float hin_s = __shfl_up(h_end, 16), pae_s = __shfl_up(PA, 16);
            const float h_in = (q == 0) ? h_run : hin_s; const float a_in = A_run * ((q == 0) ? 1.0f : pae_s);
#pragma unroll
            for (int j = 0; j < 4; ++j) { h[j] += Ap[j] * h_in; Ac[j] = Ap[j] * a_in; }
            h_run = __shfl(h_end, 48 + n); A_run *= __shfl(PA, 48 + n);
        }
#pragma unroll
        for (int j = 0; j < 4; ++j) { const size_t row = (size_t)(rowbase + t0 + 16 * mt + 4 * q + j); const float sg = sigm(ga[j]);
            M1[row * 1024 + c] = f2bf(sg * h[j]); M2[row * 1024 + c] = f2bf(sg * Ac[j]); }
    }
    if (MODE == 0 && q == 0) { ((float*)(p.ws + W_LRUA))[(size_t)(b * 8 + kc) * 1024 + c] = A_run; ((float*)(p.ws + W_LRUH))[(size_t)(b * 8 + kc) * 1024 + c] = h_run; }
    __syncthreads();
}

template <int PASS> __device__ __forceinline__ void s5_item(const P& p, int g, int sub, int lane, int wid) {
    constexpr int KS = (PASS == 1) ? 8 : 12, NTW = (PASS == 1) ? 1 : 2, LDW = (PASS == 1) ? 256 : 384;
    const int n = lane & 15, q = lane >> 4;
    const bf16_t* proj = (const bf16_t*)(p.ws + W_PROJ);
    const bf16_t* W = (PASS == 1) ? (const bf16_t*)(p.ws + W_W1) + (size_t)g * 128 * 256 : (const bf16_t*)(p.ws + W_W2) + (size_t)g * 256 * 384;
    bf16x8 Bf[NTW][KS];
#pragma unroll
    for (int i = 0; i < NTW; ++i)
#pragma unroll
        for (int kk = 0; kk < KS; ++kk) Bf[i][kk] = *(const bf16x8*)(W + (size_t)(16 * (NTW * wid + i) + n) * LDW + 32 * kk + 8 * q);
    const int rt0 = (65 * sub) >> 3, rt1 = (65 * (sub + 1)) >> 3; const bf16x8 zero = {0, 0, 0, 0, 0, 0, 0, 0};
    for (int rt = rt0; rt < rt1; ++rt) {
        const int R = 16 * rt + n; const bool valid = R < NR; const int Rc = valid ? R : 0; const int b = Rc / NCHUNK, k = Rc - b * NCHUNK;
        bf16x8 Af[KS];
        { const bf16_t* ub = proj + (size_t)(b * TT + 16 * k) * DIN + C_US + 16 * g + 8 * (q & 1);
#pragma unroll
          for (int kk = 0; kk < 8; ++kk) { const int s = 2 * kk + (q >> 1); Af[kk] = valid ? *(const bf16x8*)(ub + (size_t)s * DIN) : zero; } }
        if (PASS == 3) { const bf16_t* hb = (const bf16_t*)(p.ws + W_HPREV) + ((size_t)Rc * NG + g) * 128 + 8 * q;
#pragma unroll
          for (int kk = 8; kk < KS; ++kk) Af[kk] = valid ? *(const bf16x8*)(hb + 32 * (kk - 8)) : zero; }
        f32x4 acc[NTW];
#pragma unroll
        for (int i = 0; i < NTW; ++i) { acc[i] = (f32x4){0.f, 0.f, 0.f, 0.f};
#pragma unroll
            for (int kk = 0; kk < KS; ++kk) acc[i] = __builtin_amdgcn_mfma_f32_16x16x32_bf16(Af[kk], Bf[i][kk], acc[i], 0, 0, 0); }
#pragma unroll
        for (int j = 0; j < 4; ++j) { const int R2 = 16 * rt + 4 * q + j; if (R2 < NR) {
            if (PASS == 1) { ((float*)(p.ws + W_S))[((size_t)R2 * NG + g) * 128 + 16 * wid + n] = acc[0][j]; }
            else { const int b2 = R2 / NCHUNK, k2 = R2 - b2 * NCHUNK; bf16_t* Y = (bf16_t*)(p.ws + W_YSG) + (size_t)(b2 * TT + 16 * k2) * DSSM + 16 * g + n;
#pragma unroll
                for (int i = 0; i < NTW; ++i) Y[(size_t)(NTW * wid + i) * DSSM] = f2bf(gelu_tanh(acc[i][j])); } } }
    }
}
__device__ __forceinline__ void s5_fused(const P& p, LAS unsigned char* lds, int g, int b) {
    int tid_ = threadIdx.x; asm volatile("" : "+v"(tid_)); const int tid = tid_, lane = tid & 63, wid = tid >> 6, n = lane & 15, q = lane >> 4;
    LAS bf16_t* Us = (LAS bf16_t*)lds;
    LAS float* Ssm = (LAS float*)(lds + 68112);
    LAS bf16_t* Hs = (LAS bf16_t*)(lds + 68112);
    const bf16_t* proj = (const bf16_t*)(p.ws + W_PROJ); const bf16x8 zero = {0, 0, 0, 0, 0, 0, 0, 0};
    TIMED(231) { const bf16_t* ub = proj + (size_t)(b * TT) * DIN + C_US + 16 * g;
      u32x4 tv[9];
#pragma unroll
      for (int i = 0; i < 9; ++i) { const int it = tid + 512 * i; tv[i] = (u32x4){0u, 0u, 0u, 0u}; if (it < TT * 2) tv[i] = *(const u32x4*)(ub + (size_t)(it >> 1) * DIN + 8 * (it & 1)); }
#pragma unroll
      for (int i = 0; i < 9; ++i) { const int it = tid + 512 * i; if (it < TT * 2) { const int t = it >> 1; *(LAS u32x4*)(Us + (t >> 4) * 264 + (t & 15) * 16 + 8 * (it & 1)) = tv[i]; } } }
    __syncthreads();
    TIMED_END(231)
    TIMED(232) { const bf16_t* W = (const bf16_t*)(p.ws + W_W1) + (size_t)g * 128 * 256; bf16x8 Bf[8];
#pragma unroll
      for (int kk = 0; kk < 8; ++kk) Bf[kk] = *(const bf16x8*)(W + (size_t)(16 * wid + n) * 256 + 32 * kk + 8 * q);
#pragma unroll 1
      for (int rt = 0; rt < 9; ++rt) { const int k = 16 * rt + n; const bool valid = k < NCHUNK; const int kc = valid ? k : 0; f32x4 acc = {0.f, 0.f, 0.f, 0.f};
#pragma unroll
          for (int kk = 0; kk < 8; ++kk) { const bf16x8 uv = *(const LAS bf16x8*)(Us + kc * 264 + 32 * kk + 8 * q); const bf16x8 Af = valid ? uv : zero;
              acc = __builtin_amdgcn_mfma_f32_16x16x32_bf16(Af, Bf[kk], acc, 0, 0, 0); }
#pragma unroll
          for (int j = 0; j < 4; ++j) Ssm[(16 * rt + 4 * q + j) * 128 + 16 * wid + n] = acc[j]; } }
    __syncthreads();
    TIMED_END(232)
    bf16x8 Bw[2][12];
    { const bf16_t* W = (const bf16_t*)(p.ws + W_W2) + (size_t)g * 256 * 384;
#pragma unroll
      for (int i = 0; i < 2; ++i)
#pragma unroll
          for (int kk = 0; kk < 12; ++kk) Bw[i][kk] = *(const bf16x8*)(W + (size_t)(16 * (2 * wid + i) + n) * 384 + 32 * kk + 8 * q); }
    TIMED(233) if (wid == 0) { const float* a16 = (const float*)(p.ws + W_A16) + (g * 64 + lane) * 2; const float ar = a16[0], ai = a16[1]; float hr = 0.f, hi = 0.f;
#pragma unroll 1
        for (int kb = 0; kb < 132; kb += 4) { float sr[4], si[4];
#pragma unroll
            for (int u = 0; u < 4; ++u) { sr[u] = Ssm[(kb + u) * 128 + lane]; si[u] = Ssm[(kb + u) * 128 + 64 + lane]; }
            LDS_WAIT();
#pragma unroll
            for (int u = 0; u < 4; ++u) { const int k = kb + u; if (k < NCHUNK) { Hs[k * 136 + lane] = f2bf(hr); Hs[k * 136 + 64 + lane] = f2bf(hi);
                const float nr = ar * hr - ai * hi + sr[u], ni = ar * hi + ai * hr + si[u]; hr = nr; hi = ni; } } }
        p.out[O_PSR + ((size_t)b * NG + g) * 64 + lane] = hr; p.out[O_PSI + ((size_t)b * NG + g) * 64 + lane] = hi; }
    __syncthreads();
    TIMED_END(233)
    TIMED(234)
    {
#pragma unroll 1
      for (int rt = 0; rt < 9; ++rt) { const int k = 16 * rt + n; const bool valid = k < NCHUNK; const int kc = valid ? k : 0; f32x4 acc0 = {0.f, 0.f, 0.f, 0.f}, acc1 = {0.f, 0.f, 0.f, 0.f};
#pragma unroll
          for (int kk = 0; kk < 8; ++kk) { const bf16x8 uv = *(const LAS bf16x8*)(Us + kc * 264 + 32 * kk + 8 * q); const bf16x8 af = valid ? uv : zero;
              acc0 = __builtin_amdgcn_mfma_f32_16x16x32_bf16(af, Bw[0][kk], acc0, 0, 0, 0); acc1 = __builtin_amdgcn_mfma_f32_16x16x32_bf16(af, Bw[1][kk], acc1, 0, 0, 0); }
#pragma unroll
          for (int kk = 8; kk < 12; ++kk) { const bf16x8 hv = *(const LAS bf16x8*)(Hs + kc * 136 + 32 * (kk - 8) + 8 * q); const bf16x8 af = valid ? hv : zero;
              acc0 = __builtin_amdgcn_mfma_f32_16x16x32_bf16(af, Bw[0][kk], acc0, 0, 0, 0); acc1 = __builtin_amdgcn_mfma_f32_16x16x32_bf16(af, Bw[1][kk], acc1, 0, 0, 0); }
#pragma unroll
          for (int j = 0; j < 4; ++j) { const int k2 = 16 * rt + 4 * q + j; if (k2 < NCHUNK) { bf16_t* Y = (bf16_t*)(p.ws + W_YSG) + (size_t)(b * TT + 16 * k2 + 2 * wid) * DSSM + 16 * g + n;
              Y[0] = f2bf(gelu_tanh(acc0[j])); Y[DSSM] = f2bf(gelu_tanh(acc1[j])); } } } }
    TIMED_END(234)
}
__device__ __forceinline__ void s5_sample(const P& p, int s, int g, int lane) {
    const bf16_t* proj = (const bf16_t*)(p.ws + W_PROJ); const bf16_t* up = proj + (size_t)(MP + s) * DIN + C_US + 16 * g;
    const u32x4 u0 = *(const u32x4*)up, u1 = *(const u32x4*)(up + 8); float u[16];
    u[0] = bflo(u0.x); u[1] = bfhi(u0.x); u[2] = bflo(u0.y); u[3] = bfhi(u0.y); u[4] = bflo(u0.z); u[5] = bfhi(u0.z); u[6] = bflo(u0.w); u[7] = bfhi(u0.w);
    u[8] = bflo(u1.x); u[9] = bfhi(u1.x); u[10] = bflo(u1.y); u[11] = bfhi(u1.y); u[12] = bflo(u1.z); u[13] = bfhi(u1.z); u[14] = bflo(u1.w); u[15] = bfhi(u1.w);
    const float* a1 = (const float*)(p.ws + W_A1) + (g * 64 + lane) * 2; const float ar = a1[0], ai = a1[1];
    const float* bb = (const float*)(p.ws + W_BBAR) + (size_t)(g * 64 + lane) * 32; float bur = 0.f, bui = 0.f;
#pragma unroll
    for (int c = 0; c < 16; ++c) { bur += bb[2 * c] * u[c]; bui += bb[2 * c + 1] * u[c]; }
    const size_t si = ((size_t)s * NG + g) * 64 + lane; const float h0r = p.in[I_SSR][si], h0i = p.in[I_SSI][si];
    const float hr = ar * h0r - ai * h0i + bur, hi = ar * h0i + ai * h0r + bui;
    p.out[O_SSR + si] = hr; p.out[O_SSI + si] = hi;
    float v16[16];
#pragma unroll
    for (int c1 = 0; c1 < 16; ++c1) v16[c1] = p.in[I_SCRE][(g * 16 + c1) * 64 + lane] * hr - p.in[I_SCIM][(g * 16 + c1) * 64 + lane] * hi;
    float v8[8], v4[4], v2[2], v1;
    { const bool hi32 = (lane & 32) != 0;
#pragma unroll
      for (int i = 0; i < 8; ++i) { const float keep = hi32 ? v16[i + 8] : v16[i], send = hi32 ? v16[i] : v16[i + 8]; v8[i] = keep + __shfl_xor(send, 32); } }
    { const bool hb = (lane & 16) != 0;
#pragma unroll
      for (int i = 0; i < 4; ++i) { const float keep = hb ? v8[i + 4] : v8[i], send = hb ? v8[i] : v8[i + 4]; v4[i] = keep + __shfl_xor(send, 16); } }
    { const bool hb = (lane & 8) != 0;
#pragma unroll
      for (int i = 0; i < 2; ++i) { const float keep = hb ? v4[i + 2] : v4[i], send = hb ? v4[i] : v4[i + 2]; v2[i] = keep + __shfl_xor(send, 8); } }
    { const bool hb = (lane & 4) != 0; const float keep = hb ? v2[1] : v2[0], send = hb ? v2[0] : v2[1]; v1 = keep + __shfl_xor(send, 4); }
    v1 += __shfl_xor(v1, 1); v1 += __shfl_xor(v1, 2);
    const int c1 = ((lane >> 5) & 1) * 8 + ((lane >> 4) & 1) * 4 + ((lane >> 3) & 1) * 2 + ((lane >> 2) & 1);
    if ((lane & 3) == 0) { const float uc = bf2f(up[c1]); const float yv = v1 + p.in[I_SD][g * 16 + c1] * uc;
        ((bf16_t*)(p.ws + W_YSG))[(size_t)(MP + s) * DSSM + 16 * g + c1] = f2bf(gelu_tanh(yv)); }
}
__device__ __forceinline__ void phase2a(const P& p, LAS unsigned char* lds) {
    TIMED(22) for (int u = blockIdx.x; u < 512; u += gridDim.x) lru_unit<0>(p, lds, (u >> 3) & 7, u >> 6, u & 7); TIMED_END(22)
    TIMED(23) for (int it = blockIdx.x; it < NG * NBATCH; it += gridDim.x) s5_fused(p, lds, it & 31, it >> 5); TIMED_END(23)
}
__device__ __forceinline__ void phase2b(const P& p, LAS unsigned char* lds) {
    int tid_ = threadIdx.x; asm volatile("" : "+v"(tid_)); const int tid = tid_, lane = tid & 63, wid = tid >> 6;
    const size_t gt = (size_t)blockIdx.x * 512 + tid, GT = (size_t)gridDim.x * 512;
    for (size_t i = gt; i < (size_t)NBATCH * 1024; i += GT) { const int b = (int)(i >> 10), c = (int)(i & 1023); float h = 0.f;
        const float* A = (const float*)(p.ws + W_LRUA); const float* Hh = (const float*)(p.ws + W_LRUH); float* Cc = (float*)(p.ws + W_LRUC);
        for (int kc = 0; kc < 8; ++kc) { const size_t o = (size_t)(b * 8 + kc) * 1024 + c; Cc[o] = h; h = A[o] * h + Hh[o]; }
        p.out[O_PL + i] = h; }
    for (int u = (int)gridDim.x - 1 - (int)blockIdx.x; u < 64; u += gridDim.x) lru_unit<2>(p, lds, 0, u >> 3, u & 7);
    for (int it = blockIdx.x * 8 + wid; it < NSAMP * NG; it += gridDim.x * 8) s5_sample(p, it >> 5, it & 31, lane);
    const bf16_t* proj = (const bf16_t*)(p.ws + W_PROJ);
    for (size_t i = gt; i < (size_t)NBATCH * 3 * 1024; i += GT) { const int c = (int)(i & 1023), j = (int)((i >> 10) % 3), b = (int)(i / 3072);
        p.out[O_PCL + i] = bf2f(proj[(size_t)(b * TT + TT - 3 + j) * DIN + c]); }
    for (size_t i = gt; i < (size_t)NSAMP * 3 * 1024; i += GT) { const int c = (int)(i & 1023), j = (int)((i >> 10) % 3), s = (int)(i / 3072);
        p.out[O_SCL + i] = (j < 2) ? p.in[I_CCL][((size_t)s * 3 + j + 1) * 1024 + c] : bf2f(proj[(size_t)(MP + s) * DIN + c]); }
    for (size_t i = gt; i < (size_t)NSAMP * DFF; i += GT) { const int ch = (int)(i % DFF), s = (int)(i / DFF);
        p.out[O_SCF + ((size_t)s * 2) * DFF + ch] = p.in[I_CCF][((size_t)s * 2 + 1) * DFF + ch]; }
}
__device__ __forceinline__ void phase2c(const P& p, LAS unsigned char* lds) {
    const int lane = threadIdx.x & 63, wid = threadIdx.x >> 6;
    for (int it = blockIdx.x; it < NG * 8; it += gridDim.x) s5_item<3>(p, it >> 3, it & 7, lane, wid);
}
__device__ __forceinline__ void phase_ln1(const P& p) {
    const int lane = threadIdx.x & 63, wid = threadIdx.x >> 6; const int gw = blockIdx.x * 8 + wid, NGW = gridDim.x * 8;
    const float* R = (const float*)(p.ws + W_R1); bf16_t* X = (bf16_t*)(p.ws + W_XN);
    for (int r = gw; r < 16384; r += 2 * NGW) { const int r2 = r + NGW; const bool vb = r2 < 16384; const int rb = vb ? r2 : r;
        ln_rows2<true>(R + (size_t)r * DM, R + (size_t)rb * DM, p.in[I_L1G], p.in[I_L1B], X + (size_t)r * DM, X + (size_t)rb * DM, lane, vb); }
    for (int r = 16384 + gw; r < MTOK; r += NGW) { bf16_t* xr = X + (size_t)r * DM;
        ln_row<true>((const float*)(p.ws + W_PART) + (size_t)(r - 16384) * DM, p.in[I_L1G], p.in[I_L1B], xr, lane, 4, xr, p.in[I_BOUT]); }
}
__device__ __forceinline__ void phase_ffnfix(const P& p) {
    const size_t gt = (size_t)blockIdx.x * 512 + threadIdx.x, GT = (size_t)gridDim.x * 512;
    const float* sbg = (const float*)(p.ws + W_SBG); const float* sbv = (const float*)(p.ws + W_SBV); bf16_t* H = (bf16_t*)(p.ws + W_V);
    for (size_t it = gt; it < (size_t)256 * 2 * 384; it += GT) { const int cg8 = (int)(it % 384), rr = (int)((it / 384) & 1), blk = (int)(it / 768), ch = cg8 * 8, row = blk * 64 + rr; const int t = row % TT;
        float o[8];
#pragma unroll
        for (int hh = 0; hh < 2; ++hh) { const int c = ch + 4 * hh; const f32x4 z = {0.f, 0.f, 0.f, 0.f};
            const f32x4 g0 = *(const f32x4*)(sbg + ((size_t)blk * 4 + rr) * DFF + c), v = *(const f32x4*)(sbv + ((size_t)blk * 2 + rr) * DFF + c);
            f32x4 g1, g2;
            if (rr == 0) { g1 = (blk > 0 && t >= 1) ? *(const f32x4*)(sbg + ((size_t)(blk - 1) * 4 + 3) * DFF + c) : z; g2 = (blk > 0 && t >= 2) ? *(const f32x4*)(sbg + ((size_t)(blk - 1) * 4 + 2) * DFF + c) : z; }
            else { g1 = (t >= 1) ? *(const f32x4*)(sbg + ((size_t)blk * 4) * DFF + c) : z; g2 = (blk > 0 && t >= 2) ? *(const f32x4*)(sbg + ((size_t)(blk - 1) * 4 + 3) * DFF + c) : z; }
            const f32x4 w0 = *(const f32x4*)(p.in[I_FCW] + c), w1 = *(const f32x4*)(p.in[I_FCW] + DFF + c), w2 = *(const f32x4*)(p.in[I_FCW] + 2 * DFF + c), cbv = *(const f32x4*)(p.in[I_FCB] + c);
            const f32x4 y = cbv + w0 * g2 + w1 * g1 + w2 * g0;
            o[4 * hh] = gelu_tanh(y[0]) * v[0]; o[4 * hh + 1] = gelu_tanh(y[1]) * v[1]; o[4 * hh + 2] = gelu_tanh(y[2]) * v[2]; o[4 * hh + 3] = gelu_tanh(y[3]) * v[3]; }
        u32x4 w; w.x = cvt_pk_bf16(o[0], o[1]); w.y = cvt_pk_bf16(o[2], o[3]); w.z = cvt_pk_bf16(o[4], o[5]); w.w = cvt_pk_bf16(o[6], o[7]);
        *(u32x4*)(H + (size_t)row * DFF + ch) = w; }
}
__device__ __forceinline__ f32x4 up_tail_sum(const float* pu, const float* bias, int rl, int col, int bcol) {
    f32x4 v = *(const f32x4*)(bias + bcol);
#pragma unroll
    for (int ks = 0; ks < 4; ++ks) v += *(const f32x4*)(pu + (size_t)ks * 256 * 6144 + (size_t)rl * 6144 + col);
    return v;
}
__device__ __forceinline__ void phase_ffntail(const P& p) {
    const size_t gt = (size_t)blockIdx.x * 512 + threadIdx.x, GT = (size_t)gridDim.x * 512;
    const float* pu = (const float*)(p.ws + W_PU); const float* sbg = (const float*)(p.ws + W_SBG); bf16_t* H = (bf16_t*)(p.ws + W_V); const float* bias = p.in[I_BUP];
    for (size_t it = gt; it < (size_t)256 * 768; it += GT) { const int rl = (int)(it / 768), ch = (int)(it - (size_t)rl * 768) * 4, row = 16384 + rl; const int colg = 256 * (ch >> 7) + (ch & 127);
        const f32x4 g0 = up_tail_sum(pu, bias, rl, colg, ch), v = up_tail_sum(pu, bias, rl, colg + 128, DFF + ch); f32x4 g1, g2;
        if (row >= MP) { const int s_ = row - MP; g2 = *(const f32x4*)(p.in[I_CCF] + ((size_t)s_ * 2) * DFF + ch); g1 = *(const f32x4*)(p.in[I_CCF] + ((size_t)s_ * 2 + 1) * DFF + ch);
            *(f32x4*)(p.out + O_SCF + ((size_t)s_ * 2 + 1) * DFF + ch) = g0; }
        else {
            g1 = (rl >= 1) ? up_tail_sum(pu, bias, rl - 1, colg, ch) : *(const f32x4*)(sbg + ((size_t)255 * 4 + 3) * DFF + ch);
            g2 = (rl >= 2) ? up_tail_sum(pu, bias, rl - 2, colg, ch) : *(const f32x4*)(sbg + ((size_t)255 * 4 + 2 + rl) * DFF + ch);
            const int t = row - 7 * TT; if (t >= TT - 2) *(f32x4*)(p.out + O_PCF + ((size_t)7 * 2 + (t - (TT - 2))) * DFF + ch) = g0; }
        const f32x4 w0 = *(const f32x4*)(p.in[I_FCW] + ch), w1 = *(const f32x4*)(p.in[I_FCW] + DFF + ch), w2 = *(const f32x4*)(p.in[I_FCW] + 2 * DFF + ch), cbv = *(const f32x4*)(p.in[I_FCB] + ch);
        const f32x4 y = cbv + w0 * g2 + w1 * g1 + w2 * g0;
        u32x2 w; w.x = cvt_pk_bf16(gelu_tanh(y[0]) * v[0], gelu_tanh(y[1]) * v[1]); w.y = cvt_pk_bf16(gelu_tanh(y[2]) * v[2], gelu_tanh(y[3]) * v[3]);
        *(u32x2*)(H + (size_t)row * DFF + ch) = w; }
}
__device__ __forceinline__ float* y_row(const P& p, int r) {
    if (r >= MP) return p.out + O_YS + (size_t)(r - MP) * DM;
    const int b = r / TT, t = r - b * TT; return t < 16 ? nullptr : p.out + O_YP + ((size_t)b * 2048 + (t - 16)) * DM;
}
__device__ __forceinline__ void phase_ln2(const P& p) {
    const int lane = threadIdx.x & 63, wid = threadIdx.x >> 6; const int gw = blockIdx.x * 8 + wid, NGW = gridDim.x * 8;
    const float* R = (const float*)(p.ws + W_R2);
    for (int r = gw; r < 16384; r += 2 * NGW) { const int r2 = r + NGW; float* oa = y_row(p, r); float* ob = (r2 < 16384) ? y_row(p, r2) : nullptr;
        if (oa && ob) ln_rows2<false>(R + (size_t)r * DM, R + (size_t)r2 * DM, p.in[I_L2G], p.in[I_L2B], oa, ob, lane, true);
        else if (oa) ln_row<false>(R + (size_t)r * DM, p.in[I_L2G], p.in[I_L2B], oa, lane);
        else if (ob) ln_row<false>(R + (size_t)r2 * DM, p.in[I_L2G], p.in[I_L2B], ob, lane); }
    for (int r = 16384 + gw; r < MTOK; r += NGW) { float* o = y_row(p, r);
        if (o) ln_row<false>((const float*)(p.ws + W_PART) + (size_t)(r - 16384) * DM, p.in[I_L2G], p.in[I_L2B], o, lane, 12, (const bf16_t*)(p.ws + W_XN) + (size_t)r * DM, p.in[I_BDOWN]); }
}

__global__ __launch_bounds__(512, 2) void hawk_fwd(P p) {
    extern __shared__ __attribute__((aligned(16))) unsigned char shm[];
    LAS unsigned char* lds = (LAS unsigned char*)shm;
    cg::grid_group grid = cg::this_grid();
    volatile LAS unsigned* xst = (volatile LAS unsigned*)(lds + LDS_TOTAL - 16);
    if (threadIdx.x < 4) xst[threadIdx.x] = 0u;
    __syncthreads();
    XcdBarrier xb = xcd_barrier_post((unsigned*)(p.ws + W_BAR), xst);
    if (threadIdx.x == 0) xst[2] = xb_add((unsigned*)(p.ws + W_BAR) + XCD_BAR_WORDS + 64 * xb.x, 1u);
#define GSYNC() xcd_barrier(xb)
    if (p.ws == nullptr) grid.sync();
    TIMED(0) REPEAT(REP_P0) { phase0(p, lds); GSYNC(); } TIMED_END(0)
    if (threadIdx.x == 0) { unsigned* bar = (unsigned*)(p.ws + W_BAR); bool ok = (gridDim.x % 8u) == 0u;
        for (unsigned j = 0; j < 16; ++j) { const unsigned cnt = xb_ld(&bar[XB_XCNT(j)]); if (cnt != (j < 8 ? gridDim.x / 8u : 0u)) ok = false; }
        xst[3] = ok ? (xst[2] * 8u + xb.x) : blockIdx.x; }
    __syncthreads();
    const int vc = (int)xst[3];
    TIMED(1) REPEAT(REP_P1) { EpiProj E; E.O = (bf16_t*)(p.ws + W_PROJ); E.bias = p.in[I_BIN]; run_gemm(lds, vc, (const bf16_t*)(p.ws + W_XN), (const bf16_t*)(p.ws + W_WTIN), DIN, 1024, E);
        { const int G = (int)gridDim.x, nun = (MTOK / 256) * (DIN / 256), rem = nun % G; const int c = vc;
          if (c >= rem) transposes<1>(p, (LAS float*)(lds + (threadIdx.x >> 6) * 8704), threadIdx.x & 63, (c - rem) * 8 + (int)(threadIdx.x >> 6), (G - rem) * 8); }
        GSYNC(); } TIMED_END(1)
    TIMED(20) REPEAT(REP_P2A) { phase2a(p, lds); GSYNC(); } TIMED_END(20)
    TIMED(21) REPEAT(REP_P2B) { phase2b(p, lds); GSYNC(); } TIMED_END(21)
    TIMED(3) { EpiGlu E; E.mix = (bf16_t*)(p.ws + W_MIX); E.m2 = (const bf16_t*)(p.out + O_YP); E.carry = (const float*)(p.ws + W_LRUC); E.proj = (const bf16_t*)(p.ws + W_PROJ); E.bias = p.in[I_BGLU]; run_gemm(lds, vc, (const bf16_t*)(p.ws + W_YSG), (const bf16_t*)(p.ws + W_WTGLU), 2048, 512, E); GSYNC(); } TIMED_END(3)
    TIMED(4) REPEAT(REP_P4) { EpiRes E; E.R = (float*)(p.ws + W_R1); E.X = (const bf16_t*)(p.ws + W_XN); E.bias = p.in[I_BOUT]; E.part = (float*)(p.ws + W_PART); run_gemm_split(lds, vc, (const bf16_t*)(p.ws + W_MIX), (const bf16_t*)(p.ws + W_WTOUT), 1024, 1024, 4, E); GSYNC(); } TIMED_END(4)
    TIMED(5) REPEAT(REP_P5) { phase_ln1(p); GSYNC(); } TIMED_END(5)
    TIMED(6) REPEAT(REP_P6) { EpiUp E; E.H = (bf16_t*)(p.ws + W_V); E.bias = p.in[I_BUP]; E.out = p.out; E.cw = p.in[I_FCW]; E.cb = p.in[I_FCB]; E.cache = p.in[I_CCF]; E.sbg = (float*)(p.ws + W_SBG); E.sbv = (float*)(p.ws + W_SBV); run_gemm_main64(lds, vc, (const bf16_t*)(p.ws + W_XN), (const bf16_t*)(p.ws + W_WTUP), 6144, 1024, E);
        run_gemm_tail(lds, vc, (const bf16_t*)(p.ws + W_XN), (const bf16_t*)(p.ws + W_WTUP), 6144, 1024, 4, (float*)(p.ws + W_PU)); GSYNC(); } TIMED_END(6)
    TIMED(7) phase_ffnfix(p); phase_ffntail(p);
    GSYNC(); TIMED_END(7)
    TIMED(8) REPEAT(REP_P8) { EpiRes E; E.R = (float*)(p.ws + W_R2); E.X = (const bf16_t*)(p.ws + W_XN); E.bias = p.in[I_BDOWN]; E.part = (float*)(p.ws + W_PART); run_gemm_split(lds, vc, (const bf16_t*)(p.ws + W_V), (const bf16_t*)(p.ws + W_WTDOWN), 1024, 3072, 12, E); GSYNC(); } TIMED_END(8)
    TIMED(9) REPEAT(REP_P9) phase_ln2(p); TIMED_END(9)
}

extern "C" void kernel_launch(void* const* d_in, const int* in_sizes, int n_in, void* d_out, int out_size, void* d_ws, size_t ws_size, hipStream_t stream) {
    constexpr int LDS_BYTES = LDS_TOTAL;
    static int grid = 0;
    if (grid == 0) {
        if (n_in != N_IN || (size_t)out_size != O_END || ws_size < 268435456ull) { fprintf(stderr, "kernel_launch: unexpected shapes (n_in %d out %d ws %zu)\n", n_in, out_size, ws_size); grid = -1; return; }
        int dev = 0, cus = 0, per_cu = 0;
        if (hipGetDevice(&dev) != hipSuccess || hipDeviceGetAttribute(&cus, hipDeviceAttributeMultiprocessorCount, dev) != hipSuccess) { grid = -1; return; }
        if (hipFuncSetAttribute((const void*)hawk_fwd, hipFuncAttributeMaxDynamicSharedMemorySize, LDS_BYTES) != hipSuccess) { fprintf(stderr, "kernel_launch: hipFuncSetAttribute failed\n"); grid = -1; return; }
        if (hipOccupancyMaxActiveBlocksPerMultiprocessor(&per_cu, (const void*)hawk_fwd, 512, LDS_BYTES) != hipSuccess || per_cu < 1) { fprintf(stderr, "kernel_launch: occupancy query failed (%d)\n", per_cu); grid = -1; (void)hipGetLastError(); return; }
        grid = cus * per_cu;
    }
    if (grid < 0) return;
    if (hipMemsetAsync((char*)d_ws + W_BAR, 0, (XCD_BAR_WORDS + 64 * 16) * 4, stream) != hipSuccess) { fprintf(stderr, "kernel_launch: memset failed\n"); return; }
    P p{};
    for (int i = 0; i < N_IN; ++i) p.in[i] = (const float*)d_in[i];
    p.out = (float*)d_out; p.ws = (unsigned char*)d_ws;
    void* args[] = {&p};
    hipError_t e = hipLaunchCooperativeKernel((const void*)hawk_fwd, dim3(grid), dim3(512), args, LDS_BYTES, stream);
    if (e != hipSuccess) fprintf(stderr, "cooperative launch failed: %s (grid %d)\n", hipGetErrorString(e), grid);
}
```

```cpp
#include <hip/hip_runtime.h>
#include <hip/hip_cooperative_groups.h>
#include <cstdio>
#include <cstdint>
namespace cg = cooperative_groups;
#define REP_P0 1
#define REP_P0A 1
#define REP_P0B 1
#define REP_P0C 1
#define REP_P1 1
#define REP_P3 1
#define REP_P2A 1
#define REP_P2B 1
#define REP_P2C 1
#define REP_P4 1
#define REP_P5 1
#define REP_P6 1
#define REP_P8 1
#define REP_P9 1
#define PROBE_PHASE -1
namespace pg8 {
#define PG8_LAS __attribute__((address_space(3)))
typedef unsigned short bf16_t;
typedef short bf16x8 __attribute__((ext_vector_type(8)));
typedef float f32x4 __attribute__((ext_vector_type(4)));
typedef unsigned u32x4 __attribute__((ext_vector_type(4)));
constexpr int BM = 256, BK = 64, HALF = 128, HTB = HALF * BK * 2  , STAGE_BYTES = 8 * HTB, NXCD = 8, WGM = 8;

__host__ __device__ __forceinline__ int lds_byte(int r, int c) { const int st = (r >> 4) * 2 + (c >> 5), rr = r & 15, cc = c & 31, ob = rr * 64 + cc * 2; return st * 1024 + (ob ^ (((ob >> 9) & 1) << 5)); }
__host__ __device__ __forceinline__ void stage_rc(int b, int& R, int& C) { const int st = b / 1024, sb = b % 1024, swz = sb ^ (((sb >> 9) & 1) << 5); R = (st >> 1) * 16 + swz / 64; C = (st & 1) * 32 + (swz % 64) / 2; }
__host__ __device__ __forceinline__ int perm32(int rho) { const int n = rho >> 4, i = rho & 15; return 8 * (i >> 2) + 4 * n + (i & 3); }

struct Unit { int pm, pn, k0, nt, ks; };
struct Gemm { const bf16_t* A; const bf16_t* Bt; int M, N, K; };

struct StaticOrder {
    int nM, nN, nwg, G, c, ntk;
    __host__ __device__ void init(int M, int N, int K, int G_, int c_) { nM = M / BM; nN = N / BM; nwg = nM * nN; G = G_; c = c_; ntk = K / BK; }
    __host__ __device__ bool next(int i, Unit& u) const {
        const long L = (long)i * G + c; if (L >= nwg) return false;
        int wgid = (int)L; { const int q = nwg / NXCD, r = nwg % NXCD, xcd = wgid % NXCD, off = wgid / NXCD; wgid = (xcd < r ? xcd * (q + 1) : r * (q + 1) + (xcd - r) * q) + off; }
        const int nig = WGM * nN, gid = wgid / nig, fm = gid * WGM, gsz = (nM - fm) < WGM ? (nM - fm) : WGM;
        u.pm = fm + ((wgid % nig) % gsz); u.pn = (wgid % nig) / gsz; u.k0 = 0; u.nt = ntk; u.ks = -1; return true;
    }
    __device__ __forceinline__ void a_ready(const Unit&) const {}
    __device__ __forceinline__ void done(const Unit&) const {}
};
struct TailOrder {
    int nN, ntk, nsplit, G, c;
    __host__ __device__ void init(int N, int K, int nsplit_, int G_, int c_) { nN = N / BM; ntk = K / BK; nsplit = nsplit_; G = G_; c = c_; }
    __host__ __device__ bool next(int i, Unit& u) const {
        const long L = (long)i * G + c; const bool ok = L < (long)nN * nsplit; const int ks = (int)(L / nN), ntp = ntk / nsplit;
        u.pm = 64; u.pn = (int)(L % nN); u.ks = ks; u.nt = ntp; u.k0 = ks * ntp * BK; return ok;
    }
    __device__ __forceinline__ void a_ready(const Unit&) const {}
    __device__ __forceinline__ void done(const Unit&) const {}
};
struct SplitOrder {
    StaticOrder base; int nsplit;
    __host__ __device__ void init(int N, int K, int nsplit_, int G_, int c_) { base.init(64 * BM, N, K, G_, c_); nsplit = nsplit_; }
    __host__ __device__ bool next(int i, Unit& u) const {
        Unit t; t.pm = 0; t.pn = 0; t.k0 = 0; t.nt = base.ntk; t.ks = -1;
        const bool ok = base.next(i, t);
        const long L = (long)i * base.G + base.c - base.nwg; const bool sp = (!ok) && L >= 0 && L < (long)base.nN * nsplit;
        const int ks = (int)(L / base.nN), pn = (int)(L % base.nN), ntp = base.ntk / nsplit;
        u.pm = sp ? 64 : t.pm; u.pn = sp ? pn : t.pn; u.ks = sp ? ks : -1; u.nt = sp ? ntp : t.nt; u.k0 = sp ? ks * ntp * BK : 0;
        return ok || sp;
    }
    __device__ __forceinline__ void a_ready(const Unit&) const {}
    __device__ __forceinline__ void done(const Unit&) const {}
};
__device__ __forceinline__ unsigned cvt_pk_bf16(float lo, float hi) { unsigned r; asm volatile("v_cvt_pk_bf16_f32 %0, %1, %2" : "=v"(r) : "v"(lo), "v"(hi)); return r; }
template <class Epi, class Sched, bool STAMP = false>
__device__ __forceinline__ void gemm_phase(PG8_LAS unsigned char* lds, const Gemm g, const Sched& S, const Epi& E, unsigned long long* stamps) {
    int tid_ = threadIdx.x; asm volatile("" : "+v"(tid_)); const int tid = tid_, wid = __builtin_amdgcn_readfirstlane(tid >> 6), lane = tid & 63, wr = wid >> 2, wc = wid & 3, fr = lane & 15, fq = lane >> 4;
    const int K = g.K;
    int ts_lo = 0, ts_hi = 0, nts = 0; const unsigned long long rt_entry = STAMP ? (unsigned long long)wall_clock64() : 0ull;
#define PG8_STAMP() do { if (STAMP && wid == 0 && nts < 64) { const unsigned long long _c = (unsigned long long)clock64(); \
        ts_lo = (lane == nts) ? (int)(unsigned)_c : ts_lo; ts_hi = (lane == nts) ? (int)(unsigned)(_c >> 32) : ts_hi; ++nts; } } while (0)
    PG8_STAMP();
    unsigned voffA[2], voffB[2];
#pragma unroll
    for (int i = 0; i < 2; ++i) { int R, C; stage_rc(tid * 16 + i * 8192, R, C); const int Rb = Epi::PERM ? ((R & ~31) + perm32(R & 31)) : R;
        voffA[i] = (unsigned)(R * K + C) * 2u; voffB[i] = (unsigned)(Rb * K + C) * 2u; }
    const size_t kstep = (size_t)(BK * 2);
    const size_t hstep = (size_t)HALF * K * 2;
    const size_t tstep = 2 * hstep;
    const unsigned ldsw = (unsigned)wid * 1024u;
    const int aoff = lds_byte(wr * 64 + fr, fq * 8), boff = lds_byte(wc * 32 + fr, fq * 8);
#define PG8_SA(b, h) (((b) * 2 + (h)) * HTB)
#define PG8_SB(b, h) ((4 + (b) * 2 + (h)) * HTB)
#define PG8_STAGE(bufoff, gbase, voff) do { _Pragma("unroll") for (int _i = 0; _i < 2; ++_i) \
        __builtin_amdgcn_global_load_lds((const unsigned*)((const char*)(gbase) + (voff)[_i]), (PG8_LAS unsigned*)(lds + (bufoff) + ldsw + _i * 8192), 16, 0, 0); } while (0)
#define PG8_LDA(dst, b, h) do { _Pragma("unroll") for (int m = 0; m < 4; ++m) _Pragma("unroll") for (int k = 0; k < 2; ++k) dst[m][k] = *(const PG8_LAS bf16x8*)(lds + PG8_SA(b, h) + aoff + m * 2048 + k * 1024); } while (0)
#define PG8_LDB(dst, b, h) do { _Pragma("unroll") for (int n = 0; n < 2; ++n) _Pragma("unroll") for (int k = 0; k < 2; ++k) dst[n][k] = *(const PG8_LAS bf16x8*)(lds + PG8_SB(b, h) + boff + n * 2048 + k * 1024); } while (0)
#define PG8_MMA(ai, bj, At, Bt) do { __builtin_amdgcn_s_setprio(1); _Pragma("unroll") for (int m = 0; m < 4; ++m) _Pragma("unroll") for (int n = 0; n < 2; ++n) _Pragma("unroll") for (int k = 0; k < 2; ++k) \
        acc[ai][bj][m][n] = __builtin_amdgcn_mfma_f32_16x16x32_bf16(Bt[n][k], At[m][k], acc[ai][bj][m][n], 0, 0, 0); __builtin_amdgcn_s_setprio(0); } while (0)
#define PG8_WAIT_V(n) asm volatile("s_waitcnt vmcnt(" #n ")" ::: "memory")
#define PG8_WAIT_L(n) asm volatile("s_waitcnt lgkmcnt(" #n ")" ::: "memory")
#define PG8_BAR __builtin_amdgcn_s_barrier()
#define PG8_SCHED __builtin_amdgcn_sched_barrier(0)
    Unit cur, nxt; int ui = 0;
    if (!S.next(0, cur)) return;
    f32x4 acc[2][2][4][2];
#pragma unroll
    for (int a = 0; a < 2; ++a)
#pragma unroll
        for (int b = 0; b < 2; ++b)
#pragma unroll
            for (int m = 0; m < 4; ++m)
#pragma unroll
                for (int n = 0; n < 2; ++n) acc[a][b][m][n] = (f32x4){0.f, 0.f, 0.f, 0.f};
    bf16x8 At[4][2], B0[2][2], B1[2][2];
    const char* cA = (const char*)g.A + (size_t)cur.pm * tstep + (size_t)cur.k0 * 2; const char* cB = (const char*)g.Bt + (size_t)cur.pn * tstep + (size_t)cur.k0 * 2;
    S.a_ready(cur);
    PG8_STAGE(PG8_SB(0, 0), cB, voffB); PG8_STAGE(PG8_SA(0, 0), cA, voffA); PG8_STAGE(PG8_SB(0, 1), cB + hstep, voffB); PG8_STAGE(PG8_SA(0, 1), cA + hstep, voffA);
    if (wr == 1) PG8_BAR;
    PG8_WAIT_V(4); PG8_BAR;
    PG8_STAGE(PG8_SB(1, 0), cB + kstep, voffB); PG8_STAGE(PG8_SA(1, 0), cA + kstep, voffA); PG8_STAGE(PG8_SB(1, 1), cB + hstep + kstep, voffB);
    PG8_WAIT_V(6); PG8_BAR;
    PG8_STAMP();
    for (;;) {
        const bool has_next = S.next(ui + 1, nxt);
        const char* nA = has_next ? (const char*)g.A + (size_t)nxt.pm * tstep + (size_t)nxt.k0 * 2 : cA; const char* nB = has_next ? (const char*)g.Bt + (size_t)nxt.pn * tstep + (size_t)nxt.k0 * 2 : cB;
        const int nt = cur.nt;
        for (int t = 0; t < nt; t += 2) {
            const bool last = (t == nt - 2);
            const char* a1 = cA + (size_t)(t + 1) * kstep;
            const char* a2 = last ? nA : cA + (size_t)(t + 2) * kstep; const char* b2 = last ? nB : cB + (size_t)(t + 2) * kstep;
            const char* a3 = a2 + kstep; const char* b3 = b2 + kstep;
            if (last && has_next) S.a_ready(nxt);
            PG8_LDB(B0, 0, 0); PG8_SCHED; PG8_LDA(At, 0, 0); PG8_STAGE(PG8_SA(1, 1), a1 + hstep, voffA);
            PG8_WAIT_L(8); PG8_BAR; PG8_WAIT_L(0); PG8_MMA(0, 0, At, B0); PG8_BAR; PG8_SCHED;
            PG8_LDB(B1, 0, 1); PG8_STAGE(PG8_SB(0, 0), b2, voffB);
            PG8_BAR; PG8_WAIT_L(0); PG8_MMA(0, 1, At, B1); PG8_BAR;
            PG8_LDA(At, 0, 1); PG8_STAGE(PG8_SA(0, 0), a2, voffA);
            PG8_BAR; PG8_WAIT_L(0); PG8_MMA(1, 0, At, B0); PG8_BAR; PG8_SCHED;
            PG8_STAGE(PG8_SB(0, 1), b2 + hstep, voffB);
            PG8_WAIT_V(6); PG8_BAR; PG8_MMA(1, 1, At, B1); PG8_BAR;
            PG8_LDB(B0, 1, 0); PG8_SCHED; PG8_LDA(At, 1, 0); PG8_STAGE(PG8_SA(0, 1), a2 + hstep, voffA);
            PG8_WAIT_L(8); PG8_BAR; PG8_WAIT_L(0); PG8_MMA(0, 0, At, B0); PG8_BAR; PG8_SCHED;
            PG8_LDB(B1, 1, 1); PG8_STAGE(PG8_SB(1, 0), b3, voffB);
            PG8_BAR; PG8_WAIT_L(0); PG8_MMA(0, 1, At, B1); PG8_BAR;
            PG8_LDA(At, 1, 1); PG8_STAGE(PG8_SA(1, 0), a3, voffA);
            PG8_BAR; PG8_WAIT_L(0); PG8_MMA(1, 0, At, B0); PG8_BAR; PG8_SCHED;
            PG8_STAGE(PG8_SB(1, 1), b3 + hstep, voffB);
            PG8_WAIT_V(6); PG8_BAR; PG8_MMA(1, 1, At, B1); PG8_BAR;
        }
        PG8_STAMP();
        if constexpr (!Epi::AFTER_DRAIN) { E(acc, cur, wr, wc, fr, fq); S.done(cur); }
        PG8_STAMP();
        if (!has_next) break;
#pragma unroll
        for (int a = 0; a < 2; ++a)
#pragma unroll
            for (int b = 0; b < 2; ++b)
#pragma unroll
                for (int m = 0; m < 4; ++m)
#pragma unroll
                    for (int n = 0; n < 2; ++n) acc[a][b][m][n] = (f32x4){0.f, 0.f, 0.f, 0.f};
        cur = nxt; cA = nA; cB = nB; ++ui;
    }
    PG8_WAIT_V(0);
    if (wr == 0) PG8_BAR;
    PG8_BAR;
    if constexpr (Epi::AFTER_DRAIN) { E.fused(acc, cur, wr, wc, fr, fq, lds, wid, lane); S.done(cur); }
    PG8_STAMP();
    if (STAMP && wid == 0) { stamps[lane] = lane < nts ? (((unsigned long long)(unsigned)ts_hi << 32) | (unsigned)ts_lo) : 0ull;
        if (lane == 62) stamps[62] = rt_entry; if (lane == 63) stamps[63] = (unsigned long long)wall_clock64(); }
#undef PG8_STAMP
#undef PG8_SA
#undef PG8_SB
#undef PG8_STAGE
#undef PG8_LDA
#undef PG8_LDB
#undef PG8_MMA
#undef PG8_WAIT_V
#undef PG8_WAIT_L
#undef PG8_BAR
#undef PG8_SCHED
}
}
using pg8::bf16_t; using pg8::bf16x8; using pg8::f32x4; using pg8::u32x4; using pg8::Unit; using pg8::cvt_pk_bf16;
#define LAS __attribute__((address_space(3)))
typedef unsigned u32x2 __attribute__((ext_vector_type(2)));
#define XB_TMO      128
#define XB_XCNT(j)  (256  + 64 * (j))
#define XB_XSUB(j)  (1280 + 64 * (j))
#define XB_XGEN(j)  (2304 + 64 * (j))
#define XB_TOP      3328
#define XB_TOPGEN   3392
#define XCD_BAR_WORDS 3456
#define XB_SPIN_CAP (1u << 18)

__device__ __forceinline__ unsigned xb_ld(unsigned* p)              { return __hip_atomic_load(p, __ATOMIC_RELAXED, __HIP_MEMORY_SCOPE_AGENT); }
__device__ __forceinline__ unsigned xb_add(unsigned* p, unsigned v) { return __hip_atomic_fetch_add(p, v, __ATOMIC_RELAXED, __HIP_MEMORY_SCOPE_AGENT); }
__device__ __forceinline__ unsigned xb_xcc_id() { return (unsigned)__builtin_amdgcn_s_getreg((3 << 11) | 20) & 0xFu; }
#define XB_SPIN(cond, bar) do { unsigned _sp = 0; while (cond) { __builtin_amdgcn_s_sleep(1); \
    if ((++_sp & 255u) == 0u) { if (xb_ld(&(bar)[XB_TMO])) break; if (_sp > XB_SPIN_CAP) { atomicAdd(&(bar)[XB_TMO], 1u); break; } } } } while (0)

struct XcdBarrier {
    unsigned* bar; unsigned x;
    volatile LAS unsigned* st;
};

__device__ __forceinline__ XcdBarrier xcd_barrier_post(unsigned* bar, volatile LAS unsigned* st) {
    XcdBarrier b; b.bar = bar; b.x = xb_xcc_id(); b.st = st;
    if (threadIdx.x == 0) (void)xb_add(&bar[XB_XCNT(b.x)], 1u);
    return b;
}
__device__ __forceinline__ void xcd_barrier_complete(unsigned* bar, unsigned x, unsigned& nloc, unsigned& nx) {
    const unsigned G = gridDim.x * gridDim.y * gridDim.z;
    unsigned sum, cnt, mine, sp = 0u;
    for (;;) {
        sum = 0u; cnt = 0u; mine = 0u;
#pragma unroll
        for (unsigned j = 0; j < 16; ++j) { const unsigned c = xb_ld(&bar[XB_XCNT(j)]); sum += c; cnt += (c > 0u) ? 1u : 0u; mine = (j == x) ? c : mine; }
        if (sum == G) break;
        __builtin_amdgcn_s_sleep(1);
        if ((++sp & 255u) == 0u) { if (xb_ld(&bar[XB_TMO])) break; if (sp > XB_SPIN_CAP) { atomicAdd(&bar[XB_TMO], 1u); break; } }
    }
    nloc = mine > 0u ? mine : 1u; nx = cnt > 0u ? cnt : 1u;
}

__device__ __forceinline__ void xcd_barrier(const XcdBarrier& b) {
    asm volatile("s_waitcnt vmcnt(0)" ::: "memory");
    __syncthreads();
    if (threadIdx.x == 0) {
        unsigned* bar = b.bar;
        __builtin_amdgcn_s_waitcnt(0);
        unsigned nloc = b.st[0], nx = b.st[1];
        if (nloc == 0u) { xcd_barrier_complete(bar, b.x, nloc, nx); b.st[0] = nloc; b.st[1] = nx; }
        const unsigned old = xb_add(&bar[XB_XSUB(b.x)], 1u);
        const unsigned gen = old / nloc;
        if (old + 1u == (gen + 1u) * nloc) {
            __builtin_amdgcn_fence(__ATOMIC_RELEASE, "agent");
            asm volatile("s_waitcnt vmcnt(0)" ::: "memory");
            const unsigned og = xb_add(&bar[XB_TOP], 1u);
            const unsigned tg = og / nx;
            if (og + 1u == (tg + 1u) * nx) xb_add(&bar[XB_TOPGEN], 1u);
            else XB_SPIN(xb_ld(&bar[XB_TOPGEN]) == tg, bar);
            __builtin_amdgcn_fence(__ATOMIC_ACQUIRE, "agent");
            xb_add(&bar[XB_XGEN(b.x)], 1u);
            asm volatile("s_waitcnt vmcnt(0)" ::: "memory");
        } else {
            XB_SPIN(xb_ld(&bar[XB_XGEN(b.x)]) == gen, bar);
            __builtin_amdgcn_fence(__ATOMIC_ACQUIRE, "agent");
            asm volatile("s_waitcnt vmcnt(0)" ::: "memory");
        }
    }
    __syncthreads();
}


constexpr int DM = 1024, NBATCH = 8, TT = 2064, NSAMP = 128, MP = NBATCH * TT  , MTOK = MP + NSAMP  ;
constexpr int DIN = 3584, DSSM = 512, DFF = 3072, NG = 32, NCHUNK = 129, NR = NBATCH * NCHUNK  ;
constexpr int C_US = 1024, C_GA = 1536, C_GB = 2560;
constexpr float ALPHA = 1.189207115002721f, LN_EPS = 1e-5f;
enum { I_XP = 0, I_XS, I_CCL, I_SL, I_SSR, I_SSI, I_CCF, I_META, I_EG, I_EB, I_WIN, I_BIN, I_CLW, I_CLB, I_WR, I_BR, I_WI, I_BI, I_LAM,
       I_SLRE, I_SLIM, I_SLDT, I_SBRE, I_SBIM, I_SCRE, I_SCIM, I_SD, I_WGLU, I_BGLU, I_WOUT, I_BOUT, I_L1G, I_L1B, I_WUP, I_BUP, I_FCW, I_FCB,
       I_WDOWN, I_BDOWN, I_L2G, I_L2B, N_IN };
constexpr size_t O_YP = 0, O_YS = 16777216, O_PCL = O_YS + 131072, O_PL = O_PCL + 24576, O_PSR = O_PL + 8192, O_PSI = O_PSR + 16384, O_PCF = O_PSI + 16384,
                 O_SCL = O_PCF + 49152, O_SL = O_SCL + 393216, O_SSR = O_SL + 131072, O_SSI = O_SSR + 262144, O_SCF = O_SSI + 262144, O_END = O_SCF + 786432;
constexpr size_t W_WTUP = 0, W_WTDOWN = W_WTUP + (size_t)6144 * 1024 * 2, W_XN = W_WTDOWN + (size_t)1024 * 3072 * 2, W_C = W_XN + (size_t)MTOK * 1024 * 2;
constexpr size_t W_PROJ = W_C, W_MIX = W_PROJ + (size_t)MTOK * DIN * 2, W_YSG = W_MIX + (size_t)MTOK * 1024 * 2, W_D = W_YSG + (size_t)MTOK * 512 * 2;
constexpr size_t W_WTGLU = W_D, W_WTOUT = W_WTGLU + (size_t)2048 * 512 * 2, W_WTR = W_WTOUT + (size_t)1024 * 1024 * 2, W_WTI = W_WTR + 262144, W_W1 = W_WTI + 262144,
                 W_W2 = W_W1 + (size_t)NG * 128 * 256 * 2, W_HPREV = W_W2 + (size_t)NG * 256 * 384 * 2, W_A1 = W_HPREV + (size_t)NR * NG * 128 * 2, W_A16 = W_A1 + 16384,
                 W_BBAR = W_A16 + 16384, W_LRUA = W_BBAR + 262144, W_LRUH = W_LRUA + 262144, W_LRUC = W_LRUH + 262144, W_S = W_LRUC + 262144, W_WTIN = W_S,
                 W_S_END = W_S + (size_t)NR * NG * 128 * 4;
constexpr size_t W_BAR = (W_S_END + 4095) / 4096 * 4096;
static_assert(W_BAR + (XCD_BAR_WORDS + 64 * 16) * 4 <= 268435456, "barrier words");
constexpr size_t W_PART = W_C + (size_t)MTOK * 1024 * 4;
constexpr size_t W_SBG = W_C, W_SBV = W_SBG + (size_t)260 * 4 * DFF * 4, W_SB_END = W_SBV + (size_t)260 * 2 * DFF * 4;
constexpr size_t W_PU = W_SB_END, W_PU_END = W_PU + (size_t)4 * 256 * 6144 * 4;
constexpr size_t W_R1 = W_C, W_G = W_C, W_V = W_G + (size_t)MTOK * DFF * 2, W_V_END = W_V + (size_t)MTOK * DFF * 2, W_R2 = W_C;
static_assert(W_S_END <= 268435456 && W_V_END <= 268435456, "workspace map exceeds 256 MiB");
static_assert(W_SB_END <= W_V && W_PU_END <= W_V, "side buffers / up partials overlap H");
static_assert(W_PART + (size_t)12 * 256 * 1024 * 4 <= W_MIX && W_PART + (size_t)12 * 256 * 1024 * 4 <= W_V, "r1 / partials overlap mix or v");

constexpr int LDS_TOTAL = 147456;
struct P { const float* in[N_IN]; float* out; unsigned char* ws; };

__device__ __forceinline__ float bf2f(unsigned short b) { return __uint_as_float(((unsigned)b) << 16); }
__device__ __forceinline__ float bflo(unsigned u) { return __uint_as_float(u << 16); }
__device__ __forceinline__ float bfhi(unsigned u) { return __uint_as_float(u & 0xffff0000u); }
__device__ __forceinline__ unsigned short f2bf(float f) { return (unsigned short)(cvt_pk_bf16(f, 0.f) & 0xffffu); }
__device__ __forceinline__ float sigm(float x) { return __builtin_amdgcn_rcpf(1.f + __expf(-x)); }
__device__ __forceinline__ float gelu_tanh(float x) { return x * sigm(1.5957691216057308f * (x + 0.044715f * x * x * x)); }
__device__ __forceinline__ float wave_sum(float v) {
#pragma unroll
    for (int o = 1; o < 64; o <<= 1) v += __shfl_xor(v, o);
    return v;
}
#define LDS_WAIT() asm volatile("s_waitcnt lgkmcnt(0)" ::: "memory")
#define REPEAT(N) for (int rep_ = 0; rep_ < (N); ++rep_)
#define TIMED(N) const unsigned long long tq0_##N = (PROBE_PHASE == (N)) ? __builtin_amdgcn_s_memrealtime() : 0ull;
#define TIMED_END(N) if (PROBE_PHASE == (N)) { const unsigned long long tq1 = __builtin_amdgcn_s_memrealtime(); while (__builtin_amdgcn_s_memrealtime() - tq1 < tq1 - tq0_##N) __builtin_amdgcn_s_sleep(4); }

struct EpiProj {
    static constexpr bool PERM = true, AFTER_DRAIN = false;
    bf16_t* O; const float* bias;
    __device__ __forceinline__ void operator()(const f32x4 (&acc)[2][2][4][2], const Unit& u, int wr, int wc, int fr, int fq) const {
        const int row0 = u.pm * 256 + wr * 64 + fr, col0 = u.pn * 256 + wc * 32 + 8 * fq;
#pragma unroll
        for (int bj = 0; bj < 2; ++bj) { const int col = col0 + bj * 128; const f32x4 b0 = *(const f32x4*)(bias + col), b1 = *(const f32x4*)(bias + col + 4);
#pragma unroll
            for (int ai = 0; ai < 2; ++ai)
#pragma unroll
                for (int m = 0; m < 4; ++m) { const f32x4 v0 = acc[ai][bj][m][0] + b0, v1 = acc[ai][bj][m][1] + b1; u32x4 w;
                    w.x = cvt_pk_bf16(v0[0], v0[1]); w.y = cvt_pk_bf16(v0[2], v0[3]); w.z = cvt_pk_bf16(v1[0], v1[1]); w.w = cvt_pk_bf16(v1[2], v1[3]);
                    *(u32x4*)(O + (size_t)(row0 + ai * 128 + m * 16) * DIN + col) = w; } }
    }
};
struct EpiGlu {
    static constexpr bool PERM = false, AFTER_DRAIN = false;
    bf16_t* mix; const bf16_t* m2; const float* carry; const bf16_t* proj; const float* bias;
    __device__ __forceinline__ void operator()(const f32x4 (&acc)[2][2][4][2], const Unit& u, int wr, int wc, int fr, int fq) const {
        const int row0 = u.pm * 256 + wr * 64 + fr, j0 = u.pn * 128 + wc * 32 + 4 * fq;
#pragma unroll
        for (int n = 0; n < 2; ++n) { const int j = j0 + n * 16; const f32x4 bv = *(const f32x4*)(bias + j), bg = *(const f32x4*)(bias + 1024 + j);
#pragma unroll
            for (int ai = 0; ai < 2; ++ai) { u32x2 gbw[4], mw[4], m2w[4]; f32x4 cv[4];
#pragma unroll
                for (int m = 0; m < 4; ++m) { const int rowi = row0 + ai * 128 + m * 16; const size_t row = (size_t)rowi; int cidx = 0;
                    if (rowi < MP) { const int b = rowi / TT, t = rowi - b * TT; int kc = t >> 8; kc = kc > 7 ? 7 : kc; cidx = (b * 8 + kc) * 1024; }
                    cv[m] = *(const f32x4*)(carry + cidx + j); gbw[m] = *(const u32x2*)(proj + row * DIN + C_GB + j); mw[m] = *(const u32x2*)(mix + row * 1024 + j); m2w[m] = *(const u32x2*)(m2 + row * 1024 + j); }
#pragma unroll
                for (int m = 0; m < 4; ++m) { const size_t row = (size_t)(row0 + ai * 128 + m * 16); const f32x4 val = acc[ai][0][m][n] + bv, gate = acc[ai][1][m][n] + bg;
                    const float o0 = bflo(mw[m].x) + bflo(m2w[m].x) * cv[m][0] + sigm(bflo(gbw[m].x)) * val[0] * sigm(gate[0]), o1 = bfhi(mw[m].x) + bfhi(m2w[m].x) * cv[m][1] + sigm(bfhi(gbw[m].x)) * val[1] * sigm(gate[1]);
                    const float o2 = bflo(mw[m].y) + bflo(m2w[m].y) * cv[m][2] + sigm(bflo(gbw[m].y)) * val[2] * sigm(gate[2]), o3 = bfhi(mw[m].y) + bfhi(m2w[m].y) * cv[m][3] + sigm(bfhi(gbw[m].y)) * val[3] * sigm(gate[3]);
                    u32x2 w; w.x = cvt_pk_bf16(o0, o1); w.y = cvt_pk_bf16(o2, o3); *(u32x2*)(mix + row * 1024 + j) = w; } } }
    }
};
struct EpiRes {
    static constexpr bool PERM = false, AFTER_DRAIN = false;
    bf16_t* R; const bf16_t* X; const float* bias; float* part;
    __device__ __forceinline__ void operator()(const f32x4 (&acc)[2][2][4][2], const Unit& u, int wr, int wc, int fr, int fq) const {
        const int row0 = u.pm * 256 + wr * 64 + fr, col0 = u.pn * 256 + wc * 32 + 4 * fq;
        if (u.ks >= 0) { float* pp = part + ((size_t)u.ks * 256 - 16384) * 1024;
#pragma unroll
            for (int bj = 0; bj < 2; ++bj)
#pragma unroll
                for (int n = 0; n < 2; ++n)
#pragma unroll
                    for (int ai = 0; ai < 2; ++ai)
#pragma unroll
                        for (int m = 0; m < 4; ++m) *(f32x4*)(pp + (size_t)(row0 + ai * 128 + m * 16) * 1024 + col0 + bj * 128 + n * 16) = acc[ai][bj][m][n];
            return; }
#pragma unroll
        for (int bj = 0; bj < 2; ++bj)
#pragma unroll
            for (int n = 0; n < 2; ++n) { const int col = col0 + bj * 128 + n * 16; const f32x4 bv = *(const f32x4*)(bias + col);
#pragma unroll
                for (int ai = 0; ai < 2; ++ai) { u32x2 xw[4];
#pragma unroll
                    for (int m = 0; m < 4; ++m) xw[m] = *(const u32x2*)(X + (size_t)(row0 + ai * 128 + m * 16) * 1024 + col);
#pragma unroll
                    for (int m = 0; m < 4; ++m) { const size_t off = (size_t)(row0 + ai * 128 + m * 16) * 1024 + col;
                        f32x4 v = acc[ai][bj][m][n] + bv; v[0] += ALPHA * bflo(xw[m].x); v[1] += ALPHA * bfhi(xw[m].x); v[2] += ALPHA * bflo(xw[m].y); v[3] += ALPHA * bfhi(xw[m].y);
                        u32x2 w; w.x = cvt_pk_bf16(v[0], v[1]); w.y = cvt_pk_bf16(v[2], v[3]); *(u32x2*)(R + off) = w; } } }
    }
};
__device__ __forceinline__ float rot1(float x) { return __int_as_float(__builtin_amdgcn_update_dpp(0, __float_as_int(x), 0x121, 0xf, 0xf, false)); }
__device__ __forceinline__ float rot2(float x) { return __int_as_float(__builtin_amdgcn_update_dpp(0, __float_as_int(x), 0x122, 0xf, 0xf, false)); }
struct EpiUp {
    static constexpr bool PERM = false, AFTER_DRAIN = false;
    bf16_t* H; const float* bias; float* out; const float* cw; const float* cb; const float* cache; float* sbg; float* sbv;
    __device__ __forceinline__ void operator()(const f32x4 (&acc)[2][2][4][2], const Unit& u, int wr, int wc, int fr, int fq) const {
        const int c0 = u.pn * 128 + wc * 32 + 4 * fq;
#pragma unroll
        for (int n = 0; n < 2; ++n) { const int ch = c0 + n * 16; const f32x4 bg = *(const f32x4*)(bias + ch), bv = *(const f32x4*)(bias + DFF + ch);
            const f32x4 w0 = *(const f32x4*)(cw + ch), w1 = *(const f32x4*)(cw + DFF + ch), w2 = *(const f32x4*)(cw + 2 * DFF + ch), cbv = *(const f32x4*)(cb + ch);
#pragma unroll
            for (int ai = 0; ai < 2; ++ai) { const int blk = u.pm * 4 + ai * 2 + wr, r0 = blk * 64; const bool samp = blk >= 258;
                f32x4 gp = {0.f, 0.f, 0.f, 0.f}, gp1 = {0.f, 0.f, 0.f, 0.f}, gp2 = {0.f, 0.f, 0.f, 0.f};
#pragma unroll
                for (int m = 0; m < 4; ++m) { const int row = r0 + 16 * m + fr; const f32x4 g = acc[ai][0][m][n] + bg, v = acc[ai][1][m][n] + bv;
                    f32x4 a1, a2; a1[0] = rot1(g[0]); a1[1] = rot1(g[1]); a1[2] = rot1(g[2]); a1[3] = rot1(g[3]); a2[0] = rot2(g[0]); a2[1] = rot2(g[1]); a2[2] = rot2(g[2]); a2[3] = rot2(g[3]);
                    f32x4 g1, g2;
                    if (samp) { const int s = row - MP; g2 = *(const f32x4*)(cache + ((size_t)s * 2) * DFF + ch); g1 = *(const f32x4*)(cache + ((size_t)s * 2 + 1) * DFF + ch);
                        *(f32x4*)(out + O_SCF + ((size_t)s * 2 + 1) * DFF + ch) = g; }
                    else { g1 = (fr >= 1) ? a1 : gp1; g2 = (fr >= 2) ? a2 : gp2; const int b = row / TT, t = row - b * TT;
                        if (t == 0) g1 = (f32x4){0.f, 0.f, 0.f, 0.f}; if (t <= 1) g2 = (f32x4){0.f, 0.f, 0.f, 0.f};
                        if (t >= TT - 2) *(f32x4*)(out + O_PCF + ((size_t)b * 2 + (t - (TT - 2))) * DFF + ch) = g;
                        if (m == 0 && fr < 2) { *(f32x4*)(sbg + ((size_t)blk * 4 + fr) * DFF + ch) = g; *(f32x4*)(sbv + ((size_t)blk * 2 + fr) * DFF + ch) = v; }
                        if (m == 3 && fr >= 14) *(f32x4*)(sbg + ((size_t)blk * 4 + fr - 12) * DFF + ch) = g; }
                    const f32x4 y = cbv + w0 * g2 + w1 * g1 + w2 * g;
                    const float h0 = gelu_tanh(y[0]) * v[0], h1 = gelu_tanh(y[1]) * v[1], h2 = gelu_tanh(y[2]) * v[2], h3 = gelu_tanh(y[3]) * v[3];
                    u32x2 w; w.x = cvt_pk_bf16(h0, h1); w.y = cvt_pk_bf16(h2, h3); *(u32x2*)(H + (size_t)row * DFF + ch) = w;
                    gp = g; gp1 = a1; gp2 = a2; } } }
    }
};
struct EpiRaw {
    static constexpr bool PERM = false, AFTER_DRAIN = false;
    float* pu; int ld;
    __device__ __forceinline__ void operator()(const f32x4 (&acc)[2][2][4][2], const Unit& u, int wr, int wc, int fr, int fq) const {
        float* pp = pu + (size_t)u.ks * 256 * ld + (size_t)(wr * 64 + fr) * ld + u.pn * 256 + wc * 32 + 4 * fq;
#pragma unroll
        for (int ai = 0; ai < 2; ++ai)
#pragma unroll
            for (int m = 0; m < 4; ++m)
#pragma unroll
                for (int bj = 0; bj < 2; ++bj)
#pragma unroll
                    for (int n = 0; n < 2; ++n) *(f32x4*)(pp + (size_t)(ai * 128 + m * 16) * ld + bj * 128 + n * 16) = acc[ai][bj][m][n];
    }
};
template <class Epi> __device__ __forceinline__ void run_gemm(LAS unsigned char* lds, int vc, const bf16_t* A, const bf16_t* Bt, int N, int K, const Epi& E) {
    pg8::Gemm g; g.A = A; g.Bt = Bt; g.M = MTOK; g.N = N; g.K = K;
    pg8::StaticOrder S; S.init(MTOK, N, K, (int)gridDim.x, vc);
    pg8::gemm_phase<Epi, pg8::StaticOrder, false>(lds, g, S, E, nullptr);
}

template <class Epi> __device__ __forceinline__ void run_gemm_split(LAS unsigned char* lds, int vc, const bf16_t* A, const bf16_t* Bt, int N, int K, int nsplit, const Epi& E) {
    pg8::Gemm g; g.A = A; g.Bt = Bt; g.M = MTOK; g.N = N; g.K = K;
    pg8::SplitOrder S; S.init(N, K, nsplit, (int)gridDim.x, vc);
    pg8::gemm_phase<Epi, pg8::SplitOrder, false>(lds, g, S, E, nullptr);
}

template <class Epi> __device__ __forceinline__ void run_gemm_main64(LAS unsigned char* lds, int vc, const bf16_t* A, const bf16_t* Bt, int N, int K, const Epi& E) {
    pg8::Gemm g; g.A = A; g.Bt = Bt; g.M = 16384; g.N = N; g.K = K;
    pg8::StaticOrder S; S.init(16384, N, K, (int)gridDim.x, vc);
    pg8::gemm_phase<Epi, pg8::StaticOrder, false>(lds, g, S, E, nullptr);
}
__device__ __forceinline__ void run_gemm_tail(LAS unsigned char* lds, int vc, const bf16_t* A, const bf16_t* Bt, int N, int K, int nsplit, float* pu) {
    pg8::Gemm g; g.A = A; g.Bt = Bt; g.M = MTOK; g.N = N; g.K = K;
    pg8::TailOrder S; S.init(N, K, nsplit, (int)gridDim.x, vc);
    EpiRaw E; E.pu = pu; E.ld = N;
    pg8::gemm_phase<EpiRaw, pg8::TailOrder, false>(lds, g, S, E, nullptr);
}

__device__ __forceinline__ void transpose_item(const float* W, int N, bf16_t* WT, int K, int k0, int srcn0, int dstn0, LAS float* scr, int lane) {
    float tv[32];
#pragma unroll
    for (int i = 0; i < 32; ++i) tv[i] = W[(size_t)(k0 + 2 * i + (lane >> 5)) * N + srcn0 + (lane & 31)];
#pragma unroll
    for (int i = 0; i < 32; ++i) scr[(2 * i + (lane >> 5)) * 33 + (lane & 31)] = tv[i];
    LDS_WAIT();
    const int c = lane & 7;
#pragma unroll
    for (int j = 0; j < 4; ++j) { const int n = (lane >> 3) + 8 * j; const LAS float* s = scr + (8 * c) * 33 + n;
        u32x4 o; o.x = cvt_pk_bf16(s[0 * 33], s[1 * 33]); o.y = cvt_pk_bf16(s[2 * 33], s[3 * 33]); o.z = cvt_pk_bf16(s[4 * 33], s[5 * 33]); o.w = cvt_pk_bf16(s[6 * 33], s[7 * 33]);
        *(u32x4*)(WT + (size_t)(dstn0 + n) * K + k0 + 8 * c) = o; }
    LDS_WAIT();
}
__device__ __forceinline__ const float* src_row(const P& p, int r) {
    if (r < MP) { const int b = r / TT, t = r - b * TT; return t < 16 ? p.in[I_META] + (size_t)t * DM : p.in[I_XP] + ((size_t)b * 2048 + (t - 16)) * DM; }
    return p.in[I_XS] + (size_t)(r - MP) * DM;
}
template <bool OUT_BF16> __device__ __forceinline__ void ln_row(const float* xrow, const float* g, const float* bta, void* orow, int lane, int nsplit = 0, const bf16_t* xres = nullptr, const float* rbias = nullptr) {
    f32x4 v[4]; float s = 0.f;
#pragma unroll
    for (int j = 0; j < 4; ++j) { v[j] = *(const f32x4*)(xrow + 4 * lane + 256 * j);
        if (nsplit > 0) { for (int k = 1; k < nsplit; ++k) v[j] += *(const f32x4*)(xrow + (size_t)k * 256 * 1024 + 4 * lane + 256 * j);
            const u32x2 xw = *(const u32x2*)(xres + 4 * lane + 256 * j); const f32x4 bv = *(const f32x4*)(rbias + 4 * lane + 256 * j);
            v[j][0] += ALPHA * bflo(xw.x) + bv[0]; v[j][1] += ALPHA * bfhi(xw.x) + bv[1]; v[j][2] += ALPHA * bflo(xw.y) + bv[2]; v[j][3] += ALPHA * bfhi(xw.y) + bv[3]; }
        s += (v[j][0] + v[j][1]) + (v[j][2] + v[j][3]); }
    const float mean = wave_sum(s) * (1.f / DM); float s2 = 0.f;
#pragma unroll
    for (int j = 0; j < 4; ++j) { v[j] = v[j] - mean; s2 += (v[j][0] * v[j][0] + v[j][1] * v[j][1]) + (v[j][2] * v[j][2] + v[j][3] * v[j][3]); }
    const float rstd = 1.f / sqrtf(wave_sum(s2) * (1.f / DM) + LN_EPS);
#pragma unroll
    for (int j = 0; j < 4; ++j) { const f32x4 gg = *(const f32x4*)(g + 4 * lane + 256 * j), bb = *(const f32x4*)(bta + 4 * lane + 256 * j);
        const f32x4 o = (v[j] * rstd) * gg + bb;
        if (OUT_BF16) { u32x2 w; w.x = cvt_pk_bf16(o[0], o[1]); w.y = cvt_pk_bf16(o[2], o[3]); *(u32x2*)((bf16_t*)orow + 4 * lane + 256 * j) = w; }
        else *(f32x4*)((float*)orow + 4 * lane + 256 * j) = o; }
}
template <bool OUT_BF16> __device__ __forceinline__ void ln_rows2(const float* xa, const float* xb, const float* g, const float* bta, void* oa, void* ob, int lane, bool vb) {
    f32x4 va[4], vbv[4]; float sa = 0.f, sb = 0.f;
#pragma unroll
    for (int j = 0; j < 4; ++j) { va[j] = *(const f32x4*)(xa + 4 * lane + 256 * j); vbv[j] = *(const f32x4*)(xb + 4 * lane + 256 * j); }
#pragma unroll
    for (int j = 0; j < 4; ++j) { sa += (va[j][0] + va[j][1]) + (va[j][2] + va[j][3]); sb += (vbv[j][0] + vbv[j][1]) + (vbv[j][2] + vbv[j][3]); }
#pragma unroll
    for (int o = 1; o < 64; o <<= 1) { sa += __shfl_xor(sa, o); sb += __shfl_xor(sb, o); }
    const float ma = sa * (1.f / DM), mb = sb * (1.f / DM); float qa = 0.f, qb = 0.f;
#pragma unroll
    for (int j = 0; j < 4; ++j) { va[j] = va[j] - ma; vbv[j] = vbv[j] - mb; qa += (va[j][0] * va[j][0] + va[j][1] * va[j][1]) + (va[j][2] * va[j][2] + va[j][3] * va[j][3]);
        qb += (vbv[j][0] * vbv[j][0] + vbv[j][1] * vbv[j][1]) + (vbv[j][2] * vbv[j][2] + vbv[j][3] * vbv[j][3]); }
#pragma unroll
    for (int o = 1; o < 64; o <<= 1) { qa += __shfl_xor(qa, o); qb += __shfl_xor(qb, o); }
    const float ra = 1.f / sqrtf(qa * (1.f / DM) + LN_EPS), rb = 1.f / sqrtf(qb * (1.f / DM) + LN_EPS);
#pragma unroll
    for (int j = 0; j < 4; ++j) { const f32x4 gg = *(const f32x4*)(g + 4 * lane + 256 * j), bb = *(const f32x4*)(bta + 4 * lane + 256 * j);
        const f32x4 o1 = (va[j] * ra) * gg + bb, o2 = (vbv[j] * rb) * gg + bb;
        if (OUT_BF16) { u32x2 w; w.x = cvt_pk_bf16(o1[0], o1[1]); w.y = cvt_pk_bf16(o1[2], o1[3]); *(u32x2*)((bf16_t*)oa + 4 * lane + 256 * j) = w;
            if (vb) { w.x = cvt_pk_bf16(o2[0], o2[1]); w.y = cvt_pk_bf16(o2[2], o2[3]); *(u32x2*)((bf16_t*)ob + 4 * lane + 256 * j) = w; } }
        else { *(f32x4*)((float*)oa + 4 * lane + 256 * j) = o1; if (vb) *(f32x4*)((float*)ob + 4 * lane + 256 * j) = o2; } }
}
template <bool OUT_BF16> __device__ __forceinline__ void ln_rows2_bf(const bf16_t* xa, const bf16_t* xb, const float* g, const float* bta, void* oa, void* ob, int lane, bool vb) {
    float va[16], vq[16]; float sa = 0.f, sb = 0.f;
    { u32x4 ra[2], rb[2];
#pragma unroll
      for (int j = 0; j < 2; ++j) { ra[j] = *(const u32x4*)(xa + 8 * lane + 512 * j); rb[j] = *(const u32x4*)(xb + 8 * lane + 512 * j); }
#pragma unroll
      for (int j = 0; j < 2; ++j) { va[8 * j] = bflo(ra[j].x); va[8 * j + 1] = bfhi(ra[j].x); va[8 * j + 2] = bflo(ra[j].y); va[8 * j + 3] = bfhi(ra[j].y); va[8 * j + 4] = bflo(ra[j].z); va[8 * j + 5] = bfhi(ra[j].z); va[8 * j + 6] = bflo(ra[j].w); va[8 * j + 7] = bfhi(ra[j].w);
          vq[8 * j] = bflo(rb[j].x); vq[8 * j + 1] = bfhi(rb[j].x); vq[8 * j + 2] = bflo(rb[j].y); vq[8 * j + 3] = bfhi(rb[j].y); vq[8 * j + 4] = bflo(rb[j].z); vq[8 * j + 5] = bfhi(rb[j].z); vq[8 * j + 6] = bflo(rb[j].w); vq[8 * j + 7] = bfhi(rb[j].w); } }
#pragma unroll
    for (int e = 0; e < 16; ++e) { sa += va[e]; sb += vq[e]; }
#pragma unroll
    for (int o = 1; o < 64; o <<= 1) { sa += __shfl_xor(sa, o); sb += __shfl_xor(sb, o); }
    const float ma = sa * (1.f / DM), mb = sb * (1.f / DM); float qa = 0.f, qb = 0.f;
#pragma unroll
    for (int e = 0; e < 16; ++e) { va[e] -= ma; vq[e] -= mb; qa += va[e] * va[e]; qb += vq[e] * vq[e]; }
#pragma unroll
    for (int o = 1; o < 64; o <<= 1) { qa += __shfl_xor(qa, o); qb += __shfl_xor(qb, o); }
    const float ra_ = 1.f / sqrtf(qa * (1.f / DM) + LN_EPS), rb_ = 1.f / sqrtf(qb * (1.f / DM) + LN_EPS);
#pragma unroll
    for (int j = 0; j < 2; ++j) { const int c = 8 * lane + 512 * j; const f32x4 g0 = *(const f32x4*)(g + c), g1 = *(const f32x4*)(g + c + 4), b0 = *(const f32x4*)(bta + c), b1 = *(const f32x4*)(bta + c + 4);
        float o1[8], o2[8];
#pragma unroll
        for (int e = 0; e < 4; ++e) { o1[e] = va[8 * j + e] * ra_ * g0[e] + b0[e]; o1[4 + e] = va[8 * j + 4 + e] * ra_ * g1[e] + b1[e]; o2[e] = vq[8 * j + e] * rb_ * g0[e] + b0[e]; o2[4 + e] = vq[8 * j + 4 + e] * rb_ * g1[e] + b1[e]; }
        if (OUT_BF16) { u32x4 w; w.x = cvt_pk_bf16(o1[0], o1[1]); w.y = cvt_pk_bf16(o1[2], o1[3]); w.z = cvt_pk_bf16(o1[4], o1[5]); w.w = cvt_pk_bf16(o1[6], o1[7]); *(u32x4*)((bf16_t*)oa + c) = w;
            if (vb) { w.x = cvt_pk_bf16(o2[0], o2[1]); w.y = cvt_pk_bf16(o2[2], o2[3]); w.z = cvt_pk_bf16(o2[4], o2[5]); w.w = cvt_pk_bf16(o2[6], o2[7]); *(u32x4*)((bf16_t*)ob + c) = w; } }
        else { *(f32x4*)((float*)oa + c) = (f32x4){o1[0], o1[1], o1[2], o1[3]}; *(f32x4*)((float*)oa + c + 4) = (f32x4){o1[4], o1[5], o1[6], o1[7]};
            if (vb) { *(f32x4*)((float*)ob + c) = (f32x4){o2[0], o2[1], o2[2], o2[3]}; *(f32x4*)((float*)ob + c + 4) = (f32x4){o2[4], o2[5], o2[6], o2[7]}; } } }
}
__device__ __forceinline__ void s5_precompute(const P& p, LAS unsigned char* lds, int g) {
    LAS float* apr = (LAS float*)lds;
    LAS float* api = apr + 17 * 64;
    LAS float* bbr = api + 17 * 64;
    LAS float* bbi = bbr + 1024;
    LAS float* cr = bbi + 1024;
    LAS float* ci = cr + 1024;
    LAS float* Kl = ci + 1024;
    int tid_ = threadIdx.x; asm volatile("" : "+v"(tid_)); const int tid = tid_;
    if (tid < 64) { const int pp = tid;
        const float dt = expf(p.in[I_SLDT][g]); const float lre = p.in[I_SLRE][g * 64 + pp], lim = p.in[I_SLIM][g * 64 + pp];
        const float mag = expf(lre * dt); const float ang = lim * dt; const float abr = mag * cosf(ang), abi = mag * sinf(ang);
        const float den = lre * lre + lim * lim, nr = abr - 1.0f, ni = abi; const float fre = (nr * lre + ni * lim) / den, fim = (ni * lre - nr * lim) / den;
        float pr = 1.f, pi = 0.f;
        for (int j = 0; j <= 16; ++j) { apr[j * 64 + pp] = pr; api[j * 64 + pp] = pi; const float nr2 = pr * abr - pi * abi, ni2 = pr * abi + pi * abr; pr = nr2; pi = ni2; }
        float* a1 = (float*)(p.ws + W_A1); float* a16 = (float*)(p.ws + W_A16); float* bbar = (float*)(p.ws + W_BBAR);
        a1[(g * 64 + pp) * 2] = abr; a1[(g * 64 + pp) * 2 + 1] = abi; a16[(g * 64 + pp) * 2] = apr[16 * 64 + pp]; a16[(g * 64 + pp) * 2 + 1] = api[16 * 64 + pp];
        for (int c = 0; c < 16; ++c) { const float br = p.in[I_SBRE][(g * 64 + pp) * 16 + c], bi = p.in[I_SBIM][(g * 64 + pp) * 16 + c];
            const float xr = fre * br - fim * bi, xi = fre * bi + fim * br; bbr[pp * 16 + c] = xr; bbi[pp * 16 + c] = xi;
            bbar[((g * 64 + pp) * 16 + c) * 2] = xr; bbar[((g * 64 + pp) * 16 + c) * 2 + 1] = xi; }
    }
    for (int i = tid; i < 1024; i += 512) { cr[i] = p.in[I_SCRE][g * 1024 + i]; ci[i] = p.in[I_SCIM][g * 1024 + i]; }
    __syncthreads();
    { const int j = tid >> 5, c1 = (tid >> 1) & 15, c0 = 8 * (tid & 1); float acc8[8];
#pragma unroll
      for (int e = 0; e < 8; ++e) acc8[e] = 0.f;
      for (int pp = 0; pp < 64; ++pp) { const float xr = cr[c1 * 64 + pp], xi = ci[c1 * 64 + pp], ar = apr[j * 64 + pp], ai = api[j * 64 + pp]; const float car = xr * ar - xi * ai, cai = xr * ai + xi * ar;
          const f32x4 r0 = *(const LAS f32x4*)(bbr + pp * 16 + c0), r1 = *(const LAS f32x4*)(bbr + pp * 16 + c0 + 4), i0 = *(const LAS f32x4*)(bbi + pp * 16 + c0), i1 = *(const LAS f32x4*)(bbi + pp * 16 + c0 + 4);
          acc8[0] += car * r0[0] - cai * i0[0]; acc8[1] += car * r0[1] - cai * i0[1]; acc8[2] += car * r0[2] - cai * i0[2]; acc8[3] += car * r0[3] - cai * i0[3];
          acc8[4] += car * r1[0] - cai * i1[0]; acc8[5] += car * r1[1] - cai * i1[1]; acc8[6] += car * r1[2] - cai * i1[2]; acc8[7] += car * r1[3] - cai * i1[3]; }
#pragma unroll
      for (int e = 0; e < 8; ++e) { float v = acc8[e]; if (j == 0 && c1 == c0 + e) v += p.in[I_SD][g * 16 + c1]; Kl[(j * 16 + c1) * 16 + c0 + e] = v; } }
    __syncthreads();
    bf16_t* W1 = (bf16_t*)(p.ws + W_W1) + (size_t)g * 128 * 256; bf16_t* W2 = (bf16_t*)(p.ws + W_W2) + (size_t)g * 256 * 384;
    for (int i = tid; i < 128 * 32; i += 512) { const int n = i >> 5, ch = i & 31, s = ch >> 1, c0 = 8 * (ch & 1), pp = n & 63; const bool im = n >= 64; float v[8];
        const float ar = apr[(15 - s) * 64 + pp], ai = api[(15 - s) * 64 + pp];
#pragma unroll
        for (int e = 0; e < 8; ++e) { const float xr = bbr[pp * 16 + c0 + e], xi = bbi[pp * 16 + c0 + e]; v[e] = im ? (ar * xi + ai * xr) : (ar * xr - ai * xi); }
        u32x4 o; o.x = cvt_pk_bf16(v[0], v[1]); o.y = cvt_pk_bf16(v[2], v[3]); o.z = cvt_pk_bf16(v[4], v[5]); o.w = cvt_pk_bf16(v[6], v[7]);
        *(u32x4*)(W1 + (size_t)n * 256 + 8 * ch) = o; }
    for (int i = tid; i < 256 * 48; i += 512) { const int n = i / 48, ch = i - n * 48, t = n >> 4, c1 = n & 15; float v[8];
        if (ch < 32) { const int s = ch >> 1, c0 = 8 * (ch & 1);
#pragma unroll
            for (int e = 0; e < 8; ++e) v[e] = (s <= t) ? Kl[((t - s) * 16 + c1) * 16 + c0 + e] : 0.f; }
        else { const bool im = ch >= 40; const int p0 = 8 * (ch - (im ? 40 : 32));
#pragma unroll
            for (int e = 0; e < 8; ++e) { const int pp = p0 + e; const float ar = apr[(t + 1) * 64 + pp], ai = api[(t + 1) * 64 + pp], xr = cr[c1 * 64 + pp], xi = ci[c1 * 64 + pp];
                v[e] = im ? -(xr * ai + xi * ar) : (xr * ar - xi * ai); } }
        u32x4 o; o.x = cvt_pk_bf16(v[0], v[1]); o.y = cvt_pk_bf16(v[2], v[3]); o.z = cvt_pk_bf16(v[4], v[5]); o.w = cvt_pk_bf16(v[6], v[7]);
        *(u32x4*)(W2 + (size_t)n * 384 + 8 * ch) = o; }
    __syncthreads();
}
template <int CLS> __device__ __forceinline__ void transposes(const P& p, LAS float* scr, int lane, int gw, int NGW) {
    constexpr int I_UP = 16 * 192, I_DN = 48 * 32, I_IN = 16 * 112, I_GL = 8 * 64, I_OU = 16 * 32, I_LR = 16 * 8;
    constexpr int NITEMS = CLS == 0 ? I_IN + I_LR : I_UP + I_DN + I_GL + I_OU;
    for (int it = gw; it < NITEMS; it += NGW) { int r = it;
        if (CLS == 0) {
            if (r < I_IN) { const int kb = r / 112, nb = r % 112; transpose_item(p.in[I_WIN], DIN, (bf16_t*)(p.ws + W_WTIN), 1024, 64 * kb, 32 * nb, 32 * nb, scr, lane); continue; } r -= I_IN;
            { const int which = r >> 6, blk = (r >> 3) & 7, kb = (r >> 2) & 1, nb = r & 3;
              transpose_item(p.in[which ? I_WI : I_WR] + blk * 16384, 128, (bf16_t*)(p.ws + (which ? W_WTI : W_WTR)) + blk * 16384, 128, 64 * kb, 32 * nb, 32 * nb, scr, lane); }
        } else {
            if (r < I_UP) { const int kb = r / 192, nb = r % 192, d0 = 32 * nb, s0 = ((d0 >> 7) & 1) * DFF + (d0 >> 8) * 128 + (d0 & 127);
                transpose_item(p.in[I_WUP], 6144, (bf16_t*)(p.ws + W_WTUP), 1024, 64 * kb, s0, d0, scr, lane); continue; } r -= I_UP;
            if (r < I_DN) { const int kb = r / 32, nb = r % 32; transpose_item(p.in[I_WDOWN], 1024, (bf16_t*)(p.ws + W_WTDOWN), 3072, 64 * kb, 32 * nb, 32 * nb, scr, lane); continue; } r -= I_DN;
            if (r < I_GL) { const int kb = r / 64, nb = r % 64, d0 = 32 * nb, s0 = ((d0 >> 7) & 1) * 1024 + (d0 >> 8) * 128 + (d0 & 127);
                transpose_item(p.in[I_WGLU], 2048, (bf16_t*)(p.ws + W_WTGLU), 512, 64 * kb, s0, d0, scr, lane); continue; } r -= I_GL;
            { const int kb = r / 32, nb = r % 32; transpose_item(p.in[I_WOUT], 1024, (bf16_t*)(p.ws + W_WTOUT), 1024, 64 * kb, 32 * nb, 32 * nb, scr, lane); }
        }
    }
}
__device__ __forceinline__ void phase0(const P& p, LAS unsigned char* lds) {
    int tid_ = threadIdx.x; asm volatile("" : "+v"(tid_)); const int tid = tid_, lane = tid & 63, wid = tid >> 6;
    REPEAT(REP_P0A) for (int g = blockIdx.x; g < NG; g += gridDim.x) s5_precompute(p, lds, g);
    LAS float* scr = (LAS float*)(lds + wid * 8704);
    const int gw = blockIdx.x * 8 + wid, NGW = gridDim.x * 8;
    { const int skip = ((int)gridDim.x >= 64) ? NG : 0;
      if ((int)blockIdx.x >= skip) REPEAT(REP_P0B) transposes<0>(p, scr, lane, ((int)blockIdx.x - skip) * 8 + wid, ((int)gridDim.x - skip) * 8); }
    { const int skip = ((int)gridDim.x >= 64) ? NG : 0;
      if ((int)blockIdx.x >= skip) { const int gw2 = ((int)blockIdx.x - skip) * 8 + wid, NGW2 = ((int)gridDim.x - skip) * 8;
        REPEAT(REP_P0C) for (int r = gw2; r < MTOK; r += 2 * NGW2) { const int r2 = r + NGW2; const bool vb = r2 < MTOK; const int rb = vb ? r2 : r;
          ln_rows2<true>(src_row(p, r), src_row(p, rb), p.in[I_EG], p.in[I_EB], (bf16_t*)(p.ws + W_XN) + (size_t)r * DM, (bf16_t*)(p.ws + W_XN) + (size_t)rb * DM, lane, vb); } } }
}

template <int MODE> __device__ __forceinline__ void lru_unit(const P& p, LAS unsigned char* lds, int b, int kc, int nb) {
    int tid_ = threadIdx.x; asm volatile("" : "+v"(tid_)); const int tid = tid_, lane = tid & 63, wid = tid >> 6, q = lane >> 4, n = lane & 15;
    int mt0, nmt, rowbase;
    if (MODE == 2) { mt0 = kc; nmt = 1; rowbase = MP; } else { mt0 = (NCHUNK * kc) >> 3; nmt = ((NCHUNK * (kc + 1)) >> 3) - mt0; rowbase = b * TT; }
    const int t0 = 16 * mt0, ntok = 16 * nmt;
    const bf16_t* proj = (const bf16_t*)(p.ws + W_PROJ);
    LAS bf16_t* xcs = (LAS bf16_t*)lds;
    LAS bf16_t* gas = (LAS bf16_t*)(lds + 73984);
    if (MODE == 2) {
        for (int it = tid; it < ntok * 16; it += 512) { const int i = it >> 4, cg8 = it & 15, c0 = nb * 128 + cg8 * 8; float a[8];
            { const f32x4 b0 = *(const f32x4*)(p.in[I_CLB] + c0), b1 = *(const f32x4*)(p.in[I_CLB] + c0 + 4); a[0] = b0[0]; a[1] = b0[1]; a[2] = b0[2]; a[3] = b0[3]; a[4] = b1[0]; a[5] = b1[1]; a[6] = b1[2]; a[7] = b1[3]; }
#pragma unroll
            for (int j = 0; j < 4; ++j) { const f32x4 w0 = *(const f32x4*)(p.in[I_CLW] + j * 1024 + c0), w1 = *(const f32x4*)(p.in[I_CLW] + j * 1024 + c0 + 4); float x[8];
                if (j < 3) { const float* cp = p.in[I_CCL] + ((size_t)(t0 + i) * 3 + j) * 1024 + c0; const f32x4 x0 = *(const f32x4*)cp, x1 = *(const f32x4*)(cp + 4);
                    x[0] = x0[0]; x[1] = x0[1]; x[2] = x0[2]; x[3] = x0[3]; x[4] = x1[0]; x[5] = x1[1]; x[6] = x1[2]; x[7] = x1[3]; }
                else { const u32x4 xv = *(const u32x4*)(proj + (size_t)(rowbase + t0 + i) * DIN + c0);
                    x[0] = bflo(xv.x); x[1] = bfhi(xv.x); x[2] = bflo(xv.y); x[3] = bfhi(xv.y); x[4] = bflo(xv.z); x[5] = bfhi(xv.z); x[6] = bflo(xv.w); x[7] = bfhi(xv.w); }
                a[0] += w0[0] * x[0]; a[1] += w0[1] * x[1]; a[2] += w0[2] * x[2]; a[3] += w0[3] * x[3]; a[4] += w1[0] * x[4]; a[5] += w1[1] * x[5]; a[6] += w1[2] * x[6]; a[7] += w1[3] * x[7]; }
            u32x4 o; o.x = cvt_pk_bf16(a[0], a[1]); o.y = cvt_pk_bf16(a[2], a[3]); o.z = cvt_pk_bf16(a[4], a[5]); o.w = cvt_pk_bf16(a[6], a[7]);
            *(LAS u32x4*)(xcs + i * 136 + cg8 * 8) = o;
            *(LAS u32x4*)(gas + i * 128 + cg8 * 8) = *(const u32x4*)(proj + (size_t)(rowbase + t0 + i) * DIN + C_GA + c0); }
    } else {
        const int cg8 = tid & 15, tr = tid >> 4, c0 = nb * 128 + cg8 * 8; float w[4][8], bs[8];
        { const f32x4 b0 = *(const f32x4*)(p.in[I_CLB] + c0), b1 = *(const f32x4*)(p.in[I_CLB] + c0 + 4); bs[0] = b0[0]; bs[1] = b0[1]; bs[2] = b0[2]; bs[3] = b0[3]; bs[4] = b1[0]; bs[5] = b1[1]; bs[6] = b1[2]; bs[7] = b1[3]; }
#pragma unroll
        for (int j = 0; j < 4; ++j) { const f32x4 w0 = *(const f32x4*)(p.in[I_CLW] + j * 1024 + c0), w1 = *(const f32x4*)(p.in[I_CLW] + j * 1024 + c0 + 4);
            w[j][0] = w0[0]; w[j][1] = w0[1]; w[j][2] = w0[2]; w[j][3] = w0[3]; w[j][4] = w1[0]; w[j][5] = w1[1]; w[j][6] = w1[2]; w[j][7] = w1[3]; }
        const int i0 = tr * 9; int i1 = i0 + 9; if (i1 > ntok) i1 = ntok;
        u32x4 xr[12], gr[9];
#pragma unroll
        for (int k = 0; k < 12; ++k) { const int i = i0 - 3 + k, t = t0 + i; xr[k] = (u32x4){0u, 0u, 0u, 0u}; if (t >= 0 && i < i1) xr[k] = *(const u32x4*)(proj + (size_t)(rowbase + t) * DIN + c0); }
#pragma unroll
        for (int k = 0; k < 9; ++k) { gr[k] = (u32x4){0u, 0u, 0u, 0u}; if (i0 + k < i1) gr[k] = *(const u32x4*)(proj + (size_t)(rowbase + t0 + i0 + k) * DIN + C_GA + c0); }
#pragma unroll
        for (int k = 0; k < 9; ++k) { if (i0 + k < i1) { float a[8];
#pragma unroll
            for (int e = 0; e < 8; ++e) a[e] = bs[e];
#pragma unroll
            for (int j = 0; j < 4; ++j) { const u32x4 xv = xr[k + j];
                a[0] += w[j][0] * bflo(xv.x); a[1] += w[j][1] * bfhi(xv.x); a[2] += w[j][2] * bflo(xv.y); a[3] += w[j][3] * bfhi(xv.y);
                a[4] += w[j][4] * bflo(xv.z); a[5] += w[j][5] * bfhi(xv.z); a[6] += w[j][6] * bflo(xv.w); a[7] += w[j][7] * bfhi(xv.w); }
            u32x4 o; o.x = cvt_pk_bf16(a[0], a[1]); o.y = cvt_pk_bf16(a[2], a[3]); o.z = cvt_pk_bf16(a[4], a[5]); o.w = cvt_pk_bf16(a[6], a[7]);
            *(LAS u32x4*)(xcs + (i0 + k) * 136 + cg8 * 8) = o; *(LAS u32x4*)(gas + (i0 + k) * 128 + cg8 * 8) = gr[k]; } }
    }
    __syncthreads();
    const int c = nb * 128 + wid * 16 + n;
    bf16x8 Br[4], Bi[4];
    { const bf16_t* wr_ = (const bf16_t*)(p.ws + W_WTR) + (size_t)c * 128 + q * 8; const bf16_t* wi_ = (const bf16_t*)(p.ws + W_WTI) + (size_t)c * 128 + q * 8;
#pragma unroll
      for (int kk = 0; kk < 4; ++kk) { Br[kk] = *(const bf16x8*)(wr_ + 32 * kk); Bi[kk] = *(const bf16x8*)(wi_ + 32 * kk); } }
    const float br = p.in[I_BR][c], bi = p.in[I_BI][c]; const float c8 = -8.0f * log1pf(expf(-p.in[I_LAM][c]));
    bf16_t* M1 = (bf16_t*)(p.ws + W_MIX); bf16_t* M2 = (bf16_t*)(p.out + O_YP);
    float h_run = 0.f, A_run = 1.f;
    for (int mt = 0; mt < nmt; ++mt) {
        f32x4 accr = {0.f, 0.f, 0.f, 0.f}, acci = {0.f, 0.f, 0.f, 0.f};
#pragma unroll
        for (int kk = 0; kk < 4; ++kk) { const bf16x8 Af = *(const LAS bf16x8*)(xcs + (16 * mt + n) * 136 + 32 * kk + 8 * q);
            accr = __builtin_amdgcn_mfma_f32_16x16x32_bf16(Af, Br[kk], accr, 0, 0, 0); acci = __builtin_amdgcn_mfma_f32_16x16x32_bf16(Af, Bi[kk], acci, 0, 0, 0); }
        float a[4], bx[4], ga[4];
#pragma unroll
        for (int j = 0; j < 4; ++j) { const int tok = 16 * mt + 4 * q + j; const float xcv = bf2f(xcs[tok * 136 + wid * 16 + n]);
            ga[j] = bf2f(gas[tok * 128 + wid * 16 + n]);
            const float r = sigm(accr[j] + br), ig = sigm(acci[j] + bi), la = c8 * r; a[j] = __expf(la); bx[j] = __builtin_amdgcn_sqrtf(fmaf(-a[j], a[j], 1.0f)) * (ig * xcv); }
        float h[4], Ac[4];
        if (MODE == 2) {
#pragma unroll
            for (int j = 0; j < 4; ++j) { const int s = t0 + 16 * mt + 4 * q + j; h[j] = a[j] * p.in[I_SL][(size_t)s * 1024 + c] + bx[j]; p.out[O_SL + (size_t)s * 1024 + c] = h[j]; Ac[j] = 0.f; }
        } else {
            float Ap[4]; h[0] = bx[0]; Ap[0] = a[0];
#pragma unroll
            for (int j = 1; j < 4; ++j) { h[j] = a[j] * h[j - 1] + bx[j]; Ap[j] = a[j] * Ap[j - 1]; }
            float PA = Ap[3], PH = h[3];
            float tA = __shfl_up(PA, 16), tH = __shfl_up(PH, 16); if (q >= 1) { PH = PA * tH + PH; PA = PA * tA; }
            tA = __shfl_up(PA, 32); tH = __shfl_up(PH, 32); if (q >= 2) { PH = PA * tH + PH; PA = PA * tA; }
            const float h_end = PA * h_run + PH; const float hin_s = __shfl_up(h_end, 16), pae_s = __shfl_up(PA, 16);
            const float h_in = (q == 0) ? h_run : hin_s; const float a_in = A_run * ((q == 0) ? 1.0f : pae_s);
#pragma unroll
            for (int j = 0; j < 4; ++j) { h[j] += Ap[j] * h_in; Ac[j] = Ap[j] * a_in; }
            h_run = __shfl(h_end, 48 + n); A_run *= __shfl(PA, 48 + n);
        }
#pragma unroll
        for (int j = 0; j < 4; ++j) { const size_t row = (size_t)(rowbase + t0 + 16 * mt + 4 * q + j); const float sg = sigm(ga[j]);
            M1[row * 1024 + c] = f2bf(sg * h[j]); M2[row * 1024 + c] = f2bf(sg * Ac[j]); }
    }
    if (MODE == 0 && q == 0) { ((float*)(p.ws + W_LRUA))[(size_t)(b * 8 + kc) * 1024 + c] = A_run; ((float*)(p.ws + W_LRUH))[(size_t)(b * 8 + kc) * 1024 + c] = h_run; }
    __syncthreads();
}

template <int PASS> __device__ __forceinline__ void s5_item(const P& p, int g, int sub, int lane, int wid) {
    constexpr int KS = (PASS == 1) ? 8 : 12, NTW = (PASS == 1) ? 1 : 2, LDW = (PASS == 1) ? 256 : 384;
    const int n = lane & 15, q = lane >> 4;
    const bf16_t* proj = (const bf16_t*)(p.ws + W_PROJ);
    const bf16_t* W = (PASS == 1) ? (const bf16_t*)(p.ws + W_W1) + (size_t)g * 128 * 256 : (const bf16_t*)(p.ws + W_W2) + (size_t)g * 256 * 384;
    bf16x8 Bf[NTW][KS];
#pragma unroll
    for (int i = 0; i < NTW; ++i)
#pragma unroll
        for (int kk = 0; kk < KS; ++kk) Bf[i][kk] = *(const bf16x8*)(W + (size_t)(16 * (NTW * wid + i) + n) * LDW + 32 * kk + 8 * q);
    const int rt0 = (65 * sub) >> 3, rt1 = (65 * (sub + 1)) >> 3; const bf16x8 zero = {0, 0, 0, 0, 0, 0, 0, 0};
    for (int rt = rt0; rt < rt1; ++rt) {
        const int R = 16 * rt + n; const bool valid = R < NR; const int Rc = valid ? R : 0; const int b = Rc / NCHUNK, k = Rc - b * NCHUNK;
        bf16x8 Af[KS];
        { const bf16_t* ub = proj + (size_t)(b * TT + 16 * k) * DIN + C_US + 16 * g + 8 * (q & 1);
#pragma unroll
          for (int kk = 0; kk < 8; ++kk) { const int s = 2 * kk + (q >> 1); Af[kk] = valid ? *(const bf16x8*)(ub + (size_t)s * DIN) : zero; } }
        if (PASS == 3) { const bf16_t* hb = (const bf16_t*)(p.ws + W_HPREV) + ((size_t)Rc * NG + g) * 128 + 8 * q;
#pragma unroll
          for (int kk = 8; kk < KS; ++kk) Af[kk] = valid ? *(const bf16x8*)(hb + 32 * (kk - 8)) : zero; }
        f32x4 acc[NTW];
#pragma unroll
        for (int i = 0; i < NTW; ++i) { acc[i] = (f32x4){0.f, 0.f, 0.f, 0.f};
#pragma unroll
            for (int kk = 0; kk < KS; ++kk) acc[i] = __builtin_amdgcn_mfma_f32_16x16x32_bf16(Af[kk], Bf[i][kk], acc[i], 0, 0, 0); }
#pragma unroll
        for (int j = 0; j < 4; ++j) { const int R2 = 16 * rt + 4 * q + j; if (R2 < NR) {
            if (PASS == 1) { ((float*)(p.ws + W_S))[((size_t)R2 * NG + g) * 128 + 16 * wid + n] = acc[0][j]; }
            else { const int b2 = R2 / NCHUNK, k2 = R2 - b2 * NCHUNK; bf16_t* Y = (bf16_t*)(p.ws + W_YSG) + (size_t)(b2 * TT + 16 * k2) * DSSM + 16 * g + n;
#pragma unroll
                for (int i = 0; i < NTW; ++i) Y[(size_t)(NTW * wid + i) * DSSM] = f2bf(gelu_tanh(acc[i][j])); } } }
    }
}
__device__ __forceinline__ void s5_fused(const P& p, LAS unsigned char* lds, int g, int b) {
    int tid_ = threadIdx.x; asm volatile("" : "+v"(tid_)); const int tid = tid_, lane = tid & 63, wid = tid >> 6, n = lane & 15, q = lane >> 4;
    LAS bf16_t* Us = (LAS bf16_t*)lds;
    LAS float* Ssm = (LAS float*)(lds + 68112);
    LAS bf16_t* Hs = (LAS bf16_t*)(lds + 68112);
    const bf16_t* proj = (const bf16_t*)(p.ws + W_PROJ); const bf16x8 zero = {0, 0, 0, 0, 0, 0, 0, 0};
    TIMED(231) { const bf16_t* ub = proj + (size_t)(b * TT) * DIN + C_US + 16 * g;
      u32x4 tv[9];
#pragma unroll
      for (int i = 0; i < 9; ++i) { const int it = tid + 512 * i; tv[i] = (u32x4){0u, 0u, 0u, 0u}; if (it < TT * 2) tv[i] = *(const u32x4*)(ub + (size_t)(it >> 1) * DIN + 8 * (it & 1)); }
#pragma unroll
      for (int i = 0; i < 9; ++i) { const int it = tid + 512 * i; if (it < TT * 2) { const int t = it >> 1; *(LAS u32x4*)(Us + (t >> 4) * 264 + (t & 15) * 16 + 8 * (it & 1)) = tv[i]; } } }
    __syncthreads();
    TIMED_END(231)
    TIMED(232) { const bf16_t* W = (const bf16_t*)(p.ws + W_W1) + (size_t)g * 128 * 256; bf16x8 Bf[8];
#pragma unroll
      for (int kk = 0; kk < 8; ++kk) Bf[kk] = *(const bf16x8*)(W + (size_t)(16 * wid + n) * 256 + 32 * kk + 8 * q);
#pragma unroll 1
      for (int rt = 0; rt < 9; ++rt) { const int k = 16 * rt + n; const bool valid = k < NCHUNK; const int kc = valid ? k : 0; f32x4 acc = {0.f, 0.f, 0.f, 0.f};
#pragma unroll
          for (int kk = 0; kk < 8; ++kk) { const bf16x8 uv = *(const LAS bf16x8*)(Us + kc * 264 + 32 * kk + 8 * q); const bf16x8 Af = valid ? uv : zero;
              acc = __builtin_amdgcn_mfma_f32_16x16x32_bf16(Af, Bf[kk], acc, 0, 0, 0); }
#pragma unroll
          for (int j = 0; j < 4; ++j) Ssm[(16 * rt + 4 * q + j) * 128 + 16 * wid + n] = acc[j]; } }
    __syncthreads();
    TIMED_END(232)
    bf16x8 Bw[2][12];
    { const bf16_t* W = (const bf16_t*)(p.ws + W_W2) + (size_t)g * 256 * 384;
#pragma unroll
      for (int i = 0; i < 2; ++i)
#pragma unroll
          for (int kk = 0; kk < 12; ++kk) Bw[i][kk] = *(const bf16x8*)(W + (size_t)(16 * (2 * wid + i) + n) * 384 + 32 * kk + 8 * q); }
    TIMED(233) if (wid == 0) { const float* a16 = (const float*)(p.ws + W_A16) + (g * 64 + lane) * 2; const float ar = a16[0], ai = a16[1]; float hr = 0.f, hi = 0.f;
#pragma unroll 1
        for (int kb = 0; kb < 132; kb += 4) { float sr[4], si[4];
#pragma unroll
            for (int u = 0; u < 4; ++u) { sr[u] = Ssm[(kb + u) * 128 + lane]; si[u] = Ssm[(kb + u) * 128 + 64 + lane]; }
            LDS_WAIT();
#pragma unroll
            for (int u = 0; u < 4; ++u) { const int k = kb + u; if (k < NCHUNK) { Hs[k * 136 + lane] = f2bf(hr); Hs[k * 136 + 64 + lane] = f2bf(hi);
                const float nr = ar * hr - ai * hi + sr[u], ni = ar * hi + ai * hr + si[u]; hr = nr; hi = ni; } } }
        p.out[O_PSR + ((size_t)b * NG + g) * 64 + lane] = hr; p.out[O_PSI + ((size_t)b * NG + g) * 64 + lane] = hi; }
    __syncthreads();
    TIMED_END(233)
    TIMED(234)
    {
#pragma unroll 1
      for (int rt = 0; rt < 9; ++rt) { const int k = 16 * rt + n; const bool valid = k < NCHUNK; const int kc = valid ? k : 0; f32x4 acc0 = {0.f, 0.f, 0.f, 0.f}, acc1 = {0.f, 0.f, 0.f, 0.f};
#pragma unroll
          for (int kk = 0; kk < 8; ++kk) { const bf16x8 uv = *(const LAS bf16x8*)(Us + kc * 264 + 32 * kk + 8 * q); const bf16x8 af = valid ? uv : zero;
              acc0 = __builtin_amdgcn_mfma_f32_16x16x32_bf16(af, Bw[0][kk], acc0, 0, 0, 0); acc1 = __builtin_amdgcn_mfma_f32_16x16x32_bf16(af, Bw[1][kk], acc1, 0, 0, 0); }
#pragma unroll
          for (int kk = 8; kk < 12; ++kk) { const bf16x8 hv = *(const LAS bf16x8*)(Hs + kc * 136 + 32 * (kk - 8) + 8 * q); const bf16x8 af = valid ? hv : zero;
              acc0 = __builtin_amdgcn_mfma_f32_16x16x32_bf16(af, Bw[0][kk], acc0, 0, 0, 0); acc1 = __builtin_amdgcn_mfma_f32_16x16x32_bf16(af, Bw[1][kk], acc1, 0, 0, 0); }
#pragma unroll
          for (int j = 0; j < 4; ++j) { const int k2 = 16 * rt + 4 * q + j; if (k2 < NCHUNK) { bf16_t* Y = (bf16_t*)(p.ws + W_YSG) + (size_t)(b * TT + 16 * k2 + 2 * wid) * DSSM + 16 * g + n;
              Y[0] = f2bf(gelu_tanh(acc0[j])); Y[DSSM] = f2bf(gelu_tanh(acc1[j])); } } } }
    TIMED_END(234)
}
__device__ __forceinline__ void s5_sample(const P& p, int s, int g, int lane) {
    const bf16_t* proj = (const bf16_t*)(p.ws + W_PROJ); const bf16_t* up = proj + (size_t)(MP + s) * DIN + C_US + 16 * g;
    const u32x4 u0 = *(const u32x4*)up, u1 = *(const u32x4*)(up + 8); float u[16];
    u[0] = bflo(u0.x); u[1] = bfhi(u0.x); u[2] = bflo(u0.y); u[3] = bfhi(u0.y); u[4] = bflo(u0.z); u[5] = bfhi(u0.z); u[6] = bflo(u0.w); u[7] = bfhi(u0.w);
    u[8] = bflo(u1.x); u[9] = bfhi(u1.x); u[10] = bflo(u1.y); u[11] = bfhi(u1.y); u[12] = bflo(u1.z); u[13] = bfhi(u1.z); u[14] = bflo(u1.w); u[15] = bfhi(u1.w);
    const float* a1 = (const float*)(p.ws + W_A1) + (g * 64 + lane) * 2; const float ar = a1[0], ai = a1[1];
    const float* bb = (const float*)(p.ws + W_BBAR) + (size_t)(g * 64 + lane) * 32; float bur = 0.f, bui = 0.f;
#pragma unroll
    for (int c = 0; c < 16; ++c) { bur += bb[2 * c] * u[c]; bui += bb[2 * c + 1] * u[c]; }
    const size_t si = ((size_t)s * NG + g) * 64 + lane; const float h0r = p.in[I_SSR][si], h0i = p.in[I_SSI][si];
    const float hr = ar * h0r - ai * h0i + bur, hi = ar * h0i + ai * h0r + bui;
    p.out[O_SSR + si] = hr; p.out[O_SSI + si] = hi;
    float v16[16];
#pragma unroll
    for (int c1 = 0; c1 < 16; ++c1) v16[c1] = p.in[I_SCRE][(g * 16 + c1) * 64 + lane] * hr - p.in[I_SCIM][(g * 16 + c1) * 64 + lane] * hi;
    float v8[8], v4[4], v2[2], v1;
    { const bool hi32 = (lane & 32) != 0;
#pragma unroll
      for (int i = 0; i < 8; ++i) { const float keep = hi32 ? v16[i + 8] : v16[i], send = hi32 ? v16[i] : v16[i + 8]; v8[i] = keep + __shfl_xor(send, 32); } }
    { const bool hb = (lane & 16) != 0;
#pragma unroll
      for (int i = 0; i < 4; ++i) { const float keep = hb ? v8[i + 4] : v8[i], send = hb ? v8[i] : v8[i + 4]; v4[i] = keep + __shfl_xor(send, 16); } }
    { const bool hb = (lane & 8) != 0;
#pragma unroll
      for (int i = 0; i < 2; ++i) { const float keep = hb ? v4[i + 2] : v4[i], send = hb ? v4[i] : v4[i + 2]; v2[i] = keep + __shfl_xor(send, 8); } }
    { const bool hb = (lane & 4) != 0; const float keep = hb ? v2[1] : v2[0], send = hb ? v2[0] : v2[1]; v1 = keep + __shfl_xor(send, 4); }
    v1 += __shfl_xor(v1, 1); v1 += __shfl_xor(v1, 2);
    const int c1 = ((lane >> 5) & 1) * 8 + ((lane >> 4) & 1) * 4 + ((lane >> 3) & 1) * 2 + ((lane >> 2) & 1);
    if ((lane & 3) == 0) { const float uc = bf2f(up[c1]); const float yv = v1 + p.in[I_SD][g * 16 + c1] * uc;
        ((bf16_t*)(p.ws + W_YSG))[(size_t)(MP + s) * DSSM + 16 * g + c1] = f2bf(gelu_tanh(yv)); }
}
__device__ __forceinline__ void phase2a(const P& p, LAS unsigned char* lds) {
    TIMED(22) for (int u = blockIdx.x; u < 512; u += gridDim.x) lru_unit<0>(p, lds, (u >> 3) & 7, u >> 6, u & 7); TIMED_END(22)
    TIMED(23) for (int it = blockIdx.x; it < NG * NBATCH; it += gridDim.x) s5_fused(p, lds, it & 31, it >> 5); TIMED_END(23)
}
__device__ __forceinline__ void phase2b(const P& p, LAS unsigned char* lds) {
    int tid_ = threadIdx.x; asm volatile("" : "+v"(tid_)); const int tid = tid_, lane = tid & 63, wid = tid >> 6;
    const size_t gt = (size_t)blockIdx.x * 512 + tid, GT = (size_t)gridDim.x * 512;
    for (size_t i = gt; i < (size_t)NBATCH * 1024; i += GT) { const int b = (int)(i >> 10), c = (int)(i & 1023); float h = 0.f;
        const float* A = (const float*)(p.ws + W_LRUA); const float* Hh = (const float*)(p.ws + W_LRUH); float* Cc = (float*)(p.ws + W_LRUC);
        for (int kc = 0; kc < 8; ++kc) { const size_t o = (size_t)(b * 8 + kc) * 1024 + c; Cc[o] = h; h = A[o] * h + Hh[o]; }
        p.out[O_PL + i] = h; }
    for (int u = (int)gridDim.x - 1 - (int)blockIdx.x; u < 64; u += gridDim.x) lru_unit<2>(p, lds, 0, u >> 3, u & 7);
    for (int it = blockIdx.x * 8 + wid; it < NSAMP * NG; it += gridDim.x * 8) s5_sample(p, it >> 5, it & 31, lane);
    const bf16_t* proj = (const bf16_t*)(p.ws + W_PROJ);
    for (size_t i = gt; i < (size_t)NBATCH * 3 * 1024; i += GT) { const int c = (int)(i & 1023), j = (int)((i >> 10) % 3), b = (int)(i / 3072);
        p.out[O_PCL + i] = bf2f(proj[(size_t)(b * TT + TT - 3 + j) * DIN + c]); }
    for (size_t i = gt; i < (size_t)NSAMP * 3 * 1024; i += GT) { const int c = (int)(i & 1023), j = (int)((i >> 10) % 3), s = (int)(i / 3072);
        p.out[O_SCL + i] = (j < 2) ? p.in[I_CCL][((size_t)s * 3 + j + 1) * 1024 + c] : bf2f(proj[(size_t)(MP + s) * DIN + c]); }
    for (size_t i = gt; i < (size_t)NSAMP * DFF; i += GT) { const int ch = (int)(i % DFF), s = (int)(i / DFF);
        p.out[O_SCF + ((size_t)s * 2) * DFF + ch] = p.in[I_CCF][((size_t)s * 2 + 1) * DFF + ch]; }
}
__device__ __forceinline__ void phase2c(const P& p, LAS unsigned char* lds) {
    const int lane = threadIdx.x & 63, wid = threadIdx.x >> 6;
    for (int it = blockIdx.x; it < NG * 8; it += gridDim.x) s5_item<3>(p, it >> 3, it & 7, lane, wid);
}
__device__ __forceinline__ void phase_ln1(const P& p) {
    const int lane = threadIdx.x & 63, wid = threadIdx.x >> 6; const int gw = blockIdx.x * 8 + wid, NGW = gridDim.x * 8;
    const bf16_t* R = (const bf16_t*)(p.ws + W_R1); bf16_t* X = (bf16_t*)(p.ws + W_XN);
    for (int r = gw; r < 16384; r += 2 * NGW) { const int r2 = r + NGW; const bool vb = r2 < 16384; const int rb = vb ? r2 : r;
        ln_rows2_bf<true>(R + (size_t)r * DM, R + (size_t)rb * DM, p.in[I_L1G], p.in[I_L1B], X + (size_t)r * DM, X + (size_t)rb * DM, lane, vb); }
    for (int r = 16384 + gw; r < MTOK; r += NGW) { bf16_t* xr = X + (size_t)r * DM;
        ln_row<true>((const float*)(p.ws + W_PART) + (size_t)(r - 16384) * DM, p.in[I_L1G], p.in[I_L1B], xr, lane, 4, xr, p.in[I_BOUT]); }
}
__device__ __forceinline__ void phase_ffnfix(const P& p) {
    const size_t gt = (size_t)blockIdx.x * 512 + threadIdx.x, GT = (size_t)gridDim.x * 512;
    const float* sbg = (const float*)(p.ws + W_SBG); const float* sbv = (const float*)(p.ws + W_SBV); bf16_t* H = (bf16_t*)(p.ws + W_V);
    for (size_t it = gt; it < (size_t)256 * 2 * 384; it += GT) { const int cg8 = (int)(it % 384), rr = (int)((it / 384) & 1), blk = (int)(it / 768), ch = cg8 * 8, row = blk * 64 + rr; const int t = row % TT;
        float o[8];
#pragma unroll
        for (int hh = 0; hh < 2; ++hh) { const int c = ch + 4 * hh; const f32x4 z = {0.f, 0.f, 0.f, 0.f};
            const f32x4 g0 = *(const f32x4*)(sbg + ((size_t)blk * 4 + rr) * DFF + c), v = *(const f32x4*)(sbv + ((size_t)blk * 2 + rr) * DFF + c);
            f32x4 g1, g2;
            if (rr == 0) { g1 = (blk > 0 && t >= 1) ? *(const f32x4*)(sbg + ((size_t)(blk - 1) * 4 + 3) * DFF + c) : z; g2 = (blk > 0 && t >= 2) ? *(const f32x4*)(sbg + ((size_t)(blk - 1) * 4 + 2) * DFF + c) : z; }
            else { g1 = (t >= 1) ? *(const f32x4*)(sbg + ((size_t)blk * 4) * DFF + c) : z; g2 = (blk > 0 && t >= 2) ? *(const f32x4*)(sbg + ((size_t)(blk - 1) * 4 + 3) * DFF + c) : z; }
            const f32x4 w0 = *(const f32x4*)(p.in[I_FCW] + c), w1 = *(const f32x4*)(p.in[I_FCW] + DFF + c), w2 = *(const f32x4*)(p.in[I_FCW] + 2 * DFF + c), cbv = *(const f32x4*)(p.in[I_FCB] + c);
            const f32x4 y = cbv + w0 * g2 + w1 * g1 + w2 * g0;
            o[4 * hh] = gelu_tanh(y[0]) * v[0]; o[4 * hh + 1] = gelu_tanh(y[1]) * v[1]; o[4 * hh + 2] = gelu_tanh(y[2]) * v[2]; o[4 * hh + 3] = gelu_tanh(y[3]) * v[3]; }
        u32x4 w; w.x = cvt_pk_bf16(o[0], o[1]); w.y = cvt_pk_bf16(o[2], o[3]); w.z = cvt_pk_bf16(o[4], o[5]); w.w = cvt_pk_bf16(o[6], o[7]);
        *(u32x4*)(H + (size_t)row * DFF + ch) = w; }
}
__device__ __forceinline__ f32x4 up_tail_sum(const float* pu, const float* bias, int rl, int col, int bcol) {
    f32x4 v = *(const f32x4*)(bias + bcol);
#pragma unroll
    for (int ks = 0; ks < 4; ++ks) v += *(const f32x4*)(pu + (size_t)ks * 256 * 6144 + (size_t)rl * 6144 + col);
    return v;
}
__device__ __forceinline__ void phase_ffntail(const P& p) {
    const size_t gt = (size_t)blockIdx.x * 512 + threadIdx.x, GT = (size_t)gridDim.x * 512;
    const float* pu = (const float*)(p.ws + W_PU); const float* sbg = (const float*)(p.ws + W_SBG); bf16_t* H = (bf16_t*)(p.ws + W_V); const float* bias = p.in[I_BUP];
    for (size_t it = gt; it < (size_t)256 * 768; it += GT) { const int rl = (int)(it / 768), ch = (int)(it - (size_t)rl * 768) * 4, row = 16384 + rl; const int colg = 256 * (ch >> 7) + (ch & 127);
        const f32x4 g0 = up_tail_sum(pu, bias, rl, colg, ch), v = up_tail_sum(pu, bias, rl, colg + 128, DFF + ch); f32x4 g1, g2;
        if (row >= MP) { const int s_ = row - MP; g2 = *(const f32x4*)(p.in[I_CCF] + ((size_t)s_ * 2) * DFF + ch); g1 = *(const f32x4*)(p.in[I_CCF] + ((size_t)s_ * 2 + 1) * DFF + ch);
            *(f32x4*)(p.out + O_SCF + ((size_t)s_ * 2 + 1) * DFF + ch) = g0; }
        else {
            g1 = (rl >= 1) ? up_tail_sum(pu, bias, rl - 1, colg, ch) : *(const f32x4*)(sbg + ((size_t)255 * 4 + 3) * DFF + ch);
            g2 = (rl >= 2) ? up_tail_sum(pu, bias, rl - 2, colg, ch) : *(const f32x4*)(sbg + ((size_t)255 * 4 + 2 + rl) * DFF + ch);
            const int t = row - 7 * TT; if (t >= TT - 2) *(f32x4*)(p.out + O_PCF + ((size_t)7 * 2 + (t - (TT - 2))) * DFF + ch) = g0; }
        const f32x4 w0 = *(const f32x4*)(p.in[I_FCW] + ch), w1 = *(const f32x4*)(p.in[I_FCW] + DFF + ch), w2 = *(const f32x4*)(p.in[I_FCW] + 2 * DFF + ch), cbv = *(const f32x4*)(p.in[I_FCB] + ch);
        const f32x4 y = cbv + w0 * g2 + w1 * g1 + w2 * g0;
        u32x2 w; w.x = cvt_pk_bf16(gelu_tanh(y[0]) * v[0], gelu_tanh(y[1]) * v[1]); w.y = cvt_pk_bf16(gelu_tanh(y[2]) * v[2], gelu_tanh(y[3]) * v[3]);
        *(u32x2*)(H + (size_t)row * DFF + ch) = w; }
}
__device__ __forceinline__ float* y_row(const P& p, int r) {
    if (r >= MP) return p.out + O_YS + (size_t)(r - MP) * DM;
    const int b = r / TT, t = r - b * TT; return t < 16 ? nullptr : p.out + O_YP + ((size_t)b * 2048 + (t - 16)) * DM;
}
__device__ __forceinline__ void phase_ln2(const P& p) {
    const int lane = threadIdx.x & 63, wid = threadIdx.x >> 6; const int gw = blockIdx.x * 8 + wid, NGW = gridDim.x * 8;
    const bf16_t* R = (const bf16_t*)(p.ws + W_R2);
    for (int r = gw; r < 16384; r += 2 * NGW) { const int r2 = r + NGW; float* oa = y_row(p, r); float* ob = (r2 < 16384) ? y_row(p, r2) : nullptr;
        if (oa && ob) ln_rows2_bf<false>(R + (size_t)r * DM, R + (size_t)r2 * DM, p.in[I_L2G], p.in[I_L2B], oa, ob, lane, true);
        else if (oa) ln_rows2_bf<false>(R + (size_t)r * DM, R + (size_t)r * DM, p.in[I_L2G], p.in[I_L2B], oa, oa, lane, false);
        else if (ob) ln_rows2_bf<false>(R + (size_t)r2 * DM, R + (size_t)r2 * DM, p.in[I_L2G], p.in[I_L2B], ob, ob, lane, false); }
    for (int r = 16384 + gw; r < MTOK; r += NGW) { float* o = y_row(p, r);
        if (o) ln_row<false>((const float*)(p.ws + W_PART) + (size_t)(r - 16384) * DM, p.in[I_L2G], p.in[I_L2B], o, lane, 12, (const bf16_t*)(p.ws + W_XN) + (size_t)r * DM, p.in[I_BDOWN]); }
}

__global__ __launch_bounds__(512, 2) void hawk_fwd(P p) {
    extern __shared__ __attribute__((aligned(16))) unsigned char shm[];
    LAS unsigned char* lds = (LAS unsigned char*)shm;
    cg::grid_group grid = cg::this_grid();
    volatile LAS unsigned* xst = (volatile LAS unsigned*)(lds + LDS_TOTAL - 16);
    if (threadIdx.x < 4) xst[threadIdx.x] = 0u;
    __syncthreads();
    XcdBarrier xb = xcd_barrier_post((unsigned*)(p.ws + W_BAR), xst);
    if (threadIdx.x == 0) xst[2] = xb_add((unsigned*)(p.ws + W_BAR) + XCD_BAR_WORDS + 64 * xb.x, 1u);
#define GSYNC() xcd_barrier(xb)
    if (p.ws == nullptr) grid.sync();
    TIMED(0) REPEAT(REP_P0) { phase0(p, lds); GSYNC(); } TIMED_END(0)
    if (threadIdx.x == 0) { unsigned* bar = (unsigned*)(p.ws + W_BAR); bool ok = (gridDim.x % 8u) == 0u;
        for (unsigned j = 0; j < 16; ++j) { const unsigned cnt = xb_ld(&bar[XB_XCNT(j)]); if (cnt != (j < 8 ? gridDim.x / 8u : 0u)) ok = false; }
        xst[3] = ok ? (xst[2] * 8u + xb.x) : blockIdx.x; }
    __syncthreads();
    const int vc = (int)xst[3];
    TIMED(1) REPEAT(REP_P1) { EpiProj E; E.O = (bf16_t*)(p.ws + W_PROJ); E.bias = p.in[I_BIN]; run_gemm(lds, vc, (const bf16_t*)(p.ws + W_XN), (const bf16_t*)(p.ws + W_WTIN), DIN, 1024, E);
        { const int G = (int)gridDim.x, nun = (MTOK / 256) * (DIN / 256), rem = nun % G; const int c = vc;
          if (c >= rem) transposes<1>(p, (LAS float*)(lds + (threadIdx.x >> 6) * 8704), threadIdx.x & 63, (c - rem) * 8 + (int)(threadIdx.x >> 6), (G - rem) * 8); }
        GSYNC(); } TIMED_END(1)
    TIMED(20) REPEAT(REP_P2A) { phase2a(p, lds); GSYNC(); } TIMED_END(20)
    TIMED(21) REPEAT(REP_P2B) { phase2b(p, lds); GSYNC(); } TIMED_END(21)
    TIMED(3) { EpiGlu E; E.mix = (bf16_t*)(p.ws + W_MIX); E.m2 = (const bf16_t*)(p.out + O_YP); E.carry = (const float*)(p.ws + W_LRUC); E.proj = (const bf16_t*)(p.ws + W_PROJ); E.bias = p.in[I_BGLU]; run_gemm(lds, vc, (const bf16_t*)(p.ws + W_YSG), (const bf16_t*)(p.ws + W_WTGLU), 2048, 512, E); GSYNC(); } TIMED_END(3)
    TIMED(4) REPEAT(REP_P4) { EpiRes E; E.R = (bf16_t*)(p.ws + W_R1); E.X = (const bf16_t*)(p.ws + W_XN); E.bias = p.in[I_BOUT]; E.part = (float*)(p.ws + W_PART); run_gemm_split(lds, vc, (const bf16_t*)(p.ws + W_MIX), (const bf16_t*)(p.ws + W_WTOUT), 1024, 1024, 4, E); GSYNC(); } TIMED_END(4)
    TIMED(5) REPEAT(REP_P5) { phase_ln1(p); GSYNC(); } TIMED_END(5)
    TIMED(6) REPEAT(REP_P6) { EpiUp E; E.H = (bf16_t*)(p.ws + W_V); E.bias = p.in[I_BUP]; E.out = p.out; E.cw = p.in[I_FCW]; E.cb = p.in[I_FCB]; E.cache = p.in[I_CCF]; E.sbg = (float*)(p.ws + W_SBG); E.sbv = (float*)(p.ws + W_SBV); run_gemm_main64(lds, vc, (const bf16_t*)(p.ws + W_XN), (const bf16_t*)(p.ws + W_WTUP), 6144, 1024, E);
        run_gemm_tail(lds, vc, (const bf16_t*)(p.ws + W_XN), (const bf16_t*)(p.ws + W_WTUP), 6144, 1024, 4, (float*)(p.ws + W_PU)); GSYNC(); } TIMED_END(6)
    TIMED(7) phase_ffnfix(p); phase_ffntail(p);
    GSYNC(); TIMED_END(7)
    TIMED(8) REPEAT(REP_P8) { EpiRes E; E.R = (bf16_t*)(p.ws + W_R2); E.X = (const bf16_t*)(p.ws + W_XN); E.bias = p.in[I_BDOWN]; E.part = (float*)(p.ws + W_PART); run_gemm_split(lds, vc, (const bf16_t*)(p.ws + W_V), (const bf16_t*)(p.ws + W_WTDOWN), 1024, 3072, 12, E); GSYNC(); } TIMED_END(8)
    TIMED(9) REPEAT(REP_P9) phase_ln2(p); TIMED_END(9)
}

extern "C" void kernel_launch(void* const* d_in, const int* in_sizes, int n_in, void* d_out, int out_size, void* d_ws, size_t ws_size, hipStream_t stream) {
    constexpr int LDS_BYTES = LDS_TOTAL;
    static int grid = 0;
    if (grid == 0) {
        if (n_in != N_IN || (size_t)out_size != O_END || ws_size < 268435456ull) { fprintf(stderr, "kernel_launch: unexpected shapes (n_in %d out %d ws %zu)\n", n_in, out_size, ws_size); grid = -1; return; }
        int dev = 0, cus = 0, per_cu = 0;
        if (hipGetDevice(&dev) != hipSuccess || hipDeviceGetAttribute(&cus, hipDeviceAttributeMultiprocessorCount, dev) != hipSuccess) { grid = -1; return; }
        if (hipFuncSetAttribute((const void*)hawk_fwd, hipFuncAttributeMaxDynamicSharedMemorySize, LDS_BYTES) != hipSuccess) { fprintf(stderr, "kernel_launch: hipFuncSetAttribute failed\n"); grid = -1; return; }
        if (hipOccupancyMaxActiveBlocksPerMultiprocessor(&per_cu, (const void*)hawk_fwd, 512, LDS_BYTES) != hipSuccess || per_cu < 1) { fprintf(stderr, "kernel_launch: occupancy query failed (%d)\n", per_cu); grid = -1; (void)hipGetLastError(); return; }
        grid = cus * per_cu;
    }
    if (grid < 0) return;
    if (hipMemsetAsync((char*)d_ws + W_BAR, 0, (XCD_BAR_WORDS + 64 * 16) * 4, stream) != hipSuccess) { fprintf(stderr, "kernel_launch: memset failed\n"); return; }
    P p{};
    for (int i = 0; i < N_IN; ++i) p.in[i] = (const float*)d_in[i];
    p.out = (float*)d_out; p.ws = (unsigned char*)d_ws;
    void* args[] = {&p};
    hipError_t e = hipLaunchCooperativeKernel((const void*)hawk_fwd, dim3(grid), dim3(512), args, LDS_BYTES, stream);
    if (e != hipSuccess) fprintf(stderr, "cooperative launch failed: %s (grid %d)\n", hipGetErrorString(e), grid);
}
```

```cpp
#include <hip/hip_runtime.h>
#include <hip/hip_cooperative_groups.h>
#include <cstdio>
#include <cstdint>
namespace cg = cooperative_groups;
#define REP_P0 1
#define REP_P0A 1
#define REP_P0B 1
#define REP_P0C 1
#define REP_P1 1
#define REP_P3 1
#define REP_P2A 1
#define REP_P2B 1
#define REP_P2C 1
#define REP_P4 1
#define REP_P5 1
#define REP_P6 1
#define REP_P8 1
#define REP_P9 1
#define PROBE_PHASE -1
namespace pg8 {
#define PG8_LAS __attribute__((address_space(3)))
typedef unsigned short bf16_t;
typedef short bf16x8 __attribute__((ext_vector_type(8)));
typedef float f32x4 __attribute__((ext_vector_type(4)));
typedef unsigned u32x4 __attribute__((ext_vector_type(4)));
constexpr int BM = 256, BK = 64, HALF = 128, HTB = HALF * BK * 2  , STAGE_BYTES = 8 * HTB, NXCD = 8, WGM = 8;

__host__ __device__ __forceinline__ int lds_byte(int r, int c) { const int st = (r >> 4) * 2 + (c >> 5), rr = r & 15, cc = c & 31, ob = rr * 64 + cc * 2; return st * 1024 + (ob ^ (((ob >> 9) & 1) << 5)); }
__host__ __device__ __forceinline__ void stage_rc(int b, int& R, int& C) { const int st = b / 1024, sb = b % 1024, swz = sb ^ (((sb >> 9) & 1) << 5); R = (st >> 1) * 16 + swz / 64; C = (st & 1) * 32 + (swz % 64) / 2; }
__host__ __device__ __forceinline__ int perm32(int rho) { const int n = rho >> 4, i = rho & 15; return 8 * (i >> 2) + 4 * n + (i & 3); }

struct Unit { int pm, pn, k0, nt, ks; };
struct Gemm { const bf16_t* A; const bf16_t* Bt; int M, N, K; };

struct StaticOrder {
    int nM, nN, nwg, G, c, ntk;
    __host__ __device__ void init(int M, int N, int K, int G_, int c_) { nM = M / BM; nN = N / BM; nwg = nM * nN; G = G_; c = c_; ntk = K / BK; }
    __host__ __device__ bool next(int i, Unit& u) const {
        const long L = (long)i * G + c; if (L >= nwg) return false;
        int wgid = (int)L; { const int q = nwg / NXCD, r = nwg % NXCD, xcd = wgid % NXCD, off = wgid / NXCD; wgid = (xcd < r ? xcd * (q + 1) : r * (q + 1) + (xcd - r) * q) + off; }
        const int nig = WGM * nN, gid = wgid / nig, fm = gid * WGM, gsz = (nM - fm) < WGM ? (nM - fm) : WGM;
        u.pm = fm + ((wgid % nig) % gsz); u.pn = (wgid % nig) / gsz; u.k0 = 0; u.nt = ntk; u.ks = -1; return true;
    }
    __device__ __forceinline__ void a_ready(const Unit&) const {}
    __device__ __forceinline__ void done(const Unit&) const {}
};
struct TailOrder {
    int nN, ntk, nsplit, G, c;
    __host__ __device__ void init(int N, int K, int nsplit_, int G_, int c_) { nN = N / BM; ntk = K / BK; nsplit = nsplit_; G = G_; c = c_; }
    __host__ __device__ bool next(int i, Unit& u) const {
        const long L = (long)i * G + c; const bool ok = L < (long)nN * nsplit; const int ks = (int)(L / nN), ntp = ntk / nsplit;
        u.pm = 64; u.pn = (int)(L % nN); u.ks = ks; u.nt = ntp; u.k0 = ks * ntp * BK; return ok;
    }
    __device__ __forceinline__ void a_ready(const Unit&) const {}
    __device__ __forceinline__ void done(const Unit&) const {}
};
struct SplitOrder {
    StaticOrder base; int nsplit;
    __host__ __device__ void init(int N, int K, int nsplit_, int G_, int c_) { base.init(64 * BM, N, K, G_, c_); nsplit = nsplit_; }
    __host__ __device__ bool next(int i, Unit& u) const {
        Unit t; t.pm = 0; t.pn = 0; t.k0 = 0; t.nt = base.ntk; t.ks = -1;
        const bool ok = base.next(i, t);
        const long L = (long)i * base.G + base.c - base.nwg; const bool sp = (!ok) && L >= 0 && L < (long)base.nN * nsplit;
        const int ks = (int)(L / base.nN), pn = (int)(L % base.nN), ntp = base.ntk / nsplit;
        u.pm = sp ? 64 : t.pm; u.pn = sp ? pn : t.pn; u.ks = sp ? ks : -1; u.nt = sp ? ntp : t.nt; u.k0 = sp ? ks * ntp * BK : 0;
        return ok || sp;
    }
    __device__ __forceinline__ void a_ready(const Unit&) const {}
    __device__ __forceinline__ void done(const Unit&) const {}
};
__device__ __forceinline__ unsigned cvt_pk_bf16(float lo, float hi) { unsigned r; asm volatile("v_cvt_pk_bf16_f32 %0, %1, %2" : "=v"(r) : "v"(lo), "v"(hi)); return r; }
template <class Epi, class Sched, bool STAMP = false>
__device__ __forceinline__ void gemm_phase(PG8_LAS unsigned char* lds, const Gemm g, const Sched& S, const Epi& E, unsigned long long* stamps) {
    int tid_ = threadIdx.x; asm volatile("" : "+v"(tid_)); const int tid = tid_, wid = __builtin_amdgcn_readfirstlane(tid >> 6), lane = tid & 63, wr = wid >> 2, wc = wid & 3, fr = lane & 15, fq = lane >> 4;
    const int K = g.K;
    int ts_lo = 0, ts_hi = 0, nts = 0; const unsigned long long rt_entry = STAMP ? (unsigned long long)wall_clock64() : 0ull;
#define PG8_STAMP() do { if (STAMP && wid == 0 && nts < 64) { const unsigned long long _c = (unsigned long long)clock64(); \
        ts_lo = (lane == nts) ? (int)(unsigned)_c : ts_lo; ts_hi = (lane == nts) ? (int)(unsigned)(_c >> 32) : ts_hi; ++nts; } } while (0)
    PG8_STAMP();
    unsigned voffA[2], voffB[2];
#pragma unroll
    for (int i = 0; i < 2; ++i) { int R, C; stage_rc(tid * 16 + i * 8192, R, C); const int Rb = Epi::PERM ? ((R & ~31) + perm32(R & 31)) : R;
        voffA[i] = (unsigned)(R * K + C) * 2u; voffB[i] = (unsigned)(Rb * K + C) * 2u; }
    const size_t kstep = (size_t)(BK * 2);
    const size_t hstep = (size_t)HALF * K * 2;
    const size_t tstep = 2 * hstep;
    const unsigned ldsw = (unsigned)wid * 1024u;
    const int aoff = lds_byte(wr * 64 + fr, fq * 8), boff = lds_byte(wc * 32 + fr, fq * 8);
#define PG8_SA(b, h) (((b) * 2 + (h)) * HTB)
#define PG8_SB(b, h) ((4 + (b) * 2 + (h)) * HTB)
#define PG8_STAGE(bufoff, gbase, voff) do { _Pragma("unroll") for (int _i = 0; _i < 2; ++_i) \
        __builtin_amdgcn_global_load_lds((const unsigned*)((const char*)(gbase) + (voff)[_i]), (PG8_LAS unsigned*)(lds + (bufoff) + ldsw + _i * 8192), 16, 0, 0); } while (0)
#define PG8_LDA(dst, b, h) do { _Pragma("unroll") for (int m = 0; m < 4; ++m) _Pragma("unroll") for (int k = 0; k < 2; ++k) dst[m][k] = *(const PG8_LAS bf16x8*)(lds + PG8_SA(b, h) + aoff + m * 2048 + k * 1024); } while (0)
#define PG8_LDB(dst, b, h) do { _Pragma("unroll") for (int n = 0; n < 2; ++n) _Pragma("unroll") for (int k = 0; k < 2; ++k) dst[n][k] = *(const PG8_LAS bf16x8*)(lds + PG8_SB(b, h) + boff + n * 2048 + k * 1024); } while (0)
#define PG8_MMA(ai, bj, At, Bt) do { __builtin_amdgcn_s_setprio(1); _Pragma("unroll") for (int m = 0; m < 4; ++m) _Pragma("unroll") for (int n = 0; n < 2; ++n) _Pragma("unroll") for (int k = 0; k < 2; ++k) \
        acc[ai][bj][m][n] = __builtin_amdgcn_mfma_f32_16x16x32_bf16(Bt[n][k], At[m][k], acc[ai][bj][m][n], 0, 0, 0); __builtin_amdgcn_s_setprio(0); } while (0)
#define PG8_WAIT_V(n) asm volatile("s_waitcnt vmcnt(" #n ")" ::: "memory")
#define PG8_WAIT_L(n) asm volatile("s_waitcnt lgkmcnt(" #n ")" ::: "memory")
#define PG8_BAR __builtin_amdgcn_s_barrier()
#define PG8_SCHED __builtin_amdgcn_sched_barrier(0)
    Unit cur, nxt; int ui = 0;
    if (!S.next(0, cur)) return;
    f32x4 acc[2][2][4][2];
#pragma unroll
    for (int a = 0; a < 2; ++a)
#pragma unroll
        for (int b = 0; b < 2; ++b)
#pragma unroll
            for (int m = 0; m < 4; ++m)
#pragma unroll
                for (int n = 0; n < 2; ++n) acc[a][b][m][n] = (f32x4){0.f, 0.f, 0.f, 0.f};
    bf16x8 At[4][2], B0[2][2], B1[2][2];
    const char* cA = (const char*)g.A + (size_t)cur.pm * tstep + (size_t)cur.k0 * 2; const char* cB = (const char*)g.Bt + (size_t)cur.pn * tstep + (size_t)cur.k0 * 2;
    S.a_ready(cur);
    PG8_STAGE(PG8_SB(0, 0), cB, voffB); PG8_STAGE(PG8_SA(0, 0), cA, voffA); PG8_STAGE(PG8_SB(0, 1), cB + hstep, voffB); PG8_STAGE(PG8_SA(0, 1), cA + hstep, voffA);
    if (wr == 1) PG8_BAR;
    PG8_WAIT_V(4); PG8_BAR;
    PG8_STAGE(PG8_SB(1, 0), cB + kstep, voffB); PG8_STAGE(PG8_SA(1, 0), cA + kstep, voffA); PG8_STAGE(PG8_SB(1, 1), cB + hstep + kstep, voffB);
    PG8_WAIT_V(6); PG8_BAR;
    PG8_STAMP();
    for (;;) {
        const bool has_next = S.next(ui + 1, nxt);
        const char* nA = has_next ? (const char*)g.A + (size_t)nxt.pm * tstep + (size_t)nxt.k0 * 2 : cA; const char* nB = has_next ? (const char*)g.Bt + (size_t)nxt.pn * tstep + (size_t)nxt.k0 * 2 : cB;
        const int nt = cur.nt;
        for (int t = 0; t < nt; t += 2) {
            const bool last = (t == nt - 2);
            const char* a1 = cA + (size_t)(t + 1) * kstep;
            const char* a2 = last ? nA : cA + (size_t)(t + 2) * kstep; const char* b2 = last ? nB : cB + (size_t)(t + 2) * kstep;
            const char* a3 = a2 + kstep; const char* b3 = b2 + kstep;
            if (last && has_next) S.a_ready(nxt);
            PG8_LDB(B0, 0, 0); PG8_SCHED; PG8_LDA(At, 0, 0); PG8_STAGE(PG8_SA(1, 1), a1 + hstep, voffA);
            PG8_WAIT_L(8); PG8_BAR; PG8_WAIT_L(0); PG8_MMA(0, 0, At, B0); PG8_BAR; PG8_SCHED;
            PG8_LDB(B1, 0, 1); PG8_STAGE(PG8_SB(0, 0), b2, voffB);
            PG8_BAR; PG8_WAIT_L(0); PG8_MMA(0, 1, At, B1); PG8_BAR;
            PG8_LDA(At, 0, 1); PG8_STAGE(PG8_SA(0, 0), a2, voffA);
            PG8_BAR; PG8_WAIT_L(0); PG8_MMA(1, 0, At, B0); PG8_BAR; PG8_SCHED;
            PG8_STAGE(PG8_SB(0, 1), b2 + hstep, voffB);
            PG8_WAIT_V(6); PG8_BAR; PG8_MMA(1, 1, At, B1); PG8_BAR;
            PG8_LDB(B0, 1, 0); PG8_SCHED; PG8_LDA(At, 1, 0); PG8_STAGE(PG8_SA(0, 1), a2 + hstep, voffA);
            PG8_WAIT_L(8); PG8_BAR; PG8_WAIT_L(0); PG8_MMA(0, 0, At, B0); PG8_BAR; PG8_SCHED;
            PG8_LDB(B1, 1, 1); PG8_STAGE(PG8_SB(1, 0), b3, voffB);
            PG8_BAR; PG8_WAIT_L(0); PG8_MMA(0, 1, At, B1); PG8_BAR;
            PG8_LDA(At, 1, 1); PG8_STAGE(PG8_SA(1, 0), a3, voffA);
            PG8_BAR; PG8_WAIT_L(0); PG8_MMA(1, 0, At, B0); PG8_BAR; PG8_SCHED;
            PG8_STAGE(PG8_SB(1, 1), b3 + hstep, voffB);
            PG8_WAIT_V(6); PG8_BAR; PG8_MMA(1, 1, At, B1); PG8_BAR;
        }
        PG8_STAMP();
        if constexpr (!Epi::AFTER_DRAIN) { E(acc, cur, wr, wc, fr, fq); S.done(cur); }
        PG8_STAMP();
        if (!has_next) break;
#pragma unroll
        for (int a = 0; a < 2; ++a)
#pragma unroll
            for (int b = 0; b < 2; ++b)
#pragma unroll
                for (int m = 0; m < 4; ++m)
#pragma unroll
                    for (int n = 0; n < 2; ++n) acc[a][b][m][n] = (f32x4){0.f, 0.f, 0.f, 0.f};
        cur = nxt; cA = nA; cB = nB; ++ui;
    }
    PG8_WAIT_V(0);
    if (wr == 0) PG8_BAR;
    PG8_BAR;
    if constexpr (Epi::AFTER_DRAIN) { E.fused(acc, cur, wr, wc, fr, fq, lds, wid, lane); S.done(cur); }
    PG8_STAMP();
    if (STAMP && wid == 0) { stamps[lane] = lane < nts ? (((unsigned long long)(unsigned)ts_hi << 32) | (unsigned)ts_lo) : 0ull;
        if (lane == 62) stamps[62] = rt_entry; if (lane == 63) stamps[63] = (unsigned long long)wall_clock64(); }
#undef PG8_STAMP
#undef PG8_SA
#undef PG8_SB
#undef PG8_STAGE
#undef PG8_LDA
#undef PG8_LDB
#undef PG8_MMA
#undef PG8_WAIT_V
#undef PG8_WAIT_L
#undef PG8_BAR
#undef PG8_SCHED
}
}
using pg8::bf16_t; using pg8::bf16x8; using pg8::f32x4; using pg8::u32x4; using pg8::Unit; using pg8::cvt_pk_bf16;
#define LAS __attribute__((address_space(3)))
typedef unsigned u32x2 __attribute__((ext_vector_type(2)));
#define XB_TMO      128
#define XB_XCNT(j)  (256  + 64 * (j))
#define XB_XSUB(j)  (1280 + 64 * (j))
#define XB_XGEN(j)  (2304 + 64 * (j))
#define XB_TOP      3328
#define XB_TOPGEN   3392
#define XCD_BAR_WORDS 3456
#define XB_SPIN_CAP (1u << 18)

__device__ __forceinline__ unsigned xb_ld(unsigned* p)              { return __hip_atomic_load(p, __ATOMIC_RELAXED, __HIP_MEMORY_SCOPE_AGENT); }
__device__ __forceinline__ unsigned xb_add(unsigned* p, unsigned v) { return __hip_atomic_fetch_add(p, v, __ATOMIC_RELAXED, __HIP_MEMORY_SCOPE_AGENT); }
__device__ __forceinline__ unsigned xb_xcc_id() { return (unsigned)__builtin_amdgcn_s_getreg((3 << 11) | 20) & 0xFu; }
#define XB_SPIN(cond, bar) do { unsigned _sp = 0; while (cond) { __builtin_amdgcn_s_sleep(1); \
    if ((++_sp & 255u) == 0u) { if (xb_ld(&(bar)[XB_TMO])) break; if (_sp > XB_SPIN_CAP) { atomicAdd(&(bar)[XB_TMO], 1u); break; } } } } while (0)

struct XcdBarrier {
    unsigned* bar; unsigned x;
    volatile LAS unsigned* st;
};

__device__ __forceinline__ XcdBarrier xcd_barrier_post(unsigned* bar, volatile LAS unsigned* st) {
    XcdBarrier b; b.bar = bar; b.x = xb_xcc_id(); b.st = st;
    if (threadIdx.x == 0) (void)xb_add(&bar[XB_XCNT(b.x)], 1u);
    return b;
}
__device__ __forceinline__ void xcd_barrier_complete(unsigned* bar, unsigned x, unsigned& nloc, unsigned& nx) {
    const unsigned G = gridDim.x * gridDim.y * gridDim.z;
    unsigned sum, cnt, mine, sp = 0u;
    for (;;) {
        sum = 0u; cnt = 0u; mine = 0u;
#pragma unroll
        for (unsigned j = 0; j < 16; ++j) { const unsigned c = xb_ld(&bar[XB_XCNT(j)]); sum += c; cnt += (c > 0u) ? 1u : 0u; mine = (j == x) ? c : mine; }
        if (sum == G) break;
        __builtin_amdgcn_s_sleep(1);
        if ((++sp & 255u) == 0u) { if (xb_ld(&bar[XB_TMO])) break; if (sp > XB_SPIN_CAP) { atomicAdd(&bar[XB_TMO], 1u); break; } }
    }
    nloc = mine > 0u ? mine : 1u; nx = cnt > 0u ? cnt : 1u;
}

__device__ __forceinline__ void xcd_barrier(const XcdBarrier& b) {
    asm volatile("s_waitcnt vmcnt(0)" ::: "memory");
    __syncthreads();
    if (threadIdx.x == 0) {
        unsigned* bar = b.bar;
        __builtin_amdgcn_s_waitcnt(0);
        unsigned nloc = b.st[0], nx = b.st[1];
        if (nloc == 0u) { xcd_barrier_complete(bar, b.x, nloc, nx); b.st[0] = nloc; b.st[1] = nx; }
        const unsigned old = xb_add(&bar[XB_XSUB(b.x)], 1u);
        const unsigned gen = old / nloc;
        if (old + 1u == (gen + 1u) * nloc) {
            __builtin_amdgcn_fence(__ATOMIC_RELEASE, "agent");
            asm volatile("s_waitcnt vmcnt(0)" ::: "memory");
            const unsigned og = xb_add(&bar[XB_TOP], 1u);
            const unsigned tg = og / nx;
            if (og + 1u == (tg + 1u) * nx) xb_add(&bar[XB_TOPGEN], 1u);
            else XB_SPIN(xb_ld(&bar[XB_TOPGEN]) == tg, bar);
            __builtin_amdgcn_fence(__ATOMIC_ACQUIRE, "agent");
            xb_add(&bar[XB_XGEN(b.x)], 1u);
            asm volatile("s_waitcnt vmcnt(0)" ::: "memory");
        } else {
            XB_SPIN(xb_ld(&bar[XB_XGEN(b.x)]) == gen, bar);
            __builtin_amdgcn_fence(__ATOMIC_ACQUIRE, "agent");
            asm volatile("s_waitcnt vmcnt(0)" ::: "memory");
        }
    }
    __syncthreads();
}


constexpr int DM = 1024, NBATCH = 8, TT = 2064, NSAMP = 128, MP = NBATCH * TT  , MTOK = MP + NSAMP  ;
constexpr int DIN = 3584, DSSM = 512, DFF = 3072, NG = 32, NCHUNK = 129, NR = NBATCH * NCHUNK  ;
constexpr int C_US = 1024, C_GA = 1536, C_GB = 2560;
constexpr float ALPHA = 1.189207115002721f, LN_EPS = 1e-5f;
enum { I_XP = 0, I_XS, I_CCL, I_SL, I_SSR, I_SSI, I_CCF, I_META, I_EG, I_EB, I_WIN, I_BIN, I_CLW, I_CLB, I_WR, I_BR, I_WI, I_BI, I_LAM,
       I_SLRE, I_SLIM, I_SLDT, I_SBRE, I_SBIM, I_SCRE, I_SCIM, I_SD, I_WGLU, I_BGLU, I_WOUT, I_BOUT, I_L1G, I_L1B, I_WUP, I_BUP, I_FCW, I_FCB,
       I_WDOWN, I_BDOWN, I_L2G, I_L2B, N_IN };
constexpr size_t O_YP = 0, O_YS = 16777216, O_PCL = O_YS + 131072, O_PL = O_PCL + 24576, O_PSR = O_PL + 8192, O_PSI = O_PSR + 16384, O_PCF = O_PSI + 16384,
                 O_SCL = O_PCF + 49152, O_SL = O_SCL + 393216, O_SSR = O_SL + 131072, O_SSI = O_SSR + 262144, O_SCF = O_SSI + 262144, O_END = O_SCF + 786432;
constexpr size_t W_WTUP = 0, W_WTDOWN = W_WTUP + (size_t)6144 * 1024 * 2, W_XN = W_WTDOWN + (size_t)1024 * 3072 * 2, W_C = W_XN + (size_t)MTOK * 1024 * 2;
constexpr size_t W_PROJ = W_C, W_MIX = W_PROJ + (size_t)MTOK * DIN * 2, W_YSG = W_MIX + (size_t)MTOK * 1024 * 2, W_D = W_YSG + (size_t)MTOK * 512 * 2;
constexpr size_t W_WTGLU = W_D, W_WTOUT = W_WTGLU + (size_t)2048 * 512 * 2, W_WTR = W_WTOUT + (size_t)1024 * 1024 * 2, W_WTI = W_WTR + 262144, W_W1 = W_WTI + 262144,
                 W_W2 = W_W1 + (size_t)NG * 128 * 256 * 2, W_HPREV = W_W2 + (size_t)NG * 256 * 384 * 2, W_A1 = W_HPREV + (size_t)NR * NG * 128 * 2, W_A16 = W_A1 + 16384,
                 W_BBAR = W_A16 + 16384, W_LRUA = W_BBAR + 262144, W_LRUH = W_LRUA + 262144, W_LRUC = W_LRUH + 262144, W_S = W_LRUC + 262144, W_WTIN = W_S,
                 W_S_END = W_S + (size_t)NR * NG * 128 * 4;
constexpr size_t W_BAR = (W_S_END + 4095) / 4096 * 4096;
static_assert(W_BAR + (XCD_BAR_WORDS + 64 * 16) * 4 <= 268435456, "barrier words");
constexpr size_t W_PART = W_C + (size_t)MTOK * 1024 * 4;
constexpr size_t W_SBG = W_C, W_SBV = W_SBG + (size_t)260 * 4 * DFF * 4, W_SB_END = W_SBV + (size_t)260 * 2 * DFF * 4;
constexpr size_t W_PU = W_SB_END, W_PU_END = W_PU + (size_t)4 * 256 * 6144 * 4;
constexpr size_t W_R1 = W_C, W_G = W_C, W_V = W_G + (size_t)MTOK * DFF * 2, W_V_END = W_V + (size_t)MTOK * DFF * 2, W_R2 = W_C;
static_assert(W_S_END <= 268435456 && W_V_END <= 268435456, "workspace map exceeds 256 MiB");
static_assert(W_SB_END <= W_V && W_PU_END <= W_V, "side buffers / up partials overlap H");
static_assert(W_PART + (size_t)12 * 256 * 1024 * 4 <= W_MIX && W_PART + (size_t)12 * 256 * 1024 * 4 <= W_V, "r1 / partials overlap mix or v");

constexpr int LDS_TOTAL = 147456;
struct P { const float* in[N_IN]; float* out; unsigned char* ws; };

__device__ __forceinline__ float bf2f(unsigned short b) { return __uint_as_float(((unsigned)b) << 16); }
__device__ __forceinline__ float bflo(unsigned u) { return __uint_as_float(u << 16); }
__device__ __forceinline__ float bfhi(unsigned u) { return __uint_as_float(u & 0xffff0000u); }
__device__ __forceinline__ unsigned short f2bf(float f) { return (unsigned short)(cvt_pk_bf16(f, 0.f) & 0xffffu); }
__device__ __forceinline__ float sigm(float x) { return __builtin_amdgcn_rcpf(1.f + __expf(-x)); }
__device__ __forceinline__ float gelu_tanh(float x) { return x * sigm(1.5957691216057308f * (x + 0.044715f * x * x * x)); }
__device__ __forceinline__ float wave_sum(float v) {
#pragma unroll
    for (int o = 1; o < 64; o <<= 1) v += __shfl_xor(v, o);
    return v;
}
#define LDS_WAIT() asm volatile("s_waitcnt lgkmcnt(0)" ::: "memory")
#define REPEAT(N) for (int rep_ = 0; rep_ < (N); ++rep_)
#define TIMED(N) const unsigned long long tq0_##N = (PROBE_PHASE == (N)) ? __builtin_amdgcn_s_memrealtime() : 0ull;
#define TIMED_END(N) if (PROBE_PHASE == (N)) { const unsigned long long tq1 = __builtin_amdgcn_s_memrealtime(); while (__builtin_amdgcn_s_memrealtime() - tq1 < tq1 - tq0_##N) __builtin_amdgcn_s_sleep(4); }

struct EpiProj {
    static constexpr bool PERM = true, AFTER_DRAIN = false;
    bf16_t* O; const float* bias;
    __device__ __forceinline__ void operator()(const f32x4 (&acc)[2][2][4][2], const Unit& u, int wr, int wc, int fr, int fq) const {
        const int row0 = u.pm * 256 + wr * 64 + fr, col0 = u.pn * 256 + wc * 32 + 8 * fq;
#pragma unroll
        for (int bj = 0; bj < 2; ++bj) { const int col = col0 + bj * 128; const f32x4 b0 = *(const f32x4*)(bias + col), b1 = *(const f32x4*)(bias + col + 4);
#pragma unroll
            for (int ai = 0; ai < 2; ++ai)
#pragma unroll
                for (int m = 0; m < 4; ++m) { const f32x4 v0 = acc[ai][bj][m][0] + b0, v1 = acc[ai][bj][m][1] + b1; u32x4 w;
                    w.x = cvt_pk_bf16(v0[0], v0[1]); w.y = cvt_pk_bf16(v0[2], v0[3]); w.z = cvt_pk_bf16(v1[0], v1[1]); w.w = cvt_pk_bf16(v1[2], v1[3]);
                    *(u32x4*)(O + (size_t)(row0 + ai * 128 + m * 16) * DIN + col) = w; } }
    }
};
struct EpiGlu {
    static constexpr bool PERM = true, AFTER_DRAIN = false;
    bf16_t* mix; const bf16_t* m2; const float* carry; const bf16_t* proj; const float* bias;
    __device__ __forceinline__ void operator()(const f32x4 (&acc)[2][2][4][2], const Unit& u, int wr, int wc, int fr, int fq) const {
        const int row0 = u.pm * 256 + wr * 64 + fr, j = u.pn * 128 + wc * 32 + 8 * fq;
        const f32x4 bv0 = *(const f32x4*)(bias + j), bv1 = *(const f32x4*)(bias + j + 4), bg0 = *(const f32x4*)(bias + 1024 + j), bg1 = *(const f32x4*)(bias + 1024 + j + 4);
#pragma unroll
        for (int ai = 0; ai < 2; ++ai)
#pragma unroll
            for (int mp = 0; mp < 2; ++mp) { u32x4 gbw[2], mw[2], m2w[2]; f32x4 cv0[2], cv1[2];
#pragma unroll
                for (int mm = 0; mm < 2; ++mm) { const int rowi = row0 + ai * 128 + (2 * mp + mm) * 16; const size_t row = (size_t)rowi; int cidx = 0;
                    if (rowi < MP) { const int b = rowi / TT, t = rowi - b * TT; int kc = t >> 8; kc = kc > 7 ? 7 : kc; cidx = (b * 8 + kc) * 1024; }
                    cv0[mm] = *(const f32x4*)(carry + cidx + j); cv1[mm] = *(const f32x4*)(carry + cidx + j + 4);
                    gbw[mm] = *(const u32x4*)(proj + row * DIN + C_GB + j); mw[mm] = *(const u32x4*)(mix + row * 1024 + j); m2w[mm] = *(const u32x4*)(m2 + row * 1024 + j); }
#pragma unroll
                for (int mm = 0; mm < 2; ++mm) { const int m = 2 * mp + mm; const size_t row = (size_t)(row0 + ai * 128 + m * 16);
                    const f32x4 val0 = acc[ai][0][m][0] + bv0, val1 = acc[ai][0][m][1] + bv1, gate0 = acc[ai][1][m][0] + bg0, gate1 = acc[ai][1][m][1] + bg1;
                    const float o0 = bflo(mw[mm].x) + bflo(m2w[mm].x) * cv0[mm][0] + sigm(bflo(gbw[mm].x)) * val0[0] * sigm(gate0[0]), o1 = bfhi(mw[mm].x) + bfhi(m2w[mm].x) * cv0[mm][1] + sigm(bfhi(gbw[mm].x)) * val0[1] * sigm(gate0[1]);
                    const float o2 = bflo(mw[mm].y) + bflo(m2w[mm].y) * cv0[mm][2] + sigm(bflo(gbw[mm].y)) * val0[2] * sigm(gate0[2]), o3 = bfhi(mw[mm].y) + bfhi(m2w[mm].y) * cv0[mm][3] + sigm(bfhi(gbw[mm].y)) * val0[3] * sigm(gate0[3]);
                    const float o4 = bflo(mw[mm].z) + bflo(m2w[mm].z) * cv1[mm][0] + sigm(bflo(gbw[mm].z)) * val1[0] * sigm(gate1[0]), o5 = bfhi(mw[mm].z) + bfhi(m2w[mm].z) * cv1[mm][1] + sigm(bfhi(gbw[mm].z)) * val1[1] * sigm(gate1[1]);
                    const float o6 = bflo(mw[mm].w) + bflo(m2w[mm].w) * cv1[mm][2] + sigm(bflo(gbw[mm].w)) * val1[2] * sigm(gate1[2]), o7 = bfhi(mw[mm].w) + bfhi(m2w[mm].w) * cv1[mm][3] + sigm(bfhi(gbw[mm].w)) * val1[3] * sigm(gate1[3]);
                    u32x4 w; w.x = cvt_pk_bf16(o0, o1); w.y = cvt_pk_bf16(o2, o3); w.z = cvt_pk_bf16(o4, o5); w.w = cvt_pk_bf16(o6, o7); *(u32x4*)(mix + row * 1024 + j) = w; } }
    }
};
struct EpiRes {
    static constexpr bool PERM = true, AFTER_DRAIN = false;
    bf16_t* R; const bf16_t* X; const float* bias; float* part;
    __device__ __forceinline__ void operator()(const f32x4 (&acc)[2][2][4][2], const Unit& u, int wr, int wc, int fr, int fq) const {
        const int row0 = u.pm * 256 + wr * 64 + fr, col0 = u.pn * 256 + wc * 32 + 8 * fq;
        if (u.ks >= 0) { float* pp = part + ((size_t)u.ks * 256 - 16384) * 1024;
#pragma unroll
            for (int bj = 0; bj < 2; ++bj)
#pragma unroll
                for (int n = 0; n < 2; ++n)
#pragma unroll
                    for (int ai = 0; ai < 2; ++ai)
#pragma unroll
                        for (int m = 0; m < 4; ++m) *(f32x4*)(pp + (size_t)(row0 + ai * 128 + m * 16) * 1024 + col0 + bj * 128 + n * 4) = acc[ai][bj][m][n];
            return; }
#pragma unroll
        for (int bj = 0; bj < 2; ++bj) { const int col = col0 + bj * 128; const f32x4 b0 = *(const f32x4*)(bias + col), b1 = *(const f32x4*)(bias + col + 4);
#pragma unroll
            for (int ai = 0; ai < 2; ++ai) { u32x4 xw[4];
#pragma unroll
                for (int m = 0; m < 4; ++m) xw[m] = *(const u32x4*)(X + (size_t)(row0 + ai * 128 + m * 16) * 1024 + col);
#pragma unroll
                for (int m = 0; m < 4; ++m) { const size_t off = (size_t)(row0 + ai * 128 + m * 16) * 1024 + col;
                    f32x4 v0 = acc[ai][bj][m][0] + b0, v1 = acc[ai][bj][m][1] + b1;
                    v0[0] += ALPHA * bflo(xw[m].x); v0[1] += ALPHA * bfhi(xw[m].x); v0[2] += ALPHA * bflo(xw[m].y); v0[3] += ALPHA * bfhi(xw[m].y);
                    v1[0] += ALPHA * bflo(xw[m].z); v1[1] += ALPHA * bfhi(xw[m].z); v1[2] += ALPHA * bflo(xw[m].w); v1[3] += ALPHA * bfhi(xw[m].w);
                    u32x4 w; w.x = cvt_pk_bf16(v0[0], v0[1]); w.y = cvt_pk_bf16(v0[2], v0[3]); w.z = cvt_pk_bf16(v1[0], v1[1]); w.w = cvt_pk_bf16(v1[2], v1[3]); *(u32x4*)(R + off) = w; } } }
    }
};
__device__ __forceinline__ float rot1(float x) { return __int_as_float(__builtin_amdgcn_update_dpp(0, __float_as_int(x), 0x121, 0xf, 0xf, false)); }
__device__ __forceinline__ float rot2(float x) { return __int_as_float(__builtin_amdgcn_update_dpp(0, __float_as_int(x), 0x122, 0xf, 0xf, false)); }
struct EpiUp {
    static constexpr bool PERM = false, AFTER_DRAIN = false;
    bf16_t* H; const float* bias; float* out; const float* cw; const float* cb; const float* cache; float* sbg; float* sbv;
    __device__ __forceinline__ void operator()(const f32x4 (&acc)[2][2][4][2], const Unit& u, int wr, int wc, int fr, int fq) const {
        const int c0 = u.pn * 128 + wc * 32 + 4 * fq;
#pragma unroll
        for (int n = 0; n < 2; ++n) { const int ch = c0 + n * 16; const f32x4 bg = *(const f32x4*)(bias + ch), bv = *(const f32x4*)(bias + DFF + ch);
            const f32x4 w0 = *(const f32x4*)(cw + ch), w1 = *(const f32x4*)(cw + DFF + ch), w2 = *(const f32x4*)(cw + 2 * DFF + ch), cbv = *(const f32x4*)(cb + ch);
#pragma unroll
            for (int ai = 0; ai < 2; ++ai) { const int blk = u.pm * 4 + ai * 2 + wr, r0 = blk * 64; const bool samp = blk >= 258;
                f32x4 gp = {0.f, 0.f, 0.f, 0.f}, gp1 = {0.f, 0.f, 0.f, 0.f}, gp2 = {0.f, 0.f, 0.f, 0.f};
#pragma unroll
                for (int m = 0; m < 4; ++m) { const int row = r0 + 16 * m + fr; const f32x4 g = acc[ai][0][m][n] + bg, v = acc[ai][1][m][n] + bv;
                    f32x4 a1, a2; a1[0] = rot1(g[0]); a1[1] = rot1(g[1]); a1[2] = rot1(g[2]); a1[3] = rot1(g[3]); a2[0] = rot2(g[0]); a2[1] = rot2(g[1]); a2[2] = rot2(g[2]); a2[3] = rot2(g[3]);
                    f32x4 g1, g2;
                    if (samp) { const int s = row - MP; g2 = *(const f32x4*)(cache + ((size_t)s * 2) * DFF + ch); g1 = *(const f32x4*)(cache + ((size_t)s * 2 + 1) * DFF + ch);
                        *(f32x4*)(out + O_SCF + ((size_t)s * 2 + 1) * DFF + ch) = g; }
                    else { g1 = (fr >= 1) ? a1 : gp1; g2 = (fr >= 2) ? a2 : gp2; const int b = row / TT, t = row - b * TT;
                        if (t == 0) g1 = (f32x4){0.f, 0.f, 0.f, 0.f}; if (t <= 1) g2 = (f32x4){0.f, 0.f, 0.f, 0.f};
                        if (t >= TT - 2) *(f32x4*)(out + O_PCF + ((size_t)b * 2 + (t - (TT - 2))) * DFF + ch) = g;
                        if (m == 0 && fr < 2) { *(f32x4*)(sbg + ((size_t)blk * 4 + fr) * DFF + ch) = g; *(f32x4*)(sbv + ((size_t)blk * 2 + fr) * DFF + ch) = v; }
                        if (m == 3 && fr >= 14) *(f32x4*)(sbg + ((size_t)blk * 4 + fr - 12) * DFF + ch) = g; }
                    const f32x4 y = cbv + w0 * g2 + w1 * g1 + w2 * g;
                    const float h0 = gelu_tanh(y[0]) * v[0], h1 = gelu_tanh(y[1]) * v[1], h2 = gelu_tanh(y[2]) * v[2], h3 = gelu_tanh(y[3]) * v[3];
                    u32x2 w; w.x = cvt_pk_bf16(h0, h1); w.y = cvt_pk_bf16(h2, h3); *(u32x2*)(H + (size_t)row * DFF + ch) = w;
                    gp = g; gp1 = a1; gp2 = a2; } } }
    }
};
struct EpiRaw {
    static constexpr bool PERM = false, AFTER_DRAIN = false;
    float* pu; int ld;
    __device__ __forceinline__ void operator()(const f32x4 (&acc)[2][2][4][2], const Unit& u, int wr, int wc, int fr, int fq) const {
        float* pp = pu + (size_t)u.ks * 256 * ld + (size_t)(wr * 64 + fr) * ld + u.pn * 256 + wc * 32 + 4 * fq;
#pragma unroll
        for (int ai = 0; ai < 2; ++ai)
#pragma unroll
            for (int m = 0; m < 4; ++m)
#pragma unroll
                for (int bj = 0; bj < 2; ++bj)
#pragma unroll
                    for (int n = 0; n < 2; ++n) *(f32x4*)(pp + (size_t)(ai * 128 + m * 16) * ld + bj * 128 + n * 16) = acc[ai][bj][m][n];
    }
};
template <class Epi> __device__ __forceinline__ void run_gemm(LAS unsigned char* lds, int vc, const bf16_t* A, const bf16_t* Bt, int N, int K, const Epi& E) {
    pg8::Gemm g; g.A = A; g.Bt = Bt; g.M = MTOK; g.N = N; g.K = K;
    pg8::StaticOrder S; S.init(MTOK, N, K, (int)gridDim.x, vc);
    pg8::gemm_phase<Epi, pg8::StaticOrder, false>(lds, g, S, E, nullptr);
}

template <class Epi> __device__ __forceinline__ void run_gemm_split(LAS unsigned char* lds, int vc, const bf16_t* A, const bf16_t* Bt, int N, int K, int nsplit, const Epi& E) {
    pg8::Gemm g; g.A = A; g.Bt = Bt; g.M = MTOK; g.N = N; g.K = K;
    pg8::SplitOrder S; S.init(N, K, nsplit, (int)gridDim.x, vc);
    pg8::gemm_phase<Epi, pg8::SplitOrder, false>(lds, g, S, E, nullptr);
}

template <class Epi> __device__ __forceinline__ void run_gemm_main64(LAS unsigned char* lds, int vc, const bf16_t* A, const bf16_t* Bt, int N, int K, const Epi& E) {
    pg8::Gemm g; g.A = A; g.Bt = Bt; g.M = 16384; g.N = N; g.K = K;
    pg8::StaticOrder S; S.init(16384, N, K, (int)gridDim.x, vc);
    pg8::gemm_phase<Epi, pg8::StaticOrder, false>(lds, g, S, E, nullptr);
}
__device__ __forceinline__ void run_gemm_tail(LAS unsigned char* lds, int vc, const bf16_t* A, const bf16_t* Bt, int N, int K, int nsplit, float* pu) {
    pg8::Gemm g; g.A = A; g.Bt = Bt; g.M = MTOK; g.N = N; g.K = K;
    pg8::TailOrder S; S.init(N, K, nsplit, (int)gridDim.x, vc);
    EpiRaw E; E.pu = pu; E.ld = N;
    pg8::gemm_phase<EpiRaw, pg8::TailOrder, false>(lds, g, S, E, nullptr);
}

__device__ __forceinline__ void transpose_item(const float* W, int N, bf16_t* WT, int K, int k0, int srcn0, int dstn0, LAS float* scr, int lane) {
    float tv[32];
#pragma unroll
    for (int i = 0; i < 32; ++i) tv[i] = W[(size_t)(k0 + 2 * i + (lane >> 5)) * N + srcn0 + (lane & 31)];
#pragma unroll
    for (int i = 0; i < 32; ++i) scr[(2 * i + (lane >> 5)) * 33 + (lane & 31)] = tv[i];
    LDS_WAIT();
    const int c = lane & 7;
#pragma unroll
    for (int j = 0; j < 4; ++j) { const int n = (lane >> 3) + 8 * j; const LAS float* s = scr + (8 * c) * 33 + n;
        u32x4 o; o.x = cvt_pk_bf16(s[0 * 33], s[1 * 33]); o.y = cvt_pk_bf16(s[2 * 33], s[3 * 33]); o.z = cvt_pk_bf16(s[4 * 33], s[5 * 33]); o.w = cvt_pk_bf16(s[6 * 33], s[7 * 33]);
        *(u32x4*)(WT + (size_t)(dstn0 + n) * K + k0 + 8 * c) = o; }
    LDS_WAIT();
}
__device__ __forceinline__ const float* src_row(const P& p, int r) {
    if (r < MP) { const int b = r / TT, t = r - b * TT; return t < 16 ? p.in[I_META] + (size_t)t * DM : p.in[I_XP] + ((size_t)b * 2048 + (t - 16)) * DM; }
    return p.in[I_XS] + (size_t)(r - MP) * DM;
}
template <bool OUT_BF16> __device__ __forceinline__ void ln_row(const float* xrow, const float* g, const float* bta, void* orow, int lane, int nsplit = 0, const bf16_t* xres = nullptr, const float* rbias = nullptr) {
    f32x4 v[4]; float s = 0.f;
#pragma unroll
    for (int j = 0; j < 4; ++j) { v[j] = *(const f32x4*)(xrow + 4 * lane + 256 * j);
        if (nsplit > 0) { for (int k = 1; k < nsplit; ++k) v[j] += *(const f32x4*)(xrow + (size_t)k * 256 * 1024 + 4 * lane + 256 * j);
            const u32x2 xw = *(const u32x2*)(xres + 4 * lane + 256 * j); const f32x4 bv = *(const f32x4*)(rbias + 4 * lane + 256 * j);
            v[j][0] += ALPHA * bflo(xw.x) + bv[0]; v[j][1] += ALPHA * bfhi(xw.x) + bv[1]; v[j][2] += ALPHA * bflo(xw.y) + bv[2]; v[j][3] += ALPHA * bfhi(xw.y) + bv[3]; }
        s += (v[j][0] + v[j][1]) + (v[j][2] + v[j][3]); }
    const float mean = wave_sum(s) * (1.f / DM); float s2 = 0.f;
#pragma unroll
    for (int j = 0; j < 4; ++j) { v[j] = v[j] - mean; s2 += (v[j][0] * v[j][0] + v[j][1] * v[j][1]) + (v[j][2] * v[j][2] + v[j][3] * v[j][3]); }
    const float rstd = 1.f / sqrtf(wave_sum(s2) * (1.f / DM) + LN_EPS);
#pragma unroll
    for (int j = 0; j < 4; ++j) { const f32x4 gg = *(const f32x4*)(g + 4 * lane + 256 * j), bb = *(const f32x4*)(bta + 4 * lane + 256 * j);
        const f32x4 o = (v[j] * rstd) * gg + bb;
        if (OUT_BF16) { u32x2 w; w.x = cvt_pk_bf16(o[0], o[1]); w.y = cvt_pk_bf16(o[2], o[3]); *(u32x2*)((bf16_t*)orow + 4 * lane + 256 * j) = w; }
        else *(f32x4*)((float*)orow + 4 * lane + 256 * j) = o; }
}
template <bool OUT_BF16> __device__ __forceinline__ void ln_rows2(const float* xa, const float* xb, const float* g, const float* bta, void* oa, void* ob, int lane, bool vb) {
    f32x4 va[4], vbv[4]; float sa = 0.f, sb = 0.f;
#pragma unroll
    for (int j = 0; j < 4; ++j) { va[j] = *(const f32x4*)(xa + 4 * lane + 256 * j); vbv[j] = *(const f32x4*)(xb + 4 * lane + 256 * j); }
#pragma unroll
    for (int j = 0; j < 4; ++j) { sa += (va[j][0] + va[j][1]) + (va[j][2] + va[j][3]); sb += (vbv[j][0] + vbv[j][1]) + (vbv[j][2] + vbv[j][3]); }
#pragma unroll
    for (int o = 1; o < 64; o <<= 1) { sa += __shfl_xor(sa, o); sb += __shfl_xor(sb, o); }
    const float ma = sa * (1.f / DM), mb = sb * (1.f / DM); float qa = 0.f, qb = 0.f;
#pragma unroll
    for (int j = 0; j < 4; ++j) { va[j] = va[j] - ma; vbv[j] = vbv[j] - mb; qa += (va[j][0] * va[j][0] + va[j][1] * va[j][1]) + (va[j][2] * va[j][2] + va[j][3] * va[j][3]);
        qb += (vbv[j][0] * vbv[j][0] + vbv[j][1] * vbv[j][1]) + (vbv[j][2] * vbv[j][2] + vbv[j][3] * vbv[j][3]); }
#pragma unroll
    for (int o = 1; o < 64; o <<= 1) { qa += __shfl_xor(qa, o); qb += __shfl_xor(qb, o); }
    const float ra = 1.f / sqrtf(qa * (1.f / DM) + LN_EPS), rb = 1.f / sqrtf(qb * (1.f / DM) + LN_EPS);
#pragma unroll
    for (int j = 0; j < 4; ++j) { const f32x4 gg = *(const f32x4*)(g + 4 * lane + 256 * j), bb = *(const f32x4*)(bta + 4 * lane + 256 * j);
        const f32x4 o1 = (va[j] * ra) * gg + bb, o2 = (vbv[j] * rb) * gg + bb;
        if (OUT_BF16) { u32x2 w; w.x = cvt_pk_bf16(o1[0], o1[1]); w.y = cvt_pk_bf16(o1[2], o1[3]); *(u32x2*)((bf16_t*)oa + 4 * lane + 256 * j) = w;
            if (vb) { w.x = cvt_pk_bf16(o2[0], o2[1]); w.y = cvt_pk_bf16(o2[2], o2[3]); *(u32x2*)((bf16_t*)ob + 4 * lane + 256 * j) = w; } }
        else { *(f32x4*)((float*)oa + 4 * lane + 256 * j) = o1; if (vb) *(f32x4*)((float*)ob + 4 * lane + 256 * j) = o2; } }
}
template <bool OUT_BF16> __device__ __forceinline__ void ln_rows2_bf(const bf16_t* xa, const bf16_t* xb, const float* g, const float* bta, void* oa, void* ob, int lane, bool vb) {
    float va[16], vq[16]; float sa = 0.f, sb = 0.f;
    { u32x4 ra[2], rb[2];
#pragma unroll
      for (int j = 0; j < 2; ++j) { ra[j] = *(const u32x4*)(xa + 8 * lane + 512 * j); rb[j] = *(const u32x4*)(xb + 8 * lane + 512 * j); }
#pragma unroll
      for (int j = 0; j < 2; ++j) { va[8 * j] = bflo(ra[j].x); va[8 * j + 1] = bfhi(ra[j].x); va[8 * j + 2] = bflo(ra[j].y); va[8 * j + 3] = bfhi(ra[j].y); va[8 * j + 4] = bflo(ra[j].z); va[8 * j + 5] = bfhi(ra[j].z); va[8 * j + 6] = bflo(ra[j].w); va[8 * j + 7] = bfhi(ra[j].w);
          vq[8 * j] = bflo(rb[j].x); vq[8 * j + 1] = bfhi(rb[j].x); vq[8 * j + 2] = bflo(rb[j].y); vq[8 * j + 3] = bfhi(rb[j].y); vq[8 * j + 4] = bflo(rb[j].z); vq[8 * j + 5] = bfhi(rb[j].z); vq[8 * j + 6] = bflo(rb[j].w); vq[8 * j + 7] = bfhi(rb[j].w); } }
#pragma unroll
    for (int e = 0; e < 16; ++e) { sa += va[e]; sb += vq[e]; }
#pragma unroll
    for (int o = 1; o < 64; o <<= 1) { sa += __shfl_xor(sa, o); sb += __shfl_xor(sb, o); }
    const float ma = sa * (1.f / DM), mb = sb * (1.f / DM); float qa = 0.f, qb = 0.f;
#pragma unroll
    for (int e = 0; e < 16; ++e) { va[e] -= ma; vq[e] -= mb; qa += va[e] * va[e]; qb += vq[e] * vq[e]; }
#pragma unroll
    for (int o = 1; o < 64; o <<= 1) { qa += __shfl_xor(qa, o); qb += __shfl_xor(qb, o); }
    const float ra_ = 1.f / sqrtf(qa * (1.f / DM) + LN_EPS), rb_ = 1.f / sqrtf(qb * (1.f / DM) + LN_EPS);
#pragma unroll
    for (int j = 0; j < 2; ++j) { const int c = 8 * lane + 512 * j; const f32x4 g0 = *(const f32x4*)(g + c), g1 = *(const f32x4*)(g + c + 4), b0 = *(const f32x4*)(bta + c), b1 = *(const f32x4*)(bta + c + 4);
        float o1[8], o2[8];
#pragma unroll
        for (int e = 0; e < 4; ++e) { o1[e] = va[8 * j + e] * ra_ * g0[e] + b0[e]; o1[4 + e] = va[8 * j + 4 + e] * ra_ * g1[e] + b1[e]; o2[e] = vq[8 * j + e] * rb_ * g0[e] + b0[e]; o2[4 + e] = vq[8 * j + 4 + e] * rb_ * g1[e] + b1[e]; }
        if (OUT_BF16) { u32x4 w; w.x = cvt_pk_bf16(o1[0], o1[1]); w.y = cvt_pk_bf16(o1[2], o1[3]); w.z = cvt_pk_bf16(o1[4], o1[5]); w.w = cvt_pk_bf16(o1[6], o1[7]); *(u32x4*)((bf16_t*)oa + c) = w;
            if (vb) { w.x = cvt_pk_bf16(o2[0], o2[1]); w.y = cvt_pk_bf16(o2[2], o2[3]); w.z = cvt_pk_bf16(o2[4], o2[5]); w.w = cvt_pk_bf16(o2[6], o2[7]); *(u32x4*)((bf16_t*)ob + c) = w; } }
        else { *(f32x4*)((float*)oa + c) = (f32x4){o1[0], o1[1], o1[2], o1[3]}; *(f32x4*)((float*)oa + c + 4) = (f32x4){o1[4], o1[5], o1[6], o1[7]};
            if (vb) { *(f32x4*)((float*)ob + c) = (f32x4){o2[0], o2[1], o2[2], o2[3]}; *(f32x4*)((float*)ob + c + 4) = (f32x4){o2[4], o2[5], o2[6], o2[7]}; } } }
}
__device__ __forceinline__ void s5_precompute(const P& p, LAS unsigned char* lds, int g) {
    LAS float* apr = (LAS float*)lds;
    LAS float* api = apr + 17 * 64;
    LAS float* bbr = api + 17 * 64;
    LAS float* bbi = bbr + 1024;
    LAS float* cr = bbi + 1024;
    LAS float* ci = cr + 1024;
    LAS float* Kl = ci + 1024;
    int tid_ = threadIdx.x; asm volatile("" : "+v"(tid_)); const int tid = tid_;
    if (tid < 64) { const int pp = tid;
        const float dt = expf(p.in[I_SLDT][g]); const float lre = p.in[I_SLRE][g * 64 + pp], lim = p.in[I_SLIM][g * 64 + pp];
        const float mag = expf(lre * dt); const float ang = lim * dt; const float abr = mag * cosf(ang), abi = mag * sinf(ang);
        const float den = lre * lre + lim * lim, nr = abr - 1.0f, ni = abi; const float fre = (nr * lre + ni * lim) / den, fim = (ni * lre - nr * lim) / den;
        float pr = 1.f, pi = 0.f;
        for (int j = 0; j <= 16; ++j) { apr[j * 64 + pp] = pr; api[j * 64 + pp] = pi; const float nr2 = pr * abr - pi * abi, ni2 = pr * abi + pi * abr; pr = nr2; pi = ni2; }
        float* a1 = (float*)(p.ws + W_A1); float* a16 = (float*)(p.ws + W_A16); float* bbar = (float*)(p.ws + W_BBAR);
        a1[(g * 64 + pp) * 2] = abr; a1[(g * 64 + pp) * 2 + 1] = abi; a16[(g * 64 + pp) * 2] = apr[16 * 64 + pp]; a16[(g * 64 + pp) * 2 + 1] = api[16 * 64 + pp];
        for (int c = 0; c < 16; ++c) { const float br = p.in[I_SBRE][(g * 64 + pp) * 16 + c], bi = p.in[I_SBIM][(g * 64 + pp) * 16 + c];
            const float xr = fre * br - fim * bi, xi = fre * bi + fim * br; bbr[pp * 16 + c] = xr; bbi[pp * 16 + c] = xi;
            bbar[((g * 64 + pp) * 16 + c) * 2] = xr; bbar[((g * 64 + pp) * 16 + c) * 2 + 1] = xi; }
    }
    for (int i = tid; i < 1024; i += 512) { cr[i] = p.in[I_SCRE][g * 1024 + i]; ci[i] = p.in[I_SCIM][g * 1024 + i]; }
    __syncthreads();
    { const int j = tid >> 5, c1 = (tid >> 1) & 15, c0 = 8 * (tid & 1); float acc8[8];
#pragma unroll
      for (int e = 0; e < 8; ++e) acc8[e] = 0.f;
      for (int pp = 0; pp < 64; ++pp) { const float xr = cr[c1 * 64 + pp], xi = ci[c1 * 64 + pp], ar = apr[j * 64 + pp], ai = api[j * 64 + pp]; const float car = xr * ar - xi * ai, cai = xr * ai + xi * ar;
          const f32x4 r0 = *(const LAS f32x4*)(bbr + pp * 16 + c0), r1 = *(const LAS f32x4*)(bbr + pp * 16 + c0 + 4), i0 = *(const LAS f32x4*)(bbi + pp * 16 + c0), i1 = *(const LAS f32x4*)(bbi + pp * 16 + c0 + 4);
          acc8[0] += car * r0[0] - cai * i0[0]; acc8[1] += car * r0[1] - cai * i0[1]; acc8[2] += car * r0[2] - cai * i0[2]; acc8[3] += car * r0[3] - cai * i0[3];
          acc8[4] += car * r1[0] - cai * i1[0]; acc8[5] += car * r1[1] - cai * i1[1]; acc8[6] += car * r1[2] - cai * i1[2]; acc8[7] += car * r1[3] - cai * i1[3]; }
#pragma unroll
      for (int e = 0; e < 8; ++e) { float v = acc8[e]; if (j == 0 && c1 == c0 + e) v += p.in[I_SD][g * 16 + c1]; Kl[(j * 16 + c1) * 16 + c0 + e] = v; } }
    __syncthreads();
    bf16_t* W1 = (bf16_t*)(p.ws + W_W1) + (size_t)g * 128 * 256; bf16_t* W2 = (bf16_t*)(p.ws + W_W2) + (size_t)g * 256 * 384;
    for (int i = tid; i < 128 * 32; i += 512) { const int n = i >> 5, ch = i & 31, s = ch >> 1, c0 = 8 * (ch & 1), pp = n & 63; const bool im = n >= 64; float v[8];
        const float ar = apr[(15 - s) * 64 + pp], ai = api[(15 - s) * 64 + pp];
#pragma unroll
        for (int e = 0; e < 8; ++e) { const float xr = bbr[pp * 16 + c0 + e], xi = bbi[pp * 16 + c0 + e]; v[e] = im ? (ar * xi + ai * xr) : (ar * xr - ai * xi); }
        u32x4 o; o.x = cvt_pk_bf16(v[0], v[1]); o.y = cvt_pk_bf16(v[2], v[3]); o.z = cvt_pk_bf16(v[4], v[5]); o.w = cvt_pk_bf16(v[6], v[7]);
        *(u32x4*)(W1 + (size_t)n * 256 + 8 * ch) = o; }
    for (int i = tid; i < 256 * 48; i += 512) { const int n = i / 48, ch = i - n * 48, t = n >> 4, c1 = n & 15; float v[8];
        if (ch < 32) { const int s = ch >> 1, c0 = 8 * (ch & 1);
#pragma unroll
            for (int e = 0; e < 8; ++e) v[e] = (s <= t) ? Kl[((t - s) * 16 + c1) * 16 + c0 + e] : 0.f; }
        else { const bool im = ch >= 40; const int p0 = 8 * (ch - (im ? 40 : 32));
#pragma unroll
            for (int e = 0; e < 8; ++e) { const int pp = p0 + e; const float ar = apr[(t + 1) * 64 + pp], ai = api[(t + 1) * 64 + pp], xr = cr[c1 * 64 + pp], xi = ci[c1 * 64 + pp];
                v[e] = im ? -(xr * ai + xi * ar) : (xr * ar - xi * ai); } }
        u32x4 o; o.x = cvt_pk_bf16(v[0], v[1]); o.y = cvt_pk_bf16(v[2], v[3]); o.z = cvt_pk_bf16(v[4], v[5]); o.w = cvt_pk_bf16(v[6], v[7]);
        *(u32x4*)(W2 + (size_t)n * 384 + 8 * ch) = o; }
    __syncthreads();
}
template <int CLS> __device__ __forceinline__ void transposes(const P& p, LAS float* scr, int lane, int gw, int NGW) {
    constexpr int I_UP = 16 * 192, I_DN = 48 * 32, I_IN = 16 * 112, I_GL = 8 * 64, I_OU = 16 * 32, I_LR = 16 * 8;
    constexpr int NITEMS = CLS == 0 ? I_IN + I_LR : I_UP + I_DN + I_GL + I_OU;
    for (int it = gw; it < NITEMS; it += NGW) { int r = it;
        if (CLS == 0) {
            if (r < I_IN) { const int kb = r / 112, nb = r % 112; transpose_item(p.in[I_WIN], DIN, (bf16_t*)(p.ws + W_WTIN), 1024, 64 * kb, 32 * nb, 32 * nb, scr, lane); continue; } r -= I_IN;
            { const int which = r >> 6, blk = (r >> 3) & 7, kb = (r >> 2) & 1, nb = r & 3;
              transpose_item(p.in[which ? I_WI : I_WR] + blk * 16384, 128, (bf16_t*)(p.ws + (which ? W_WTI : W_WTR)) + blk * 16384, 128, 64 * kb, 32 * nb, 32 * nb, scr, lane); }
        } else {
            if (r < I_UP) { const int kb = r / 192, nb = r % 192, d0 = 32 * nb, s0 = ((d0 >> 7) & 1) * DFF + (d0 >> 8) * 128 + (d0 & 127);
                transpose_item(p.in[I_WUP], 6144, (bf16_t*)(p.ws + W_WTUP), 1024, 64 * kb, s0, d0, scr, lane); continue; } r -= I_UP;
            if (r < I_DN) { const int kb = r / 32, nb = r % 32; transpose_item(p.in[I_WDOWN], 1024, (bf16_t*)(p.ws + W_WTDOWN), 3072, 64 * kb, 32 * nb, 32 * nb, scr, lane); continue; } r -= I_DN;
            if (r < I_GL) { const int kb = r / 64, nb = r % 64, d0 = 32 * nb, s0 = ((d0 >> 7) & 1) * 1024 + (d0 >> 8) * 128 + (d0 & 127);
                transpose_item(p.in[I_WGLU], 2048, (bf16_t*)(p.ws + W_WTGLU), 512, 64 * kb, s0, d0, scr, lane); continue; } r -= I_GL;
            { const int kb = r / 32, nb = r % 32; transpose_item(p.in[I_WOUT], 1024, (bf16_t*)(p.ws + W_WTOUT), 1024, 64 * kb, 32 * nb, 32 * nb, scr, lane); }
        }
    }
}
__device__ __forceinline__ void phase0(const P& p, LAS unsigned char* lds) {
    int tid_ = threadIdx.x; asm volatile("" : "+v"(tid_)); const int tid = tid_, lane = tid & 63, wid = tid >> 6;
    REPEAT(REP_P0A) for (int g = blockIdx.x; g < NG; g += gridDim.x) s5_precompute(p, lds, g);
    LAS float* scr = (LAS float*)(lds + wid * 8704);
    const int gw = blockIdx.x * 8 + wid, NGW = gridDim.x * 8;
    { const int skip = ((int)gridDim.x >= 64) ? NG : 0;
      if ((int)blockIdx.x >= skip) REPEAT(REP_P0B) transposes<0>(p, scr, lane, ((int)blockIdx.x - skip) * 8 + wid, ((int)gridDim.x - skip) * 8); }
    { const int skip = ((int)gridDim.x >= 64) ? NG : 0;
      if ((int)blockIdx.x >= skip) { const int gw2 = ((int)blockIdx.x - skip) * 8 + wid, NGW2 = ((int)gridDim.x - skip) * 8;
        REPEAT(REP_P0C) for (int r = gw2; r < MTOK; r += 2 * NGW2) { const int r2 = r + NGW2; const bool vb = r2 < MTOK; const int rb = vb ? r2 : r;
          ln_rows2<true>(src_row(p, r), src_row(p, rb), p.in[I_EG], p.in[I_EB], (bf16_t*)(p.ws + W_XN) + (size_t)r * DM, (bf16_t*)(p.ws + W_XN) + (size_t)rb * DM, lane, vb); } } }
}

template <int MODE> __device__ __forceinline__ void lru_unit(const P& p, LAS unsigned char* lds, int b, int kc, int nb) {
    int tid_ = threadIdx.x; asm volatile("" : "+v"(tid_)); const int tid = tid_, lane = tid & 63, wid = tid >> 6, q = lane >> 4, n = lane & 15;
    int mt0, nmt, rowbase;
    if (MODE == 2) { mt0 = kc; nmt = 1; rowbase = MP; } else { mt0 = (NCHUNK * kc) >> 3; nmt = ((NCHUNK * (kc + 1)) >> 3) - mt0; rowbase = b * TT; }
    const int t0 = 16 * mt0, ntok = 16 * nmt;
    const bf16_t* proj = (const bf16_t*)(p.ws + W_PROJ);
    LAS bf16_t* xcs = (LAS bf16_t*)lds;
    LAS bf16_t* gas = (LAS bf16_t*)(lds + 73984);
    if (MODE == 2) {
        for (int it = tid; it < ntok * 16; it += 512) { const int i = it >> 4, cg8 = it & 15, c0 = nb * 128 + cg8 * 8; float a[8];
            { const f32x4 b0 = *(const f32x4*)(p.in[I_CLB] + c0), b1 = *(const f32x4*)(p.in[I_CLB] + c0 + 4); a[0] = b0[0]; a[1] = b0[1]; a[2] = b0[2]; a[3] = b0[3]; a[4] = b1[0]; a[5] = b1[1]; a[6] = b1[2]; a[7] = b1[3]; }
#pragma unroll
            for (int j = 0; j < 4; ++j) { const f32x4 w0 = *(const f32x4*)(p.in[I_CLW] + j * 1024 + c0), w1 = *(const f32x4*)(p.in[I_CLW] + j * 1024 + c0 + 4); float x[8];
                if (j < 3) { const float* cp = p.in[I_CCL] + ((size_t)(t0 + i) * 3 + j) * 1024 + c0; const f32x4 x0 = *(const f32x4*)cp, x1 = *(const f32x4*)(cp + 4);
                    x[0] = x0[0]; x[1] = x0[1]; x[2] = x0[2]; x[3] = x0[3]; x[4] = x1[0]; x[5] = x1[1]; x[6] = x1[2]; x[7] = x1[3]; }
                else { const u32x4 xv = *(const u32x4*)(proj + (size_t)(rowbase + t0 + i) * DIN + c0);
                    x[0] = bflo(xv.x); x[1] = bfhi(xv.x); x[2] = bflo(xv.y); x[3] = bfhi(xv.y); x[4] = bflo(xv.z); x[5] = bfhi(xv.z); x[6] = bflo(xv.w); x[7] = bfhi(xv.w); }
                a[0] += w0[0] * x[0]; a[1] += w0[1] * x[1]; a[2] += w0[2] * x[2]; a[3] += w0[3] * x[3]; a[4] += w1[0] * x[4]; a[5] += w1[1] * x[5]; a[6] += w1[2] * x[6]; a[7] += w1[3] * x[7]; }
            u32x4 o; o.x = cvt_pk_bf16(a[0], a[1]); o.y = cvt_pk_bf16(a[2], a[3]); o.z = cvt_pk_bf16(a[4], a[5]); o.w = cvt_pk_bf16(a[6], a[7]);
            *(LAS u32x4*)(xcs + i * 136 + cg8 * 8) = o;
            *(LAS u32x4*)(gas + i * 128 + cg8 * 8) = *(const u32x4*)(proj + (size_t)(rowbase + t0 + i) * DIN + C_GA + c0); }
    } else {
        const int cg8 = tid & 15, tr = tid >> 4, c0 = nb * 128 + cg8 * 8; float w[4][8], bs[8];
        { const f32x4 b0 = *(const f32x4*)(p.in[I_CLB] + c0), b1 = *(const f32x4*)(p.in[I_CLB] + c0 + 4); bs[0] = b0[0]; bs[1] = b0[1]; bs[2] = b0[2]; bs[3] = b0[3]; bs[4] = b1[0]; bs[5] = b1[1]; bs[6] = b1[2]; bs[7] = b1[3]; }
#pragma unroll
        for (int j = 0; j < 4; ++j) { const f32x4 w0 = *(const f32x4*)(p.in[I_CLW] + j * 1024 + c0), w1 = *(const f32x4*)(p.in[I_CLW] + j * 1024 + c0 + 4);
            w[j][0] = w0[0]; w[j][1] = w0[1]; w[j][2] = w0[2]; w[j][3] = w0[3]; w[j][4] = w1[0]; w[j][5] = w1[1]; w[j][6] = w1[2]; w[j][7] = w1[3]; }
        const int i0 = tr * 9; int i1 = i0 + 9; if (i1 > ntok) i1 = ntok;
        u32x4 xr[12], gr[9];
#pragma unroll
        for (int k = 0; k < 12; ++k) { const int i = i0 - 3 + k, t = t0 + i; xr[k] = (u32x4){0u, 0u, 0u, 0u}; if (t >= 0 && i < i1) xr[k] = *(const u32x4*)(proj + (size_t)(rowbase + t) * DIN + c0); }
#pragma unroll
        for (int k = 0; k < 9; ++k) { gr[k] = (u32x4){0u, 0u, 0u, 0u}; if (i0 + k < i1) gr[k] = *(const u32x4*)(proj + (size_t)(rowbase + t0 + i0 + k) * DIN + C_GA + c0); }
#pragma unroll
        for (int k = 0; k < 9; ++k) { if (i0 + k < i1) { float a[8];
#pragma unroll
            for (int e = 0; e < 8; ++e) a[e] = bs[e];
#pragma unroll
            for (int j = 0; j < 4; ++j) { const u32x4 xv = xr[k + j];
                a[0] += w[j][0] * bflo(xv.x); a[1] += w[j][1] * bfhi(xv.x); a[2] += w[j][2] * bflo(xv.y); a[3] += w[j][3] * bfhi(xv.y);
                a[4] += w[j][4] * bflo(xv.z); a[5] += w[j][5] * bfhi(xv.z); a[6] += w[j][6] * bflo(xv.w); a[7] += w[j][7] * bfhi(xv.w); }
            u32x4 o; o.x = cvt_pk_bf16(a[0], a[1]); o.y = cvt_pk_bf16(a[2], a[3]); o.z = cvt_pk_bf16(a[4], a[5]); o.w = cvt_pk_bf16(a[6], a[7]);
            *(LAS u32x4*)(xcs + (i0 + k) * 136 + cg8 * 8) = o; *(LAS u32x4*)(gas + (i0 + k) * 128 + cg8 * 8) = gr[k]; } }
    }
    __syncthreads();
    const int c = nb * 128 + wid * 16 + n;
    bf16x8 Br[4], Bi[4];
    { const bf16_t* wr_ = (const bf16_t*)(p.ws + W_WTR) + (size_t)c * 128 + q * 8; const bf16_t* wi_ = (const bf16_t*)(p.ws + W_WTI) + (size_t)c * 128 + q * 8;
#pragma unroll
      for (int kk = 0; kk < 4; ++kk) { Br[kk] = *(const bf16x8*)(wr_ + 32 * kk); Bi[kk] = *(const bf16x8*)(wi_ + 32 * kk); } }
    const float br = p.in[I_BR][c], bi = p.in[I_BI][c]; const float c8 = -8.0f * log1pf(expf(-p.in[I_LAM][c]));
    bf16_t* M1 = (bf16_t*)(p.ws + W_MIX); bf16_t* M2 = (bf16_t*)(p.out + O_YP);
    float h_run = 0.f, A_run = 1.f;
    for (int mt = 0; mt < nmt; ++mt) {
        f32x4 accr = {0.f, 0.f, 0.f, 0.f}, acci = {0.f, 0.f, 0.f, 0.f};
#pragma unroll
        for (int kk = 0; kk < 4; ++kk) { const bf16x8 Af = *(const LAS bf16x8*)(xcs + (16 * mt + n) * 136 + 32 * kk + 8 * q);
            accr = __builtin_amdgcn_mfma_f32_16x16x32_bf16(Af, Br[kk], accr, 0, 0, 0); acci = __builtin_amdgcn_mfma_f32_16x16x32_bf16(Af, Bi[kk], acci, 0, 0, 0); }
        float a[4], bx[4], ga[4];
#pragma unroll
        for (int j = 0; j < 4; ++j) { const int tok = 16 * mt + 4 * q + j; const float xcv = bf2f(xcs[tok * 136 + wid * 16 + n]);
            ga[j] = bf2f(gas[tok * 128 + wid * 16 + n]);
            const float r = sigm(accr[j] + br), ig = sigm(acci[j] + bi), la = c8 * r; a[j] = __expf(la); bx[j] = __builtin_amdgcn_sqrtf(fmaf(-a[j], a[j], 1.0f)) * (ig * xcv); }
        float h[4], Ac[4];
        if (MODE == 2) {
#pragma unroll
            for (int j = 0; j < 4; ++j) { const int s = t0 + 16 * mt + 4 * q + j; h[j] = a[j] * p.in[I_SL][(size_t)s * 1024 + c] + bx[j]; p.out[O_SL + (size_t)s * 1024 + c] = h[j]; Ac[j] = 0.f; }
        } else {
            float Ap[4]; h[0] = bx[0]; Ap[0] = a[0];
#pragma unroll
            for (int j = 1; j < 4; ++j) { h[j] = a[j] * h[j - 1] + bx[j]; Ap[j] = a[j] * Ap[j - 1]; }
            float PA = Ap[3], PH = h[3];
            float tA = __shfl_up(PA, 16), tH = __shfl_up(PH, 16); if (q >= 1) { PH = PA * tH + PH; PA = PA * tA; }
            tA = __shfl_up(PA, 32); tH = __shfl_up(PH, 32); if (q >= 2) { PH = PA * tH + PH; PA = PA * tA; }
            const float h_end = PA * h_run + PH; const float hin_s = __shfl_up(h_end, 16), pae_s = __shfl_up(PA, 16);
            const float h_in = (q == 0) ? h_run : hin_s; const float a_in = A_run * ((q == 0) ? 1.0f : pae_s);
#pragma unroll
            for (int j = 0; j < 4; ++j) { h[j] += Ap[j] * h_in; Ac[j] = Ap[j] * a_in; }
            h_run = __shfl(h_end, 48 + n); A_run *= __shfl(PA, 48 + n);
        }
#pragma unroll
        for (int j = 0; j < 4; ++j) { const size_t row = (size_t)(rowbase + t0 + 16 * mt + 4 * q + j); const float sg = sigm(ga[j]);
            M1[row * 1024 + c] = f2bf(sg * h[j]); M2[row * 1024 + c] = f2bf(sg * Ac[j]); }
    }
    if (MODE == 0 && q == 0) { ((float*)(p.ws + W_LRUA))[(size_t)(b * 8 + kc) * 1024 + c] = A_run; ((float*)(p.ws + W_LRUH))[(size_t)(b * 8 + kc) * 1024 + c] = h_run; }
    __syncthreads();
}

template <int PASS> __device__ __forceinline__ void s5_item(const P& p, int g, int sub, int lane, int wid) {
    constexpr int KS = (PASS == 1) ? 8 : 12, NTW = (PASS == 1) ? 1 : 2, LDW = (PASS == 1) ? 256 : 384;
    const int n = lane & 15, q = lane >> 4;
    const bf16_t* proj = (const bf16_t*)(p.ws + W_PROJ);
    const bf16_t* W = (PASS == 1) ? (const bf16_t*)(p.ws + W_W1) + (size_t)g * 128 * 256 : (const bf16_t*)(p.ws + W_W2) + (size_t)g * 256 * 384;
    bf16x8 Bf[NTW][KS];
#pragma unroll
    for (int i = 0; i < NTW; ++i)
#pragma unroll
        for (int kk = 0; kk < KS; ++kk) Bf[i][kk] = *(const bf16x8*)(W + (size_t)(16 * (NTW * wid + i) + n) * LDW + 32 * kk + 8 * q);
    const int rt0 = (65 * sub) >> 3, rt1 = (65 * (sub + 1)) >> 3; const bf16x8 zero = {0, 0, 0, 0, 0, 0, 0, 0};
    for (int rt = rt0; rt < rt1; ++rt) {
        const int R = 16 * rt + n; const bool valid = R < NR; const int Rc = valid ? R : 0; const int b = Rc / NCHUNK, k = Rc - b * NCHUNK;
        bf16x8 Af[KS];
        { const bf16_t* ub = proj + (size_t)(b * TT + 16 * k) * DIN + C_US + 16 * g + 8 * (q & 1);
#pragma unroll
          for (int kk = 0; kk < 8; ++kk) { const int s = 2 * kk + (q >> 1); Af[kk] = valid ? *(const bf16x8*)(ub + (size_t)s * DIN) : zero; } }
        if (PASS == 3) { const bf16_t* hb = (const bf16_t*)(p.ws + W_HPREV) + ((size_t)Rc * NG + g) * 128 + 8 * q;
#pragma unroll
          for (int kk = 8; kk < KS; ++kk) Af[kk] = valid ? *(const bf16x8*)(hb + 32 * (kk - 8)) : zero; }
        f32x4 acc[NTW];
#pragma unroll
        for (int i = 0; i < NTW; ++i) { acc[i] = (f32x4){0.f, 0.f, 0.f, 0.f};
#pragma unroll
            for (int kk = 0; kk < KS; ++kk) acc[i] = __builtin_amdgcn_mfma_f32_16x16x32_bf16(Af[kk], Bf[i][kk], acc[i], 0, 0, 0); }
#pragma unroll
        for (int j = 0; j < 4; ++j) { const int R2 = 16 * rt + 4 * q + j; if (R2 < NR) {
            if (PASS == 1) { ((float*)(p.ws + W_S))[((size_t)R2 * NG + g) * 128 + 16 * wid + n] = acc[0][j]; }
            else { const int b2 = R2 / NCHUNK, k2 = R2 - b2 * NCHUNK; bf16_t* Y = (bf16_t*)(p.ws + W_YSG) + (size_t)(b2 * TT + 16 * k2) * DSSM + 16 * g + n;
#pragma unroll
                for (int i = 0; i < NTW; ++i) Y[(size_t)(NTW * wid + i) * DSSM] = f2bf(gelu_tanh(acc[i][j])); } } }
    }
}
__device__ __forceinline__ void s5_fused(const P& p, LAS unsigned char* lds, int g, int b) {
    int tid_ = threadIdx.x; asm volatile("" : "+v"(tid_)); const int tid = tid_, lane = tid & 63, wid = tid >> 6, n = lane & 15, q = lane >> 4;
    LAS bf16_t* Us = (LAS bf16_t*)lds;
    LAS float* Ssm = (LAS float*)(lds + 68112);
    LAS bf16_t* Hs = (LAS bf16_t*)(lds + 68112);
    const bf16_t* proj = (const bf16_t*)(p.ws + W_PROJ); const bf16x8 zero = {0, 0, 0, 0, 0, 0, 0, 0};
    TIMED(231) { const bf16_t* ub = proj + (size_t)(b * TT) * DIN + C_US + 16 * g;
      u32x4 tv[9];
#pragma unroll
      for (int i = 0; i < 9; ++i) { const int it = tid + 512 * i; tv[i] = (u32x4){0u, 0u, 0u, 0u}; if (it < TT * 2) tv[i] = *(const u32x4*)(ub + (size_t)(it >> 1) * DIN + 8 * (it & 1)); }
#pragma unroll
      for (int i = 0; i < 9; ++i) { const int it = tid + 512 * i; if (it < TT * 2) { const int t = it >> 1; *(LAS u32x4*)(Us + (t >> 4) * 264 + (t & 15) * 16 + 8 * (it & 1)) = tv[i]; } } }
    __syncthreads();
    TIMED_END(231)
    TIMED(232) { const bf16_t* W = (const bf16_t*)(p.ws + W_W1) + (size_t)g * 128 * 256; bf16x8 Bf[8];
#pragma unroll
      for (int kk = 0; kk < 8; ++kk) Bf[kk] = *(const bf16x8*)(W + (size_t)(16 * wid + n) * 256 + 32 * kk + 8 * q);
#pragma unroll 1
      for (int rt = 0; rt < 9; ++rt) { const int k = 16 * rt + n; const bool valid = k < NCHUNK; const int kc = valid ? k : 0; f32x4 acc = {0.f, 0.f, 0.f, 0.f};
#pragma unroll
          for (int kk = 0; kk < 8; ++kk) { const bf16x8 uv = *(const LAS bf16x8*)(Us + kc * 264 + 32 * kk + 8 * q); const bf16x8 Af = valid ? uv : zero;
              acc = __builtin_amdgcn_mfma_f32_16x16x32_bf16(Af, Bf[kk], acc, 0, 0, 0); }
#pragma unroll
          for (int j = 0; j < 4; ++j) Ssm[(16 * rt + 4 * q + j) * 128 + 16 * wid + n] = acc[j]; } }
    __syncthreads();
    TIMED_END(232)
    bf16x8 Bw[2][12];
    { const bf16_t* W = (const bf16_t*)(p.ws + W_W2) + (size_t)g * 256 * 384;
#pragma unroll
      for (int i = 0; i < 2; ++i)
#pragma unroll
          for (int kk = 0; kk < 12; ++kk) Bw[i][kk] = *(const bf16x8*)(W + (size_t)(16 * (2 * wid + i) + n) * 384 + 32 * kk + 8 * q); }
    TIMED(233) if (wid == 0) { const float* a16 = (const float*)(p.ws + W_A16) + (g * 64 + lane) * 2; const float ar = a16[0], ai = a16[1]; float hr = 0.f, hi = 0.f;
#pragma unroll 1
        for (int kb = 0; kb < 132; kb += 4) { float sr[4], si[4];
#pragma unroll
            for (int u = 0; u < 4; ++u) { sr[u] = Ssm[(kb + u) * 128 + lane]; si[u] = Ssm[(kb + u) * 128 + 64 + lane]; }
            LDS_WAIT();
#pragma unroll
            for (int u = 0; u < 4; ++u) { const int k = kb + u; if (k < NCHUNK) { Hs[k * 136 + lane] = f2bf(hr); Hs[k * 136 + 64 + lane] = f2bf(hi);
                const float nr = ar * hr - ai * hi + sr[u], ni = ar * hi + ai * hr + si[u]; hr = nr; hi = ni; } } }
        p.out[O_PSR + ((size_t)b * NG + g) * 64 + lane] = hr; p.out[O_PSI + ((size_t)b * NG + g) * 64 + lane] = hi; }
    __syncthreads();
    TIMED_END(233)
    TIMED(234)
    {
#pragma unroll 1
      for (int rt = 0; rt < 9; ++rt) { const int k = 16 * rt + n; const bool valid = k < NCHUNK; const int kc = valid ? k : 0; f32x4 acc0 = {0.f, 0.f, 0.f, 0.f}, acc1 = {0.f, 0.f, 0.f, 0.f};
#pragma unroll
          for (int kk = 0; kk < 8; ++kk) { const bf16x8 uv = *(const LAS bf16x8*)(Us + kc * 264 + 32 * kk + 8 * q); const bf16x8 af = valid ? uv : zero;
              acc0 = __builtin_amdgcn_mfma_f32_16x16x32_bf16(af, Bw[0][kk], acc0, 0, 0, 0); acc1 = __builtin_amdgcn_mfma_f32_16x16x32_bf16(af, Bw[1][kk], acc1, 0, 0, 0); }
#pragma unroll
          for (int kk = 8; kk < 12; ++kk) { const bf16x8 hv = *(const LAS bf16x8*)(Hs + kc * 136 + 32 * (kk - 8) + 8 * q); const bf16x8 af = valid ? hv : zero;
              acc0 = __builtin_amdgcn_mfma_f32_16x16x32_bf16(af, Bw[0][kk], acc0, 0, 0, 0); acc1 = __builtin_amdgcn_mfma_f32_16x16x32_bf16(af, Bw[1][kk], acc1, 0, 0, 0); }
#pragma unroll
          for (int j = 0; j < 4; ++j) { const int k2 = 16 * rt + 4 * q + j; if (k2 < NCHUNK) { bf16_t* Y = (bf16_t*)(p.ws + W_YSG) + (size_t)(b * TT + 16 * k2 + 2 * wid) * DSSM + 16 * g + n;
              Y[0] = f2bf(gelu_tanh(acc0[j])); Y[DSSM] = f2bf(gelu_tanh(acc1[j])); } } } }
    TIMED_END(234)
}
__device__ __forceinline__ void s5_sample(const P& p, int s, int g, int lane) {
    const bf16_t* proj = (const bf16_t*)(p.ws + W_PROJ); const bf16_t* up = proj + (size_t)(MP + s) * DIN + C_US + 16 * g;
    const u32x4 u0 = *(const u32x4*)up, u1 = *(const u32x4*)(up + 8); float u[16];
    u[0] = bflo(u0.x); u[1] = bfhi(u0.x); u[2] = bflo(u0.y); u[3] = bfhi(u0.y); u[4] = bflo(u0.z); u[5] = bfhi(u0.z); u[6] = bflo(u0.w); u[7] = bfhi(u0.w);
    u[8] = bflo(u1.x); u[9] = bfhi(u1.x); u[10] = bflo(u1.y); u[11] = bfhi(u1.y); u[12] = bflo(u1.z); u[13] = bfhi(u1.z); u[14] = bflo(u1.w); u[15] = bfhi(u1.w);
    const float* a1 = (const float*)(p.ws + W_A1) + (g * 64 + lane) * 2; const float ar = a1[0], ai = a1[1];
    const float* bb = (const float*)(p.ws + W_BBAR) + (size_t)(g * 64 + lane) * 32; float bur = 0.f, bui = 0.f;
#pragma unroll
    for (int c = 0; c < 16; ++c) { bur += bb[2 * c] * u[c]; bui += bb[2 * c + 1] * u[c]; }
    const size_t si = ((size_t)s * NG + g) * 64 + lane; const float h0r = p.in[I_SSR][si], h0i = p.in[I_SSI][si];
    const float hr = ar * h0r - ai * h0i + bur, hi = ar * h0i + ai * h0r + bui;
    p.out[O_SSR + si] = hr; p.out[O_SSI + si] = hi;
    float v16[16];
#pragma unroll
    for (int c1 = 0; c1 < 16; ++c1) v16[c1] = p.in[I_SCRE][(g * 16 + c1) * 64 + lane] * hr - p.in[I_SCIM][(g * 16 + c1) * 64 + lane] * hi;
    float v8[8], v4[4], v2[2], v1;
    { const bool hi32 = (lane & 32) != 0;
#pragma unroll
      for (int i = 0; i < 8; ++i) { const float keep = hi32 ? v16[i + 8] : v16[i], send = hi32 ? v16[i] : v16[i + 8]; v8[i] = keep + __shfl_xor(send, 32); } }
    { const bool hb = (lane & 16) != 0;
#pragma unroll
      for (int i = 0; i < 4; ++i) { const float keep = hb ? v8[i + 4] : v8[i], send = hb ? v8[i] : v8[i + 4]; v4[i] = keep + __shfl_xor(send, 16); } }
    { const bool hb = (lane & 8) != 0;
#pragma unroll
      for (int i = 0; i < 2; ++i) { const float keep = hb ? v4[i + 2] : v4[i], send = hb ? v4[i] : v4[i + 2]; v2[i] = keep + __shfl_xor(send, 8); } }
    { const bool hb = (lane & 4) != 0; const float keep = hb ? v2[1] : v2[0], send = hb ? v2[0] : v2[1]; v1 = keep + __shfl_xor(send, 4); }
    v1 += __shfl_xor(v1, 1); v1 += __shfl_xor(v1, 2);
    const int c1 = ((lane >> 5) & 1) * 8 + ((lane >> 4) & 1) * 4 + ((lane >> 3) & 1) * 2 + ((lane >> 2) & 1);
    if ((lane & 3) == 0) { const float uc = bf2f(up[c1]); const float yv = v1 + p.in[I_SD][g * 16 + c1] * uc;
        ((bf16_t*)(p.ws + W_YSG))[(size_t)(MP + s) * DSSM + 16 * g + c1] = f2bf(gelu_tanh(yv)); }
}
__device__ __forceinline__ void phase2a(const P& p, LAS unsigned char* lds) {
    TIMED(22) for (int u = blockIdx.x; u < 512; u += gridDim.x) lru_unit<0>(p, lds, (u >> 3) & 7, u >> 6, u & 7); TIMED_END(22)
    TIMED(23) for (int it = blockIdx.x; it < NG * NBATCH; it += gridDim.x) s5_fused(p, lds, it & 31, it >> 5); TIMED_END(23)
}
__device__ __forceinline__ void phase2b(const P& p, LAS unsigned char* lds) {
    int tid_ = threadIdx.x; asm volatile("" : "+v"(tid_)); const int tid = tid_, lane = tid & 63, wid = tid >> 6;
    const size_t gt = (size_t)blockIdx.x * 512 + tid, GT = (size_t)gridDim.x * 512;
    for (size_t i = gt; i < (size_t)NBATCH * 1024; i += GT) { const int b = (int)(i >> 10), c = (int)(i & 1023); float h = 0.f;
        const float* A = (const float*)(p.ws + W_LRUA); const float* Hh = (const float*)(p.ws + W_LRUH); float* Cc = (float*)(p.ws + W_LRUC);
        for (int kc = 0; kc < 8; ++kc) { const size_t o = (size_t)(b * 8 + kc) * 1024 + c; Cc[o] = h; h = A[o] * h + Hh[o]; }
        p.out[O_PL + i] = h; }
    for (int u = (int)gridDim.x - 1 - (int)blockIdx.x; u < 64; u += gridDim.x) lru_unit<2>(p, lds, 0, u >> 3, u & 7);
    for (int it = blockIdx.x * 8 + wid; it < NSAMP * NG; it += gridDim.x * 8) s5_sample(p, it >> 5, it & 31, lane);
    const bf16_t* proj = (const bf16_t*)(p.ws + W_PROJ);
    for (size_t i = gt; i < (size_t)NBATCH * 3 * 1024; i += GT) { const int c = (int)(i & 1023), j = (int)((i >> 10) % 3), b = (int)(i / 3072);
        p.out[O_PCL + i] = bf2f(proj[(size_t)(b * TT + TT - 3 + j) * DIN + c]); }
    for (size_t i = gt; i < (size_t)NSAMP * 3 * 1024; i += GT) { const int c = (int)(i & 1023), j = (int)((i >> 10) % 3), s = (int)(i / 3072);
        p.out[O_SCL + i] = (j < 2) ? p.in[I_CCL][((size_t)s * 3 + j + 1) * 1024 + c] : bf2f(proj[(size_t)(MP + s) * DIN + c]); }
    for (size_t i = gt; i < (size_t)NSAMP * DFF; i += GT) { const int ch = (int)(i % DFF), s = (int)(i / DFF);
        p.out[O_SCF + ((size_t)s * 2) * DFF + ch] = p.in[I_CCF][((size_t)s * 2 + 1) * DFF + ch]; }
}
__device__ __forceinline__ void phase2c(const P& p, LAS unsigned char* lds) {
    const int lane = threadIdx.x & 63, wid = threadIdx.x >> 6;
    for (int it = blockIdx.x; it < NG * 8; it += gridDim.x) s5_item<3>(p, it >> 3, it & 7, lane, wid);
}
__device__ __forceinline__ void phase_ln1(const P& p) {
    const int lane = threadIdx.x & 63, wid = threadIdx.x >> 6; const int gw = blockIdx.x * 8 + wid, NGW = gridDim.x * 8;
    const bf16_t* R = (const bf16_t*)(p.ws + W_R1); bf16_t* X = (bf16_t*)(p.ws + W_XN);
    for (int r = gw; r < 16384; r += 2 * NGW) { const int r2 = r + NGW; const bool vb = r2 < 16384; const int rb = vb ? r2 : r;
        ln_rows2_bf<true>(R + (size_t)r * DM, R + (size_t)rb * DM, p.in[I_L1G], p.in[I_L1B], X + (size_t)r * DM, X + (size_t)rb * DM, lane, vb); }
    for (int r = 16384 + gw; r < MTOK; r += NGW) { bf16_t* xr = X + (size_t)r * DM;
        ln_row<true>((const float*)(p.ws + W_PART) + (size_t)(r - 16384) * DM, p.in[I_L1G], p.in[I_L1B], xr, lane, 4, xr, p.in[I_BOUT]); }
}
__device__ __forceinline__ void phase_ffnfix(const P& p) {
    const size_t gt = (size_t)blockIdx.x * 512 + threadIdx.x, GT = (size_t)gridDim.x * 512;
    const float* sbg = (const float*)(p.ws + W_SBG); const float* sbv = (const float*)(p.ws + W_SBV); bf16_t* H = (bf16_t*)(p.ws + W_V);
    for (size_t it = gt; it < (size_t)256 * 2 * 384; it += GT) { const int cg8 = (int)(it % 384), rr = (int)((it / 384) & 1), blk = (int)(it / 768), ch = cg8 * 8, row = blk * 64 + rr; const int t = row % TT;
        float o[8];
#pragma unroll
        for (int hh = 0; hh < 2; ++hh) { const int c = ch + 4 * hh; const f32x4 z = {0.f, 0.f, 0.f, 0.f};
            const f32x4 g0 = *(const f32x4*)(sbg + ((size_t)blk * 4 + rr) * DFF + c), v = *(const f32x4*)(sbv + ((size_t)blk * 2 + rr) * DFF + c);
            f32x4 g1, g2;
            if (rr == 0) { g1 = (blk > 0 && t >= 1) ? *(const f32x4*)(sbg + ((size_t)(blk - 1) * 4 + 3) * DFF + c) : z; g2 = (blk > 0 && t >= 2) ? *(const f32x4*)(sbg + ((size_t)(blk - 1) * 4 + 2) * DFF + c) : z; }
            else { g1 = (t >= 1) ? *(const f32x4*)(sbg + ((size_t)blk * 4) * DFF + c) : z; g2 = (blk > 0 && t >= 2) ? *(const f32x4*)(sbg + ((size_t)(blk - 1) * 4 + 3) * DFF + c) : z; }
            const f32x4 w0 = *(const f32x4*)(p.in[I_FCW] + c), w1 = *(const f32x4*)(p.in[I_FCW] + DFF + c), w2 = *(const f32x4*)(p.in[I_FCW] + 2 * DFF + c), cbv = *(const f32x4*)(p.in[I_FCB] + c);
            const f32x4 y = cbv + w0 * g2 + w1 * g1 + w2 * g0;
            o[4 * hh] = gelu_tanh(y[0]) * v[0]; o[4 * hh + 1] = gelu_tanh(y[1]) * v[1]; o[4 * hh + 2] = gelu_tanh(y[2]) * v[2]; o[4 * hh + 3] = gelu_tanh(y[3]) * v[3]; }
        u32x4 w; w.x = cvt_pk_bf16(o[0], o[1]); w.y = cvt_pk_bf16(o[2], o[3]); w.z = cvt_pk_bf16(o[4], o[5]); w.w = cvt_pk_bf16(o[6], o[7]);
        *(u32x4*)(H + (size_t)row * DFF + ch) = w; }
}
__device__ __forceinline__ f32x4 up_tail_sum(const float* pu, const float* bias, int rl, int col, int bcol) {
    f32x4 v = *(const f32x4*)(bias + bcol);
#pragma unroll
    for (int ks = 0; ks < 4; ++ks) v += *(const f32x4*)(pu + (size_t)ks * 256 * 6144 + (size_t)rl * 6144 + col);
    return v;
}
__device__ __forceinline__ void phase_ffntail(const P& p) {
    const size_t gt = (size_t)blockIdx.x * 512 + threadIdx.x, GT = (size_t)gridDim.x * 512;
    const float* pu = (const float*)(p.ws + W_PU); const float* sbg = (const float*)(p.ws + W_SBG); bf16_t* H = (bf16_t*)(p.ws + W_V); const float* bias = p.in[I_BUP];
    for (size_t it = gt; it < (size_t)256 * 768; it += GT) { const int rl = (int)(it / 768), ch = (int)(it - (size_t)rl * 768) * 4, row = 16384 + rl; const int colg = 256 * (ch >> 7) + (ch & 127);
        const f32x4 g0 = up_tail_sum(pu, bias, rl, colg, ch), v = up_tail_sum(pu, bias, rl, colg + 128, DFF + ch); f32x4 g1, g2;
        if (row >= MP) { const int s_ = row - MP; g2 = *(const f32x4*)(p.in[I_CCF] + ((size_t)s_ * 2) * DFF + ch); g1 = *(const f32x4*)(p.in[I_CCF] + ((size_t)s_ * 2 + 1) * DFF + ch);
            *(f32x4*)(p.out + O_SCF + ((size_t)s_ * 2 + 1) * DFF + ch) = g0; }
        else {
            g1 = (rl >= 1) ? up_tail_sum(pu, bias, rl - 1, colg, ch) : *(const f32x4*)(sbg + ((size_t)255 * 4 + 3) * DFF + ch);
            g2 = (rl >= 2) ? up_tail_sum(pu, bias, rl - 2, colg, ch) : *(const f32x4*)(sbg + ((size_t)255 * 4 + 2 + rl) * DFF + ch);
            const int t = row - 7 * TT; if (t >= TT - 2) *(f32x4*)(p.out + O_PCF + ((size_t)7 * 2 + (t - (TT - 2))) * DFF + ch) = g0; }
        const f32x4 w0 = *(const f32x4*)(p.in[I_FCW] + ch), w1 = *(const f32x4*)(p.in[I_FCW] + DFF + ch), w2 = *(const f32x4*)(p.in[I_FCW] + 2 * DFF + ch), cbv = *(const f32x4*)(p.in[I_FCB] + ch);
        const f32x4 y = cbv + w0 * g2 + w1 * g1 + w2 * g0;
        u32x2 w; w.x = cvt_pk_bf16(gelu_tanh(y[0]) * v[0], gelu_tanh(y[1]) * v[1]); w.y = cvt_pk_bf16(gelu_tanh(y[2]) * v[2], gelu_tanh(y[3]) * v[3]);
        *(u32x2*)(H + (size_t)row * DFF + ch) = w; }
}
__device__ __forceinline__ float* y_row(const P& p, int r) {
    if (r >= MP) return p.out + O_YS + (size_t)(r - MP) * DM;
    const int b = r / TT, t = r - b * TT; return t < 16 ? nullptr : p.out + O_YP + ((size_t)b * 2048 + (t - 16)) * DM;
}
__device__ __forceinline__ void phase_ln2(const P& p) {
    const int lane = threadIdx.x & 63, wid = threadIdx.x >> 6; const int gw = blockIdx.x * 8 + wid, NGW = gridDim.x * 8;
    const bf16_t* R = (const bf16_t*)(p.ws + W_R2);
    for (int r = gw; r < 16384; r += 2 * NGW) { const int r2 = r + NGW; float* oa = y_row(p, r); float* ob = (r2 < 16384) ? y_row(p, r2) : nullptr;
        if (oa && ob) ln_rows2_bf<false>(R + (size_t)r * DM, R + (size_t)r2 * DM, p.in[I_L2G], p.in[I_L2B], oa, ob, lane, true);
        else if (oa) ln_rows2_bf<false>(R + (size_t)r * DM, R + (size_t)r * DM, p.in[I_L2G], p.in[I_L2B], oa, oa, lane, false);
        else if (ob) ln_rows2_bf<false>(R + (size_t)r2 * DM, R + (size_t)r2 * DM, p.in[I_L2G], p.in[I_L2B], ob, ob, lane, false); }
    for (int r = 16384 + gw; r < MTOK; r += NGW) { float* o = y_row(p, r);
        if (o) ln_row<false>((const float*)(p.ws + W_PART) + (size_t)(r - 16384) * DM, p.in[I_L2G], p.in[I_L2B], o, lane, 12, (const bf16_t*)(p.ws + W_XN) + (size_t)r * DM, p.in[I_BDOWN]); }
}

__global__ __launch_bounds__(512, 2) void hawk_fwd(P p) {
    extern __shared__ __attribute__((aligned(16))) unsigned char shm[];
    LAS unsigned char* lds = (LAS unsigned char*)shm;
    cg::grid_group grid = cg::this_grid();
    volatile LAS unsigned* xst = (volatile LAS unsigned*)(lds + LDS_TOTAL - 16);
    if (threadIdx.x < 4) xst[threadIdx.x] = 0u;
    __syncthreads();
    XcdBarrier xb = xcd_barrier_post((unsigned*)(p.ws + W_BAR), xst);
    if (threadIdx.x == 0) xst[2] = xb_add((unsigned*)(p.ws + W_BAR) + XCD_BAR_WORDS + 64 * xb.x, 1u);
#define GSYNC() xcd_barrier(xb)
    if (p.ws == nullptr) grid.sync();
    TIMED(0) REPEAT(REP_P0) { phase0(p, lds); GSYNC(); } TIMED_END(0)
    if (threadIdx.x == 0) { unsigned* bar = (unsigned*)(p.ws + W_BAR); bool ok = (gridDim.x % 8u) == 0u;
        for (unsigned j = 0; j < 16; ++j) { const unsigned cnt = xb_ld(&bar[XB_XCNT(j)]); if (cnt != (j < 8 ? gridDim.x / 8u : 0u)) ok = false; }
        xst[3] = ok ? (xst[2] * 8u + xb.x) : blockIdx.x; }
    __syncthreads();
    const int vc = (int)xst[3];
    TIMED(1) REPEAT(REP_P1) { EpiProj E; E.O = (bf16_t*)(p.ws + W_PROJ); E.bias = p.in[I_BIN]; run_gemm(lds, vc, (const bf16_t*)(p.ws + W_XN), (const bf16_t*)(p.ws + W_WTIN), DIN, 1024, E);
        { const int G = (int)gridDim.x, nun = (MTOK / 256) * (DIN / 256), rem = nun % G; const int c = vc;
          if (c >= rem) transposes<1>(p, (LAS float*)(lds + (threadIdx.x >> 6) * 8704), threadIdx.x & 63, (c - rem) * 8 + (int)(threadIdx.x >> 6), (G - rem) * 8); }
        GSYNC(); } TIMED_END(1)
    TIMED(20) REPEAT(REP_P2A) { phase2a(p, lds); GSYNC(); } TIMED_END(20)
    TIMED(21) REPEAT(REP_P2B) { phase2b(p, lds); GSYNC(); } TIMED_END(21)
    TIMED(3) { EpiGlu E; E.mix = (bf16_t*)(p.ws + W_MIX); E.m2 = (const bf16_t*)(p.out + O_YP); E.carry = (const float*)(p.ws + W_LRUC); E.proj = (const bf16_t*)(p.ws + W_PROJ); E.bias = p.in[I_BGLU]; run_gemm(lds, vc, (const bf16_t*)(p.ws + W_YSG), (const bf16_t*)(p.ws + W_WTGLU), 2048, 512, E); GSYNC(); } TIMED_END(3)
    TIMED(4) REPEAT(REP_P4) { EpiRes E; E.R = (bf16_t*)(p.ws + W_R1); E.X = (const bf16_t*)(p.ws + W_XN); E.bias = p.in[I_BOUT]; E.part = (float*)(p.ws + W_PART); run_gemm_split(lds, vc, (const bf16_t*)(p.ws + W_MIX), (const bf16_t*)(p.ws + W_WTOUT), 1024, 1024, 4, E); GSYNC(); } TIMED_END(4)
    TIMED(5) REPEAT(REP_P5) { phase_ln1(p); GSYNC(); } TIMED_END(5)
    TIMED(6) REPEAT(REP_P6) { EpiUp E; E.H = (bf16_t*)(p.ws + W_V); E.bias = p.in[I_BUP]; E.out = p.out; E.cw = p.in[I_FCW]; E.cb = p.in[I_FCB]; E.cache = p.in[I_CCF]; E.sbg = (float*)(p.ws + W_SBG); E.sbv = (float*)(p.ws + W_SBV); run_gemm_main64(lds, vc, (const bf16_t*)(p.ws + W_XN), (const bf16_t*)(p.ws + W_WTUP), 6144, 1024, E);
        run_gemm_tail(lds, vc, (const bf16_t*)(p.ws + W_XN), (const bf16_t*)(p.ws + W_WTUP), 6144, 1024, 4, (float*)(p.ws + W_PU)); GSYNC(); } TIMED_END(6)
    TIMED(7) phase_ffnfix(p); phase_ffntail(p);
    GSYNC(); TIMED_END(7)
    TIMED(8) REPEAT(REP_P8) { EpiRes E; E.R = (bf16_t*)(p.ws + W_R2); E.X = (const bf16_t*)(p.ws + W_XN); E.bias = p.in[I_BDOWN]; E.part = (float*)(p.ws + W_PART); run_gemm_split(lds, vc, (const bf16_t*)(p.ws + W_V), (const bf16_t*)(p.ws + W_WTDOWN), 1024, 3072, 12, E); GSYNC(); } TIMED_END(8)
    TIMED(9) REPEAT(REP_P9) phase_ln2(p); TIMED_END(9)
}

extern "C" void kernel_launch(void* const* d_in, const int* in_sizes, int n_in, void* d_out, int out_size, void* d_ws, size_t ws_size, hipStream_t stream) {
    constexpr int LDS_BYTES = LDS_TOTAL;
    static int grid = 0;
    if (grid == 0) {
        if (n_in != N_IN || (size_t)out_size != O_END || ws_size < 268435456ull) { fprintf(stderr, "kernel_launch: unexpected shapes (n_in %d out %d ws %zu)\n", n_in, out_size, ws_size); grid = -1; return; }
        int dev = 0, cus = 0, per_cu = 0;
        if (hipGetDevice(&dev) != hipSuccess || hipDeviceGetAttribute(&cus, hipDeviceAttributeMultiprocessorCount, dev) != hipSuccess) { grid = -1; return; }
        if (hipFuncSetAttribute((const void*)hawk_fwd, hipFuncAttributeMaxDynamicSharedMemorySize, LDS_BYTES) != hipSuccess) { fprintf(stderr, "kernel_launch: hipFuncSetAttribute failed\n"); grid = -1; return; }
        if (hipOccupancyMaxActiveBlocksPerMultiprocessor(&per_cu, (const void*)hawk_fwd, 512, LDS_BYTES) != hipSuccess || per_cu < 1) { fprintf(stderr, "kernel_launch: occupancy query failed (%d)\n", per_cu); grid = -1; (void)hipGetLastError(); return; }
        grid = cus * per_cu;
    }
    if (grid < 0) return;
    if (hipMemsetAsync((char*)d_ws + W_BAR, 0, (XCD_BAR_WORDS + 64 * 16) * 4, stream) != hipSuccess) { fprintf(stderr, "kernel_launch: memset failed\n"); return; }
    P p{};
    for (int i = 0; i < N_IN; ++i) p.in[i] = (const float*)d_in[i];
    p.out = (float*)d_out; p.ws = (unsigned char*)d_ws;
    void* args[] = {&p};
    hipError_t e = hipLaunchCooperativeKernel((const void*)hawk_fwd, dim3(grid), dim3(512), args, LDS_BYTES, stream);
    if (e != hipSuccess) fprintf(stderr, "cooperative launch failed: %s (grid %d)\n", hipGetErrorString(e), grid);
}
```

```cpp
#include <hip/hip_runtime.h>
#include <hip/hip_cooperative_groups.h>
#include <cstdio>
#include <cstdint>
namespace cg = cooperative_groups;
#define REP_P0 1
#define REP_P0A 1
#define REP_P0B 1
#define REP_P0C 1
#define REP_P1 1
#define REP_P3 1
#define REP_P2A 1
#define REP_P2B 1
#define REP_P2C 1
#define REP_P4 1
#define REP_P5 1
#define REP_P6 1
#define REP_P8 1
#define REP_P9 1
#define PROBE_PHASE -1
namespace pg8 {
#define PG8_LAS __attribute__((address_space(3)))
typedef unsigned short bf16_t;
typedef short bf16x8 __attribute__((ext_vector_type(8)));
typedef float f32x4 __attribute__((ext_vector_type(4)));
typedef unsigned u32x4 __attribute__((ext_vector_type(4)));
constexpr int BM = 256, BK = 64, HALF = 128, HTB = HALF * BK * 2  , STAGE_BYTES = 8 * HTB, NXCD = 8, WGM = 8;

__host__ __device__ __forceinline__ int lds_byte(int r, int c) { const int st = (r >> 4) * 2 + (c >> 5), rr = r & 15, cc = c & 31, ob = rr * 64 + cc * 2; return st * 1024 + (ob ^ (((ob >> 9) & 1) << 5)); }
__host__ __device__ __forceinline__ void stage_rc(int b, int& R, int& C) { const int st = b / 1024, sb = b % 1024, swz = sb ^ (((sb >> 9) & 1) << 5); R = (st >> 1) * 16 + swz / 64; C = (st & 1) * 32 + (swz % 64) / 2; }
__host__ __device__ __forceinline__ int perm32(int rho) { const int n = rho >> 4, i = rho & 15; return 8 * (i >> 2) + 4 * n + (i & 3); }

struct Unit { int pm, pn, k0, nt, ks; };
struct Gemm { const bf16_t* A; const bf16_t* Bt; int M, N, K; };

struct StaticOrder {
    int nM, nN, nwg, G, c, ntk;
    __host__ __device__ void init(int M, int N, int K, int G_, int c_) { nM = M / BM; nN = N / BM; nwg = nM * nN; G = G_; c = c_; ntk = K / BK; }
    __host__ __device__ bool next(int i, Unit& u) const {
        const long L = (long)i * G + c; if (L >= nwg) return false;
        int wgid = (int)L; { const int q = nwg / NXCD, r = nwg % NXCD, xcd = wgid % NXCD, off = wgid / NXCD; wgid = (xcd < r ? xcd * (q + 1) : r * (q + 1) + (xcd - r) * q) + off; }
        const int nig = WGM * nN, gid = wgid / nig, fm = gid * WGM, gsz = (nM - fm) < WGM ? (nM - fm) : WGM;
        u.pm = fm + ((wgid % nig) % gsz); u.pn = (wgid % nig) / gsz; u.k0 = 0; u.nt = ntk; u.ks = -1; return true;
    }
    __device__ __forceinline__ void a_ready(const Unit&) const {}
    __device__ __forceinline__ void done(const Unit&) const {}
};
struct TailOrder {
    int nN, ntk, nsplit, G, c;
    __host__ __device__ void init(int N, int K, int nsplit_, int G_, int c_) { nN = N / BM; ntk = K / BK; nsplit = nsplit_; G = G_; c = c_; }
    __host__ __device__ bool next(int i, Unit& u) const {
        const long L = (long)i * G + c; const bool ok = L < (long)nN * nsplit; const int ks = (int)(L / nN), ntp = ntk / nsplit;
        u.pm = 64; u.pn = (int)(L % nN); u.ks = ks; u.nt = ntp; u.k0 = ks * ntp * BK; return ok;
    }
    __device__ __forceinline__ void a_ready(const Unit&) const {}
    __device__ __forceinline__ void done(const Unit&) const {}
};
struct SplitOrder {
    StaticOrder base; int nsplit;
    __host__ __device__ void init(int N, int K, int nsplit_, int G_, int c_) { base.init(64 * BM, N, K, G_, c_); nsplit = nsplit_; }
    __host__ __device__ bool next(int i, Unit& u) const {
        Unit t; t.pm = 0; t.pn = 0; t.k0 = 0; t.nt = base.ntk; t.ks = -1;
        const bool ok = base.next(i, t);
        const long L = (long)i * base.G + base.c - base.nwg; const bool sp = (!ok) && L >= 0 && L < (long)base.nN * nsplit;
        const int ks = (int)(L / base.nN), pn = (int)(L % base.nN), ntp = base.ntk / nsplit;
        u.pm = sp ? 64 : t.pm; u.pn = sp ? pn : t.pn; u.ks = sp ? ks : -1; u.nt = sp ? ntp : t.nt; u.k0 = sp ? ks * ntp * BK : 0;
        return ok || sp;
    }
    __device__ __forceinline__ void a_ready(const Unit&) const {}
    __device__ __forceinline__ void done(const Unit&) const {}
};
__device__ __forceinline__ unsigned cvt_pk_bf16(float lo, float hi) { unsigned r; asm volatile("v_cvt_pk_bf16_f32 %0, %1, %2" : "=v"(r) : "v"(lo), "v"(hi)); return r; }
template <class Epi, class Sched, bool STAMP = false>
__device__ __forceinline__ void gemm_phase(PG8_LAS unsigned char* lds, const Gemm g, const Sched& S, const Epi& E, unsigned long long* stamps) {
    int tid_ = threadIdx.x; asm volatile("" : "+v"(tid_)); const int tid = tid_, wid = __builtin_amdgcn_readfirstlane(tid >> 6), lane = tid & 63, wr = wid >> 2, wc = wid & 3, fr = lane & 15, fq = lane >> 4;
    const int K = g.K;
    int ts_lo = 0, ts_hi = 0, nts = 0; const unsigned long long rt_entry = STAMP ? (unsigned long long)wall_clock64() : 0ull;
#define PG8_STAMP() do { if (STAMP && wid == 0 && nts < 64) { const unsigned long long _c = (unsigned long long)clock64(); \
        ts_lo = (lane == nts) ? (int)(unsigned)_c : ts_lo; ts_hi = (lane == nts) ? (int)(unsigned)(_c >> 32) : ts_hi; ++nts; } } while (0)
    PG8_STAMP();
    unsigned voffA[2], voffB[2];
#pragma unroll
    for (int i = 0; i < 2; ++i) { int R, C; stage_rc(tid * 16 + i * 8192, R, C); const int Rb = Epi::PERM ? ((R & ~31) + perm32(R & 31)) : R;
        voffA[i] = (unsigned)(R * K + C) * 2u; voffB[i] = (unsigned)(Rb * K + C) * 2u; }
    const size_t kstep = (size_t)(BK * 2);
    const size_t hstep = (size_t)HALF * K * 2;
    const size_t tstep = 2 * hstep;
    const unsigned ldsw = (unsigned)wid * 1024u;
    const int aoff = lds_byte(wr * 64 + fr, fq * 8), boff = lds_byte(wc * 32 + fr, fq * 8);
#define PG8_SA(b, h) (((b) * 2 + (h)) * HTB)
#define PG8_SB(b, h) ((4 + (b) * 2 + (h)) * HTB)
#define PG8_STAGE(bufoff, gbase, voff) do { _Pragma("unroll") for (int _i = 0; _i < 2; ++_i) \
        __builtin_amdgcn_global_load_lds((const unsigned*)((const char*)(gbase) + (voff)[_i]), (PG8_LAS unsigned*)(lds + (bufoff) + ldsw + _i * 8192), 16, 0, 0); } while (0)
#define PG8_LDA(dst, b, h) do { _Pragma("unroll") for (int m = 0; m < 4; ++m) _Pragma("unroll") for (int k = 0; k < 2; ++k) dst[m][k] = *(const PG8_LAS bf16x8*)(lds + PG8_SA(b, h) + aoff + m * 2048 + k * 1024); } while (0)
#define PG8_LDB(dst, b, h) do { _Pragma("unroll") for (int n = 0; n < 2; ++n) _Pragma("unroll") for (int k = 0; k < 2; ++k) dst[n][k] = *(const PG8_LAS bf16x8*)(lds + PG8_SB(b, h) + boff + n * 2048 + k * 1024); } while (0)
#define PG8_MMA(ai, bj, At, Bt) do { __builtin_amdgcn_s_setprio(1); _Pragma("unroll") for (int m = 0; m < 4; ++m) _Pragma("unroll") for (int n = 0; n < 2; ++n) _Pragma("unroll") for (int k = 0; k < 2; ++k) \
        acc[ai][bj][m][n] = __builtin_amdgcn_mfma_f32_16x16x32_bf16(Bt[n][k], At[m][k], acc[ai][bj][m][n], 0, 0, 0); __builtin_amdgcn_s_setprio(0); } while (0)
#define PG8_WAIT_V(n) asm volatile("s_waitcnt vmcnt(" #n ")" ::: "memory")
#define PG8_WAIT_L(n) asm volatile("s_waitcnt lgkmcnt(" #n ")" ::: "memory")
#define PG8_BAR __builtin_amdgcn_s_barrier()
#define PG8_SCHED __builtin_amdgcn_sched_barrier(0)
    Unit cur, nxt; int ui = 0;
    if (!S.next(0, cur)) return;
    f32x4 acc[2][2][4][2];
#pragma unroll
    for (int a = 0; a < 2; ++a)
#pragma unroll
        for (int b = 0; b < 2; ++b)
#pragma unroll
            for (int m = 0; m < 4; ++m)
#pragma unroll
                for (int n = 0; n < 2; ++n) acc[a][b][m][n] = (f32x4){0.f, 0.f, 0.f, 0.f};
    bf16x8 At[4][2], B0[2][2], B1[2][2];
    const char* cA = (const char*)g.A + (size_t)cur.pm * tstep + (size_t)cur.k0 * 2; const char* cB = (const char*)g.Bt + (size_t)cur.pn * tstep + (size_t)cur.k0 * 2;
    S.a_ready(cur);
    PG8_STAGE(PG8_SB(0, 0), cB, voffB); PG8_STAGE(PG8_SA(0, 0), cA, voffA); PG8_STAGE(PG8_SB(0, 1), cB + hstep, voffB); PG8_STAGE(PG8_SA(0, 1), cA + hstep, voffA);
    if (wr == 1) PG8_BAR;
    PG8_WAIT_V(4); PG8_BAR;
    PG8_STAGE(PG8_SB(1, 0), cB + kstep, voffB); PG8_STAGE(PG8_SA(1, 0), cA + kstep, voffA); PG8_STAGE(PG8_SB(1, 1), cB + hstep + kstep, voffB);
    PG8_WAIT_V(6); PG8_BAR;
    PG8_STAMP();
    for (;;) {
        const bool has_next = S.next(ui + 1, nxt);
        const char* nA = has_next ? (const char*)g.A + (size_t)nxt.pm * tstep + (size_t)nxt.k0 * 2 : cA; const char* nB = has_next ? (const char*)g.Bt + (size_t)nxt.pn * tstep + (size_t)nxt.k0 * 2 : cB;
        const int nt = cur.nt;
        for (int t = 0; t < nt; t += 2) {
            const bool last = (t == nt - 2);
            const char* a1 = cA + (size_t)(t + 1) * kstep;
            const char* a2 = last ? nA : cA + (size_t)(t + 2) * kstep; const char* b2 = last ? nB : cB + (size_t)(t + 2) * kstep;
            const char* a3 = a2 + kstep; const char* b3 = b2 + kstep;
            if (last && has_next) S.a_ready(nxt);
            PG8_LDB(B0, 0, 0); PG8_SCHED; PG8_LDA(At, 0, 0); PG8_STAGE(PG8_SA(1, 1), a1 + hstep, voffA);
            PG8_WAIT_L(8); PG8_BAR; PG8_WAIT_L(0); PG8_MMA(0, 0, At, B0); PG8_BAR; PG8_SCHED;
            PG8_LDB(B1, 0, 1); PG8_STAGE(PG8_SB(0, 0), b2, voffB);
            PG8_BAR; PG8_WAIT_L(0); PG8_MMA(0, 1, At, B1); PG8_BAR;
            PG8_LDA(At, 0, 1); PG8_STAGE(PG8_SA(0, 0), a2, voffA);
            PG8_BAR; PG8_WAIT_L(0); PG8_MMA(1, 0, At, B0); PG8_BAR; PG8_SCHED;
            PG8_STAGE(PG8_SB(0, 1), b2 + hstep, voffB);
            PG8_WAIT_V(6); PG8_BAR; PG8_MMA(1, 1, At, B1); PG8_BAR;
            PG8_LDB(B0, 1, 0); PG8_SCHED; PG8_LDA(At, 1, 0); PG8_STAGE(PG8_SA(0, 1), a2 + hstep, voffA);
            PG8_WAIT_L(8); PG8_BAR; PG8_WAIT_L(0); PG8_MMA(0, 0, At, B0); PG8_BAR; PG8_SCHED;
            PG8_LDB(B1, 1, 1); PG8_STAGE(PG8_SB(1, 0), b3, voffB);
            PG8_BAR; PG8_WAIT_L(0); PG8_MMA(0, 1, At, B1); PG8_BAR;
            PG8_LDA(At, 1, 1); PG8_STAGE(PG8_SA(1, 0), a3, voffA);
            PG8_BAR; PG8_WAIT_L(0); PG8_MMA(1, 0, At, B0); PG8_BAR; PG8_SCHED;
            PG8_STAGE(PG8_SB(1, 1), b3 + hstep, voffB);
            PG8_WAIT_V(6); PG8_BAR; PG8_MMA(1, 1, At, B1); PG8_BAR;
        }
        PG8_STAMP();
        if constexpr (!Epi::AFTER_DRAIN) { E(acc, cur, wr, wc, fr, fq); S.done(cur); }
        PG8_STAMP();
        if (!has_next) break;
#pragma unroll
        for (int a = 0; a < 2; ++a)
#pragma unroll
            for (int b = 0; b < 2; ++b)
#pragma unroll
                for (int m = 0; m < 4; ++m)
#pragma unroll
                    for (int n = 0; n < 2; ++n) acc[a][b][m][n] = (f32x4){0.f, 0.f, 0.f, 0.f};
        cur = nxt; cA = nA; cB = nB; ++ui;
    }
    PG8_WAIT_V(0);
    if (wr == 0) PG8_BAR;
    PG8_BAR;
    if constexpr (Epi::AFTER_DRAIN) { E.fused(acc, cur, wr, wc, fr, fq, lds, wid, lane); S.done(cur); }
    PG8_STAMP();
    if (STAMP && wid == 0) { stamps[lane] = lane < nts ? (((unsigned long long)(unsigned)ts_hi << 32) | (unsigned)ts_lo) : 0ull;
        if (lane == 62) stamps[62] = rt_entry; if (lane == 63) stamps[63] = (unsigned long long)wall_clock64(); }
#undef PG8_STAMP
#undef PG8_SA
#undef PG8_SB
#undef PG8_STAGE
#undef PG8_LDA
#undef PG8_LDB
#undef PG8_MMA
#undef PG8_WAIT_V
#undef PG8_WAIT_L
#undef PG8_BAR
#undef PG8_SCHED
}
}
using pg8::bf16_t; using pg8::bf16x8; using pg8::f32x4; using pg8::u32x4; using pg8::Unit; using pg8::cvt_pk_bf16;
#define LAS __attribute__((address_space(3)))
typedef unsigned u32x2 __attribute__((ext_vector_type(2)));
#define XB_TMO      128
#define XB_XCNT(j)  (256  + 64 * (j))
#define XB_XSUB(j)  (1280 + 64 * (j))
#define XB_XGEN(j)  (2304 + 64 * (j))
#define XB_TOP      3328
#define XB_TOPGEN   3392
#define XCD_BAR_WORDS 3456
#define XB_SPIN_CAP (1u << 18)

__device__ __forceinline__ unsigned xb_ld(unsigned* p)              { return __hip_atomic_load(p, __ATOMIC_RELAXED, __HIP_MEMORY_SCOPE_AGENT); }
__device__ __forceinline__ unsigned xb_add(unsigned* p, unsigned v) { return __hip_atomic_fetch_add(p, v, __ATOMIC_RELAXED, __HIP_MEMORY_SCOPE_AGENT); }
__device__ __forceinline__ unsigned xb_xcc_id() { return (unsigned)__builtin_amdgcn_s_getreg((3 << 11) | 20) & 0xFu; }
#define XB_SPIN(cond, bar) do { unsigned _sp = 0; while (cond) { __builtin_amdgcn_s_sleep(1); \
    if ((++_sp & 255u) == 0u) { if (xb_ld(&(bar)[XB_TMO])) break; if (_sp > XB_SPIN_CAP) { atomicAdd(&(bar)[XB_TMO], 1u); break; } } } } while (0)

struct XcdBarrier {
    unsigned* bar; unsigned x;
    volatile LAS unsigned* st;
};

__device__ __forceinline__ XcdBarrier xcd_barrier_post(unsigned* bar, volatile LAS unsigned* st) {
    XcdBarrier b; b.bar = bar; b.x = xb_xcc_id(); b.st = st;
    if (threadIdx.x == 0) (void)xb_add(&bar[XB_XCNT(b.x)], 1u);
    return b;
}
__device__ __forceinline__ void xcd_barrier_complete(unsigned* bar, unsigned x, unsigned& nloc, unsigned& nx) {
    const unsigned G = gridDim.x * gridDim.y * gridDim.z;
    unsigned sum, cnt, mine, sp = 0u;
    for (;;) {
        sum = 0u; cnt = 0u; mine = 0u;
#pragma unroll
        for (unsigned j = 0; j < 16; ++j) { const unsigned c = xb_ld(&bar[XB_XCNT(j)]); sum += c; cnt += (c > 0u) ? 1u : 0u; mine = (j == x) ? c : mine; }
        if (sum == G) break;
        __builtin_amdgcn_s_sleep(1);
        if ((++sp & 255u) == 0u) { if (xb_ld(&bar[XB_TMO])) break; if (sp > XB_SPIN_CAP) { atomicAdd(&bar[XB_TMO], 1u); break; } }
    }
    nloc = mine > 0u ? mine : 1u; nx = cnt > 0u ? cnt : 1u;
}

__device__ __forceinline__ void xcd_barrier(const XcdBarrier& b) {
    asm volatile("s_waitcnt vmcnt(0)" ::: "memory");
    __syncthreads();
    if (threadIdx.x == 0) {
        unsigned* bar = b.bar;
        __builtin_amdgcn_s_waitcnt(0);
        unsigned nloc = b.st[0], nx = b.st[1];
        if (nloc == 0u) { xcd_barrier_complete(bar, b.x, nloc, nx); b.st[0] = nloc; b.st[1] = nx; }
        const unsigned old = xb_add(&bar[XB_XSUB(b.x)], 1u);
        const unsigned gen = old / nloc;
        if (old + 1u == (gen + 1u) * nloc) {
            __builtin_amdgcn_fence(__ATOMIC_RELEASE, "agent");
            asm volatile("s_waitcnt vmcnt(0)" ::: "memory");
            const unsigned og = xb_add(&bar[XB_TOP], 1u);
            const unsigned tg = og / nx;
            if (og + 1u == (tg + 1u) * nx) xb_add(&bar[XB_TOPGEN], 1u);
            else XB_SPIN(xb_ld(&bar[XB_TOPGEN]) == tg, bar);
            __builtin_amdgcn_fence(__ATOMIC_ACQUIRE, "agent");
            xb_add(&bar[XB_XGEN(b.x)], 1u);
            asm volatile("s_waitcnt vmcnt(0)" ::: "memory");
        } else {
            XB_SPIN(xb_ld(&bar[XB_XGEN(b.x)]) == gen, bar);
            __builtin_amdgcn_fence(__ATOMIC_ACQUIRE, "agent");
            asm volatile("s_waitcnt vmcnt(0)" ::: "memory");
        }
    }
    __syncthreads();
}


constexpr int DM = 1024, NBATCH = 8, TT = 2064, NSAMP = 128, MP = NBATCH * TT  , MTOK = MP + NSAMP  ;
constexpr int DIN = 3584, DSSM = 512, DFF = 3072, NG = 32, NCHUNK = 129, NR = NBATCH * NCHUNK  ;
constexpr int C_US = 1024, C_GA = 1536, C_GB = 2560;
constexpr float ALPHA = 1.189207115002721f, LN_EPS = 1e-5f;
enum { I_XP = 0, I_XS, I_CCL, I_SL, I_SSR, I_SSI, I_CCF, I_META, I_EG, I_EB, I_WIN, I_BIN, I_CLW, I_CLB, I_WR, I_BR, I_WI, I_BI, I_LAM,
       I_SLRE, I_SLIM, I_SLDT, I_SBRE, I_SBIM, I_SCRE, I_SCIM, I_SD, I_WGLU, I_BGLU, I_WOUT, I_BOUT, I_L1G, I_L1B, I_WUP, I_BUP, I_FCW, I_FCB,
       I_WDOWN, I_BDOWN, I_L2G, I_L2B, N_IN };
constexpr size_t O_YP = 0, O_YS = 16777216, O_PCL = O_YS + 131072, O_PL = O_PCL + 24576, O_PSR = O_PL + 8192, O_PSI = O_PSR + 16384, O_PCF = O_PSI + 16384,
                 O_SCL = O_PCF + 49152, O_SL = O_SCL + 393216, O_SSR = O_SL + 131072, O_SSI = O_SSR + 262144, O_SCF = O_SSI + 262144, O_END = O_SCF + 786432;
constexpr size_t W_WTUP = 0, W_WTDOWN = W_WTUP + (size_t)6144 * 1024 * 2, W_XN = W_WTDOWN + (size_t)1024 * 3072 * 2, W_C = W_XN + (size_t)MTOK * 1024 * 2;
constexpr size_t W_PROJ = W_C, W_MIX = W_PROJ + (size_t)MTOK * DIN * 2, W_YSG = W_MIX + (size_t)MTOK * 1024 * 2, W_D = W_YSG + (size_t)MTOK * 512 * 2;
constexpr size_t W_WTGLU = W_D, W_WTOUT = W_WTGLU + (size_t)2048 * 512 * 2, W_WTR = W_WTOUT + (size_t)1024 * 1024 * 2, W_WTI = W_WTR + 262144, W_W1 = W_WTI + 262144,
                 W_W2 = W_W1 + (size_t)NG * 128 * 256 * 2, W_HPREV = W_W2 + (size_t)NG * 256 * 384 * 2, W_A1 = W_HPREV + (size_t)NR * NG * 128 * 2, W_A16 = W_A1 + 16384,
                 W_BBAR = W_A16 + 16384, W_LRUA = W_BBAR + 262144, W_LRUH = W_LRUA + 262144, W_LRUC = W_LRUH + 262144, W_S = W_LRUC + 262144, W_WTIN = W_S,
                 W_S_END = W_S + (size_t)NR * NG * 128 * 4;
constexpr size_t W_BAR = (W_S_END + 4095) / 4096 * 4096;
static_assert(W_BAR + (XCD_BAR_WORDS + 64 * 16) * 4 <= 268435456, "barrier words");
constexpr size_t W_PART = W_C + (size_t)MTOK * 1024 * 4;
constexpr size_t W_SBG = W_C, W_SBV = W_SBG + (size_t)260 * 4 * DFF * 4, W_SB_END = W_SBV + (size_t)260 * 2 * DFF * 4;
constexpr size_t W_PU = W_SB_END, W_PU_END = W_PU + (size_t)4 * 256 * 6144 * 4;
constexpr size_t W_R1 = W_C, W_G = W_C, W_V = W_G + (size_t)MTOK * DFF * 2, W_V_END = W_V + (size_t)MTOK * DFF * 2, W_R2 = W_C;
static_assert(W_S_END <= 268435456 && W_V_END <= 268435456, "workspace map exceeds 256 MiB");
static_assert(W_SB_END <= W_V && W_PU_END <= W_V, "side buffers / up partials overlap H");
static_assert(W_PART + (size_t)12 * 256 * 1024 * 4 <= W_MIX && W_PART + (size_t)12 * 256 * 1024 * 4 <= W_V, "r1 / partials overlap mix or v");

constexpr int LDS_TOTAL = 147456;
struct P { const float* in[N_IN]; float* out; unsigned char* ws; };

__device__ __forceinline__ float bf2f(unsigned short b) { return __uint_as_float(((unsigned)b) << 16); }
__device__ __forceinline__ float bflo(unsigned u) { return __uint_as_float(u << 16); }
__device__ __forceinline__ float bfhi(unsigned u) { return __uint_as_float(u & 0xffff0000u); }
__device__ __forceinline__ unsigned short f2bf(float f) { return (unsigned short)(cvt_pk_bf16(f, 0.f) & 0xffffu); }
__device__ __forceinline__ float sigm(float x) { return __builtin_amdgcn_rcpf(1.f + __expf(-x)); }
__device__ __forceinline__ float gelu_tanh(float x) { return x * sigm(1.5957691216057308f * (x + 0.044715f * x * x * x)); }
__device__ __forceinline__ float wave_sum(float v) {
#pragma unroll
    for (int o = 1; o < 64; o <<= 1) v += __shfl_xor(v, o);
    return v;
}
#define LDS_WAIT() asm volatile("s_waitcnt lgkmcnt(0)" ::: "memory")
#define REPEAT(N) for (int rep_ = 0; rep_ < (N); ++rep_)
#define TIMED(N) const unsigned long long tq0_##N = (PROBE_PHASE == (N)) ? __builtin_amdgcn_s_memrealtime() : 0ull;
#define TIMED_END(N) if (PROBE_PHASE == (N)) { const unsigned long long tq1 = __builtin_amdgcn_s_memrealtime(); while (__builtin_amdgcn_s_memrealtime() - tq1 < tq1 - tq0_##N) __builtin_amdgcn_s_sleep(4); }

struct EpiProj {
    static constexpr bool PERM = true, AFTER_DRAIN = false;
    bf16_t* O; const float* bias;
    __device__ __forceinline__ void operator()(const f32x4 (&acc)[2][2][4][2], const Unit& u, int wr, int wc, int fr, int fq) const {
        const int row0 = u.pm * 256 + wr * 64 + fr, col0 = u.pn * 256 + wc * 32 + 8 * fq;
#pragma unroll
        for (int bj = 0; bj < 2; ++bj) { const int col = col0 + bj * 128; const f32x4 b0 = *(const f32x4*)(bias + col), b1 = *(const f32x4*)(bias + col + 4);
#pragma unroll
            for (int ai = 0; ai < 2; ++ai)
#pragma unroll
                for (int m = 0; m < 4; ++m) { const f32x4 v0 = acc[ai][bj][m][0] + b0, v1 = acc[ai][bj][m][1] + b1; u32x4 w;
                    w.x = cvt_pk_bf16(v0[0], v0[1]); w.y = cvt_pk_bf16(v0[2], v0[3]); w.z = cvt_pk_bf16(v1[0], v1[1]); w.w = cvt_pk_bf16(v1[2], v1[3]);
                    *(u32x4*)(O + (size_t)(row0 + ai * 128 + m * 16) * DIN + col) = w; } }
    }
};
struct EpiGlu {
    static constexpr bool PERM = true, AFTER_DRAIN = false;
    bf16_t* mix; const bf16_t* m2; const float* carry; const bf16_t* proj; const float* bias;
    __device__ __forceinline__ void operator()(const f32x4 (&acc)[2][2][4][2], const Unit& u, int wr, int wc, int fr, int fq) const {
        const int row0 = u.pm * 256 + wr * 64 + fr, j = u.pn * 128 + wc * 32 + 8 * fq;
        const f32x4 bv0 = *(const f32x4*)(bias + j), bv1 = *(const f32x4*)(bias + j + 4), bg0 = *(const f32x4*)(bias + 1024 + j), bg1 = *(const f32x4*)(bias + 1024 + j + 4);
#pragma unroll
        for (int ai = 0; ai < 2; ++ai)
#pragma unroll
            for (int mp = 0; mp < 2; ++mp) { u32x4 gbw[2], mw[2], m2w[2]; f32x4 cv0[2], cv1[2];
#pragma unroll
                for (int mm = 0; mm < 2; ++mm) { const int rowi = row0 + ai * 128 + (2 * mp + mm) * 16; const size_t row = (size_t)rowi; int cidx = 0;
                    if (rowi < MP) { const int b = rowi / TT, t = rowi - b * TT; int kc = t >> 8; kc = kc > 7 ? 7 : kc; cidx = (b * 8 + kc) * 1024; }
                    cv0[mm] = *(const f32x4*)(carry + cidx + j); cv1[mm] = *(const f32x4*)(carry + cidx + j + 4);
                    gbw[mm] = *(const u32x4*)(proj + row * DIN + C_GB + j); mw[mm] = *(const u32x4*)(mix + row * 1024 + j); m2w[mm] = *(const u32x4*)(m2 + row * 1024 + j); }
#pragma unroll
                for (int mm = 0; mm < 2; ++mm) { const int m = 2 * mp + mm; const size_t row = (size_t)(row0 + ai * 128 + m * 16);
                    const f32x4 val0 = acc[ai][0][m][0] + bv0, val1 = acc[ai][0][m][1] + bv1, gate0 = acc[ai][1][m][0] + bg0, gate1 = acc[ai][1][m][1] + bg1;
                    const float o0 = bflo(mw[mm].x) + bflo(m2w[mm].x) * cv0[mm][0] + sigm(bflo(gbw[mm].x)) * val0[0] * sigm(gate0[0]), o1 = bfhi(mw[mm].x) + bfhi(m2w[mm].x) * cv0[mm][1] + sigm(bfhi(gbw[mm].x)) * val0[1] * sigm(gate0[1]);
                    const float o2 = bflo(mw[mm].y) + bflo(m2w[mm].y) * cv0[mm][2] + sigm(bflo(gbw[mm].y)) * val0[2] * sigm(gate0[2]), o3 = bfhi(mw[mm].y) + bfhi(m2w[mm].y) * cv0[mm][3] + sigm(bfhi(gbw[mm].y)) * val0[3] * sigm(gate0[3]);
                    const float o4 = bflo(mw[mm].z) + bflo(m2w[mm].z) * cv1[mm][0] + sigm(bflo(gbw[mm].z)) * val1[0] * sigm(gate1[0]), o5 = bfhi(mw[mm].z) + bfhi(m2w[mm].z) * cv1[mm][1] + sigm(bfhi(gbw[mm].z)) * val1[1] * sigm(gate1[1]);
                    const float o6 = bflo(mw[mm].w) + bflo(m2w[mm].w) * cv1[mm][2] + sigm(bflo(gbw[mm].w)) * val1[2] * sigm(gate1[2]), o7 = bfhi(mw[mm].w) + bfhi(m2w[mm].w) * cv1[mm][3] + sigm(bfhi(gbw[mm].w)) * val1[3] * sigm(gate1[3]);
                    u32x4 w; w.x = cvt_pk_bf16(o0, o1); w.y = cvt_pk_bf16(o2, o3); w.z = cvt_pk_bf16(o4, o5); w.w = cvt_pk_bf16(o6, o7); *(u32x4*)(mix + row * 1024 + j) = w; } }
    }
};
struct EpiRes {
    static constexpr bool PERM = true, AFTER_DRAIN = false;
    bf16_t* R; const bf16_t* X; const float* bias; float* part;
    __device__ __forceinline__ void operator()(const f32x4 (&acc)[2][2][4][2], const Unit& u, int wr, int wc, int fr, int fq) const {
        const int row0 = u.pm * 256 + wr * 64 + fr, col0 = u.pn * 256 + wc * 32 + 8 * fq;
        if (u.ks >= 0) { float* pp = part + ((size_t)u.ks * 256 - 16384) * 1024;
#pragma unroll
            for (int bj = 0; bj < 2; ++bj)
#pragma unroll
                for (int n = 0; n < 2; ++n)
#pragma unroll
                    for (int ai = 0; ai < 2; ++ai)
#pragma unroll
                        for (int m = 0; m < 4; ++m) *(f32x4*)(pp + (size_t)(row0 + ai * 128 + m * 16) * 1024 + col0 + bj * 128 + n * 4) = acc[ai][bj][m][n];
            return; }
#pragma unroll
        for (int bj = 0; bj < 2; ++bj) { const int col = col0 + bj * 128; const f32x4 b0 = *(const f32x4*)(bias + col), b1 = *(const f32x4*)(bias + col + 4);
#pragma unroll
            for (int ai = 0; ai < 2; ++ai) { u32x4 xw[4];
#pragma unroll
                for (int m = 0; m < 4; ++m) xw[m] = *(const u32x4*)(X + (size_t)(row0 + ai * 128 + m * 16) * 1024 + col);
#pragma unroll
                for (int m = 0; m < 4; ++m) { const size_t off = (size_t)(row0 + ai * 128 + m * 16) * 1024 + col;
                    f32x4 v0 = acc[ai][bj][m][0] + b0, v1 = acc[ai][bj][m][1] + b1;
                    v0[0] += ALPHA * bflo(xw[m].x); v0[1] += ALPHA * bfhi(xw[m].x); v0[2] += ALPHA * bflo(xw[m].y); v0[3] += ALPHA * bfhi(xw[m].y);
                    v1[0] += ALPHA * bflo(xw[m].z); v1[1] += ALPHA * bfhi(xw[m].z); v1[2] += ALPHA * bflo(xw[m].w); v1[3] += ALPHA * bfhi(xw[m].w);
                    u32x4 w; w.x = cvt_pk_bf16(v0[0], v0[1]); w.y = cvt_pk_bf16(v0[2], v0[3]); w.z = cvt_pk_bf16(v1[0], v1[1]); w.w = cvt_pk_bf16(v1[2], v1[3]); *(u32x4*)(R + off) = w; } } }
    }
};
__device__ __forceinline__ float rot1(float x) { return __int_as_float(__builtin_amdgcn_update_dpp(0, __float_as_int(x), 0x121, 0xf, 0xf, false)); }
__device__ __forceinline__ float rot2(float x) { return __int_as_float(__builtin_amdgcn_update_dpp(0, __float_as_int(x), 0x122, 0xf, 0xf, false)); }
struct EpiUp {
    static constexpr bool PERM = true, AFTER_DRAIN = false;
    bf16_t* H; const float* bias; float* out; const float* cw; const float* cb; const float* cache; float* sbg; float* sbv;
    __device__ __forceinline__ void operator()(const f32x4 (&acc)[2][2][4][2], const Unit& u, int wr, int wc, int fr, int fq) const {
        const int c0 = u.pn * 128 + wc * 32 + 8 * fq;
        f32x4 bg[2], bv[2], w0[2], w1[2], w2[2], cbv[2];
#pragma unroll
        for (int n = 0; n < 2; ++n) { const int ch = c0 + 4 * n; bg[n] = *(const f32x4*)(bias + ch); bv[n] = *(const f32x4*)(bias + DFF + ch);
            w0[n] = *(const f32x4*)(cw + ch); w1[n] = *(const f32x4*)(cw + DFF + ch); w2[n] = *(const f32x4*)(cw + 2 * DFF + ch); cbv[n] = *(const f32x4*)(cb + ch); }
#pragma unroll
        for (int ai = 0; ai < 2; ++ai) { const int blk = u.pm * 4 + ai * 2 + wr, r0 = blk * 64;
            f32x4 gp1[2], gp2[2];
#pragma unroll
            for (int n = 0; n < 2; ++n) { gp1[n] = (f32x4){0.f, 0.f, 0.f, 0.f}; gp2[n] = (f32x4){0.f, 0.f, 0.f, 0.f}; }
#pragma unroll
            for (int m = 0; m < 4; ++m) { const int row = r0 + 16 * m + fr; const int b = row / TT, t = row - b * TT; float h[8];
#pragma unroll
                for (int n = 0; n < 2; ++n) { const int ch = c0 + 4 * n; const f32x4 g = acc[ai][0][m][n] + bg[n], v = acc[ai][1][m][n] + bv[n];
                    f32x4 a1, a2; a1[0] = rot1(g[0]); a1[1] = rot1(g[1]); a1[2] = rot1(g[2]); a1[3] = rot1(g[3]); a2[0] = rot2(g[0]); a2[1] = rot2(g[1]); a2[2] = rot2(g[2]); a2[3] = rot2(g[3]);
                    f32x4 g1 = (fr >= 1) ? a1 : gp1[n], g2 = (fr >= 2) ? a2 : gp2[n];
                    if (t == 0) g1 = (f32x4){0.f, 0.f, 0.f, 0.f}; if (t <= 1) g2 = (f32x4){0.f, 0.f, 0.f, 0.f};
                    if (t >= TT - 2) *(f32x4*)(out + O_PCF + ((size_t)b * 2 + (t - (TT - 2))) * DFF + ch) = g;
                    if (m == 0 && fr < 2) { *(f32x4*)(sbg + ((size_t)blk * 4 + fr) * DFF + ch) = g; *(f32x4*)(sbv + ((size_t)blk * 2 + fr) * DFF + ch) = v; }
                    if (m == 3 && fr >= 14) *(f32x4*)(sbg + ((size_t)blk * 4 + fr - 12) * DFF + ch) = g;
                    const f32x4 y = cbv[n] + w0[n] * g2 + w1[n] * g1 + w2[n] * g;
                    h[4 * n] = gelu_tanh(y[0]) * v[0]; h[4 * n + 1] = gelu_tanh(y[1]) * v[1]; h[4 * n + 2] = gelu_tanh(y[2]) * v[2]; h[4 * n + 3] = gelu_tanh(y[3]) * v[3];
                    gp1[n] = a1; gp2[n] = a2; }
                u32x4 w; w.x = cvt_pk_bf16(h[0], h[1]); w.y = cvt_pk_bf16(h[2], h[3]); w.z = cvt_pk_bf16(h[4], h[5]); w.w = cvt_pk_bf16(h[6], h[7]); *(u32x4*)(H + (size_t)row * DFF + c0) = w; } }
    }
};
struct EpiRaw {
    static constexpr bool PERM = false, AFTER_DRAIN = false;
    float* pu; int ld;
    __device__ __forceinline__ void operator()(const f32x4 (&acc)[2][2][4][2], const Unit& u, int wr, int wc, int fr, int fq) const {
        float* pp = pu + (size_t)u.ks * 256 * ld + (size_t)(wr * 64 + fr) * ld + u.pn * 256 + wc * 32 + 4 * fq;
#pragma unroll
        for (int ai = 0; ai < 2; ++ai)
#pragma unroll
            for (int m = 0; m < 4; ++m)
#pragma unroll
                for (int bj = 0; bj < 2; ++bj)
#pragma unroll
                    for (int n = 0; n < 2; ++n) *(f32x4*)(pp + (size_t)(ai * 128 + m * 16) * ld + bj * 128 + n * 16) = acc[ai][bj][m][n];
    }
};
template <class Epi> __device__ __forceinline__ void run_gemm(LAS unsigned char* lds, int vc, const bf16_t* A, const bf16_t* Bt, int N, int K, const Epi& E) {
    pg8::Gemm g; g.A = A; g.Bt = Bt; g.M = MTOK; g.N = N; g.K = K;
    pg8::StaticOrder S; S.init(MTOK, N, K, (int)gridDim.x, vc);
    pg8::gemm_phase<Epi, pg8::StaticOrder, false>(lds, g, S, E, nullptr);
}

template <class Epi> __device__ __forceinline__ void run_gemm_split(LAS unsigned char* lds, int vc, const bf16_t* A, const bf16_t* Bt, int N, int K, int nsplit, const Epi& E) {
    pg8::Gemm g; g.A = A; g.Bt = Bt; g.M = MTOK; g.N = N; g.K = K;
    pg8::SplitOrder S; S.init(N, K, nsplit, (int)gridDim.x, vc);
    pg8::gemm_phase<Epi, pg8::SplitOrder, false>(lds, g, S, E, nullptr);
}

template <class Epi> __device__ __forceinline__ void run_gemm_main64(LAS unsigned char* lds, int vc, const bf16_t* A, const bf16_t* Bt, int N, int K, const Epi& E) {
    pg8::Gemm g; g.A = A; g.Bt = Bt; g.M = 16384; g.N = N; g.K = K;
    pg8::StaticOrder S; S.init(16384, N, K, (int)gridDim.x, vc);
    pg8::gemm_phase<Epi, pg8::StaticOrder, false>(lds, g, S, E, nullptr);
}
__device__ __forceinline__ void run_gemm_tail(LAS unsigned char* lds, int vc, const bf16_t* A, const bf16_t* Bt, int N, int K, int nsplit, float* pu) {
    pg8::Gemm g; g.A = A; g.Bt = Bt; g.M = MTOK; g.N = N; g.K = K;
    pg8::TailOrder S; S.init(N, K, nsplit, (int)gridDim.x, vc);
    EpiRaw E; E.pu = pu; E.ld = N;
    pg8::gemm_phase<EpiRaw, pg8::TailOrder, false>(lds, g, S, E, nullptr);
}

__device__ __forceinline__ void transpose_item(const float* W, int N, bf16_t* WT, int K, int k0, int srcn0, int dstn0, LAS float* scr, int lane) {
    float tv[32];
#pragma unroll
    for (int i = 0; i < 32; ++i) tv[i] = W[(size_t)(k0 + 2 * i + (lane >> 5)) * N + srcn0 + (lane & 31)];
#pragma unroll
    for (int i = 0; i < 32; ++i) scr[(2 * i + (lane >> 5)) * 33 + (lane & 31)] = tv[i];
    LDS_WAIT();
    const int c = lane & 7;
#pragma unroll
    for (int j = 0; j < 4; ++j) { const int n = (lane >> 3) + 8 * j; const LAS float* s = scr + (8 * c) * 33 + n;
        u32x4 o; o.x = cvt_pk_bf16(s[0 * 33], s[1 * 33]); o.y = cvt_pk_bf16(s[2 * 33], s[3 * 33]); o.z = cvt_pk_bf16(s[4 * 33], s[5 * 33]); o.w = cvt_pk_bf16(s[6 * 33], s[7 * 33]);
        *(u32x4*)(WT + (size_t)(dstn0 + n) * K + k0 + 8 * c) = o; }
    LDS_WAIT();
}
__device__ __forceinline__ const float* src_row(const P& p, int r) {
    if (r < MP) { const int b = r / TT, t = r - b * TT; return t < 16 ? p.in[I_META] + (size_t)t * DM : p.in[I_XP] + ((size_t)b * 2048 + (t - 16)) * DM; }
    return p.in[I_XS] + (size_t)(r - MP) * DM;
}
template <bool OUT_BF16> __device__ __forceinline__ void ln_row(const float* xrow, const float* g, const float* bta, void* orow, int lane, int nsplit = 0, const bf16_t* xres = nullptr, const float* rbias = nullptr) {
    f32x4 v[4]; float s = 0.f;
#pragma unroll
    for (int j = 0; j < 4; ++j) { v[j] = *(const f32x4*)(xrow + 4 * lane + 256 * j);
        if (nsplit > 0) { for (int k = 1; k < nsplit; ++k) v[j] += *(const f32x4*)(xrow + (size_t)k * 256 * 1024 + 4 * lane + 256 * j);
            const u32x2 xw = *(const u32x2*)(xres + 4 * lane + 256 * j); const f32x4 bv = *(const f32x4*)(rbias + 4 * lane + 256 * j);
            v[j][0] += ALPHA * bflo(xw.x) + bv[0]; v[j][1] += ALPHA * bfhi(xw.x) + bv[1]; v[j][2] += ALPHA * bflo(xw.y) + bv[2]; v[j][3] += ALPHA * bfhi(xw.y) + bv[3]; }
        s += (v[j][0] + v[j][1]) + (v[j][2] + v[j][3]); }
    const float mean = wave_sum(s) * (1.f / DM); float s2 = 0.f;
#pragma unroll
    for (int j = 0; j < 4; ++j) { v[j] = v[j] - mean; s2 += (v[j][0] * v[j][0] + v[j][1] * v[j][1]) + (v[j][2] * v[j][2] + v[j][3] * v[j][3]); }
    const float rstd = 1.f / sqrtf(wave_sum(s2) * (1.f / DM) + LN_EPS);
#pragma unroll
    for (int j = 0; j < 4; ++j) { const f32x4 gg = *(const f32x4*)(g + 4 * lane + 256 * j), bb = *(const f32x4*)(bta + 4 * lane + 256 * j);
        const f32x4 o = (v[j] * rstd) * gg + bb;
        if (OUT_BF16) { u32x2 w; w.x = cvt_pk_bf16(o[0], o[1]); w.y = cvt_pk_bf16(o[2], o[3]); *(u32x2*)((bf16_t*)orow + 4 * lane + 256 * j) = w; }
        else *(f32x4*)((float*)orow + 4 * lane + 256 * j) = o; }
}
template <bool OUT_BF16> __device__ __forceinline__ void ln_rows2(const float* xa, const float* xb, const float* g, const float* bta, void* oa, void* ob, int lane, bool vb) {
    f32x4 va[4], vbv[4]; float sa = 0.f, sb = 0.f;
#pragma unroll
    for (int j = 0; j < 4; ++j) { va[j] = *(const f32x4*)(xa + 4 * lane + 256 * j); vbv[j] = *(const f32x4*)(xb + 4 * lane + 256 * j); }
#pragma unroll
    for (int j = 0; j < 4; ++j) { sa += (va[j][0] + va[j][1]) + (va[j][2] + va[j][3]); sb += (vbv[j][0] + vbv[j][1]) + (vbv[j][2] + vbv[j][3]); }
#pragma unroll
    for (int o = 1; o < 64; o <<= 1) { sa += __shfl_xor(sa, o); sb += __shfl_xor(sb, o); }
    const float ma = sa * (1.f / DM), mb = sb * (1.f / DM); float qa = 0.f, qb = 0.f;
#pragma unroll
    for (int j = 0; j < 4; ++j) { va[j] = va[j] - ma; vbv[j] = vbv[j] - mb; qa += (va[j][0] * va[j][0] + va[j][1] * va[j][1]) + (va[j][2] * va[j][2] + va[j][3] * va[j][3]);
        qb += (vbv[j][0] * vbv[j][0] + vbv[j][1] * vbv[j][1]) + (vbv[j][2] * vbv[j][2] + vbv[j][3] * vbv[j][3]); }
#pragma unroll
    for (int o = 1; o < 64; o <<= 1) { qa += __shfl_xor(qa, o); qb += __shfl_xor(qb, o); }
    const float ra = 1.f / sqrtf(qa * (1.f / DM) + LN_EPS), rb = 1.f / sqrtf(qb * (1.f / DM) + LN_EPS);
#pragma unroll
    for (int j = 0; j < 4; ++j) { const f32x4 gg = *(const f32x4*)(g + 4 * lane + 256 * j), bb = *(const f32x4*)(bta + 4 * lane + 256 * j);
        const f32x4 o1 = (va[j] * ra) * gg + bb, o2 = (vbv[j] * rb) * gg + bb;
        if (OUT_BF16) { u32x2 w; w.x = cvt_pk_bf16(o1[0], o1[1]); w.y = cvt_pk_bf16(o1[2], o1[3]); *(u32x2*)((bf16_t*)oa + 4 * lane + 256 * j) = w;
            if (vb) { w.x = cvt_pk_bf16(o2[0], o2[1]); w.y = cvt_pk_bf16(o2[2], o2[3]); *(u32x2*)((bf16_t*)ob + 4 * lane + 256 * j) = w; } }
        else { *(f32x4*)((float*)oa + 4 * lane + 256 * j) = o1; if (vb) *(f32x4*)((float*)ob + 4 * lane + 256 * j) = o2; } }
}
template <bool OUT_BF16> __device__ __forceinline__ void ln_rows2_bf(const bf16_t* xa, const bf16_t* xb, const float* g, const float* bta, void* oa, void* ob, int lane, bool vb) {
    float va[16], vq[16]; float sa = 0.f, sb = 0.f;
    { u32x4 ra[2], rb[2];
#pragma unroll
      for (int j = 0; j < 2; ++j) { ra[j] = *(const u32x4*)(xa + 8 * lane + 512 * j); rb[j] = *(const u32x4*)(xb + 8 * lane + 512 * j); }
#pragma unroll
      for (int j = 0; j < 2; ++j) { va[8 * j] = bflo(ra[j].x); va[8 * j + 1] = bfhi(ra[j].x); va[8 * j + 2] = bflo(ra[j].y); va[8 * j + 3] = bfhi(ra[j].y); va[8 * j + 4] = bflo(ra[j].z); va[8 * j + 5] = bfhi(ra[j].z); va[8 * j + 6] = bflo(ra[j].w); va[8 * j + 7] = bfhi(ra[j].w);
          vq[8 * j] = bflo(rb[j].x); vq[8 * j + 1] = bfhi(rb[j].x); vq[8 * j + 2] = bflo(rb[j].y); vq[8 * j + 3] = bfhi(rb[j].y); vq[8 * j + 4] = bflo(rb[j].z); vq[8 * j + 5] = bfhi(rb[j].z); vq[8 * j + 6] = bflo(rb[j].w); vq[8 * j + 7] = bfhi(rb[j].w); } }
#pragma unroll
    for (int e = 0; e < 16; ++e) { sa += va[e]; sb += vq[e]; }
#pragma unroll
    for (int o = 1; o < 64; o <<= 1) { sa += __shfl_xor(sa, o); sb += __shfl_xor(sb, o); }
    const float ma = sa * (1.f / DM), mb = sb * (1.f / DM); float qa = 0.f, qb = 0.f;
#pragma unroll
    for (int e = 0; e < 16; ++e) { va[e] -= ma; vq[e] -= mb; qa += va[e] * va[e]; qb += vq[e] * vq[e]; }
#pragma unroll
    for (int o = 1; o < 64; o <<= 1) { qa += __shfl_xor(qa, o); qb += __shfl_xor(qb, o); }
    const float ra_ = 1.f / sqrtf(qa * (1.f / DM) + LN_EPS), rb_ = 1.f / sqrtf(qb * (1.f / DM) + LN_EPS);
#pragma unroll
    for (int j = 0; j < 2; ++j) { const int c = 8 * lane + 512 * j; const f32x4 g0 = *(const f32x4*)(g + c), g1 = *(const f32x4*)(g + c + 4), b0 = *(const f32x4*)(bta + c), b1 = *(const f32x4*)(bta + c + 4);
        float o1[8], o2[8];
#pragma unroll
        for (int e = 0; e < 4; ++e) { o1[e] = va[8 * j + e] * ra_ * g0[e] + b0[e]; o1[4 + e] = va[8 * j + 4 + e] * ra_ * g1[e] + b1[e]; o2[e] = vq[8 * j + e] * rb_ * g0[e] + b0[e]; o2[4 + e] = vq[8 * j + 4 + e] * rb_ * g1[e] + b1[e]; }
        if (OUT_BF16) { u32x4 w; w.x = cvt_pk_bf16(o1[0], o1[1]); w.y = cvt_pk_bf16(o1[2], o1[3]); w.z = cvt_pk_bf16(o1[4], o1[5]); w.w = cvt_pk_bf16(o1[6], o1[7]); *(u32x4*)((bf16_t*)oa + c) = w;
            if (vb) { w.x = cvt_pk_bf16(o2[0], o2[1]); w.y = cvt_pk_bf16(o2[2], o2[3]); w.z = cvt_pk_bf16(o2[4], o2[5]); w.w = cvt_pk_bf16(o2[6], o2[7]); *(u32x4*)((bf16_t*)ob + c) = w; } }
        else { *(f32x4*)((float*)oa + c) = (f32x4){o1[0], o1[1], o1[2], o1[3]}; *(f32x4*)((float*)oa + c + 4) = (f32x4){o1[4], o1[5], o1[6], o1[7]};
            if (vb) { *(f32x4*)((float*)ob + c) = (f32x4){o2[0], o2[1], o2[2], o2[3]}; *(f32x4*)((float*)ob + c + 4) = (f32x4){o2[4], o2[5], o2[6], o2[7]}; } } }
}
__device__ __forceinline__ void s5_precompute(const P& p, LAS unsigned char* lds, int g) {
    LAS float* apr = (LAS float*)lds;
    LAS float* api = apr + 17 * 64;
    LAS float* bbr = api + 17 * 64;
    LAS float* bbi = bbr + 1024;
    LAS float* cr = bbi + 1024;
    LAS float* ci = cr + 1024;
    LAS float* Kl = ci + 1024;
    int tid_ = threadIdx.x; asm volatile("" : "+v"(tid_)); const int tid = tid_;
    if (tid < 64) { const int pp = tid;
        const float dt = expf(p.in[I_SLDT][g]); const float lre = p.in[I_SLRE][g * 64 + pp], lim = p.in[I_SLIM][g * 64 + pp];
        const float mag = expf(lre * dt); const float ang = lim * dt; const float abr = mag * cosf(ang), abi = mag * sinf(ang);
        const float den = lre * lre + lim * lim, nr = abr - 1.0f, ni = abi; const float fre = (nr * lre + ni * lim) / den, fim = (ni * lre - nr * lim) / den;
        float pr = 1.f, pi = 0.f;
        for (int j = 0; j <= 16; ++j) { apr[j * 64 + pp] = pr; api[j * 64 + pp] = pi; const float nr2 = pr * abr - pi * abi, ni2 = pr * abi + pi * abr; pr = nr2; pi = ni2; }
        float* a1 = (float*)(p.ws + W_A1); float* a16 = (float*)(p.ws + W_A16); float* bbar = (float*)(p.ws + W_BBAR);
        a1[(g * 64 + pp) * 2] = abr; a1[(g * 64 + pp) * 2 + 1] = abi; a16[(g * 64 + pp) * 2] = apr[16 * 64 + pp]; a16[(g * 64 + pp) * 2 + 1] = api[16 * 64 + pp];
        for (int c = 0; c < 16; ++c) { const float br = p.in[I_SBRE][(g * 64 + pp) * 16 + c], bi = p.in[I_SBIM][(g * 64 + pp) * 16 + c];
            const float xr = fre * br - fim * bi, xi = fre * bi + fim * br; bbr[pp * 16 + c] = xr; bbi[pp * 16 + c] = xi;
            bbar[((g * 64 + pp) * 16 + c) * 2] = xr; bbar[((g * 64 + pp) * 16 + c) * 2 + 1] = xi; }
    }
    for (int i = tid; i < 1024; i += 512) { cr[i] = p.in[I_SCRE][g * 1024 + i]; ci[i] = p.in[I_SCIM][g * 1024 + i]; }
    __syncthreads();
    { const int j = tid >> 5, c1 = (tid >> 1) & 15, c0 = 8 * (tid & 1); float acc8[8];
#pragma unroll
      for (int e = 0; e < 8; ++e) acc8[e] = 0.f;
      for (int pp = 0; pp < 64; ++pp) { const float xr = cr[c1 * 64 + pp], xi = ci[c1 * 64 + pp], ar = apr[j * 64 + pp], ai = api[j * 64 + pp]; const float car = xr * ar - xi * ai, cai = xr * ai + xi * ar;
          const f32x4 r0 = *(const LAS f32x4*)(bbr + pp * 16 + c0), r1 = *(const LAS f32x4*)(bbr + pp * 16 + c0 + 4), i0 = *(const LAS f32x4*)(bbi + pp * 16 + c0), i1 = *(const LAS f32x4*)(bbi + pp * 16 + c0 + 4);
          acc8[0] += car * r0[0] - cai * i0[0]; acc8[1] += car * r0[1] - cai * i0[1]; acc8[2] += car * r0[2] - cai * i0[2]; acc8[3] += car * r0[3] - cai * i0[3];
          acc8[4] += car * r1[0] - cai * i1[0]; acc8[5] += car * r1[1] - cai * i1[1]; acc8[6] += car * r1[2] - cai * i1[2]; acc8[7] += car * r1[3] - cai * i1[3]; }
#pragma unroll
      for (int e = 0; e < 8; ++e) { float v = acc8[e]; if (j == 0 && c1 == c0 + e) v += p.in[I_SD][g * 16 + c1]; Kl[(j * 16 + c1) * 16 + c0 + e] = v; } }
    __syncthreads();
    bf16_t* W1 = (bf16_t*)(p.ws + W_W1) + (size_t)g * 128 * 256; bf16_t* W2 = (bf16_t*)(p.ws + W_W2) + (size_t)g * 256 * 384;
    for (int i = tid; i < 128 * 32; i += 512) { const int n = i >> 5, ch = i & 31, s = ch >> 1, c0 = 8 * (ch & 1), pp = n & 63; const bool im = n >= 64; float v[8];
        const float ar = apr[(15 - s) * 64 + pp], ai = api[(15 - s) * 64 + pp];
#pragma unroll
        for (int e = 0; e < 8; ++e) { const float xr = bbr[pp * 16 + c0 + e], xi = bbi[pp * 16 + c0 + e]; v[e] = im ? (ar * xi + ai * xr) : (ar * xr - ai * xi); }
        u32x4 o; o.x = cvt_pk_bf16(v[0], v[1]); o.y = cvt_pk_bf16(v[2], v[3]); o.z = cvt_pk_bf16(v[4], v[5]); o.w = cvt_pk_bf16(v[6], v[7]);
        *(u32x4*)(W1 + (size_t)n * 256 + 8 * ch) = o; }
    for (int i = tid; i < 256 * 48; i += 512) { const int n = i / 48, ch = i - n * 48, t = n >> 4, c1 = n & 15; float v[8];
        if (ch < 32) { const int s = ch >> 1, c0 = 8 * (ch & 1);
#pragma unroll
            for (int e = 0; e < 8; ++e) v[e] = (s <= t) ? Kl[((t - s) * 16 + c1) * 16 + c0 + e] : 0.f; }
        else { const bool im = ch >= 40; const int p0 = 8 * (ch - (im ? 40 : 32));
#pragma unroll
            for (int e = 0; e < 8; ++e) { const int pp = p0 + e; const float ar = apr[(t + 1) * 64 + pp], ai = api[(t + 1) * 64 + pp], xr = cr[c1 * 64 + pp], xi = ci[c1 * 64 + pp];
                v[e] = im ? -(xr * ai + xi * ar) : (xr * ar - xi * ai); } }
        u32x4 o; o.x = cvt_pk_bf16(v[0], v[1]); o.y = cvt_pk_bf16(v[2], v[3]); o.z = cvt_pk_bf16(v[4], v[5]); o.w = cvt_pk_bf16(v[6], v[7]);
        *(u32x4*)(W2 + (size_t)n * 384 + 8 * ch) = o; }
    __syncthreads();
}
template <int CLS> __device__ __forceinline__ void transposes(const P& p, LAS float* scr, int lane, int gw, int NGW) {
    constexpr int I_UP = 16 * 192, I_DN = 48 * 32, I_IN = 16 * 112, I_GL = 8 * 64, I_OU = 16 * 32, I_LR = 16 * 8;
    constexpr int NITEMS = CLS == 0 ? I_IN + I_LR : I_UP + I_DN + I_GL + I_OU;
    for (int it = gw; it < NITEMS; it += NGW) { int r = it;
        if (CLS == 0) {
            if (r < I_IN) { const int kb = r / 112, nb = r % 112; transpose_item(p.in[I_WIN], DIN, (bf16_t*)(p.ws + W_WTIN), 1024, 64 * kb, 32 * nb, 32 * nb, scr, lane); continue; } r -= I_IN;
            { const int which = r >> 6, blk = (r >> 3) & 7, kb = (r >> 2) & 1, nb = r & 3;
              transpose_item(p.in[which ? I_WI : I_WR] + blk * 16384, 128, (bf16_t*)(p.ws + (which ? W_WTI : W_WTR)) + blk * 16384, 128, 64 * kb, 32 * nb, 32 * nb, scr, lane); }
        } else {
            if (r < I_UP) { const int kb = r / 192, nb = r % 192, d0 = 32 * nb, s0 = ((d0 >> 7) & 1) * DFF + (d0 >> 8) * 128 + (d0 & 127);
                transpose_item(p.in[I_WUP], 6144, (bf16_t*)(p.ws + W_WTUP), 1024, 64 * kb, s0, d0, scr, lane); continue; } r -= I_UP;
            if (r < I_DN) { const int kb = r / 32, nb = r % 32; transpose_item(p.in[I_WDOWN], 1024, (bf16_t*)(p.ws + W_WTDOWN), 3072, 64 * kb, 32 * nb, 32 * nb, scr, lane); continue; } r -= I_DN;
            if (r < I_GL) { const int kb = r / 64, nb = r % 64, d0 = 32 * nb, s0 = ((d0 >> 7) & 1) * 1024 + (d0 >> 8) * 128 + (d0 & 127);
                transpose_item(p.in[I_WGLU], 2048, (bf16_t*)(p.ws + W_WTGLU), 512, 64 * kb, s0, d0, scr, lane); continue; } r -= I_GL;
            { const int kb = r / 32, nb = r % 32; transpose_item(p.in[I_WOUT], 1024, (bf16_t*)(p.ws + W_WTOUT), 1024, 64 * kb, 32 * nb, 32 * nb, scr, lane); }
        }
    }
}
__device__ __forceinline__ void phase0(const P& p, LAS unsigned char* lds) {
    int tid_ = threadIdx.x; asm volatile("" : "+v"(tid_)); const int tid = tid_, lane = tid & 63, wid = tid >> 6;
    REPEAT(REP_P0A) for (int g = blockIdx.x; g < NG; g += gridDim.x) s5_precompute(p, lds, g);
    LAS float* scr = (LAS float*)(lds + wid * 8704);
    const int gw = blockIdx.x * 8 + wid, NGW = gridDim.x * 8;
    { const int skip = ((int)gridDim.x >= 64) ? NG : 0;
      if ((int)blockIdx.x >= skip) REPEAT(REP_P0B) transposes<0>(p, scr, lane, ((int)blockIdx.x - skip) * 8 + wid, ((int)gridDim.x - skip) * 8); }
    { const int skip = ((int)gridDim.x >= 64) ? NG : 0;
      if ((int)blockIdx.x >= skip) { const int gw2 = ((int)blockIdx.x - skip) * 8 + wid, NGW2 = ((int)gridDim.x - skip) * 8;
        REPEAT(REP_P0C) for (int r = gw2; r < MTOK; r += 2 * NGW2) { const int r2 = r + NGW2; const bool vb = r2 < MTOK; const int rb = vb ? r2 : r;
          ln_rows2<true>(src_row(p, r), src_row(p, rb), p.in[I_EG], p.in[I_EB], (bf16_t*)(p.ws + W_XN) + (size_t)r * DM, (bf16_t*)(p.ws + W_XN) + (size_t)rb * DM, lane, vb); } } }
}

template <int MODE> __device__ __forceinline__ void lru_unit(const P& p, LAS unsigned char* lds, int b, int kc, int nb) {
    int tid_ = threadIdx.x; asm volatile("" : "+v"(tid_)); const int tid = tid_, lane = tid & 63, wid = tid >> 6, q = lane >> 4, n = lane & 15;
    int mt0, nmt, rowbase;
    if (MODE == 2) { mt0 = kc; nmt = 1; rowbase = MP; } else { mt0 = (NCHUNK * kc) >> 3; nmt = ((NCHUNK * (kc + 1)) >> 3) - mt0; rowbase = b * TT; }
    const int t0 = 16 * mt0, ntok = 16 * nmt;
    const bf16_t* proj = (const bf16_t*)(p.ws + W_PROJ);
    LAS bf16_t* xcs = (LAS bf16_t*)lds;
    LAS bf16_t* gas = (LAS bf16_t*)(lds + 73984);
    if (MODE == 2) {
        for (int it = tid; it < ntok * 16; it += 512) { const int i = it >> 4, cg8 = it & 15, c0 = nb * 128 + cg8 * 8; float a[8];
            { const f32x4 b0 = *(const f32x4*)(p.in[I_CLB] + c0), b1 = *(const f32x4*)(p.in[I_CLB] + c0 + 4); a[0] = b0[0]; a[1] = b0[1]; a[2] = b0[2]; a[3] = b0[3]; a[4] = b1[0]; a[5] = b1[1]; a[6] = b1[2]; a[7] = b1[3]; }
#pragma unroll
            for (int j = 0; j < 4; ++j) { const f32x4 w0 = *(const f32x4*)(p.in[I_CLW] + j * 1024 + c0), w1 = *(const f32x4*)(p.in[I_CLW] + j * 1024 + c0 + 4); float x[8];
                if (j < 3) { const float* cp = p.in[I_CCL] + ((size_t)(t0 + i) * 3 + j) * 1024 + c0; const f32x4 x0 = *(const f32x4*)cp, x1 = *(const f32x4*)(cp + 4);
                    x[0] = x0[0]; x[1] = x0[1]; x[2] = x0[2]; x[3] = x0[3]; x[4] = x1[0]; x[5] = x1[1]; x[6] = x1[2]; x[7] = x1[3]; }
                else { const u32x4 xv = *(const u32x4*)(proj + (size_t)(rowbase + t0 + i) * DIN + c0);
                    x[0] = bflo(xv.x); x[1] = bfhi(xv.x); x[2] = bflo(xv.y); x[3] = bfhi(xv.y); x[4] = bflo(xv.z); x[5] = bfhi(xv.z); x[6] = bflo(xv.w); x[7] = bfhi(xv.w); }
                a[0] += w0[0] * x[0]; a[1] += w0[1] * x[1]; a[2] += w0[2] * x[2]; a[3] += w0[3] * x[3]; a[4] += w1[0] * x[4]; a[5] += w1[1] * x[5]; a[6] += w1[2] * x[6]; a[7] += w1[3] * x[7]; }
            u32x4 o; o.x = cvt_pk_bf16(a[0], a[1]); o.y = cvt_pk_bf16(a[2], a[3]); o.z = cvt_pk_bf16(a[4], a[5]); o.w = cvt_pk_bf16(a[6], a[7]);
            *(LAS u32x4*)(xcs + i * 136 + cg8 * 8) = o;
            *(LAS u32x4*)(gas + i * 128 + cg8 * 8) = *(const u32x4*)(proj + (size_t)(rowbase + t0 + i) * DIN + C_GA + c0); }
    } else {
        const int cg8 = tid & 15, tr = tid >> 4, c0 = nb * 128 + cg8 * 8; float w[4][8], bs[8];
        { const f32x4 b0 = *(const f32x4*)(p.in[I_CLB] + c0), b1 = *(const f32x4*)(p.in[I_CLB] + c0 + 4); bs[0] = b0[0]; bs[1] = b0[1]; bs[2] = b0[2]; bs[3] = b0[3]; bs[4] = b1[0]; bs[5] = b1[1]; bs[6] = b1[2]; bs[7] = b1[3]; }
#pragma unroll
        for (int j = 0; j < 4; ++j) { const f32x4 w0 = *(const f32x4*)(p.in[I_CLW] + j * 1024 + c0), w1 = *(const f32x4*)(p.in[I_CLW] + j * 1024 + c0 + 4);
            w[j][0] = w0[0]; w[j][1] = w0[1]; w[j][2] = w0[2]; w[j][3] = w0[3]; w[j][4] = w1[0]; w[j][5] = w1[1]; w[j][6] = w1[2]; w[j][7] = w1[3]; }
        const int i0 = tr * 9; int i1 = i0 + 9; if (i1 > ntok) i1 = ntok;
        u32x4 xr[12], gr[9];
#pragma unroll
        for (int k = 0; k < 12; ++k) { const int i = i0 - 3 + k, t = t0 + i; xr[k] = (u32x4){0u, 0u, 0u, 0u}; if (t >= 0 && i < i1) xr[k] = *(const u32x4*)(proj + (size_t)(rowbase + t) * DIN + c0); }
#pragma unroll
        for (int k = 0; k < 9; ++k) { gr[k] = (u32x4){0u, 0u, 0u, 0u}; if (i0 + k < i1) gr[k] = *(const u32x4*)(proj + (size_t)(rowbase + t0 + i0 + k) * DIN + C_GA + c0); }
#pragma unroll
        for (int k = 0; k < 9; ++k) { if (i0 + k < i1) { float a[8];
#pragma unroll
            for (int e = 0; e < 8; ++e) a[e] = bs[e];
#pragma unroll
            for (int j = 0; j < 4; ++j) { const u32x4 xv = xr[k + j];
                a[0] += w[j][0] * bflo(xv.x); a[1] += w[j][1] * bfhi(xv.x); a[2] += w[j][2] * bflo(xv.y); a[3] += w[j][3] * bfhi(xv.y);
                a[4] += w[j][4] * bflo(xv.z); a[5] += w[j][5] * bfhi(xv.z); a[6] += w[j][6] * bflo(xv.w); a[7] += w[j][7] * bfhi(xv.w); }
            u32x4 o; o.x = cvt_pk_bf16(a[0], a[1]); o.y = cvt_pk_bf16(a[2], a[3]); o.z = cvt_pk_bf16(a[4], a[5]); o.w = cvt_pk_bf16(a[6], a[7]);
            *(LAS u32x4*)(xcs + (i0 + k) * 136 + cg8 * 8) = o; *(LAS u32x4*)(gas + (i0 + k) * 128 + cg8 * 8) = gr[k]; } }
    }
    __syncthreads();
    const int c = nb * 128 + wid * 16 + n;
    bf16x8 Br[4], Bi[4];
    { const bf16_t* wr_ = (const bf16_t*)(p.ws + W_WTR) + (size_t)c * 128 + q * 8; const bf16_t* wi_ = (const bf16_t*)(p.ws + W_WTI) + (size_t)c * 128 + q * 8;
#pragma unroll
      for (int kk = 0; kk < 4; ++kk) { Br[kk] = *(const bf16x8*)(wr_ + 32 * kk); Bi[kk] = *(const bf16x8*)(wi_ + 32 * kk); } }
    const float br = p.in[I_BR][c], bi = p.in[I_BI][c]; const float c8 = -8.0f * log1pf(expf(-p.in[I_LAM][c]));
    bf16_t* M1 = (bf16_t*)(p.ws + W_MIX); bf16_t* M2 = (bf16_t*)(p.out + O_YP);
    float h_run = 0.f, A_run = 1.f;
    for (int mt = 0; mt < nmt; ++mt) {
        f32x4 accr = {0.f, 0.f, 0.f, 0.f}, acci = {0.f, 0.f, 0.f, 0.f};
#pragma unroll
        for (int kk = 0; kk < 4; ++kk) { const bf16x8 Af = *(const LAS bf16x8*)(xcs + (16 * mt + n) * 136 + 32 * kk + 8 * q);
            accr = __builtin_amdgcn_mfma_f32_16x16x32_bf16(Af, Br[kk], accr, 0, 0, 0); acci = __builtin_amdgcn_mfma_f32_16x16x32_bf16(Af, Bi[kk], acci, 0, 0, 0); }
        float a[4], bx[4], ga[4];
#pragma unroll
        for (int j = 0; j < 4; ++j) { const int tok = 16 * mt + 4 * q + j; const float xcv = bf2f(xcs[tok * 136 + wid * 16 + n]);
            ga[j] = bf2f(gas[tok * 128 + wid * 16 + n]);
            const float r = sigm(accr[j] + br), ig = sigm(acci[j] + bi), la = c8 * r; a[j] = __expf(la); bx[j] = __builtin_amdgcn_sqrtf(fmaf(-a[j], a[j], 1.0f)) * (ig * xcv); }
        float h[4], Ac[4];
        if (MODE == 2) {
#pragma unroll
            for (int j = 0; j < 4; ++j) { const int s = t0 + 16 * mt + 4 * q + j; h[j] = a[j] * p.in[I_SL][(size_t)s * 1024 + c] + bx[j]; p.out[O_SL + (size_t)s * 1024 + c] = h[j]; Ac[j] = 0.f; }
        } else {
            float Ap[4]; h[0] = bx[0]; Ap[0] = a[0];
#pragma unroll
            for (int j = 1; j < 4; ++j) { h[j] = a[j] * h[j - 1] + bx[j]; Ap[j] = a[j] * Ap[j - 1]; }
            float PA = Ap[3], PH = h[3];
            float tA = __shfl_up(PA, 16), tH = __shfl_up(PH, 16); if (q >= 1) { PH = PA * tH + PH; PA = PA * tA; }
            tA = __shfl_up(PA, 32); tH = __shfl_up(PH, 32); if (q >= 2) { PH = PA * tH + PH; PA = PA * tA; }
            const float h_end = PA * h_run + PH; const float hin_s = __shfl_up(h_end, 16), pae_s = __shfl_up(PA, 16);
            const float h_in = (q == 0) ? h_run : hin_s; const float a_in = A_run * ((q == 0) ? 1.0f : pae_s);
#pragma unroll
            for (int j = 0; j < 4; ++j) { h[j] += Ap[j] * h_in; Ac[j] = Ap[j] * a_in; }
            h_run = __shfl(h_end, 48 + n); A_run *= __shfl(PA, 48 + n);
        }
#pragma unroll
        for (int j = 0; j < 4; ++j) { const size_t row = (size_t)(rowbase + t0 + 16 * mt + 4 * q + j); const float sg = sigm(ga[j]);
            M1[row * 1024 + c] = f2bf(sg * h[j]); M2[row * 1024 + c] = f2bf(sg * Ac[j]); }
    }
    if (MODE == 0 && q == 0) { ((float*)(p.ws + W_LRUA))[(size_t)(b * 8 + kc) * 1024 + c] = A_run; ((float*)(p.ws + W_LRUH))[(size_t)(b * 8 + kc) * 1024 + c] = h_run; }
    __syncthreads();
}

template <int PASS> __device__ __forceinline__ void s5_item(const P& p, int g, int sub, int lane, int wid) {
    constexpr int KS = (PASS == 1) ? 8 : 12, NTW = (PASS == 1) ? 1 : 2, LDW = (PASS == 1) ? 256 : 384;
    const int n = lane & 15, q = lane >> 4;
    const bf16_t* proj = (const bf16_t*)(p.ws + W_PROJ);
    const bf16_t* W = (PASS == 1) ? (const bf16_t*)(p.ws + W_W1) + (size_t)g * 128 * 256 : (const bf16_t*)(p.ws + W_W2) + (size_t)g * 256 * 384;
    bf16x8 Bf[NTW][KS];
#pragma unroll
    for (int i = 0; i < NTW; ++i)
#pragma unroll
        for (int kk = 0; kk < KS; ++kk) Bf[i][kk] = *(const bf16x8*)(W + (size_t)(16 * (NTW * wid + i) + n) * LDW + 32 * kk + 8 * q);
    const int rt0 = (65 * sub) >> 3, rt1 = (65 * (sub + 1)) >> 3; const bf16x8 zero = {0, 0, 0, 0, 0, 0, 0, 0};
    for (int rt = rt0; rt < rt1; ++rt) {
        const int R = 16 * rt + n; const bool valid = R < NR; const int Rc = valid ? R : 0; const int b = Rc / NCHUNK, k = Rc - b * NCHUNK;
        bf16x8 Af[KS];
        { const bf16_t* ub = proj + (size_t)(b * TT + 16 * k) * DIN + C_US + 16 * g + 8 * (q & 1);
#pragma unroll
          for (int kk = 0; kk < 8; ++kk) { const int s = 2 * kk + (q >> 1); Af[kk] = valid ? *(const bf16x8*)(ub + (size_t)s * DIN) : zero; } }
        if (PASS == 3) { const bf16_t* hb = (const bf16_t*)(p.ws + W_HPREV) + ((size_t)Rc * NG + g) * 128 + 8 * q;
#pragma unroll
          for (int kk = 8; kk < KS; ++kk) Af[kk] = valid ? *(const bf16x8*)(hb + 32 * (kk - 8)) : zero; }
        f32x4 acc[NTW];
#pragma unroll
        for (int i = 0; i < NTW; ++i) { acc[i] = (f32x4){0.f, 0.f, 0.f, 0.f};
#pragma unroll
            for (int kk = 0; kk < KS; ++kk) acc[i] = __builtin_amdgcn_mfma_f32_16x16x32_bf16(Af[kk], Bf[i][kk], acc[i], 0, 0, 0); }
#pragma unroll
        for (int j = 0; j < 4; ++j) { const int R2 = 16 * rt + 4 * q + j; if (R2 < NR) {
            if (PASS == 1) { ((float*)(p.ws + W_S))[((size_t)R2 * NG + g) * 128 + 16 * wid + n] = acc[0][j]; }
            else { const int b2 = R2 / NCHUNK, k2 = R2 - b2 * NCHUNK; bf16_t* Y = (bf16_t*)(p.ws + W_YSG) + (size_t)(b2 * TT + 16 * k2) * DSSM + 16 * g + n;
#pragma unroll
                for (int i = 0; i < NTW; ++i) Y[(size_t)(NTW * wid + i) * DSSM] = f2bf(gelu_tanh(acc[i][j])); } } }
    }
}
__device__ __forceinline__ void s5_fused(const P& p, LAS unsigned char* lds, int g, int b) {
    int tid_ = threadIdx.x; asm volatile("" : "+v"(tid_)); const int tid = tid_, lane = tid & 63, wid = tid >> 6, n = lane & 15, q = lane >> 4;
    LAS bf16_t* Us = (LAS bf16_t*)lds;
    LAS float* Ssm = (LAS float*)(lds + 68112);
    LAS bf16_t* Hs = (LAS bf16_t*)(lds + 68112);
    const bf16_t* proj = (const bf16_t*)(p.ws + W_PROJ); const bf16x8 zero = {0, 0, 0, 0, 0, 0, 0, 0};
    TIMED(231) { const bf16_t* ub = proj + (size_t)(b * TT) * DIN + C_US + 16 * g;
      u32x4 tv[9];
#pragma unroll
      for (int i = 0; i < 9; ++i) { const int it = tid + 512 * i; tv[i] = (u32x4){0u, 0u, 0u, 0u}; if (it < TT * 2) tv[i] = *(const u32x4*)(ub + (size_t)(it >> 1) * DIN + 8 * (it & 1)); }
#pragma unroll
      for (int i = 0; i < 9; ++i) { const int it = tid + 512 * i; if (it < TT * 2) { const int t = it >> 1; *(LAS u32x4*)(Us + (t >> 4) * 264 + (t & 15) * 16 + 8 * (it & 1)) = tv[i]; } } }
    __syncthreads();
    TIMED_END(231)
    TIMED(232) { const bf16_t* W = (const bf16_t*)(p.ws + W_W1) + (size_t)g * 128 * 256; bf16x8 Bf[8];
#pragma unroll
      for (int kk = 0; kk < 8; ++kk) Bf[kk] = *(const bf16x8*)(W + (size_t)(16 * wid + n) * 256 + 32 * kk + 8 * q);
#pragma unroll 1
      for (int rt = 0; rt < 9; ++rt) { const int k = 16 * rt + n; const bool valid = k < NCHUNK; const int kc = valid ? k : 0; f32x4 acc = {0.f, 0.f, 0.f, 0.f};
#pragma unroll
          for (int kk = 0; kk < 8; ++kk) { const bf16x8 uv = *(const LAS bf16x8*)(Us + kc * 264 + 32 * kk + 8 * q); const bf16x8 Af = valid ? uv : zero;
              acc = __builtin_amdgcn_mfma_f32_16x16x32_bf16(Af, Bf[kk], acc, 0, 0, 0); }
#pragma unroll
          for (int j = 0; j < 4; ++j) Ssm[(16 * rt + 4 * q + j) * 128 + 16 * wid + n] = acc[j]; } }
    __syncthreads();
    TIMED_END(232)
    bf16x8 Bw[2][12];
    { const bf16_t* W = (const bf16_t*)(p.ws + W_W2) + (size_t)g * 256 * 384;
#pragma unroll
      for (int i = 0; i < 2; ++i)
#pragma unroll
          for (int kk = 0; kk < 12; ++kk) Bw[i][kk] = *(const bf16x8*)(W + (size_t)(16 * (2 * wid + i) + n) * 384 + 32 * kk + 8 * q); }
    TIMED(233) if (wid == 0) { const float* a16 = (const float*)(p.ws + W_A16) + (g * 64 + lane) * 2; const float ar = a16[0], ai = a16[1]; float hr = 0.f, hi = 0.f;
#pragma unroll 1
        for (int kb = 0; kb < 132; kb += 4) { float sr[4], si[4];
#pragma unroll
            for (int u = 0; u < 4; ++u) { sr[u] = Ssm[(kb + u) * 128 + lane]; si[u] = Ssm[(kb + u) * 128 + 64 + lane]; }
            LDS_WAIT();
#pragma unroll
            for (int u = 0; u < 4; ++u) { const int k = kb + u; if (k < NCHUNK) { Hs[k * 136 + lane] = f2bf(hr); Hs[k * 136 + 64 + lane] = f2bf(hi);
                const float nr = ar * hr - ai * hi + sr[u], ni = ar * hi + ai * hr + si[u]; hr = nr; hi = ni; } } }
        p.out[O_PSR + ((size_t)b * NG + g) * 64 + lane] = hr; p.out[O_PSI + ((size_t)b * NG + g) * 64 + lane] = hi; }
    __syncthreads();
    TIMED_END(233)
    TIMED(234)
    {
#pragma unroll 1
      for (int rt = 0; rt < 9; ++rt) { const int k = 16 * rt + n; const bool valid = k < NCHUNK; const int kc = valid ? k : 0; f32x4 acc0 = {0.f, 0.f, 0.f, 0.f}, acc1 = {0.f, 0.f, 0.f, 0.f};
#pragma unroll
          for (int kk = 0; kk < 8; ++kk) { const bf16x8 uv = *(const LAS bf16x8*)(Us + kc * 264 + 32 * kk + 8 * q); const bf16x8 af = valid ? uv : zero;
              acc0 = __builtin_amdgcn_mfma_f32_16x16x32_bf16(af, Bw[0][kk], acc0, 0, 0, 0); acc1 = __builtin_amdgcn_mfma_f32_16x16x32_bf16(af, Bw[1][kk], acc1, 0, 0, 0); }
#pragma unroll
          for (int kk = 8; kk < 12; ++kk) { const bf16x8 hv = *(const LAS bf16x8*)(Hs + kc * 136 + 32 * (kk - 8) + 8 * q); const bf16x8 af = valid ? hv : zero;
              acc0 = __builtin_amdgcn_mfma_f32_16x16x32_bf16(af, Bw[0][kk], acc0, 0, 0, 0); acc1 = __builtin_amdgcn_mfma_f32_16x16x32_bf16(af, Bw[1][kk], acc1, 0, 0, 0); }
#pragma unroll
          for (int j = 0; j < 4; ++j) { const int k2 = 16 * rt + 4 * q + j; if (k2 < NCHUNK) { bf16_t* Y = (bf16_t*)(p.ws + W_YSG) + (size_t)(b * TT + 16 * k2 + 2 * wid) * DSSM + 16 * g + n;
              Y[0] = f2bf(gelu_tanh(acc0[j])); Y[DSSM] = f2bf(gelu_tanh(acc1[j])); } } } }
    TIMED_END(234)
}
__device__ __forceinline__ void s5_sample(const P& p, int s, int g, int lane) {
    const bf16_t* proj = (const bf16_t*)(p.ws + W_PROJ); const bf16_t* up = proj + (size_t)(MP + s) * DIN + C_US + 16 * g;
    const u32x4 u0 = *(const u32x4*)up, u1 = *(const u32x4*)(up + 8); float u[16];
    u[0] = bflo(u0.x); u[1] = bfhi(u0.x); u[2] = bflo(u0.y); u[3] = bfhi(u0.y); u[4] = bflo(u0.z); u[5] = bfhi(u0.z); u[6] = bflo(u0.w); u[7] = bfhi(u0.w);
    u[8] = bflo(u1.x); u[9] = bfhi(u1.x); u[10] = bflo(u1.y); u[11] = bfhi(u1.y); u[12] = bflo(u1.z); u[13] = bfhi(u1.z); u[14] = bflo(u1.w); u[15] = bfhi(u1.w);
    const float* a1 = (const float*)(p.ws + W_A1) + (g * 64 + lane) * 2; const float ar = a1[0], ai = a1[1];
    const float* bb = (const float*)(p.ws + W_BBAR) + (size_t)(g * 64 + lane) * 32; float bur = 0.f, bui = 0.f;
#pragma unroll
    for (int c = 0; c < 16; ++c) { bur += bb[2 * c] * u[c]; bui += bb[2 * c + 1] * u[c]; }
    const size_t si = ((size_t)s * NG + g) * 64 + lane; const float h0r = p.in[I_SSR][si], h0i = p.in[I_SSI][si];
    const float hr = ar * h0r - ai * h0i + bur, hi = ar * h0i + ai * h0r + bui;
    p.out[O_SSR + si] = hr; p.out[O_SSI + si] = hi;
    float v16[16];
#pragma unroll
    for (int c1 = 0; c1 < 16; ++c1) v16[c1] = p.in[I_SCRE][(g * 16 + c1) * 64 + lane] * hr - p.in[I_SCIM][(g * 16 + c1) * 64 + lane] * hi;
    float v8[8], v4[4], v2[2], v1;
    { const bool hi32 = (lane & 32) != 0;
#pragma unroll
      for (int i = 0; i < 8; ++i) { const float keep = hi32 ? v16[i + 8] : v16[i], send = hi32 ? v16[i] : v16[i + 8]; v8[i] = keep + __shfl_xor(send, 32); } }
    { const bool hb = (lane & 16) != 0;
#pragma unroll
      for (int i = 0; i < 4; ++i) { const float keep = hb ? v8[i + 4] : v8[i], send = hb ? v8[i] : v8[i + 4]; v4[i] = keep + __shfl_xor(send, 16); } }
    { const bool hb = (lane & 8) != 0;
#pragma unroll
      for (int i = 0; i < 2; ++i) { const float keep = hb ? v4[i + 2] : v4[i], send = hb ? v4[i] : v4[i + 2]; v2[i] = keep + __shfl_xor(send, 8); } }
    { const bool hb = (lane & 4) != 0; const float keep = hb ? v2[1] : v2[0], send = hb ? v2[0] : v2[1]; v1 = keep + __shfl_xor(send, 4); }
    v1 += __shfl_xor(v1, 1); v1 += __shfl_xor(v1, 2);
    const int c1 = ((lane >> 5) & 1) * 8 + ((lane >> 4) & 1) * 4 + ((lane >> 3) & 1) * 2 + ((lane >> 2) & 1);
    if ((lane & 3) == 0) { const float uc = bf2f(up[c1]); const float yv = v1 + p.in[I_SD][g * 16 + c1] * uc;
        ((bf16_t*)(p.ws + W_YSG))[(size_t)(MP + s) * DSSM + 16 * g + c1] = f2bf(gelu_tanh(yv)); }
}
__device__ __forceinline__ void phase2a(const P& p, LAS unsigned char* lds) {
    TIMED(22) for (int u = blockIdx.x; u < 512; u += gridDim.x) lru_unit<0>(p, lds, (u >> 3) & 7, u >> 6, u & 7); TIMED_END(22)
    TIMED(23) for (int it = blockIdx.x; it < NG * NBATCH; it += gridDim.x) s5_fused(p, lds, it & 31, it >> 5); TIMED_END(23)
}
__device__ __forceinline__ void phase2b(const P& p, LAS unsigned char* lds) {
    int tid_ = threadIdx.x; asm volatile("" : "+v"(tid_)); const int tid = tid_, lane = tid & 63, wid = tid >> 6;
    const size_t gt = (size_t)blockIdx.x * 512 + tid, GT = (size_t)gridDim.x * 512;
    for (size_t i = gt; i < (size_t)NBATCH * 1024; i += GT) { const int b = (int)(i >> 10), c = (int)(i & 1023); float h = 0.f;
        const float* A = (const float*)(p.ws + W_LRUA); const float* Hh = (const float*)(p.ws + W_LRUH); float* Cc = (float*)(p.ws + W_LRUC);
        for (int kc = 0; kc < 8; ++kc) { const size_t o = (size_t)(b * 8 + kc) * 1024 + c; Cc[o] = h; h = A[o] * h + Hh[o]; }
        p.out[O_PL + i] = h; }
    for (int u = (int)gridDim.x - 1 - (int)blockIdx.x; u < 64; u += gridDim.x) lru_unit<2>(p, lds, 0, u >> 3, u & 7);
    for (int it = blockIdx.x * 8 + wid; it < NSAMP * NG; it += gridDim.x * 8) s5_sample(p, it >> 5, it & 31, lane);
    const bf16_t* proj = (const bf16_t*)(p.ws + W_PROJ);
    for (size_t i = gt; i < (size_t)NBATCH * 3 * 1024; i += GT) { const int c = (int)(i & 1023), j = (int)((i >> 10) % 3), b = (int)(i / 3072);
        p.out[O_PCL + i] = bf2f(proj[(size_t)(b * TT + TT - 3 + j) * DIN + c]); }
    for (size_t i = gt; i < (size_t)NSAMP * 3 * 1024; i += GT) { const int c = (int)(i & 1023), j = (int)((i >> 10) % 3), s = (int)(i / 3072);
        p.out[O_SCL + i] = (j < 2) ? p.in[I_CCL][((size_t)s * 3 + j + 1) * 1024 + c] : bf2f(proj[(size_t)(MP + s) * DIN + c]); }
    for (size_t i = gt; i < (size_t)NSAMP * DFF; i += GT) { const int ch = (int)(i % DFF), s = (int)(i / DFF);
        p.out[O_SCF + ((size_t)s * 2) * DFF + ch] = p.in[I_CCF][((size_t)s * 2 + 1) * DFF + ch]; }
}
__device__ __forceinline__ void phase2c(const P& p, LAS unsigned char* lds) {
    const int lane = threadIdx.x & 63, wid = threadIdx.x >> 6;
    for (int it = blockIdx.x; it < NG * 8; it += gridDim.x) s5_item<3>(p, it >> 3, it & 7, lane, wid);
}
__device__ __forceinline__ void phase_ln1(const P& p) {
    const int lane = threadIdx.x & 63, wid = threadIdx.x >> 6; const int gw = blockIdx.x * 8 + wid, NGW = gridDim.x * 8;
    const bf16_t* R = (const bf16_t*)(p.ws + W_R1); bf16_t* X = (bf16_t*)(p.ws + W_XN);
    for (int r = gw; r < 16384; r += 2 * NGW) { const int r2 = r + NGW; const bool vb = r2 < 16384; const int rb = vb ? r2 : r;
        ln_rows2_bf<true>(R + (size_t)r * DM, R + (size_t)rb * DM, p.in[I_L1G], p.in[I_L1B], X + (size_t)r * DM, X + (size_t)rb * DM, lane, vb); }
    for (int r = 16384 + gw; r < MTOK; r += NGW) { bf16_t* xr = X + (size_t)r * DM;
        ln_row<true>((const float*)(p.ws + W_PART) + (size_t)(r - 16384) * DM, p.in[I_L1G], p.in[I_L1B], xr, lane, 4, xr, p.in[I_BOUT]); }
}
__device__ __forceinline__ void phase_ffnfix(const P& p) {
    const size_t gt = (size_t)blockIdx.x * 512 + threadIdx.x, GT = (size_t)gridDim.x * 512;
    const float* sbg = (const float*)(p.ws + W_SBG); const float* sbv = (const float*)(p.ws + W_SBV); bf16_t* H = (bf16_t*)(p.ws + W_V);
    for (size_t it = gt; it < (size_t)256 * 2 * 384; it += GT) { const int cg8 = (int)(it % 384), rr = (int)((it / 384) & 1), blk = (int)(it / 768), ch = cg8 * 8, row = blk * 64 + rr; const int t = row % TT;
        float o[8];
#pragma unroll
        for (int hh = 0; hh < 2; ++hh) { const int c = ch + 4 * hh; const f32x4 z = {0.f, 0.f, 0.f, 0.f};
            const f32x4 g0 = *(const f32x4*)(sbg + ((size_t)blk * 4 + rr) * DFF + c), v = *(const f32x4*)(sbv + ((size_t)blk * 2 + rr) * DFF + c);
            f32x4 g1, g2;
            if (rr == 0) { g1 = (blk > 0 && t >= 1) ? *(const f32x4*)(sbg + ((size_t)(blk - 1) * 4 + 3) * DFF + c) : z; g2 = (blk > 0 && t >= 2) ? *(const f32x4*)(sbg + ((size_t)(blk - 1) * 4 + 2) * DFF + c) : z; }
            else { g1 = (t >= 1) ? *(const f32x4*)(sbg + ((size_t)blk * 4) * DFF + c) : z; g2 = (blk > 0 && t >= 2) ? *(const f32x4*)(sbg + ((size_t)(blk - 1) * 4 + 3) * DFF + c) : z; }
            const f32x4 w0 = *(const f32x4*)(p.in[I_FCW] + c), w1 = *(const f32x4*)(p.in[I_FCW] + DFF + c), w2 = *(const f32x4*)(p.in[I_FCW] + 2 * DFF + c), cbv = *(const f32x4*)(p.in[I_FCB] + c);
            const f32x4 y = cbv + w0 * g2 + w1 * g1 + w2 * g0;
            o[4 * hh] = gelu_tanh(y[0]) * v[0]; o[4 * hh + 1] = gelu_tanh(y[1]) * v[1]; o[4 * hh + 2] = gelu_tanh(y[2]) * v[2]; o[4 * hh + 3] = gelu_tanh(y[3]) * v[3]; }
        u32x4 w; w.x = cvt_pk_bf16(o[0], o[1]); w.y = cvt_pk_bf16(o[2], o[3]); w.z = cvt_pk_bf16(o[4], o[5]); w.w = cvt_pk_bf16(o[6], o[7]);
        *(u32x4*)(H + (size_t)row * DFF + ch) = w; }
}
__device__ __forceinline__ f32x4 up_tail_sum(const float* pu, const float* bias, int rl, int col, int bcol) {
    f32x4 v = *(const f32x4*)(bias + bcol);
#pragma unroll
    for (int ks = 0; ks < 4; ++ks) v += *(const f32x4*)(pu + (size_t)ks * 256 * 6144 + (size_t)rl * 6144 + col);
    return v;
}
__device__ __forceinline__ void phase_ffntail(const P& p) {
    const size_t gt = (size_t)blockIdx.x * 512 + threadIdx.x, GT = (size_t)gridDim.x * 512;
    const float* pu = (const float*)(p.ws + W_PU); const float* sbg = (const float*)(p.ws + W_SBG); bf16_t* H = (bf16_t*)(p.ws + W_V); const float* bias = p.in[I_BUP];
    for (size_t it = gt; it < (size_t)256 * 768; it += GT) { const int rl = (int)(it / 768), ch = (int)(it - (size_t)rl * 768) * 4, row = 16384 + rl; const int colg = 256 * (ch >> 7) + (ch & 127);
        const f32x4 g0 = up_tail_sum(pu, bias, rl, colg, ch), v = up_tail_sum(pu, bias, rl, colg + 128, DFF + ch); f32x4 g1, g2;
        if (row >= MP) { const int s_ = row - MP; g2 = *(const f32x4*)(p.in[I_CCF] + ((size_t)s_ * 2) * DFF + ch); g1 = *(const f32x4*)(p.in[I_CCF] + ((size_t)s_ * 2 + 1) * DFF + ch);
            *(f32x4*)(p.out + O_SCF + ((size_t)s_ * 2 + 1) * DFF + ch) = g0; }
        else {
            g1 = (rl >= 1) ? up_tail_sum(pu, bias, rl - 1, colg, ch) : *(const f32x4*)(sbg + ((size_t)255 * 4 + 3) * DFF + ch);
            g2 = (rl >= 2) ? up_tail_sum(pu, bias, rl - 2, colg, ch) : *(const f32x4*)(sbg + ((size_t)255 * 4 + 2 + rl) * DFF + ch);
            const int t = row - 7 * TT; if (t >= TT - 2) *(f32x4*)(p.out + O_PCF + ((size_t)7 * 2 + (t - (TT - 2))) * DFF + ch) = g0; }
        const f32x4 w0 = *(const f32x4*)(p.in[I_FCW] + ch), w1 = *(const f32x4*)(p.in[I_FCW] + DFF + ch), w2 = *(const f32x4*)(p.in[I_FCW] + 2 * DFF + ch), cbv = *(const f32x4*)(p.in[I_FCB] + ch);
        const f32x4 y = cbv + w0 * g2 + w1 * g1 + w2 * g0;
        u32x2 w; w.x = cvt_pk_bf16(gelu_tanh(y[0]) * v[0], gelu_tanh(y[1]) * v[1]); w.y = cvt_pk_bf16(gelu_tanh(y[2]) * v[2], gelu_tanh(y[3]) * v[3]);
        *(u32x2*)(H + (size_t)row * DFF + ch) = w; }
}
__device__ __forceinline__ float* y_row(const P& p, int r) {
    if (r >= MP) return p.out + O_YS + (size_t)(r - MP) * DM;
    const int b = r / TT, t = r - b * TT; return t < 16 ? nullptr : p.out + O_YP + ((size_t)b * 2048 + (t - 16)) * DM;
}
__device__ __forceinline__ void phase_ln2(const P& p) {
    const int lane = threadIdx.x & 63, wid = threadIdx.x >> 6; const int gw = blockIdx.x * 8 + wid, NGW = gridDim.x * 8;
    const bf16_t* R = (const bf16_t*)(p.ws + W_R2);
    for (int r = gw; r < 16384; r += 2 * NGW) { const int r2 = r + NGW; float* oa = y_row(p, r); float* ob = (r2 < 16384) ? y_row(p, r2) : nullptr;
        if (oa && ob) ln_rows2_bf<false>(R + (size_t)r * DM, R + (size_t)r2 * DM, p.in[I_L2G], p.in[I_L2B], oa, ob, lane, true);
        else if (oa) ln_rows2_bf<false>(R + (size_t)r * DM, R + (size_t)r * DM, p.in[I_L2G], p.in[I_L2B], oa, oa, lane, false);
        else if (ob) ln_rows2_bf<false>(R + (size_t)r2 * DM, R + (size_t)r2 * DM, p.in[I_L2G], p.in[I_L2B], ob, ob, lane, false); }
    for (int r = 16384 + gw; r < MTOK; r += NGW) { float* o = y_row(p, r);
        if (o) ln_row<false>((const float*)(p.ws + W_PART) + (size_t)(r - 16384) * DM, p.in[I_L2G], p.in[I_L2B], o, lane, 12, (const bf16_t*)(p.ws + W_XN) + (size_t)r * DM, p.in[I_BDOWN]); }
}

__global__ __launch_bounds__(512, 2) void hawk_fwd(P p) {
    extern __shared__ __attribute__((aligned(16))) unsigned char shm[];
    LAS unsigned char* lds = (LAS unsigned char*)shm;
    cg::grid_group grid = cg::this_grid();
    volatile LAS unsigned* xst = (volatile LAS unsigned*)(lds + LDS_TOTAL - 16);
    if (threadIdx.x < 4) xst[threadIdx.x] = 0u;
    __syncthreads();
    XcdBarrier xb = xcd_barrier_post((unsigned*)(p.ws + W_BAR), xst);
    if (threadIdx.x == 0) xst[2] = xb_add((unsigned*)(p.ws + W_BAR) + XCD_BAR_WORDS + 64 * xb.x, 1u);
#define GSYNC() xcd_barrier(xb)
    if (p.ws == nullptr) grid.sync();
    TIMED(0) REPEAT(REP_P0) { phase0(p, lds); GSYNC(); } TIMED_END(0)
    if (threadIdx.x == 0) { unsigned* bar = (unsigned*)(p.ws + W_BAR); bool ok = (gridDim.x % 8u) == 0u;
        for (unsigned j = 0; j < 16; ++j) { const unsigned cnt = xb_ld(&bar[XB_XCNT(j)]); if (cnt != (j < 8 ? gridDim.x / 8u : 0u)) ok = false; }
        xst[3] = ok ? (xst[2] * 8u + xb.x) : blockIdx.x; }
    __syncthreads();
    const int vc = (int)xst[3];
    TIMED(1) REPEAT(REP_P1) { EpiProj E; E.O = (bf16_t*)(p.ws + W_PROJ); E.bias = p.in[I_BIN]; run_gemm(lds, vc, (const bf16_t*)(p.ws + W_XN), (const bf16_t*)(p.ws + W_WTIN), DIN, 1024, E);
        { const int G = (int)gridDim.x, nun = (MTOK / 256) * (DIN / 256), rem = nun % G; const int c = vc;
          if (c >= rem) transposes<1>(p, (LAS float*)(lds + (threadIdx.x >> 6) * 8704), threadIdx.x & 63, (c - rem) * 8 + (int)(threadIdx.x >> 6), (G - rem) * 8); }
        GSYNC(); } TIMED_END(1)
    TIMED(20) REPEAT(REP_P2A) { phase2a(p, lds); GSYNC(); } TIMED_END(20)
    TIMED(21) REPEAT(REP_P2B) { phase2b(p, lds); GSYNC(); } TIMED_END(21)
    TIMED(3) { EpiGlu E; E.mix = (bf16_t*)(p.ws + W_MIX); E.m2 = (const bf16_t*)(p.out + O_YP); E.carry = (const float*)(p.ws + W_LRUC); E.proj = (const bf16_t*)(p.ws + W_PROJ); E.bias = p.in[I_BGLU]; run_gemm(lds, vc, (const bf16_t*)(p.ws + W_YSG), (const bf16_t*)(p.ws + W_WTGLU), 2048, 512, E); GSYNC(); } TIMED_END(3)
    TIMED(4) REPEAT(REP_P4) { EpiRes E; E.R = (bf16_t*)(p.ws + W_R1); E.X = (const bf16_t*)(p.ws + W_XN); E.bias = p.in[I_BOUT]; E.part = (float*)(p.ws + W_PART); run_gemm_split(lds, vc, (const bf16_t*)(p.ws + W_MIX), (const bf16_t*)(p.ws + W_WTOUT), 1024, 1024, 4, E); GSYNC(); } TIMED_END(4)
    TIMED(5) REPEAT(REP_P5) { phase_ln1(p); GSYNC(); } TIMED_END(5)
    TIMED(6) REPEAT(REP_P6) { EpiUp E; E.H = (bf16_t*)(p.ws + W_V); E.bias = p.in[I_BUP]; E.out = p.out; E.cw = p.in[I_FCW]; E.cb = p.in[I_FCB]; E.cache = p.in[I_CCF]; E.sbg = (float*)(p.ws + W_SBG); E.sbv = (float*)(p.ws + W_SBV); run_gemm_main64(lds, vc, (const bf16_t*)(p.ws + W_XN), (const bf16_t*)(p.ws + W_WTUP), 6144, 1024, E);
        run_gemm_tail(lds, vc, (const bf16_t*)(p.ws + W_XN), (const bf16_t*)(p.ws + W_WTUP), 6144, 1024, 4, (float*)(p.ws + W_PU)); GSYNC(); } TIMED_END(6)
    TIMED(7) phase_ffnfix(p); phase_ffntail(p);
    GSYNC(); TIMED_END(7)
    TIMED(8) REPEAT(REP_P8) { EpiRes E; E.R = (bf16_t*)(p.ws + W_R2); E.X = (const bf16_t*)(p.ws + W_XN); E.bias = p.in[I_BDOWN]; E.part = (float*)(p.ws + W_PART); run_gemm_split(lds, vc, (const bf16_t*)(p.ws + W_V), (const bf16_t*)(p.ws + W_WTDOWN), 1024, 3072, 12, E); GSYNC(); } TIMED_END(8)
    TIMED(9) REPEAT(REP_P9) phase_ln2(p); TIMED_END(9)
}

extern "C" void kernel_launch(void* const* d_in, const int* in_sizes, int n_in, void* d_out, int out_size, void* d_ws, size_t ws_size, hipStream_t stream) {
    constexpr int LDS_BYTES = LDS_TOTAL;
    static int grid = 0;
    if (grid == 0) {
        if (n_in != N_IN || (size_t)out_size != O_END || ws_size < 268435456ull) { fprintf(stderr, "kernel_launch: unexpected shapes (n_in %d out %d ws %zu)\n", n_in, out_size, ws_size); grid = -1; return; }
        int dev = 0, cus = 0, per_cu = 0;
        if (hipGetDevice(&dev) != hipSuccess || hipDeviceGetAttribute(&cus, hipDeviceAttributeMultiprocessorCount, dev) != hipSuccess) { grid = -1; return; }
        if (hipFuncSetAttribute((const void*)hawk_fwd, hipFuncAttributeMaxDynamicSharedMemorySize, LDS_BYTES) != hipSuccess) { fprintf(stderr, "kernel_launch: hipFuncSetAttribute failed\n"); grid = -1; return; }
        if (hipOccupancyMaxActiveBlocksPerMultiprocessor(&per_cu, (const void*)hawk_fwd, 512, LDS_BYTES) != hipSuccess || per_cu < 1) { fprintf(stderr, "kernel_launch: occupancy query failed (%d)\n", per_cu); grid = -1; (void)hipGetLastError(); return; }
        grid = cus * per_cu;
    }
    if (grid < 0) return;
    if (hipMemsetAsync((char*)d_ws + W_BAR, 0, (XCD_BAR_WORDS + 64 * 16) * 4, stream) != hipSuccess) { fprintf(stderr, "kernel_launch: memset failed\n"); return; }
    P p{};
    for (int i = 0; i < N_IN; ++i) p.in[i] = (const float*)d_in[i];
    p.out = (float*)d_out; p.ws = (unsigned char*)d_ws;
    void* args[] = {&p};
    hipError_t e = hipLaunchCooperativeKernel((const void*)hawk_fwd, dim3(grid), dim3(512), args, LDS_BYTES, stream);
    if (e != hipSuccess) fprintf(stderr, "cooperative launch failed: %s (grid %d)\n", hipGetErrorString(e), grid);
}
```

```cpp
#include <hip/hip_runtime.h>
#include <hip/hip_cooperative_groups.h>
#include <cstdio>
#include <cstdint>
namespace cg = cooperative_groups;
#define REP_P0 1
#define REP_P0A 1
#define REP_P0B 1
#define REP_P0C 1
#define REP_P1 1
#define REP_P3 1
#define REP_P2A 1
#define REP_P2B 1
#define REP_P2C 1
#define REP_P4 1
#define REP_P5 1
#define REP_P6 1
#define REP_P8 1
#define REP_P9 1
#define PROBE_PHASE -1
namespace pg8 {
#define PG8_LAS __attribute__((address_space(3)))
typedef unsigned short bf16_t;
typedef short bf16x8 __attribute__((ext_vector_type(8)));
typedef float f32x4 __attribute__((ext_vector_type(4)));
typedef unsigned u32x4 __attribute__((ext_vector_type(4)));
constexpr int BM = 256, BK = 64, HALF = 128, HTB = HALF * BK * 2  , STAGE_BYTES = 8 * HTB, NXCD = 8, WGM = 8;

__host__ __device__ __forceinline__ int lds_byte(int r, int c) { const int st = (r >> 4) * 2 + (c >> 5), rr = r & 15, cc = c & 31, ob = rr * 64 + cc * 2; return st * 1024 + (ob ^ (((ob >> 9) & 1) << 5)); }
__host__ __device__ __forceinline__ void stage_rc(int b, int& R, int& C) { const int st = b / 1024, sb = b % 1024, swz = sb ^ (((sb >> 9) & 1) << 5); R = (st >> 1) * 16 + swz / 64; C = (st & 1) * 32 + (swz % 64) / 2; }
__host__ __device__ __forceinline__ int perm32(int rho) { const int n = rho >> 4, i = rho & 15; return 8 * (i >> 2) + 4 * n + (i & 3); }

struct Unit { int pm, pn, k0, nt, ks; };
struct Gemm { const bf16_t* A; const bf16_t* Bt; int M, N, K; };

struct StaticOrder {
    int nM, nN, nwg, G, c, ntk;
    __host__ __device__ void init(int M, int N, int K, int G_, int c_) { nM = M / BM; nN = N / BM; nwg = nM * nN; G = G_; c = c_; ntk = K / BK; }
    __host__ __device__ bool next(int i, Unit& u) const {
        const long L = (long)i * G + c; if (L >= nwg) return false;
        int wgid = (int)L; { const int q = nwg / NXCD, r = nwg % NXCD, xcd = wgid % NXCD, off = wgid / NXCD; wgid = (xcd < r ? xcd * (q + 1) : r * (q + 1) + (xcd - r) * q) + off; }
        const int nig = WGM * nN, gid = wgid / nig, fm = gid * WGM, gsz = (nM - fm) < WGM ? (nM - fm) : WGM;
        u.pm = fm + ((wgid % nig) % gsz); u.pn = (wgid % nig) / gsz; u.k0 = 0; u.nt = ntk; u.ks = -1; return true;
    }
    __device__ __forceinline__ void a_ready(const Unit&) const {}
    __device__ __forceinline__ void done(const Unit&) const {}
};
struct TailOrder {
    int nN, ntk, nsplit, G, c;
    __host__ __device__ void init(int N, int K, int nsplit_, int G_, int c_) { nN = N / BM; ntk = K / BK; nsplit = nsplit_; G = G_; c = c_; }
    __host__ __device__ bool next(int i, Unit& u) const {
        const long L = (long)i * G + c; const bool ok = L < (long)nN * nsplit; const int ks = (int)(L / nN), ntp = ntk / nsplit;
        u.pm = 64; u.pn = (int)(L % nN); u.ks = ks; u.nt = ntp; u.k0 = ks * ntp * BK; return ok;
    }
    __device__ __forceinline__ void a_ready(const Unit&) const {}
    __device__ __forceinline__ void done(const Unit&) const {}
};
struct SplitOrder {
    StaticOrder base; int nsplit;
    __host__ __device__ void init(int N, int K, int nsplit_, int G_, int c_) { base.init(64 * BM, N, K, G_, c_); nsplit = nsplit_; }
    __host__ __device__ bool next(int i, Unit& u) const {
        Unit t; t.pm = 0; t.pn = 0; t.k0 = 0; t.nt = base.ntk; t.ks = -1;
        const bool ok = base.next(i, t);
        const long L = (long)i * base.G + base.c - base.nwg; const bool sp = (!ok) && L >= 0 && L < (long)base.nN * nsplit;
        const int ks = (int)(L / base.nN), pn = (int)(L % base.nN), ntp = base.ntk / nsplit;
        u.pm = sp ? 64 : t.pm; u.pn = sp ? pn : t.pn; u.ks = sp ? ks : -1; u.nt = sp ? ntp : t.nt; u.k0 = sp ? ks * ntp * BK : 0;
        return ok || sp;
    }
    __device__ __forceinline__ void a_ready(const Unit&) const {}
    __device__ __forceinline__ void done(const Unit&) const {}
};
__device__ __forceinline__ unsigned cvt_pk_bf16(float lo, float hi) { unsigned r; asm volatile("v_cvt_pk_bf16_f32 %0, %1, %2" : "=v"(r) : "v"(lo), "v"(hi)); return r; }
template <class Epi, class Sched, bool STAMP = false>
__device__ __forceinline__ void gemm_phase(PG8_LAS unsigned char* lds, const Gemm g, const Sched& S, const Epi& E, unsigned long long* stamps) {
    int tid_ = threadIdx.x; asm volatile("" : "+v"(tid_)); const int tid = tid_, wid = __builtin_amdgcn_readfirstlane(tid >> 6), lane = tid & 63, wr = wid >> 2, wc = wid & 3, fr = lane & 15, fq = lane >> 4;
    const int K = g.K;
    int ts_lo = 0, ts_hi = 0, nts = 0; const unsigned long long rt_entry = STAMP ? (unsigned long long)wall_clock64() : 0ull;
#define PG8_STAMP() do { if (STAMP && wid == 0 && nts < 64) { const unsigned long long _c = (unsigned long long)clock64(); \
        ts_lo = (lane == nts) ? (int)(unsigned)_c : ts_lo; ts_hi = (lane == nts) ? (int)(unsigned)(_c >> 32) : ts_hi; ++nts; } } while (0)
    PG8_STAMP();
    unsigned voffA[2], voffB[2];
#pragma unroll
    for (int i = 0; i < 2; ++i) { int R, C; stage_rc(tid * 16 + i * 8192, R, C); const int Rb = Epi::PERM ? ((R & ~31) + perm32(R & 31)) : R;
        voffA[i] = (unsigned)(R * K + C) * 2u; voffB[i] = (unsigned)(Rb * K + C) * 2u; }
    const size_t kstep = (size_t)(BK * 2);
    const size_t hstep = (size_t)HALF * K * 2;
    const size_t tstep = 2 * hstep;
    const unsigned ldsw = (unsigned)wid * 1024u;
    const int aoff = lds_byte(wr * 64 + fr, fq * 8), boff = lds_byte(wc * 32 + fr, fq * 8);
#define PG8_SA(b, h) (((b) * 2 + (h)) * HTB)
#define PG8_SB(b, h) ((4 + (b) * 2 + (h)) * HTB)
#define PG8_STAGE(bufoff, gbase, voff) do { _Pragma("unroll") for (int _i = 0; _i < 2; ++_i) \
        __builtin_amdgcn_global_load_lds((const unsigned*)((const char*)(gbase) + (voff)[_i]), (PG8_LAS unsigned*)(lds + (bufoff) + ldsw + _i * 8192), 16, 0, 0); } while (0)
#define PG8_LDA(dst, b, h) do { _Pragma("unroll") for (int m = 0; m < 4; ++m) _Pragma("unroll") for (int k = 0; k < 2; ++k) dst[m][k] = *(const PG8_LAS bf16x8*)(lds + PG8_SA(b, h) + aoff + m * 2048 + k * 1024); } while (0)
#define PG8_LDB(dst, b, h) do { _Pragma("unroll") for (int n = 0; n < 2; ++n) _Pragma("unroll") for (int k = 0; k < 2; ++k) dst[n][k] = *(const PG8_LAS bf16x8*)(lds + PG8_SB(b, h) + boff + n * 2048 + k * 1024); } while (0)
#define PG8_MMA(ai, bj, At, Bt) do { __builtin_amdgcn_s_setprio(1); _Pragma("unroll") for (int m = 0; m < 4; ++m) _Pragma("unroll") for (int n = 0; n < 2; ++n) _Pragma("unroll") for (int k = 0; k < 2; ++k) \
        acc[ai][bj][m][n] = __builtin_amdgcn_mfma_f32_16x16x32_bf16(Bt[n][k], At[m][k], acc[ai][bj][m][n], 0, 0, 0); __builtin_amdgcn_s_setprio(0); } while (0)
#define PG8_WAIT_V(n) asm volatile("s_waitcnt vmcnt(" #n ")" ::: "memory")
#define PG8_WAIT_L(n) asm volatile("s_waitcnt lgkmcnt(" #n ")" ::: "memory")
#define PG8_BAR __builtin_amdgcn_s_barrier()
#define PG8_SCHED __builtin_amdgcn_sched_barrier(0)
    Unit cur, nxt; int ui = 0;
    if (!S.next(0, cur)) return;
    f32x4 acc[2][2][4][2];
#pragma unroll
    for (int a = 0; a < 2; ++a)
#pragma unroll
        for (int b = 0; b < 2; ++b)
#pragma unroll
            for (int m = 0; m < 4; ++m)
#pragma unroll
                for (int n = 0; n < 2; ++n) acc[a][b][m][n] = (f32x4){0.f, 0.f, 0.f, 0.f};
    bf16x8 At[4][2], B0[2][2], B1[2][2];
    const char* cA = (const char*)g.A + (size_t)cur.pm * tstep + (size_t)cur.k0 * 2; const char* cB = (const char*)g.Bt + (size_t)cur.pn * tstep + (size_t)cur.k0 * 2;
    S.a_ready(cur);
    PG8_STAGE(PG8_SB(0, 0), cB, voffB); PG8_STAGE(PG8_SA(0, 0), cA, voffA); PG8_STAGE(PG8_SB(0, 1), cB + hstep, voffB); PG8_STAGE(PG8_SA(0, 1), cA + hstep, voffA);
    if (wr == 1) PG8_BAR;
    PG8_WAIT_V(4); PG8_BAR;
    PG8_STAGE(PG8_SB(1, 0), cB + kstep, voffB); PG8_STAGE(PG8_SA(1, 0), cA + kstep, voffA); PG8_STAGE(PG8_SB(1, 1), cB + hstep + kstep, voffB);
    PG8_WAIT_V(6); PG8_BAR;
    PG8_STAMP();
    for (;;) {
        const bool has_next = S.next(ui + 1, nxt);
        const char* nA = has_next ? (const char*)g.A + (size_t)nxt.pm * tstep + (size_t)nxt.k0 * 2 : cA; const char* nB = has_next ? (const char*)g.Bt + (size_t)nxt.pn * tstep + (size_t)nxt.k0 * 2 : cB;
        const int nt = cur.nt;
        for (int t = 0; t < nt; t += 2) {
            const bool last = (t == nt - 2);
            const char* a1 = cA + (size_t)(t + 1) * kstep;
            const char* a2 = last ? nA : cA + (size_t)(t + 2) * kstep; const char* b2 = last ? nB : cB + (size_t)(t + 2) * kstep;
            const char* a3 = a2 + kstep; const char* b3 = b2 + kstep;
            if (last && has_next) S.a_ready(nxt);
            PG8_LDB(B0, 0, 0); PG8_SCHED; PG8_LDA(At, 0, 0); PG8_STAGE(PG8_SA(1, 1), a1 + hstep, voffA);
            PG8_WAIT_L(8); PG8_BAR; PG8_WAIT_L(0); PG8_MMA(0, 0, At, B0); PG8_BAR; PG8_SCHED;
            PG8_LDB(B1, 0, 1); PG8_STAGE(PG8_SB(0, 0), b2, voffB);
            PG8_BAR; PG8_WAIT_L(0); PG8_MMA(0, 1, At, B1); PG8_BAR;
            PG8_LDA(At, 0, 1); PG8_STAGE(PG8_SA(0, 0), a2, voffA);
            PG8_BAR; PG8_WAIT_L(0); PG8_MMA(1, 0, At, B0); PG8_BAR; PG8_SCHED;
            PG8_STAGE(PG8_SB(0, 1), b2 + hstep, voffB);
            PG8_WAIT_V(6); PG8_BAR; PG8_MMA(1, 1, At, B1); PG8_BAR;
            PG8_LDB(B0, 1, 0); PG8_SCHED; PG8_LDA(At, 1, 0); PG8_STAGE(PG8_SA(0, 1), a2 + hstep, voffA);
            PG8_WAIT_L(8); PG8_BAR; PG8_WAIT_L(0); PG8_MMA(0, 0, At, B0); PG8_BAR; PG8_SCHED;
            PG8_LDB(B1, 1, 1); PG8_STAGE(PG8_SB(1, 0), b3, voffB);
            PG8_BAR; PG8_WAIT_L(0); PG8_MMA(0, 1, At, B1); PG8_BAR;
            PG8_LDA(At, 1, 1); PG8_STAGE(PG8_SA(1, 0), a3, voffA);
            PG8_BAR; PG8_WAIT_L(0); PG8_MMA(1, 0, At, B0); PG8_BAR; PG8_SCHED;
            PG8_STAGE(PG8_SB(1, 1), b3 + hstep, voffB);
            PG8_WAIT_V(6); PG8_BAR; PG8_MMA(1, 1, At, B1); PG8_BAR;
        }
        PG8_STAMP();
        if constexpr (!Epi::AFTER_DRAIN) { E(acc, cur, wr, wc, fr, fq); S.done(cur); }
        PG8_STAMP();
        if (!has_next) break;
#pragma unroll
        for (int a = 0; a < 2; ++a)
#pragma unroll
            for (int b = 0; b < 2; ++b)
#pragma unroll
                for (int m = 0; m < 4; ++m)
#pragma unroll
                    for (int n = 0; n < 2; ++n) acc[a][b][m][n] = (f32x4){0.f, 0.f, 0.f, 0.f};
        cur = nxt; cA = nA; cB = nB; ++ui;
    }
    PG8_WAIT_V(0);
    if (wr == 0) PG8_BAR;
    PG8_BAR;
    if constexpr (Epi::AFTER_DRAIN) { E.fused(acc, cur, wr, wc, fr, fq, lds, wid, lane); S.done(cur); }
    PG8_STAMP();
    if (STAMP && wid == 0) { stamps[lane] = lane < nts ? (((unsigned long long)(unsigned)ts_hi << 32) | (unsigned)ts_lo) : 0ull;
        if (lane == 62) stamps[62] = rt_entry; if (lane == 63) stamps[63] = (unsigned long long)wall_clock64(); }
#undef PG8_STAMP
#undef PG8_SA
#undef PG8_SB
#undef PG8_STAGE
#undef PG8_LDA
#undef PG8_LDB
#undef PG8_MMA
#undef PG8_WAIT_V
#undef PG8_WAIT_L
#undef PG8_BAR
#undef PG8_SCHED
}
}
using pg8::bf16_t; using pg8::bf16x8; using pg8::f32x4; using pg8::u32x4; using pg8::Unit; using pg8::cvt_pk_bf16;
#define LAS __attribute__((address_space(3)))
typedef unsigned u32x2 __attribute__((ext_vector_type(2)));
#define XB_TMO      128
#define XB_XCNT(j)  (256  + 64 * (j))
#define XB_XSUB(j)  (1280 + 64 * (j))
#define XB_XGEN(j)  (2304 + 64 * (j))
#define XB_TOP      3328
#define XB_TOPGEN   3392
#define XCD_BAR_WORDS 3456
#define XB_SPIN_CAP (1u << 18)

__device__ __forceinline__ unsigned xb_ld(unsigned* p)              { return __hip_atomic_load(p, __ATOMIC_RELAXED, __HIP_MEMORY_SCOPE_AGENT); }
__device__ __forceinline__ unsigned xb_add(unsigned* p, unsigned v) { return __hip_atomic_fetch_add(p, v, __ATOMIC_RELAXED, __HIP_MEMORY_SCOPE_AGENT); }
__device__ __forceinline__ unsigned xb_xcc_id() { return (unsigned)__builtin_amdgcn_s_getreg((3 << 11) | 20) & 0xFu; }
#define XB_SPIN(cond, bar) do { unsigned _sp = 0; while (cond) { __builtin_amdgcn_s_sleep(1); \
    if ((++_sp & 255u) == 0u) { if (xb_ld(&(bar)[XB_TMO])) break; if (_sp > XB_SPIN_CAP) { atomicAdd(&(bar)[XB_TMO], 1u); break; } } } } while (0)

struct XcdBarrier {
    unsigned* bar; unsigned x;
    volatile LAS unsigned* st;
};

__device__ __forceinline__ XcdBarrier xcd_barrier_post(unsigned* bar, volatile LAS unsigned* st) {
    XcdBarrier b; b.bar = bar; b.x = xb_xcc_id(); b.st = st;
    if (threadIdx.x == 0) (void)xb_add(&bar[XB_XCNT(b.x)], 1u);
    return b;
}
__device__ __forceinline__ void xcd_barrier_complete(unsigned* bar, unsigned x, unsigned& nloc, unsigned& nx) {
    const unsigned G = gridDim.x * gridDim.y * gridDim.z;
    unsigned sum, cnt, mine, sp = 0u;
    for (;;) {
        sum = 0u; cnt = 0u; mine = 0u;
#pragma unroll
        for (unsigned j = 0; j < 16; ++j) { const unsigned c = xb_ld(&bar[XB_XCNT(j)]); sum += c; cnt += (c > 0u) ? 1u : 0u; mine = (j == x) ? c : mine; }
        if (sum == G) break;
        __builtin_amdgcn_s_sleep(1);
        if ((++sp & 255u) == 0u) { if (xb_ld(&bar[XB_TMO])) break; if (sp > XB_SPIN_CAP) { atomicAdd(&bar[XB_TMO], 1u); break; } }
    }
    nloc = mine > 0u ? mine : 1u; nx = cnt > 0u ? cnt : 1u;
}

__device__ __forceinline__ void xcd_barrier(const XcdBarrier& b) {
    asm volatile("s_waitcnt vmcnt(0)" ::: "memory");
    __syncthreads();
    if (threadIdx.x == 0) {
        unsigned* bar = b.bar;
        __builtin_amdgcn_s_waitcnt(0);
        unsigned nloc = b.st[0], nx = b.st[1];
        if (nloc == 0u) { xcd_barrier_complete(bar, b.x, nloc, nx); b.st[0] = nloc; b.st[1] = nx; }
        const unsigned old = xb_add(&bar[XB_XSUB(b.x)], 1u);
        const unsigned gen = old / nloc;
        if (old + 1u == (gen + 1u) * nloc) {
            __builtin_amdgcn_fence(__ATOMIC_RELEASE, "agent");
            asm volatile("s_waitcnt vmcnt(0)" ::: "memory");
            const unsigned og = xb_add(&bar[XB_TOP], 1u);
            const unsigned tg = og / nx;
            if (og + 1u == (tg + 1u) * nx) xb_add(&bar[XB_TOPGEN], 1u);
            else XB_SPIN(xb_ld(&bar[XB_TOPGEN]) == tg, bar);
            __builtin_amdgcn_fence(__ATOMIC_ACQUIRE, "agent");
            xb_add(&bar[XB_XGEN(b.x)], 1u);
            asm volatile("s_waitcnt vmcnt(0)" ::: "memory");
        } else {
            XB_SPIN(xb_ld(&bar[XB_XGEN(b.x)]) == gen, bar);
            __builtin_amdgcn_fence(__ATOMIC_ACQUIRE, "agent");
            asm volatile("s_waitcnt vmcnt(0)" ::: "memory");
        }
    }
    __syncthreads();
}


constexpr int DM = 1024, NBATCH = 8, TT = 2064, NSAMP = 128, MP = NBATCH * TT  , MTOK = MP + NSAMP  ;
constexpr int DIN = 3584, DSSM = 512, DFF = 3072, NG = 32, NCHUNK = 129, NR = NBATCH * NCHUNK  ;
constexpr int C_US = 1024, C_GA = 1536, C_GB = 2560;
constexpr float ALPHA = 1.189207115002721f, LN_EPS = 1e-5f;
enum { I_XP = 0, I_XS, I_CCL, I_SL, I_SSR, I_SSI, I_CCF, I_META, I_EG, I_EB, I_WIN, I_BIN, I_CLW, I_CLB, I_WR, I_BR, I_WI, I_BI, I_LAM,
       I_SLRE, I_SLIM, I_SLDT, I_SBRE, I_SBIM, I_SCRE, I_SCIM, I_SD, I_WGLU, I_BGLU, I_WOUT, I_BOUT, I_L1G, I_L1B, I_WUP, I_BUP, I_FCW, I_FCB,
       I_WDOWN, I_BDOWN, I_L2G, I_L2B, N_IN };
constexpr size_t O_YP = 0, O_YS = 16777216, O_PCL = O_YS + 131072, O_PL = O_PCL + 24576, O_PSR = O_PL + 8192, O_PSI = O_PSR + 16384, O_PCF = O_PSI + 16384,
                 O_SCL = O_PCF + 49152, O_SL = O_SCL + 393216, O_SSR = O_SL + 131072, O_SSI = O_SSR + 262144, O_SCF = O_SSI + 262144, O_END = O_SCF + 786432;
constexpr size_t W_WTUP = 0, W_WTDOWN = W_WTUP + (size_t)6144 * 1024 * 2, W_XN = W_WTDOWN + (size_t)1024 * 3072 * 2, W_C = W_XN + (size_t)MTOK * 1024 * 2;
constexpr size_t W_PROJ = W_C, W_MIX = W_PROJ + (size_t)MTOK * DIN * 2, W_YSG = W_MIX + (size_t)MTOK * 1024 * 2, W_D = W_YSG + (size_t)MTOK * 512 * 2;
constexpr size_t W_WTGLU = W_D, W_WTOUT = W_WTGLU + (size_t)2048 * 512 * 2, W_WTR = W_WTOUT + (size_t)1024 * 1024 * 2, W_WTI = W_WTR + 262144, W_W1 = W_WTI + 262144,
                 W_W2 = W_W1 + (size_t)NG * 128 * 256 * 2, W_HPREV = W_W2 + (size_t)NG * 256 * 384 * 2, W_A1 = W_HPREV + (size_t)NR * NG * 128 * 2, W_A16 = W_A1 + 16384,
                 W_BBAR = W_A16 + 16384, W_LRUA = W_BBAR + 262144, W_LRUH = W_LRUA + 262144, W_LRUC = W_LRUH + 262144, W_S = W_LRUC + 262144, W_WTIN = W_S,
                 W_S_END = W_S + (size_t)NR * NG * 128 * 4;
constexpr size_t W_BAR = (W_S_END + 4095) / 4096 * 4096;
static_assert(W_BAR + (XCD_BAR_WORDS + 64 * 16) * 4 <= 268435456, "barrier words");
constexpr size_t W_PART = W_C + (size_t)MTOK * 1024 * 4;
constexpr size_t W_SBG = W_C, W_SBV = W_SBG + (size_t)260 * 4 * DFF * 4, W_SB_END = W_SBV + (size_t)260 * 2 * DFF * 4;
constexpr size_t W_PU = W_SB_END, W_PU_END = W_PU + (size_t)4 * 256 * 6144 * 4;
constexpr size_t W_PG = W_S;
constexpr size_t W_R1 = W_C, W_G = W_C, W_V = W_G + (size_t)MTOK * DFF * 2, W_V_END = W_V + (size_t)MTOK * DFF * 2, W_R2 = W_C;
static_assert(W_S_END <= 268435456 && W_V_END <= 268435456, "workspace map exceeds 256 MiB");
static_assert(W_SB_END <= W_V && W_PU_END <= W_V, "side buffers / up partials overlap H");
static_assert(W_PART + (size_t)12 * 256 * 1024 * 4 <= W_MIX && W_PART + (size_t)12 * 256 * 1024 * 4 <= W_V, "r1 / partials overlap mix or v");

constexpr int LDS_TOTAL = 147456;
struct P { const float* in[N_IN]; float* out; unsigned char* ws; };

__device__ __forceinline__ float bf2f(unsigned short b) { return __uint_as_float(((unsigned)b) << 16); }
__device__ __forceinline__ float bflo(unsigned u) { return __uint_as_float(u << 16); }
__device__ __forceinline__ float bfhi(unsigned u) { return __uint_as_float(u & 0xffff0000u); }
__device__ __forceinline__ unsigned short f2bf(float f) { return (unsigned short)(cvt_pk_bf16(f, 0.f) & 0xffffu); }
__device__ __forceinline__ float sigm(float x) { return __builtin_amdgcn_rcpf(1.f + __expf(-x)); }
__device__ __forceinline__ float gelu_tanh(float x) { return x * sigm(1.5957691216057308f * (x + 0.044715f * x * x * x)); }
__device__ __forceinline__ float wave_sum(float v) {
#pragma unroll
    for (int o = 1; o < 64; o <<= 1) v += __shfl_xor(v, o);
    return v;
}
#define LDS_WAIT() asm volatile("s_waitcnt lgkmcnt(0)" ::: "memory")
#define REPEAT(N) for (int rep_ = 0; rep_ < (N); ++rep_)
#define TIMED(N) const unsigned long long tq0_##N = (PROBE_PHASE == (N)) ? __builtin_amdgcn_s_memrealtime() : 0ull;
#define TIMED_END(N) if (PROBE_PHASE == (N)) { const unsigned long long tq1 = __builtin_amdgcn_s_memrealtime(); while (__builtin_amdgcn_s_memrealtime() - tq1 < tq1 - tq0_##N) __builtin_amdgcn_s_sleep(4); }

struct EpiProj {
    static constexpr bool PERM = true, AFTER_DRAIN = false;
    bf16_t* O; const float* bias;
    __device__ __forceinline__ void operator()(const f32x4 (&acc)[2][2][4][2], const Unit& u, int wr, int wc, int fr, int fq) const {
        const int row0 = u.pm * 256 + wr * 64 + fr, col0 = u.pn * 256 + wc * 32 + 8 * fq;
#pragma unroll
        for (int bj = 0; bj < 2; ++bj) { const int col = col0 + bj * 128; const f32x4 b0 = *(const f32x4*)(bias + col), b1 = *(const f32x4*)(bias + col + 4);
#pragma unroll
            for (int ai = 0; ai < 2; ++ai)
#pragma unroll
                for (int m = 0; m < 4; ++m) { const f32x4 v0 = acc[ai][bj][m][0] + b0, v1 = acc[ai][bj][m][1] + b1; u32x4 w;
                    w.x = cvt_pk_bf16(v0[0], v0[1]); w.y = cvt_pk_bf16(v0[2], v0[3]); w.z = cvt_pk_bf16(v1[0], v1[1]); w.w = cvt_pk_bf16(v1[2], v1[3]);
                    *(u32x4*)(O + (size_t)(row0 + ai * 128 + m * 16) * DIN + col) = w; } }
    }
};
struct EpiGlu {
    static constexpr bool PERM = true, AFTER_DRAIN = false;
    bf16_t* mix; const bf16_t* m2; const float* carry; const bf16_t* proj; const float* bias;
    __device__ __forceinline__ void operator()(const f32x4 (&acc)[2][2][4][2], const Unit& u, int wr, int wc, int fr, int fq) const {
        const int row0 = u.pm * 256 + wr * 64 + fr, j = u.pn * 128 + wc * 32 + 8 * fq;
        const f32x4 bv0 = *(const f32x4*)(bias + j), bv1 = *(const f32x4*)(bias + j + 4), bg0 = *(const f32x4*)(bias + 1024 + j), bg1 = *(const f32x4*)(bias + 1024 + j + 4);
#pragma unroll
        for (int ai = 0; ai < 2; ++ai)
#pragma unroll
            for (int mp = 0; mp < 2; ++mp) { u32x4 gbw[2], mw[2], m2w[2]; f32x4 cv0[2], cv1[2];
#pragma unroll
                for (int mm = 0; mm < 2; ++mm) { const int rowi = row0 + ai * 128 + (2 * mp + mm) * 16; const size_t row = (size_t)rowi; int cidx = 0;
                    if (rowi < MP) { const int b = rowi / TT, t = rowi - b * TT; int kc = t >> 8; kc = kc > 7 ? 7 : kc; cidx = (b * 8 + kc) * 1024; }
                    cv0[mm] = *(const f32x4*)(carry + cidx + j); cv1[mm] = *(const f32x4*)(carry + cidx + j + 4);
                    gbw[mm] = *(const u32x4*)(proj + row * DIN + C_GB + j); mw[mm] = *(const u32x4*)(mix + row * 1024 + j); m2w[mm] = *(const u32x4*)(m2 + row * 1024 + j); }
#pragma unroll
                for (int mm = 0; mm < 2; ++mm) { const int m = 2 * mp + mm; const size_t row = (size_t)(row0 + ai * 128 + m * 16);
                    const f32x4 val0 = acc[ai][0][m][0] + bv0, val1 = acc[ai][0][m][1] + bv1, gate0 = acc[ai][1][m][0] + bg0, gate1 = acc[ai][1][m][1] + bg1;
                    const float o0 = bflo(mw[mm].x) + bflo(m2w[mm].x) * cv0[mm][0] + sigm(bflo(gbw[mm].x)) * val0[0] * sigm(gate0[0]), o1 = bfhi(mw[mm].x) + bfhi(m2w[mm].x) * cv0[mm][1] + sigm(bfhi(gbw[mm].x)) * val0[1] * sigm(gate0[1]);
                    const float o2 = bflo(mw[mm].y) + bflo(m2w[mm].y) * cv0[mm][2] + sigm(bflo(gbw[mm].y)) * val0[2] * sigm(gate0[2]), o3 = bfhi(mw[mm].y) + bfhi(m2w[mm].y) * cv0[mm][3] + sigm(bfhi(gbw[mm].y)) * val0[3] * sigm(gate0[3]);
                    const float o4 = bflo(mw[mm].z) + bflo(m2w[mm].z) * cv1[mm][0] + sigm(bflo(gbw[mm].z)) * val1[0] * sigm(gate1[0]), o5 = bfhi(mw[mm].z) + bfhi(m2w[mm].z) * cv1[mm][1] + sigm(bfhi(gbw[mm].z)) * val1[1] * sigm(gate1[1]);
                    const float o6 = bflo(mw[mm].w) + bflo(m2w[mm].w) * cv1[mm][2] + sigm(bflo(gbw[mm].w)) * val1[2] * sigm(gate1[2]), o7 = bfhi(mw[mm].w) + bfhi(m2w[mm].w) * cv1[mm][3] + sigm(bfhi(gbw[mm].w)) * val1[3] * sigm(gate1[3]);
                    u32x4 w; w.x = cvt_pk_bf16(o0, o1); w.y = cvt_pk_bf16(o2, o3); w.z = cvt_pk_bf16(o4, o5); w.w = cvt_pk_bf16(o6, o7); *(u32x4*)(mix + row * 1024 + j) = w; } }
    }
};
struct EpiRes {
    static constexpr bool PERM = true, AFTER_DRAIN = false;
    bf16_t* R; const bf16_t* X; const float* bias; float* part;
    __device__ __forceinline__ void operator()(const f32x4 (&acc)[2][2][4][2], const Unit& u, int wr, int wc, int fr, int fq) const {
        const int row0 = u.pm * 256 + wr * 64 + fr, col0 = u.pn * 256 + wc * 32 + 8 * fq;
        if (u.ks >= 0) { float* pp = part + ((size_t)u.ks * 256 - 16384) * 1024;
#pragma unroll
            for (int bj = 0; bj < 2; ++bj)
#pragma unroll
                for (int n = 0; n < 2; ++n)
#pragma unroll
                    for (int ai = 0; ai < 2; ++ai)
#pragma unroll
                        for (int m = 0; m < 4; ++m) *(f32x4*)(pp + (size_t)(row0 + ai * 128 + m * 16) * 1024 + col0 + bj * 128 + n * 4) = acc[ai][bj][m][n];
            return; }
#pragma unroll
        for (int bj = 0; bj < 2; ++bj) { const int col = col0 + bj * 128; const f32x4 b0 = *(const f32x4*)(bias + col), b1 = *(const f32x4*)(bias + col + 4);
#pragma unroll
            for (int ai = 0; ai < 2; ++ai) { u32x4 xw[4];
#pragma unroll
                for (int m = 0; m < 4; ++m) xw[m] = *(const u32x4*)(X + (size_t)(row0 + ai * 128 + m * 16) * 1024 + col);
#pragma unroll
                for (int m = 0; m < 4; ++m) { const size_t off = (size_t)(row0 + ai * 128 + m * 16) * 1024 + col;
                    f32x4 v0 = acc[ai][bj][m][0] + b0, v1 = acc[ai][bj][m][1] + b1;
                    v0[0] += ALPHA * bflo(xw[m].x); v0[1] += ALPHA * bfhi(xw[m].x); v0[2] += ALPHA * bflo(xw[m].y); v0[3] += ALPHA * bfhi(xw[m].y);
                    v1[0] += ALPHA * bflo(xw[m].z); v1[1] += ALPHA * bfhi(xw[m].z); v1[2] += ALPHA * bflo(xw[m].w); v1[3] += ALPHA * bfhi(xw[m].w);
                    u32x4 w; w.x = cvt_pk_bf16(v0[0], v0[1]); w.y = cvt_pk_bf16(v0[2], v0[3]); w.z = cvt_pk_bf16(v1[0], v1[1]); w.w = cvt_pk_bf16(v1[2], v1[3]); *(u32x4*)(R + off) = w; } } }
    }
};
__device__ __forceinline__ float rot1(float x) { return __int_as_float(__builtin_amdgcn_update_dpp(0, __float_as_int(x), 0x121, 0xf, 0xf, false)); }
__device__ __forceinline__ float rot2(float x) { return __int_as_float(__builtin_amdgcn_update_dpp(0, __float_as_int(x), 0x122, 0xf, 0xf, false)); }
struct EpiUp {
    static constexpr bool PERM = true, AFTER_DRAIN = false;
    bf16_t* H; const float* bias; float* out; const float* cw; const float* cb; const float* cache; float* sbg; float* sbv;
    __device__ __forceinline__ void operator()(const f32x4 (&acc)[2][2][4][2], const Unit& u, int wr, int wc, int fr, int fq) const {
        const int c0 = u.pn * 128 + wc * 32 + 8 * fq;
        f32x4 bg[2], bv[2], w0[2], w1[2], w2[2], cbv[2];
#pragma unroll
        for (int n = 0; n < 2; ++n) { const int ch = c0 + 4 * n; bg[n] = *(const f32x4*)(bias + ch); bv[n] = *(const f32x4*)(bias + DFF + ch);
            w0[n] = *(const f32x4*)(cw + ch); w1[n] = *(const f32x4*)(cw + DFF + ch); w2[n] = *(const f32x4*)(cw + 2 * DFF + ch); cbv[n] = *(const f32x4*)(cb + ch); }
#pragma unroll
        for (int ai = 0; ai < 2; ++ai) { const int blk = u.pm * 4 + ai * 2 + wr, r0 = blk * 64;
            f32x4 gp1[2], gp2[2];
#pragma unroll
            for (int n = 0; n < 2; ++n) { gp1[n] = (f32x4){0.f, 0.f, 0.f, 0.f}; gp2[n] = (f32x4){0.f, 0.f, 0.f, 0.f}; }
#pragma unroll
            for (int m = 0; m < 4; ++m) { const int row = r0 + 16 * m + fr; const int b = row / TT, t = row - b * TT; float h[8];
#pragma unroll
                for (int n = 0; n < 2; ++n) { const int ch = c0 + 4 * n; const f32x4 g = acc[ai][0][m][n] + bg[n], v = acc[ai][1][m][n] + bv[n];
                    f32x4 a1, a2; a1[0] = rot1(g[0]); a1[1] = rot1(g[1]); a1[2] = rot1(g[2]); a1[3] = rot1(g[3]); a2[0] = rot2(g[0]); a2[1] = rot2(g[1]); a2[2] = rot2(g[2]); a2[3] = rot2(g[3]);
                    f32x4 g1 = (fr >= 1) ? a1 : gp1[n], g2 = (fr >= 2) ? a2 : gp2[n];
                    if (t == 0) g1 = (f32x4){0.f, 0.f, 0.f, 0.f}; if (t <= 1) g2 = (f32x4){0.f, 0.f, 0.f, 0.f};
                    if (t >= TT - 2) *(f32x4*)(out + O_PCF + ((size_t)b * 2 + (t - (TT - 2))) * DFF + ch) = g;
                    if (m == 0 && fr < 2) { *(f32x4*)(sbg + ((size_t)blk * 4 + fr) * DFF + ch) = g; *(f32x4*)(sbv + ((size_t)blk * 2 + fr) * DFF + ch) = v; }
                    if (m == 3 && fr >= 14) *(f32x4*)(sbg + ((size_t)blk * 4 + fr - 12) * DFF + ch) = g;
                    const f32x4 y = cbv[n] + w0[n] * g2 + w1[n] * g1 + w2[n] * g;
                    h[4 * n] = gelu_tanh(y[0]) * v[0]; h[4 * n + 1] = gelu_tanh(y[1]) * v[1]; h[4 * n + 2] = gelu_tanh(y[2]) * v[2]; h[4 * n + 3] = gelu_tanh(y[3]) * v[3];
                    gp1[n] = a1; gp2[n] = a2; }
                u32x4 w; w.x = cvt_pk_bf16(h[0], h[1]); w.y = cvt_pk_bf16(h[2], h[3]); w.z = cvt_pk_bf16(h[4], h[5]); w.w = cvt_pk_bf16(h[6], h[7]); *(u32x4*)(H + (size_t)row * DFF + c0) = w; } }
    }
};
struct EpiRaw {
    static constexpr bool PERM = false, AFTER_DRAIN = false;
    float* pu; int ld;
    __device__ __forceinline__ void operator()(const f32x4 (&acc)[2][2][4][2], const Unit& u, int wr, int wc, int fr, int fq) const {
        float* pp = pu + (size_t)u.ks * 256 * ld + (size_t)(wr * 64 + fr) * ld + u.pn * 256 + wc * 32 + 4 * fq;
#pragma unroll
        for (int ai = 0; ai < 2; ++ai)
#pragma unroll
            for (int m = 0; m < 4; ++m)
#pragma unroll
                for (int bj = 0; bj < 2; ++bj)
#pragma unroll
                    for (int n = 0; n < 2; ++n) *(f32x4*)(pp + (size_t)(ai * 128 + m * 16) * ld + bj * 128 + n * 16) = acc[ai][bj][m][n];
    }
};
template <class Epi> __device__ __forceinline__ void run_gemm(LAS unsigned char* lds, int vc, const bf16_t* A, const bf16_t* Bt, int N, int K, const Epi& E) {
    pg8::Gemm g; g.A = A; g.Bt = Bt; g.M = MTOK; g.N = N; g.K = K;
    pg8::StaticOrder S; S.init(MTOK, N, K, (int)gridDim.x, vc);
    pg8::gemm_phase<Epi, pg8::StaticOrder, false>(lds, g, S, E, nullptr);
}

template <class Epi> __device__ __forceinline__ void run_gemm_split(LAS unsigned char* lds, int vc, const bf16_t* A, const bf16_t* Bt, int N, int K, int nsplit, const Epi& E) {
    pg8::Gemm g; g.A = A; g.Bt = Bt; g.M = MTOK; g.N = N; g.K = K;
    pg8::SplitOrder S; S.init(N, K, nsplit, (int)gridDim.x, vc);
    pg8::gemm_phase<Epi, pg8::SplitOrder, false>(lds, g, S, E, nullptr);
}

template <class Epi> __device__ __forceinline__ void run_gemm_main64(LAS unsigned char* lds, int vc, const bf16_t* A, const bf16_t* Bt, int N, int K, const Epi& E) {
    pg8::Gemm g; g.A = A; g.Bt = Bt; g.M = 16384; g.N = N; g.K = K;
    pg8::StaticOrder S; S.init(16384, N, K, (int)gridDim.x, vc);
    pg8::gemm_phase<Epi, pg8::StaticOrder, false>(lds, g, S, E, nullptr);
}
__device__ __forceinline__ void run_gemm_tail(LAS unsigned char* lds, int vc, const bf16_t* A, const bf16_t* Bt, int N, int K, int nsplit, float* pu) {
    pg8::Gemm g; g.A = A; g.Bt = Bt; g.M = MTOK; g.N = N; g.K = K;
    pg8::TailOrder S; S.init(N, K, nsplit, (int)gridDim.x, vc);
    EpiRaw E; E.pu = pu; E.ld = N;
    pg8::gemm_phase<EpiRaw, pg8::TailOrder, false>(lds, g, S, E, nullptr);
}

__device__ __forceinline__ void transpose_item(const float* W, int N, bf16_t* WT, int K, int k0, int srcn0, int dstn0, LAS float* scr, int lane) {
    float tv[32];
#pragma unroll
    for (int i = 0; i < 32; ++i) tv[i] = W[(size_t)(k0 + 2 * i + (lane >> 5)) * N + srcn0 + (lane & 31)];
#pragma unroll
    for (int i = 0; i < 32; ++i) scr[(2 * i + (lane >> 5)) * 33 + (lane & 31)] = tv[i];
    LDS_WAIT();
    const int c = lane & 7;
#pragma unroll
    for (int j = 0; j < 4; ++j) { const int n = (lane >> 3) + 8 * j; const LAS float* s = scr + (8 * c) * 33 + n;
        u32x4 o; o.x = cvt_pk_bf16(s[0 * 33], s[1 * 33]); o.y = cvt_pk_bf16(s[2 * 33], s[3 * 33]); o.z = cvt_pk_bf16(s[4 * 33], s[5 * 33]); o.w = cvt_pk_bf16(s[6 * 33], s[7 * 33]);
        *(u32x4*)(WT + (size_t)(dstn0 + n) * K + k0 + 8 * c) = o; }
    LDS_WAIT();
}
__device__ __forceinline__ const float* src_row(const P& p, int r) {
    if (r < MP) { const int b = r / TT, t = r - b * TT; return t < 16 ? p.in[I_META] + (size_t)t * DM : p.in[I_XP] + ((size_t)b * 2048 + (t - 16)) * DM; }
    return p.in[I_XS] + (size_t)(r - MP) * DM;
}
template <bool OUT_BF16> __device__ __forceinline__ void ln_row(const float* xrow, const float* g, const float* bta, void* orow, int lane, int nsplit = 0, const bf16_t* xres = nullptr, const float* rbias = nullptr) {
    f32x4 v[4]; float s = 0.f;
#pragma unroll
    for (int j = 0; j < 4; ++j) { v[j] = *(const f32x4*)(xrow + 4 * lane + 256 * j);
        if (nsplit > 0) { for (int k = 1; k < nsplit; ++k) v[j] += *(const f32x4*)(xrow + (size_t)k * 256 * 1024 + 4 * lane + 256 * j);
            const u32x2 xw = *(const u32x2*)(xres + 4 * lane + 256 * j); const f32x4 bv = *(const f32x4*)(rbias + 4 * lane + 256 * j);
            v[j][0] += ALPHA * bflo(xw.x) + bv[0]; v[j][1] += ALPHA * bfhi(xw.x) + bv[1]; v[j][2] += ALPHA * bflo(xw.y) + bv[2]; v[j][3] += ALPHA * bfhi(xw.y) + bv[3]; }
        s += (v[j][0] + v[j][1]) + (v[j][2] + v[j][3]); }
    const float mean = wave_sum(s) * (1.f / DM); float s2 = 0.f;
#pragma unroll
    for (int j = 0; j < 4; ++j) { v[j] = v[j] - mean; s2 += (v[j][0] * v[j][0] + v[j][1] * v[j][1]) + (v[j][2] * v[j][2] + v[j][3] * v[j][3]); }
    const float rstd = 1.f / sqrtf(wave_sum(s2) * (1.f / DM) + LN_EPS);
#pragma unroll
    for (int j = 0; j < 4; ++j) { const f32x4 gg = *(const f32x4*)(g + 4 * lane + 256 * j), bb = *(const f32x4*)(bta + 4 * lane + 256 * j);
        const f32x4 o = (v[j] * rstd) * gg + bb;
        if (OUT_BF16) { u32x2 w; w.x = cvt_pk_bf16(o[0], o[1]); w.y = cvt_pk_bf16(o[2], o[3]); *(u32x2*)((bf16_t*)orow + 4 * lane + 256 * j) = w; }
        else *(f32x4*)((float*)orow + 4 * lane + 256 * j) = o; }
}
template <bool OUT_BF16> __device__ __forceinline__ void ln_rows2(const float* xa, const float* xb, const float* g, const float* bta, void* oa, void* ob, int lane, bool vb) {
    f32x4 va[4], vbv[4]; float sa = 0.f, sb = 0.f;
#pragma unroll
    for (int j = 0; j < 4; ++j) { va[j] = *(const f32x4*)(xa + 4 * lane + 256 * j); vbv[j] = *(const f32x4*)(xb + 4 * lane + 256 * j); }
#pragma unroll
    for (int j = 0; j < 4; ++j) { sa += (va[j][0] + va[j][1]) + (va[j][2] + va[j][3]); sb += (vbv[j][0] + vbv[j][1]) + (vbv[j][2] + vbv[j][3]); }
#pragma unroll
    for (int o = 1; o < 64; o <<= 1) { sa += __shfl_xor(sa, o); sb += __shfl_xor(sb, o); }
    const float ma = sa * (1.f / DM), mb = sb * (1.f / DM); float qa = 0.f, qb = 0.f;
#pragma unroll
    for (int j = 0; j < 4; ++j) { va[j] = va[j] - ma; vbv[j] = vbv[j] - mb; qa += (va[j][0] * va[j][0] + va[j][1] * va[j][1]) + (va[j][2] * va[j][2] + va[j][3] * va[j][3]);
        qb += (vbv[j][0] * vbv[j][0] + vbv[j][1] * vbv[j][1]) + (vbv[j][2] * vbv[j][2] + vbv[j][3] * vbv[j][3]); }
#pragma unroll
    for (int o = 1; o < 64; o <<= 1) { qa += __shfl_xor(qa, o); qb += __shfl_xor(qb, o); }
    const float ra = 1.f / sqrtf(qa * (1.f / DM) + LN_EPS), rb = 1.f / sqrtf(qb * (1.f / DM) + LN_EPS);
#pragma unroll
    for (int j = 0; j < 4; ++j) { const f32x4 gg = *(const f32x4*)(g + 4 * lane + 256 * j), bb = *(const f32x4*)(bta + 4 * lane + 256 * j);
        const f32x4 o1 = (va[j] * ra) * gg + bb, o2 = (vbv[j] * rb) * gg + bb;
        if (OUT_BF16) { u32x2 w; w.x = cvt_pk_bf16(o1[0], o1[1]); w.y = cvt_pk_bf16(o1[2], o1[3]); *(u32x2*)((bf16_t*)oa + 4 * lane + 256 * j) = w;
            if (vb) { w.x = cvt_pk_bf16(o2[0], o2[1]); w.y = cvt_pk_bf16(o2[2], o2[3]); *(u32x2*)((bf16_t*)ob + 4 * lane + 256 * j) = w; } }
        else { *(f32x4*)((float*)oa + 4 * lane + 256 * j) = o1; if (vb) *(f32x4*)((float*)ob + 4 * lane + 256 * j) = o2; } }
}
template <bool OUT_BF16> __device__ __forceinline__ void ln_rows2_bf(const bf16_t* xa, const bf16_t* xb, const float* g, const float* bta, void* oa, void* ob, int lane, bool vb) {
    float va[16], vq[16]; float sa = 0.f, sb = 0.f;
    { u32x4 ra[2], rb[2];
#pragma unroll
      for (int j = 0; j < 2; ++j) { ra[j] = *(const u32x4*)(xa + 8 * lane + 512 * j); rb[j] = *(const u32x4*)(xb + 8 * lane + 512 * j); }
#pragma unroll
      for (int j = 0; j < 2; ++j) { va[8 * j] = bflo(ra[j].x); va[8 * j + 1] = bfhi(ra[j].x); va[8 * j + 2] = bflo(ra[j].y); va[8 * j + 3] = bfhi(ra[j].y); va[8 * j + 4] = bflo(ra[j].z); va[8 * j + 5] = bfhi(ra[j].z); va[8 * j + 6] = bflo(ra[j].w); va[8 * j + 7] = bfhi(ra[j].w);
          vq[8 * j] = bflo(rb[j].x); vq[8 * j + 1] = bfhi(rb[j].x); vq[8 * j + 2] = bflo(rb[j].y); vq[8 * j + 3] = bfhi(rb[j].y); vq[8 * j + 4] = bflo(rb[j].z); vq[8 * j + 5] = bfhi(rb[j].z); vq[8 * j + 6] = bflo(rb[j].w); vq[8 * j + 7] = bfhi(rb[j].w); } }
#pragma unroll
    for (int e = 0; e < 16; ++e) { sa += va[e]; sb += vq[e]; }
#pragma unroll
    for (int o = 1; o < 64; o <<= 1) { sa += __shfl_xor(sa, o); sb += __shfl_xor(sb, o); }
    const float ma = sa * (1.f / DM), mb = sb * (1.f / DM); float qa = 0.f, qb = 0.f;
#pragma unroll
    for (int e = 0; e < 16; ++e) { va[e] -= ma; vq[e] -= mb; qa += va[e] * va[e]; qb += vq[e] * vq[e]; }
#pragma unroll
    for (int o = 1; o < 64; o <<= 1) { qa += __shfl_xor(qa, o); qb += __shfl_xor(qb, o); }
    const float ra_ = 1.f / sqrtf(qa * (1.f / DM) + LN_EPS), rb_ = 1.f / sqrtf(qb * (1.f / DM) + LN_EPS);
#pragma unroll
    for (int j = 0; j < 2; ++j) { const int c = 8 * lane + 512 * j; const f32x4 g0 = *(const f32x4*)(g + c), g1 = *(const f32x4*)(g + c + 4), b0 = *(const f32x4*)(bta + c), b1 = *(const f32x4*)(bta + c + 4);
        float o1[8], o2[8];
#pragma unroll
        for (int e = 0; e < 4; ++e) { o1[e] = va[8 * j + e] * ra_ * g0[e] + b0[e]; o1[4 + e] = va[8 * j + 4 + e] * ra_ * g1[e] + b1[e]; o2[e] = vq[8 * j + e] * rb_ * g0[e] + b0[e]; o2[4 + e] = vq[8 * j + 4 + e] * rb_ * g1[e] + b1[e]; }
        if (OUT_BF16) { u32x4 w; w.x = cvt_pk_bf16(o1[0], o1[1]); w.y = cvt_pk_bf16(o1[2], o1[3]); w.z = cvt_pk_bf16(o1[4], o1[5]); w.w = cvt_pk_bf16(o1[6], o1[7]); *(u32x4*)((bf16_t*)oa + c) = w;
            if (vb) { w.x = cvt_pk_bf16(o2[0], o2[1]); w.y = cvt_pk_bf16(o2[2], o2[3]); w.z = cvt_pk_bf16(o2[4], o2[5]); w.w = cvt_pk_bf16(o2[6], o2[7]); *(u32x4*)((bf16_t*)ob + c) = w; } }
        else { *(f32x4*)((float*)oa + c) = (f32x4){o1[0], o1[1], o1[2], o1[3]}; *(f32x4*)((float*)oa + c + 4) = (f32x4){o1[4], o1[5], o1[6], o1[7]};
            if (vb) { *(f32x4*)((float*)ob + c) = (f32x4){o2[0], o2[1], o2[2], o2[3]}; *(f32x4*)((float*)ob + c + 4) = (f32x4){o2[4], o2[5], o2[6], o2[7]}; } } }
}
__device__ __forceinline__ void s5_precompute(const P& p, LAS unsigned char* lds, int g) {
    LAS float* apr = (LAS float*)lds;
    LAS float* api = apr + 17 * 64;
    LAS float* bbr = api + 17 * 64;
    LAS float* bbi = bbr + 1024;
    LAS float* cr = bbi + 1024;
    LAS float* ci = cr + 1024;
    LAS float* Kl = ci + 1024;
    int tid_ = threadIdx.x; asm volatile("" : "+v"(tid_)); const int tid = tid_;
    if (tid < 64) { const int pp = tid;
        const float dt = expf(p.in[I_SLDT][g]); const float lre = p.in[I_SLRE][g * 64 + pp], lim = p.in[I_SLIM][g * 64 + pp];
        const float mag = expf(lre * dt); const float ang = lim * dt; const float abr = mag * cosf(ang), abi = mag * sinf(ang);
        const float den = lre * lre + lim * lim, nr = abr - 1.0f, ni = abi; const float fre = (nr * lre + ni * lim) / den, fim = (ni * lre - nr * lim) / den;
        float pr = 1.f, pi = 0.f;
        for (int j = 0; j <= 16; ++j) { apr[j * 64 + pp] = pr; api[j * 64 + pp] = pi; const float nr2 = pr * abr - pi * abi, ni2 = pr * abi + pi * abr; pr = nr2; pi = ni2; }
        float* a1 = (float*)(p.ws + W_A1); float* a16 = (float*)(p.ws + W_A16); float* bbar = (float*)(p.ws + W_BBAR);
        a1[(g * 64 + pp) * 2] = abr; a1[(g * 64 + pp) * 2 + 1] = abi; a16[(g * 64 + pp) * 2] = apr[16 * 64 + pp]; a16[(g * 64 + pp) * 2 + 1] = api[16 * 64 + pp];
        for (int c = 0; c < 16; ++c) { const float br = p.in[I_SBRE][(g * 64 + pp) * 16 + c], bi = p.in[I_SBIM][(g * 64 + pp) * 16 + c];
            const float xr = fre * br - fim * bi, xi = fre * bi + fim * br; bbr[pp * 16 + c] = xr; bbi[pp * 16 + c] = xi;
            bbar[((g * 64 + pp) * 16 + c) * 2] = xr; bbar[((g * 64 + pp) * 16 + c) * 2 + 1] = xi; }
    }
    for (int i = tid; i < 1024; i += 512) { cr[i] = p.in[I_SCRE][g * 1024 + i]; ci[i] = p.in[I_SCIM][g * 1024 + i]; }
    __syncthreads();
    { const int j = tid >> 5, c1 = (tid >> 1) & 15, c0 = 8 * (tid & 1); float acc8[8];
#pragma unroll
      for (int e = 0; e < 8; ++e) acc8[e] = 0.f;
      for (int pp = 0; pp < 64; ++pp) { const float xr = cr[c1 * 64 + pp], xi = ci[c1 * 64 + pp], ar = apr[j * 64 + pp], ai = api[j * 64 + pp]; const float car = xr * ar - xi * ai, cai = xr * ai + xi * ar;
          const f32x4 r0 = *(const LAS f32x4*)(bbr + pp * 16 + c0), r1 = *(const LAS f32x4*)(bbr + pp * 16 + c0 + 4), i0 = *(const LAS f32x4*)(bbi + pp * 16 + c0), i1 = *(const LAS f32x4*)(bbi + pp * 16 + c0 + 4);
          acc8[0] += car * r0[0] - cai * i0[0]; acc8[1] += car * r0[1] - cai * i0[1]; acc8[2] += car * r0[2] - cai * i0[2]; acc8[3] += car * r0[3] - cai * i0[3];
          acc8[4] += car * r1[0] - cai * i1[0]; acc8[5] += car * r1[1] - cai * i1[1]; acc8[6] += car * r1[2] - cai * i1[2]; acc8[7] += car * r1[3] - cai * i1[3]; }
#pragma unroll
      for (int e = 0; e < 8; ++e) { float v = acc8[e]; if (j == 0 && c1 == c0 + e) v += p.in[I_SD][g * 16 + c1]; Kl[(j * 16 + c1) * 16 + c0 + e] = v; } }
    __syncthreads();
    bf16_t* W1 = (bf16_t*)(p.ws + W_W1) + (size_t)g * 128 * 256; bf16_t* W2 = (bf16_t*)(p.ws + W_W2) + (size_t)g * 256 * 384;
    for (int i = tid; i < 128 * 32; i += 512) { const int n = i >> 5, ch = i & 31, s = ch >> 1, c0 = 8 * (ch & 1), pp = n & 63; const bool im = n >= 64; float v[8];
        const float ar = apr[(15 - s) * 64 + pp], ai = api[(15 - s) * 64 + pp];
#pragma unroll
        for (int e = 0; e < 8; ++e) { const float xr = bbr[pp * 16 + c0 + e], xi = bbi[pp * 16 + c0 + e]; v[e] = im ? (ar * xi + ai * xr) : (ar * xr - ai * xi); }
        u32x4 o; o.x = cvt_pk_bf16(v[0], v[1]); o.y = cvt_pk_bf16(v[2], v[3]); o.z = cvt_pk_bf16(v[4], v[5]); o.w = cvt_pk_bf16(v[6], v[7]);
        *(u32x4*)(W1 + (size_t)n * 256 + 8 * ch) = o; }
    for (int i = tid; i < 256 * 48; i += 512) { const int n = i / 48, ch = i - n * 48, t = n >> 4, c1 = n & 15; float v[8];
        if (ch < 32) { const int s = ch >> 1, c0 = 8 * (ch & 1);
#pragma unroll
            for (int e = 0; e < 8; ++e) v[e] = (s <= t) ? Kl[((t - s) * 16 + c1) * 16 + c0 + e] : 0.f; }
        else { const bool im = ch >= 40; const int p0 = 8 * (ch - (im ? 40 : 32));
#pragma unroll
            for (int e = 0; e < 8; ++e) { const int pp = p0 + e; const float ar = apr[(t + 1) * 64 + pp], ai = api[(t + 1) * 64 + pp], xr = cr[c1 * 64 + pp], xi = ci[c1 * 64 + pp];
                v[e] = im ? -(xr * ai + xi * ar) : (xr * ar - xi * ai); } }
        u32x4 o; o.x = cvt_pk_bf16(v[0], v[1]); o.y = cvt_pk_bf16(v[2], v[3]); o.z = cvt_pk_bf16(v[4], v[5]); o.w = cvt_pk_bf16(v[6], v[7]);
        *(u32x4*)(W2 + (size_t)n * 384 + 8 * ch) = o; }
    __syncthreads();
}
template <int CLS> __device__ __forceinline__ void transposes(const P& p, LAS float* scr, int lane, int gw, int NGW) {
    constexpr int I_UP = 16 * 192, I_DN = 48 * 32, I_IN = 16 * 112, I_GL = 8 * 64, I_OU = 16 * 32, I_LR = 16 * 8;
    constexpr int NITEMS = CLS == 0 ? I_IN + I_LR : I_UP + I_DN + I_GL + I_OU;
    for (int it = gw; it < NITEMS; it += NGW) { int r = it;
        if (CLS == 0) {
            if (r < I_IN) { const int kb = r / 112, nb = r % 112; transpose_item(p.in[I_WIN], DIN, (bf16_t*)(p.ws + W_WTIN), 1024, 64 * kb, 32 * nb, 32 * nb, scr, lane); continue; } r -= I_IN;
            { const int which = r >> 6, blk = (r >> 3) & 7, kb = (r >> 2) & 1, nb = r & 3;
              transpose_item(p.in[which ? I_WI : I_WR] + blk * 16384, 128, (bf16_t*)(p.ws + (which ? W_WTI : W_WTR)) + blk * 16384, 128, 64 * kb, 32 * nb, 32 * nb, scr, lane); }
        } else {
            if (r < I_UP) { const int kb = r / 192, nb = r % 192, d0 = 32 * nb, s0 = ((d0 >> 7) & 1) * DFF + (d0 >> 8) * 128 + (d0 & 127);
                transpose_item(p.in[I_WUP], 6144, (bf16_t*)(p.ws + W_WTUP), 1024, 64 * kb, s0, d0, scr, lane); continue; } r -= I_UP;
            if (r < I_DN) { const int kb = r / 32, nb = r % 32; transpose_item(p.in[I_WDOWN], 1024, (bf16_t*)(p.ws + W_WTDOWN), 3072, 64 * kb, 32 * nb, 32 * nb, scr, lane); continue; } r -= I_DN;
            if (r < I_GL) { const int kb = r / 64, nb = r % 64, d0 = 32 * nb, s0 = ((d0 >> 7) & 1) * 1024 + (d0 >> 8) * 128 + (d0 & 127);
                transpose_item(p.in[I_WGLU], 2048, (bf16_t*)(p.ws + W_WTGLU), 512, 64 * kb, s0, d0, scr, lane); continue; } r -= I_GL;
            { const int kb = r / 32, nb = r % 32; transpose_item(p.in[I_WOUT], 1024, (bf16_t*)(p.ws + W_WTOUT), 1024, 64 * kb, 32 * nb, 32 * nb, scr, lane); }
        }
    }
}
__device__ __forceinline__ void phase0(const P& p, LAS unsigned char* lds) {
    int tid_ = threadIdx.x; asm volatile("" : "+v"(tid_)); const int tid = tid_, lane = tid & 63, wid = tid >> 6;
    REPEAT(REP_P0A) for (int g = blockIdx.x; g < NG; g += gridDim.x) s5_precompute(p, lds, g);
    LAS float* scr = (LAS float*)(lds + wid * 8704);
    const int gw = blockIdx.x * 8 + wid, NGW = gridDim.x * 8;
    { const int skip = ((int)gridDim.x >= 64) ? NG : 0;
      if ((int)blockIdx.x >= skip) REPEAT(REP_P0B) transposes<0>(p, scr, lane, ((int)blockIdx.x - skip) * 8 + wid, ((int)gridDim.x - skip) * 8); }
    { const int skip = ((int)gridDim.x >= 64) ? NG : 0;
      if ((int)blockIdx.x >= skip) { const int gw2 = ((int)blockIdx.x - skip) * 8 + wid, NGW2 = ((int)gridDim.x - skip) * 8;
        REPEAT(REP_P0C) for (int r = gw2; r < MTOK; r += 2 * NGW2) { const int r2 = r + NGW2; const bool vb = r2 < MTOK; const int rb = vb ? r2 : r;
          ln_rows2<true>(src_row(p, r), src_row(p, rb), p.in[I_EG], p.in[I_EB], (bf16_t*)(p.ws + W_XN) + (size_t)r * DM, (bf16_t*)(p.ws + W_XN) + (size_t)rb * DM, lane, vb); } } }
}

template <int MODE> __device__ __forceinline__ void lru_unit(const P& p, LAS unsigned char* lds, int b, int kc, int nb) {
    int tid_ = threadIdx.x; asm volatile("" : "+v"(tid_)); const int tid = tid_, lane = tid & 63, wid = tid >> 6, q = lane >> 4, n = lane & 15;
    int mt0, nmt, rowbase;
    if (MODE == 2) { mt0 = kc; nmt = 1; rowbase = MP; } else { mt0 = (NCHUNK * kc) >> 3; nmt = ((NCHUNK * (kc + 1)) >> 3) - mt0; rowbase = b * TT; }
    const int t0 = 16 * mt0, ntok = 16 * nmt;
    const bf16_t* proj = (const bf16_t*)(p.ws + W_PROJ);
    LAS bf16_t* xcs = (LAS bf16_t*)lds;
    LAS bf16_t* gas = (LAS bf16_t*)(lds + 73984);
    if (MODE == 2) {
        for (int it = tid; it < ntok * 16; it += 512) { const int i = it >> 4, cg8 = it & 15, c0 = nb * 128 + cg8 * 8; float a[8];
            { const f32x4 b0 = *(const f32x4*)(p.in[I_CLB] + c0), b1 = *(const f32x4*)(p.in[I_CLB] + c0 + 4); a[0] = b0[0]; a[1] = b0[1]; a[2] = b0[2]; a[3] = b0[3]; a[4] = b1[0]; a[5] = b1[1]; a[6] = b1[2]; a[7] = b1[3]; }
#pragma unroll
            for (int j = 0; j < 4; ++j) { const f32x4 w0 = *(const f32x4*)(p.in[I_CLW] + j * 1024 + c0), w1 = *(const f32x4*)(p.in[I_CLW] + j * 1024 + c0 + 4); float x[8];
                if (j < 3) { const float* cp = p.in[I_CCL] + ((size_t)(t0 + i) * 3 + j) * 1024 + c0; const f32x4 x0 = *(const f32x4*)cp, x1 = *(const f32x4*)(cp + 4);
                    x[0] = x0[0]; x[1] = x0[1]; x[2] = x0[2]; x[3] = x0[3]; x[4] = x1[0]; x[5] = x1[1]; x[6] = x1[2]; x[7] = x1[3]; }
                else { const u32x4 xv = *(const u32x4*)(proj + (size_t)(rowbase + t0 + i) * DIN + c0);
                    x[0] = bflo(xv.x); x[1] = bfhi(xv.x); x[2] = bflo(xv.y); x[3] = bfhi(xv.y); x[4] = bflo(xv.z); x[5] = bfhi(xv.z); x[6] = bflo(xv.w); x[7] = bfhi(xv.w); }
                a[0] += w0[0] * x[0]; a[1] += w0[1] * x[1]; a[2] += w0[2] * x[2]; a[3] += w0[3] * x[3]; a[4] += w1[0] * x[4]; a[5] += w1[1] * x[5]; a[6] += w1[2] * x[6]; a[7] += w1[3] * x[7]; }
            u32x4 o; o.x = cvt_pk_bf16(a[0], a[1]); o.y = cvt_pk_bf16(a[2], a[3]); o.z = cvt_pk_bf16(a[4], a[5]); o.w = cvt_pk_bf16(a[6], a[7]);
            *(LAS u32x4*)(xcs + i * 136 + cg8 * 8) = o;
            *(LAS u32x4*)(gas + i * 128 + cg8 * 8) = *(const u32x4*)(proj + (size_t)(rowbase + t0 + i) * DIN + C_GA + c0); }
    } else {
        const int cg8 = tid & 15, tr = tid >> 4, c0 = nb * 128 + cg8 * 8; float w[4][8], bs[8];
        { const f32x4 b0 = *(const f32x4*)(p.in[I_CLB] + c0), b1 = *(const f32x4*)(p.in[I_CLB] + c0 + 4); bs[0] = b0[0]; bs[1] = b0[1]; bs[2] = b0[2]; bs[3] = b0[3]; bs[4] = b1[0]; bs[5] = b1[1]; bs[6] = b1[2]; bs[7] = b1[3]; }
#pragma unroll
        for (int j = 0; j < 4; ++j) { const f32x4 w0 = *(const f32x4*)(p.in[I_CLW] + j * 1024 + c0), w1 = *(const f32x4*)(p.in[I_CLW] + j * 1024 + c0 + 4);
            w[j][0] = w0[0]; w[j][1] = w0[1]; w[j][2] = w0[2]; w[j][3] = w0[3]; w[j][4] = w1[0]; w[j][5] = w1[1]; w[j][6] = w1[2]; w[j][7] = w1[3]; }
        const int i0 = tr * 9; int i1 = i0 + 9; if (i1 > ntok) i1 = ntok;
        u32x4 xr[12], gr[9];
#pragma unroll
        for (int k = 0; k < 12; ++k) { const int i = i0 - 3 + k, t = t0 + i; xr[k] = (u32x4){0u, 0u, 0u, 0u}; if (t >= 0 && i < i1) xr[k] = *(const u32x4*)(proj + (size_t)(rowbase + t) * DIN + c0); }
#pragma unroll
        for (int k = 0; k < 9; ++k) { gr[k] = (u32x4){0u, 0u, 0u, 0u}; if (i0 + k < i1) gr[k] = *(const u32x4*)(proj + (size_t)(rowbase + t0 + i0 + k) * DIN + C_GA + c0); }
#pragma unroll
        for (int k = 0; k < 9; ++k) { if (i0 + k < i1) { float a[8];
#pragma unroll
            for (int e = 0; e < 8; ++e) a[e] = bs[e];
#pragma unroll
            for (int j = 0; j < 4; ++j) { const u32x4 xv = xr[k + j];
                a[0] += w[j][0] * bflo(xv.x); a[1] += w[j][1] * bfhi(xv.x); a[2] += w[j][2] * bflo(xv.y); a[3] += w[j][3] * bfhi(xv.y);
                a[4] += w[j][4] * bflo(xv.z); a[5] += w[j][5] * bfhi(xv.z); a[6] += w[j][6] * bflo(xv.w); a[7] += w[j][7] * bfhi(xv.w); }
            u32x4 o; o.x = cvt_pk_bf16(a[0], a[1]); o.y = cvt_pk_bf16(a[2], a[3]); o.z = cvt_pk_bf16(a[4], a[5]); o.w = cvt_pk_bf16(a[6], a[7]);
            *(LAS u32x4*)(xcs + (i0 + k) * 136 + cg8 * 8) = o; *(LAS u32x4*)(gas + (i0 + k) * 128 + cg8 * 8) = gr[k]; } }
    }
    __syncthreads();
    const int c = nb * 128 + wid * 16 + n;
    bf16x8 Br[4], Bi[4];
    { const bf16_t* wr_ = (const bf16_t*)(p.ws + W_WTR) + (size_t)c * 128 + q * 8; const bf16_t* wi_ = (const bf16_t*)(p.ws + W_WTI) + (size_t)c * 128 + q * 8;
#pragma unroll
      for (int kk = 0; kk < 4; ++kk) { Br[kk] = *(const bf16x8*)(wr_ + 32 * kk); Bi[kk] = *(const bf16x8*)(wi_ + 32 * kk); } }
    const float br = p.in[I_BR][c], bi = p.in[I_BI][c]; const float c8 = -8.0f * log1pf(expf(-p.in[I_LAM][c]));
    bf16_t* M1 = (bf16_t*)(p.ws + W_MIX); bf16_t* M2 = (bf16_t*)(p.out + O_YP);
    float h_run = 0.f, A_run = 1.f;
    for (int mt = 0; mt < nmt; ++mt) {
        f32x4 accr = {0.f, 0.f, 0.f, 0.f}, acci = {0.f, 0.f, 0.f, 0.f};
#pragma unroll
        for (int kk = 0; kk < 4; ++kk) { const bf16x8 Af = *(const LAS bf16x8*)(xcs + (16 * mt + n) * 136 + 32 * kk + 8 * q);
            accr = __builtin_amdgcn_mfma_f32_16x16x32_bf16(Af, Br[kk], accr, 0, 0, 0); acci = __builtin_amdgcn_mfma_f32_16x16x32_bf16(Af, Bi[kk], acci, 0, 0, 0); }
        float a[4], bx[4], ga[4];
#pragma unroll
        for (int j = 0; j < 4; ++j) { const int tok = 16 * mt + 4 * q + j; const float xcv = bf2f(xcs[tok * 136 + wid * 16 + n]);
            ga[j] = bf2f(gas[tok * 128 + wid * 16 + n]);
            const float r = sigm(accr[j] + br), ig = sigm(acci[j] + bi), la = c8 * r; a[j] = __expf(la); bx[j] = __builtin_amdgcn_sqrtf(fmaf(-a[j], a[j], 1.0f)) * (ig * xcv); }
        float h[4], Ac[4];
        if (MODE == 2) {
#pragma unroll
            for (int j = 0; j < 4; ++j) { const int s = t0 + 16 * mt + 4 * q + j; h[j] = a[j] * p.in[I_SL][(size_t)s * 1024 + c] + bx[j]; p.out[O_SL + (size_t)s * 1024 + c] = h[j]; Ac[j] = 0.f; }
        } else {
            float Ap[4]; h[0] = bx[0]; Ap[0] = a[0];
#pragma unroll
            for (int j = 1; j < 4; ++j) { h[j] = a[j] * h[j - 1] + bx[j]; Ap[j] = a[j] * Ap[j - 1]; }
            float PA = Ap[3], PH = h[3];
            float tA = __shfl_up(PA, 16), tH = __shfl_up(PH, 16); if (q >= 1) { PH = PA * tH + PH; PA = PA * tA; }
            tA = __shfl_up(PA, 32); tH = __shfl_up(PH, 32); if (q >= 2) { PH = PA * tH + PH; PA = PA * tA; }
            const float h_end = PA * h_run + PH; const float hin_s = __shfl_up(h_end, 16), pae_s = __shfl_up(PA, 16);
            const float h_in = (q == 0) ? h_run : hin_s; const float a_in = A_run * ((q == 0) ? 1.0f : pae_s);
#pragma unroll
            for (int j = 0; j < 4; ++j) { h[j] += Ap[j] * h_in; Ac[j] = Ap[j] * a_in; }
            h_run = __shfl(h_end, 48 + n); A_run *= __shfl(PA, 48 + n);
        }
#pragma unroll
        for (int j = 0; j < 4; ++j) { const size_t row = (size_t)(rowbase + t0 + 16 * mt + 4 * q + j); const float sg = sigm(ga[j]);
            M1[row * 1024 + c] = f2bf(sg * h[j]); M2[row * 1024 + c] = f2bf(sg * Ac[j]); }
    }
    if (MODE == 0 && q == 0) { ((float*)(p.ws + W_LRUA))[(size_t)(b * 8 + kc) * 1024 + c] = A_run; ((float*)(p.ws + W_LRUH))[(size_t)(b * 8 + kc) * 1024 + c] = h_run; }
    __syncthreads();
}

template <int PASS> __device__ __forceinline__ void s5_item(const P& p, int g, int sub, int lane, int wid) {
    constexpr int KS = (PASS == 1) ? 8 : 12, NTW = (PASS == 1) ? 1 : 2, LDW = (PASS == 1) ? 256 : 384;
    const int n = lane & 15, q = lane >> 4;
    const bf16_t* proj = (const bf16_t*)(p.ws + W_PROJ);
    const bf16_t* W = (PASS == 1) ? (const bf16_t*)(p.ws + W_W1) + (size_t)g * 128 * 256 : (const bf16_t*)(p.ws + W_W2) + (size_t)g * 256 * 384;
    bf16x8 Bf[NTW][KS];
#pragma unroll
    for (int i = 0; i < NTW; ++i)
#pragma unroll
        for (int kk = 0; kk < KS; ++kk) Bf[i][kk] = *(const bf16x8*)(W + (size_t)(16 * (NTW * wid + i) + n) * LDW + 32 * kk + 8 * q);
    const int rt0 = (65 * sub) >> 3, rt1 = (65 * (sub + 1)) >> 3; const bf16x8 zero = {0, 0, 0, 0, 0, 0, 0, 0};
    for (int rt = rt0; rt < rt1; ++rt) {
        const int R = 16 * rt + n; const bool valid = R < NR; const int Rc = valid ? R : 0; const int b = Rc / NCHUNK, k = Rc - b * NCHUNK;
        bf16x8 Af[KS];
        { const bf16_t* ub = proj + (size_t)(b * TT + 16 * k) * DIN + C_US + 16 * g + 8 * (q & 1);
#pragma unroll
          for (int kk = 0; kk < 8; ++kk) { const int s = 2 * kk + (q >> 1); Af[kk] = valid ? *(const bf16x8*)(ub + (size_t)s * DIN) : zero; } }
        if (PASS == 3) { const bf16_t* hb = (const bf16_t*)(p.ws + W_HPREV) + ((size_t)Rc * NG + g) * 128 + 8 * q;
#pragma unroll
          for (int kk = 8; kk < KS; ++kk) Af[kk] = valid ? *(const bf16x8*)(hb + 32 * (kk - 8)) : zero; }
        f32x4 acc[NTW];
#pragma unroll
        for (int i = 0; i < NTW; ++i) { acc[i] = (f32x4){0.f, 0.f, 0.f, 0.f};
#pragma unroll
            for (int kk = 0; kk < KS; ++kk) acc[i] = __builtin_amdgcn_mfma_f32_16x16x32_bf16(Af[kk], Bf[i][kk], acc[i], 0, 0, 0); }
#pragma unroll
        for (int j = 0; j < 4; ++j) { const int R2 = 16 * rt + 4 * q + j; if (R2 < NR) {
            if (PASS == 1) { ((float*)(p.ws + W_S))[((size_t)R2 * NG + g) * 128 + 16 * wid + n] = acc[0][j]; }
            else { const int b2 = R2 / NCHUNK, k2 = R2 - b2 * NCHUNK; bf16_t* Y = (bf16_t*)(p.ws + W_YSG) + (size_t)(b2 * TT + 16 * k2) * DSSM + 16 * g + n;
#pragma unroll
                for (int i = 0; i < NTW; ++i) Y[(size_t)(NTW * wid + i) * DSSM] = f2bf(gelu_tanh(acc[i][j])); } } }
    }
}
__device__ __forceinline__ void s5_fused(const P& p, LAS unsigned char* lds, int g, int b) {
    int tid_ = threadIdx.x; asm volatile("" : "+v"(tid_)); const int tid = tid_, lane = tid & 63, wid = tid >> 6, n = lane & 15, q = lane >> 4;
    LAS bf16_t* Us = (LAS bf16_t*)lds;
    LAS float* Ssm = (LAS float*)(lds + 68112);
    LAS bf16_t* Hs = (LAS bf16_t*)(lds + 68112);
    const bf16_t* proj = (const bf16_t*)(p.ws + W_PROJ); const bf16x8 zero = {0, 0, 0, 0, 0, 0, 0, 0};
    TIMED(231) { const bf16_t* ub = proj + (size_t)(b * TT) * DIN + C_US + 16 * g;
      u32x4 tv[9];
#pragma unroll
      for (int i = 0; i < 9; ++i) { const int it = tid + 512 * i; tv[i] = (u32x4){0u, 0u, 0u, 0u}; if (it < TT * 2) tv[i] = *(const u32x4*)(ub + (size_t)(it >> 1) * DIN + 8 * (it & 1)); }
#pragma unroll
      for (int i = 0; i < 9; ++i) { const int it = tid + 512 * i; if (it < TT * 2) { const int t = it >> 1; *(LAS u32x4*)(Us + (t >> 4) * 264 + (t & 15) * 16 + 8 * (it & 1)) = tv[i]; } } }
    __syncthreads();
    TIMED_END(231)
    TIMED(232) { const bf16_t* W = (const bf16_t*)(p.ws + W_W1) + (size_t)g * 128 * 256; bf16x8 Bf[8];
#pragma unroll
      for (int kk = 0; kk < 8; ++kk) Bf[kk] = *(const bf16x8*)(W + (size_t)(16 * wid + n) * 256 + 32 * kk + 8 * q);
#pragma unroll 1
      for (int rt = 0; rt < 9; ++rt) { const int k = 16 * rt + n; const bool valid = k < NCHUNK; const int kc = valid ? k : 0; f32x4 acc = {0.f, 0.f, 0.f, 0.f};
#pragma unroll
          for (int kk = 0; kk < 8; ++kk) { const bf16x8 uv = *(const LAS bf16x8*)(Us + kc * 264 + 32 * kk + 8 * q); const bf16x8 Af = valid ? uv : zero;
              acc = __builtin_amdgcn_mfma_f32_16x16x32_bf16(Af, Bf[kk], acc, 0, 0, 0); }
#pragma unroll
          for (int j = 0; j < 4; ++j) Ssm[(16 * rt + 4 * q + j) * 128 + 16 * wid + n] = acc[j]; } }
    __syncthreads();
    TIMED_END(232)
    bf16x8 Bw[2][12];
    { const bf16_t* W = (const bf16_t*)(p.ws + W_W2) + (size_t)g * 256 * 384;
#pragma unroll
      for (int i = 0; i < 2; ++i)
#pragma unroll
          for (int kk = 0; kk < 12; ++kk) Bw[i][kk] = *(const bf16x8*)(W + (size_t)(16 * (2 * wid + i) + n) * 384 + 32 * kk + 8 * q); }
    TIMED(233) if (wid == 0) { const float* a16 = (const float*)(p.ws + W_A16) + (g * 64 + lane) * 2; const float ar = a16[0], ai = a16[1]; float hr = 0.f, hi = 0.f;
#pragma unroll 1
        for (int kb = 0; kb < 132; kb += 4) { float sr[4], si[4];
#pragma unroll
            for (int u = 0; u < 4; ++u) { sr[u] = Ssm[(kb + u) * 128 + lane]; si[u] = Ssm[(kb + u) * 128 + 64 + lane]; }
            LDS_WAIT();
#pragma unroll
            for (int u = 0; u < 4; ++u) { const int k = kb + u; if (k < NCHUNK) { Hs[k * 136 + lane] = f2bf(hr); Hs[k * 136 + 64 + lane] = f2bf(hi);
                const float nr = ar * hr - ai * hi + sr[u], ni = ar * hi + ai * hr + si[u]; hr = nr; hi = ni; } } }
        p.out[O_PSR + ((size_t)b * NG + g) * 64 + lane] = hr; p.out[O_PSI + ((size_t)b * NG + g) * 64 + lane] = hi; }
    __syncthreads();
    TIMED_END(233)
    TIMED(234)
    {
#pragma unroll 1
      for (int rt = 0; rt < 9; ++rt) { const int k = 16 * rt + n; const bool valid = k < NCHUNK; const int kc = valid ? k : 0; f32x4 acc0 = {0.f, 0.f, 0.f, 0.f}, acc1 = {0.f, 0.f, 0.f, 0.f};
#pragma unroll
          for (int kk = 0; kk < 8; ++kk) { const bf16x8 uv = *(const LAS bf16x8*)(Us + kc * 264 + 32 * kk + 8 * q); const bf16x8 af = valid ? uv : zero;
              acc0 = __builtin_amdgcn_mfma_f32_16x16x32_bf16(af, Bw[0][kk], acc0, 0, 0, 0); acc1 = __builtin_amdgcn_mfma_f32_16x16x32_bf16(af, Bw[1][kk], acc1, 0, 0, 0); }
#pragma unroll
          for (int kk = 8; kk < 12; ++kk) { const bf16x8 hv = *(const LAS bf16x8*)(Hs + kc * 136 + 32 * (kk - 8) + 8 * q); const bf16x8 af = valid ? hv : zero;
              acc0 = __builtin_amdgcn_mfma_f32_16x16x32_bf16(af, Bw[0][kk], acc0, 0, 0, 0); acc1 = __builtin_amdgcn_mfma_f32_16x16x32_bf16(af, Bw[1][kk], acc1, 0, 0, 0); }
#pragma unroll
          for (int j = 0; j < 4; ++j) { const int k2 = 16 * rt + 4 * q + j; if (k2 < NCHUNK) { bf16_t* Y = (bf16_t*)(p.ws + W_YSG) + (size_t)(b * TT + 16 * k2 + 2 * wid) * DSSM + 16 * g + n;
              Y[0] = f2bf(gelu_tanh(acc0[j])); Y[DSSM] = f2bf(gelu_tanh(acc1[j])); } } } }
    TIMED_END(234)
}
__device__ __forceinline__ void s5_sample(const P& p, int s, int g, int lane) {
    const bf16_t* proj = (const bf16_t*)(p.ws + W_PROJ); const bf16_t* up = proj + (size_t)(MP + s) * DIN + C_US + 16 * g;
    const u32x4 u0 = *(const u32x4*)up, u1 = *(const u32x4*)(up + 8); float u[16];
    u[0] = bflo(u0.x); u[1] = bfhi(u0.x); u[2] = bflo(u0.y); u[3] = bfhi(u0.y); u[4] = bflo(u0.z); u[5] = bfhi(u0.z); u[6] = bflo(u0.w); u[7] = bfhi(u0.w);
    u[8] = bflo(u1.x); u[9] = bfhi(u1.x); u[10] = bflo(u1.y); u[11] = bfhi(u1.y); u[12] = bflo(u1.z); u[13] = bfhi(u1.z); u[14] = bflo(u1.w); u[15] = bfhi(u1.w);
    const float* a1 = (const float*)(p.ws + W_A1) + (g * 64 + lane) * 2; const float ar = a1[0], ai = a1[1];
    const float* bb = (const float*)(p.ws + W_BBAR) + (size_t)(g * 64 + lane) * 32; float bur = 0.f, bui = 0.f;
#pragma unroll
    for (int c = 0; c < 16; ++c) { bur += bb[2 * c] * u[c]; bui += bb[2 * c + 1] * u[c]; }
    const size_t si = ((size_t)s * NG + g) * 64 + lane; const float h0r = p.in[I_SSR][si], h0i = p.in[I_SSI][si];
    const float hr = ar * h0r - ai * h0i + bur, hi = ar * h0i + ai * h0r + bui;
    p.out[O_SSR + si] = hr; p.out[O_SSI + si] = hi;
    float v16[16];
#pragma unroll
    for (int c1 = 0; c1 < 16; ++c1) v16[c1] = p.in[I_SCRE][(g * 16 + c1) * 64 + lane] * hr - p.in[I_SCIM][(g * 16 + c1) * 64 + lane] * hi;
    float v8[8], v4[4], v2[2], v1;
    { const bool hi32 = (lane & 32) != 0;
#pragma unroll
      for (int i = 0; i < 8; ++i) { const float keep = hi32 ? v16[i + 8] : v16[i], send = hi32 ? v16[i] : v16[i + 8]; v8[i] = keep + __shfl_xor(send, 32); } }
    { const bool hb = (lane & 16) != 0;
#pragma unroll
      for (int i = 0; i < 4; ++i) { const float keep = hb ? v8[i + 4] : v8[i], send = hb ? v8[i] : v8[i + 4]; v4[i] = keep + __shfl_xor(send, 16); } }
    { const bool hb = (lane & 8) != 0;
#pragma unroll
      for (int i = 0; i < 2; ++i) { const float keep = hb ? v4[i + 2] : v4[i], send = hb ? v4[i] : v4[i + 2]; v2[i] = keep + __shfl_xor(send, 8); } }
    { const bool hb = (lane & 4) != 0; const float keep = hb ? v2[1] : v2[0], send = hb ? v2[0] : v2[1]; v1 = keep + __shfl_xor(send, 4); }
    v1 += __shfl_xor(v1, 1); v1 += __shfl_xor(v1, 2);
    const int c1 = ((lane >> 5) & 1) * 8 + ((lane >> 4) & 1) * 4 + ((lane >> 3) & 1) * 2 + ((lane >> 2) & 1);
    if ((lane & 3) == 0) { const float uc = bf2f(up[c1]); const float yv = v1 + p.in[I_SD][g * 16 + c1] * uc;
        ((bf16_t*)(p.ws + W_YSG))[(size_t)(MP + s) * DSSM + 16 * g + c1] = f2bf(gelu_tanh(yv)); }
}
__device__ __forceinline__ void phase2a(const P& p, LAS unsigned char* lds) {
    TIMED(22) for (int u = blockIdx.x; u < 512; u += gridDim.x) lru_unit<0>(p, lds, (u >> 3) & 7, u >> 6, u & 7); TIMED_END(22)
    TIMED(23) for (int it = blockIdx.x; it < NG * NBATCH; it += gridDim.x) s5_fused(p, lds, it & 31, it >> 5); TIMED_END(23)
}
__device__ __forceinline__ void phase2b(const P& p, LAS unsigned char* lds) {
    int tid_ = threadIdx.x; asm volatile("" : "+v"(tid_)); const int tid = tid_, lane = tid & 63, wid = tid >> 6;
    const size_t gt = (size_t)blockIdx.x * 512 + tid, GT = (size_t)gridDim.x * 512;
    for (size_t i = gt; i < (size_t)NBATCH * 1024; i += GT) { const int b = (int)(i >> 10), c = (int)(i & 1023); float h = 0.f;
        const float* A = (const float*)(p.ws + W_LRUA); const float* Hh = (const float*)(p.ws + W_LRUH); float* Cc = (float*)(p.ws + W_LRUC);
        for (int kc = 0; kc < 8; ++kc) { const size_t o = (size_t)(b * 8 + kc) * 1024 + c; Cc[o] = h; h = A[o] * h + Hh[o]; }
        p.out[O_PL + i] = h; }
    for (int u = (int)gridDim.x - 1 - (int)blockIdx.x; u < 64; u += gridDim.x) lru_unit<2>(p, lds, 0, u >> 3, u & 7);
    for (int it = blockIdx.x * 8 + wid; it < NSAMP * NG; it += gridDim.x * 8) s5_sample(p, it >> 5, it & 31, lane);
    const bf16_t* proj = (const bf16_t*)(p.ws + W_PROJ);
    for (size_t i = gt; i < (size_t)NBATCH * 3 * 1024; i += GT) { const int c = (int)(i & 1023), j = (int)((i >> 10) % 3), b = (int)(i / 3072);
        p.out[O_PCL + i] = bf2f(proj[(size_t)(b * TT + TT - 3 + j) * DIN + c]); }
    for (size_t i = gt; i < (size_t)NSAMP * 3 * 1024; i += GT) { const int c = (int)(i & 1023), j = (int)((i >> 10) % 3), s = (int)(i / 3072);
        p.out[O_SCL + i] = (j < 2) ? p.in[I_CCL][((size_t)s * 3 + j + 1) * 1024 + c] : bf2f(proj[(size_t)(MP + s) * DIN + c]); }
    for (size_t i = gt; i < (size_t)NSAMP * DFF; i += GT) { const int ch = (int)(i % DFF), s = (int)(i / DFF);
        p.out[O_SCF + ((size_t)s * 2) * DFF + ch] = p.in[I_CCF][((size_t)s * 2 + 1) * DFF + ch]; }
}
__device__ __forceinline__ void phase2c(const P& p, LAS unsigned char* lds) {
    const int lane = threadIdx.x & 63, wid = threadIdx.x >> 6;
    for (int it = blockIdx.x; it < NG * 8; it += gridDim.x) s5_item<3>(p, it >> 3, it & 7, lane, wid);
}
__device__ __forceinline__ void phase_glutail(const P& p) {
    const size_t gt = (size_t)blockIdx.x * 512 + threadIdx.x, GT = (size_t)gridDim.x * 512;
    const float* pg = (const float*)(p.ws + W_PG); const float* bias = p.in[I_BGLU]; const bf16_t* proj = (const bf16_t*)(p.ws + W_PROJ);
    bf16_t* mix = (bf16_t*)(p.ws + W_MIX); const bf16_t* m2 = (const bf16_t*)(p.out + O_YP); const float* carry = (const float*)(p.ws + W_LRUC);
    for (size_t it = gt; it < (size_t)256 * 256; it += GT) { const int rl = (int)(it >> 8), j = (int)(it & 255) * 4, rowi = 16384 + rl; const size_t row = (size_t)rowi; const int col = 256 * (j >> 7) + (j & 127);
        f32x4 val = *(const f32x4*)(bias + j), gate = *(const f32x4*)(bias + 1024 + j);
#pragma unroll
        for (int ks = 0; ks < 2; ++ks) { val += *(const f32x4*)(pg + (size_t)ks * 256 * 2048 + (size_t)rl * 2048 + col); gate += *(const f32x4*)(pg + (size_t)ks * 256 * 2048 + (size_t)rl * 2048 + col + 128); }
        int cidx = 0; if (rowi < MP) { const int b = rowi / TT, t = rowi - b * TT; int kc = t >> 8; kc = kc > 7 ? 7 : kc; cidx = (b * 8 + kc) * 1024; }
        const f32x4 cv = *(const f32x4*)(carry + cidx + j); const u32x2 gbw = *(const u32x2*)(proj + row * DIN + C_GB + j), mw = *(const u32x2*)(mix + row * 1024 + j), m2w = *(const u32x2*)(m2 + row * 1024 + j);
        const float o0 = bflo(mw.x) + bflo(m2w.x) * cv[0] + sigm(bflo(gbw.x)) * val[0] * sigm(gate[0]), o1 = bfhi(mw.x) + bfhi(m2w.x) * cv[1] + sigm(bfhi(gbw.x)) * val[1] * sigm(gate[1]);
        const float o2 = bflo(mw.y) + bflo(m2w.y) * cv[2] + sigm(bflo(gbw.y)) * val[2] * sigm(gate[2]), o3 = bfhi(mw.y) + bfhi(m2w.y) * cv[3] + sigm(bfhi(gbw.y)) * val[3] * sigm(gate[3]);
        u32x2 w; w.x = cvt_pk_bf16(o0, o1); w.y = cvt_pk_bf16(o2, o3); *(u32x2*)(mix + row * 1024 + j) = w; }
}
__device__ __forceinline__ void phase_ln1(const P& p) {
    const int lane = threadIdx.x & 63, wid = threadIdx.x >> 6; const int gw = blockIdx.x * 8 + wid, NGW = gridDim.x * 8;
    const bf16_t* R = (const bf16_t*)(p.ws + W_R1); bf16_t* X = (bf16_t*)(p.ws + W_XN);
    for (int r = gw; r < 16384; r += 2 * NGW) { const int r2 = r + NGW; const bool vb = r2 < 16384; const int rb = vb ? r2 : r;
        ln_rows2_bf<true>(R + (size_t)r * DM, R + (size_t)rb * DM, p.in[I_L1G], p.in[I_L1B], X + (size_t)r * DM, X + (size_t)rb * DM, lane, vb); }
    for (int r = 16384 + gw; r < MTOK; r += NGW) { bf16_t* xr = X + (size_t)r * DM;
        ln_row<true>((const float*)(p.ws + W_PART) + (size_t)(r - 16384) * DM, p.in[I_L1G], p.in[I_L1B], xr, lane, 4, xr, p.in[I_BOUT]); }
}
__device__ __forceinline__ void phase_ffnfix(const P& p) {
    const size_t gt = (size_t)blockIdx.x * 512 + threadIdx.x, GT = (size_t)gridDim.x * 512;
    const float* sbg = (const float*)(p.ws + W_SBG); const float* sbv = (const float*)(p.ws + W_SBV); bf16_t* H = (bf16_t*)(p.ws + W_V);
    for (size_t it = gt; it < (size_t)256 * 2 * 384; it += GT) { const int cg8 = (int)(it % 384), rr = (int)((it / 384) & 1), blk = (int)(it / 768), ch = cg8 * 8, row = blk * 64 + rr; const int t = row % TT;
        float o[8];
#pragma unroll
        for (int hh = 0; hh < 2; ++hh) { const int c = ch + 4 * hh; const f32x4 z = {0.f, 0.f, 0.f, 0.f};
            const f32x4 g0 = *(const f32x4*)(sbg + ((size_t)blk * 4 + rr) * DFF + c), v = *(const f32x4*)(sbv + ((size_t)blk * 2 + rr) * DFF + c);
            f32x4 g1, g2;
            if (rr == 0) { g1 = (blk > 0 && t >= 1) ? *(const f32x4*)(sbg + ((size_t)(blk - 1) * 4 + 3) * DFF + c) : z; g2 = (blk > 0 && t >= 2) ? *(const f32x4*)(sbg + ((size_t)(blk - 1) * 4 + 2) * DFF + c) : z; }
            else { g1 = (t >= 1) ? *(const f32x4*)(sbg + ((size_t)blk * 4) * DFF + c) : z; g2 = (blk > 0 && t >= 2) ? *(const f32x4*)(sbg + ((size_t)(blk - 1) * 4 + 3) * DFF + c) : z; }
            const f32x4 w0 = *(const f32x4*)(p.in[I_FCW] + c), w1 = *(const f32x4*)(p.in[I_FCW] + DFF + c), w2 = *(const f32x4*)(p.in[I_FCW] + 2 * DFF + c), cbv = *(const f32x4*)(p.in[I_FCB] + c);
            const f32x4 y = cbv + w0 * g2 + w1 * g1 + w2 * g0;
            o[4 * hh] = gelu_tanh(y[0]) * v[0]; o[4 * hh + 1] = gelu_tanh(y[1]) * v[1]; o[4 * hh + 2] = gelu_tanh(y[2]) * v[2]; o[4 * hh + 3] = gelu_tanh(y[3]) * v[3]; }
        u32x4 w; w.x = cvt_pk_bf16(o[0], o[1]); w.y = cvt_pk_bf16(o[2], o[3]); w.z = cvt_pk_bf16(o[4], o[5]); w.w = cvt_pk_bf16(o[6], o[7]);
        *(u32x4*)(H + (size_t)row * DFF + ch) = w; }
}
__device__ __forceinline__ f32x4 up_tail_sum(const float* pu, const float* bias, int rl, int col, int bcol) {
    f32x4 v = *(const f32x4*)(bias + bcol);
#pragma unroll
    for (int ks = 0; ks < 4; ++ks) v += *(const f32x4*)(pu + (size_t)ks * 256 * 6144 + (size_t)rl * 6144 + col);
    return v;
}
__device__ __forceinline__ void phase_ffntail(const P& p) {
    const size_t gt = (size_t)blockIdx.x * 512 + threadIdx.x, GT = (size_t)gridDim.x * 512;
    const float* pu = (const float*)(p.ws + W_PU); const float* sbg = (const float*)(p.ws + W_SBG); bf16_t* H = (bf16_t*)(p.ws + W_V); const float* bias = p.in[I_BUP];
    for (size_t it = gt; it < (size_t)256 * 768; it += GT) { const int rl = (int)(it / 768), ch = (int)(it - (size_t)rl * 768) * 4, row = 16384 + rl; const int colg = 256 * (ch >> 7) + (ch & 127);
        const f32x4 g0 = up_tail_sum(pu, bias, rl, colg, ch), v = up_tail_sum(pu, bias, rl, colg + 128, DFF + ch); f32x4 g1, g2;
        if (row >= MP) { const int s_ = row - MP; g2 = *(const f32x4*)(p.in[I_CCF] + ((size_t)s_ * 2) * DFF + ch); g1 = *(const f32x4*)(p.in[I_CCF] + ((size_t)s_ * 2 + 1) * DFF + ch);
            *(f32x4*)(p.out + O_SCF + ((size_t)s_ * 2 + 1) * DFF + ch) = g0; }
        else {
            g1 = (rl >= 1) ? up_tail_sum(pu, bias, rl - 1, colg, ch) : *(const f32x4*)(sbg + ((size_t)255 * 4 + 3) * DFF + ch);
            g2 = (rl >= 2) ? up_tail_sum(pu, bias, rl - 2, colg, ch) : *(const f32x4*)(sbg + ((size_t)255 * 4 + 2 + rl) * DFF + ch);
            const int t = row - 7 * TT; if (t >= TT - 2) *(f32x4*)(p.out + O_PCF + ((size_t)7 * 2 + (t - (TT - 2))) * DFF + ch) = g0; }
        const f32x4 w0 = *(const f32x4*)(p.in[I_FCW] + ch), w1 = *(const f32x4*)(p.in[I_FCW] + DFF + ch), w2 = *(const f32x4*)(p.in[I_FCW] + 2 * DFF + ch), cbv = *(const f32x4*)(p.in[I_FCB] + ch);
        const f32x4 y = cbv + w0 * g2 + w1 * g1 + w2 * g0;
        u32x2 w; w.x = cvt_pk_bf16(gelu_tanh(y[0]) * v[0], gelu_tanh(y[1]) * v[1]); w.y = cvt_pk_bf16(gelu_tanh(y[2]) * v[2], gelu_tanh(y[3]) * v[3]);
        *(u32x2*)(H + (size_t)row * DFF + ch) = w; }
}
__device__ __forceinline__ float* y_row(const P& p, int r) {
    if (r >= MP) return p.out + O_YS + (size_t)(r - MP) * DM;
    const int b = r / TT, t = r - b * TT; return t < 16 ? nullptr : p.out + O_YP + ((size_t)b * 2048 + (t - 16)) * DM;
}
__device__ __forceinline__ void phase_ln2(const P& p) {
    const int lane = threadIdx.x & 63, wid = threadIdx.x >> 6; const int gw = blockIdx.x * 8 + wid, NGW = gridDim.x * 8;
    const bf16_t* R = (const bf16_t*)(p.ws + W_R2);
    for (int r = gw; r < 16384; r += 2 * NGW) { const int r2 = r + NGW; float* oa = y_row(p, r); float* ob = (r2 < 16384) ? y_row(p, r2) : nullptr;
        if (oa && ob) ln_rows2_bf<false>(R + (size_t)r * DM, R + (size_t)r2 * DM, p.in[I_L2G], p.in[I_L2B], oa, ob, lane, true);
        else if (oa) ln_rows2_bf<false>(R + (size_t)r * DM, R + (size_t)r * DM, p.in[I_L2G], p.in[I_L2B], oa, oa, lane, false);
        else if (ob) ln_rows2_bf<false>(R + (size_t)r2 * DM, R + (size_t)r2 * DM, p.in[I_L2G], p.in[I_L2B], ob, ob, lane, false); }
    for (int r = 16384 + gw; r < MTOK; r += NGW) { float* o = y_row(p, r);
        if (o) ln_row<false>((const float*)(p.ws + W_PART) + (size_t)(r - 16384) * DM, p.in[I_L2G], p.in[I_L2B], o, lane, 12, (const bf16_t*)(p.ws + W_XN) + (size_t)r * DM, p.in[I_BDOWN]); }
}

__global__ __launch_bounds__(512, 2) void hawk_fwd(P p) {
    extern __shared__ __attribute__((aligned(16))) unsigned char shm[];
    LAS unsigned char* lds = (LAS unsigned char*)shm;
    cg::grid_group grid = cg::this_grid();
    volatile LAS unsigned* xst = (volatile LAS unsigned*)(lds + LDS_TOTAL - 16);
    if (threadIdx.x < 4) xst[threadIdx.x] = 0u;
    __syncthreads();
    XcdBarrier xb = xcd_barrier_post((unsigned*)(p.ws + W_BAR), xst);
    if (threadIdx.x == 0) xst[2] = xb_add((unsigned*)(p.ws + W_BAR) + XCD_BAR_WORDS + 64 * xb.x, 1u);
#define GSYNC() xcd_barrier(xb)
    if (p.ws == nullptr) grid.sync();
    TIMED(0) REPEAT(REP_P0) { phase0(p, lds); GSYNC(); } TIMED_END(0)
    if (threadIdx.x == 0) { unsigned* bar = (unsigned*)(p.ws + W_BAR); bool ok = (gridDim.x % 8u) == 0u;
        for (unsigned j = 0; j < 16; ++j) { const unsigned cnt = xb_ld(&bar[XB_XCNT(j)]); if (cnt != (j < 8 ? gridDim.x / 8u : 0u)) ok = false; }
        xst[3] = ok ? (xst[2] * 8u + xb.x) : blockIdx.x; }
    __syncthreads();
    const int vc = (int)xst[3];
    TIMED(1) REPEAT(REP_P1) { EpiProj E; E.O = (bf16_t*)(p.ws + W_PROJ); E.bias = p.in[I_BIN]; run_gemm(lds, vc, (const bf16_t*)(p.ws + W_XN), (const bf16_t*)(p.ws + W_WTIN), DIN, 1024, E);
        { const int G = (int)gridDim.x, nun = (MTOK / 256) * (DIN / 256), rem = nun % G; const int c = vc;
          if (c >= rem) transposes<1>(p, (LAS float*)(lds + (threadIdx.x >> 6) * 8704), threadIdx.x & 63, (c - rem) * 8 + (int)(threadIdx.x >> 6), (G - rem) * 8); }
        GSYNC(); } TIMED_END(1)
    TIMED(20) REPEAT(REP_P2A) { phase2a(p, lds); GSYNC(); } TIMED_END(20)
    TIMED(21) REPEAT(REP_P2B) { phase2b(p, lds); GSYNC(); } TIMED_END(21)
    TIMED(3) { EpiGlu E; E.mix = (bf16_t*)(p.ws + W_MIX); E.m2 = (const bf16_t*)(p.out + O_YP); E.carry = (const float*)(p.ws + W_LRUC); E.proj = (const bf16_t*)(p.ws + W_PROJ); E.bias = p.in[I_BGLU]; run_gemm_main64(lds, vc, (const bf16_t*)(p.ws + W_YSG), (const bf16_t*)(p.ws + W_WTGLU), 2048, 512, E);
        run_gemm_tail(lds, vc, (const bf16_t*)(p.ws + W_YSG), (const bf16_t*)(p.ws + W_WTGLU), 2048, 512, 2, (float*)(p.ws + W_PG)); GSYNC();
        phase_glutail(p); GSYNC(); } TIMED_END(3)
    TIMED(4) REPEAT(REP_P4) { EpiRes E; E.R = (bf16_t*)(p.ws + W_R1); E.X = (const bf16_t*)(p.ws + W_XN); E.bias = p.in[I_BOUT]; E.part = (float*)(p.ws + W_PART); run_gemm_split(lds, vc, (const bf16_t*)(p.ws + W_MIX), (const bf16_t*)(p.ws + W_WTOUT), 1024, 1024, 4, E); GSYNC(); } TIMED_END(4)
    TIMED(5) REPEAT(REP_P5) { phase_ln1(p); GSYNC(); } TIMED_END(5)
    TIMED(6) REPEAT(REP_P6) { EpiUp E; E.H = (bf16_t*)(p.ws + W_V); E.bias = p.in[I_BUP]; E.out = p.out; E.cw = p.in[I_FCW]; E.cb = p.in[I_FCB]; E.cache = p.in[I_CCF]; E.sbg = (float*)(p.ws + W_SBG); E.sbv = (float*)(p.ws + W_SBV); run_gemm_main64(lds, vc, (const bf16_t*)(p.ws + W_XN), (const bf16_t*)(p.ws + W_WTUP), 6144, 1024, E);
        run_gemm_tail(lds, vc, (const bf16_t*)(p.ws + W_XN), (const bf16_t*)(p.ws + W_WTUP), 6144, 1024, 4, (float*)(p.ws + W_PU)); GSYNC(); } TIMED_END(6)
    TIMED(7) phase_ffnfix(p); phase_ffntail(p);
    GSYNC(); TIMED_END(7)
    TIMED(8) REPEAT(REP_P8) { EpiRes E; E.R = (bf16_t*)(p.ws + W_R2); E.X = (const bf16_t*)(p.ws + W_XN); E.bias = p.in[I_BDOWN]; E.part = (float*)(p.ws + W_PART); run_gemm_split(lds, vc, (const bf16_t*)(p.ws + W_V), (const bf16_t*)(p.ws + W_WTDOWN), 1024, 3072, 12, E); GSYNC(); } TIMED_END(8)
    TIMED(9) REPEAT(REP_P9) phase_ln2(p); TIMED_END(9)
}

extern "C" void kernel_launch(void* const* d_in, const int* in_sizes, int n_in, void* d_out, int out_size, void* d_ws, size_t ws_size, hipStream_t stream) {
    constexpr int LDS_BYTES = LDS_TOTAL;
    static int grid = 0;
    if (grid == 0) {
        if (n_in != N_IN || (size_t)out_size != O_END || ws_size < 268435456ull) { fprintf(stderr, "kernel_launch: unexpected shapes (n_in %d out %d ws %zu)\n", n_in, out_size, ws_size); grid = -1; return; }
        int dev = 0, cus = 0, per_cu = 0;
        if (hipGetDevice(&dev) != hipSuccess || hipDeviceGetAttribute(&cus, hipDeviceAttributeMultiprocessorCount, dev) != hipSuccess) { grid = -1; return; }
        if (hipFuncSetAttribute((const void*)hawk_fwd, hipFuncAttributeMaxDynamicSharedMemorySize, LDS_BYTES) != hipSuccess) { fprintf(stderr, "kernel_launch: hipFuncSetAttribute failed\n"); grid = -1; return; }
        if (hipOccupancyMaxActiveBlocksPerMultiprocessor(&per_cu, (const void*)hawk_fwd, 512, LDS_BYTES) != hipSuccess || per_cu < 1) { fprintf(stderr, "kernel_launch: occupancy query failed (%d)\n", per_cu); grid = -1; (void)hipGetLastError(); return; }
        grid = cus * per_cu;
    }
    if (grid < 0) return;
    if (hipMemsetAsync((char*)d_ws + W_BAR, 0, (XCD_BAR_WORDS + 64 * 16) * 4, stream) != hipSuccess) { fprintf(stderr, "kernel_launch: memset failed\n"); return; }
    P p{};
    for (int i = 0; i < N_IN; ++i) p.in[i] = (const float*)d_in[i];
    p.out = (float*)d_out; p.ws = (unsigned char*)d_ws;
    void* args[] = {&p};
    hipError_t e = hipLaunchCooperativeKernel((const void*)hawk_fwd, dim3(grid), dim3(512), args, LDS_BYTES, stream);
    if (e != hipSuccess) fprintf(stderr, "cooperative launch failed: %s (grid %d)\n", hipGetErrorString(e), grid);
}
```

```cpp
#include <hip/hip_runtime.h>
#include <hip/hip_cooperative_groups.h>
#include <cstdio>
#include <cstdint>
namespace cg = cooperative_groups;
#define REP_P0 1
#define REP_P0A 1
#define REP_P0B 1
#define REP_P0C 1
#define REP_P1 1
#define REP_P3 1
#define REP_P2A 1
#define REP_P2B 1
#define REP_P2C 1
#define REP_P4 1
#define REP_P5 1
#define REP_P6 1
#define REP_P8 1
#define REP_P9 1
#define PROBE_PHASE -1
namespace pg8 {
#define PG8_LAS __attribute__((address_space(3)))
typedef unsigned short bf16_t;
typedef short bf16x8 __attribute__((ext_vector_type(8)));
typedef float f32x4 __attribute__((ext_vector_type(4)));
typedef unsigned u32x4 __attribute__((ext_vector_type(4)));
constexpr int BM = 256, BK = 64, HALF = 128, HTB = HALF * BK * 2  , STAGE_BYTES = 8 * HTB, NXCD = 8, WGM = 8;

__host__ __device__ __forceinline__ int lds_byte(int r, int c) { const int st = (r >> 4) * 2 + (c >> 5), rr = r & 15, cc = c & 31, ob = rr * 64 + cc * 2; return st * 1024 + (ob ^ (((ob >> 9) & 1) << 5)); }
__host__ __device__ __forceinline__ void stage_rc(int b, int& R, int& C) { const int st = b / 1024, sb = b % 1024, swz = sb ^ (((sb >> 9) & 1) << 5); R = (st >> 1) * 16 + swz / 64; C = (st & 1) * 32 + (swz % 64) / 2; }
__host__ __device__ __forceinline__ int perm32(int rho) { const int n = rho >> 4, i = rho & 15; return 8 * (i >> 2) + 4 * n + (i & 3); }

struct Unit { int pm, pn, k0, nt, ks; };
struct Gemm { const bf16_t* A; const bf16_t* Bt; int M, N, K; };

struct StaticOrder {
    int nM, nN, nwg, G, c, ntk;
    __host__ __device__ void init(int M, int N, int K, int G_, int c_) { nM = M / BM; nN = N / BM; nwg = nM * nN; G = G_; c = c_; ntk = K / BK; }
    __host__ __device__ bool next(int i, Unit& u) const {
        const long L = (long)i * G + c; if (L >= nwg) return false;
        int wgid = (int)L; { const int q = nwg / NXCD, r = nwg % NXCD, xcd = wgid % NXCD, off = wgid / NXCD; wgid = (xcd < r ? xcd * (q + 1) : r * (q + 1) + (xcd - r) * q) + off; }
        const int nig = WGM * nN, gid = wgid / nig, fm = gid * WGM, gsz = (nM - fm) < WGM ? (nM - fm) : WGM;
        u.pm = fm + ((wgid % nig) % gsz); u.pn = (wgid % nig) / gsz; u.k0 = 0; u.nt = ntk; u.ks = -1; return true;
    }
    __device__ __forceinline__ void a_ready(const Unit&) const {}
    __device__ __forceinline__ void done(const Unit&) const {}
};
struct TailOrder {
    int nN, ntk, nsplit, G, c;
    __host__ __device__ void init(int N, int K, int nsplit_, int G_, int c_) { nN = N / BM; ntk = K / BK; nsplit = nsplit_; G = G_; c = c_; }
    __host__ __device__ bool next(int i, Unit& u) const {
        const long L = (long)i * G + c; const bool ok = L < (long)nN * nsplit; const int ks = (int)(L / nN), ntp = ntk / nsplit;
        u.pm = 64; u.pn = (int)(L % nN); u.ks = ks; u.nt = ntp; u.k0 = ks * ntp * BK; return ok;
    }
    __device__ __forceinline__ void a_ready(const Unit&) const {}
    __device__ __forceinline__ void done(const Unit&) const {}
};
struct SplitOrder {
    StaticOrder base; int nsplit;
    __host__ __device__ void init(int N, int K, int nsplit_, int G_, int c_) { base.init(64 * BM, N, K, G_, c_); nsplit = nsplit_; }
    __host__ __device__ bool next(int i, Unit& u) const {
        Unit t; t.pm = 0; t.pn = 0; t.k0 = 0; t.nt = base.ntk; t.ks = -1;
        const bool ok = base.next(i, t);
        const long L = (long)i * base.G + base.c - base.nwg; const bool sp = (!ok) && L >= 0 && L < (long)base.nN * nsplit;
        const int ks = (int)(L / base.nN), pn = (int)(L % base.nN), ntp = base.ntk / nsplit;
        u.pm = sp ? 64 : t.pm; u.pn = sp ? pn : t.pn; u.ks = sp ? ks : -1; u.nt = sp ? ntp : t.nt; u.k0 = sp ? ks * ntp * BK : 0;
        return ok || sp;
    }
    __device__ __forceinline__ void a_ready(const Unit&) const {}
    __device__ __forceinline__ void done(const Unit&) const {}
};
__device__ __forceinline__ unsigned cvt_pk_bf16(float lo, float hi) { unsigned r; asm volatile("v_cvt_pk_bf16_f32 %0, %1, %2" : "=v"(r) : "v"(lo), "v"(hi)); return r; }
template <class Epi, class Sched, bool STAMP = false>
__device__ __forceinline__ void gemm_phase(PG8_LAS unsigned char* lds, const Gemm g, const Sched& S, const Epi& E, unsigned long long* stamps) {
    int tid_ = threadIdx.x; asm volatile("" : "+v"(tid_)); const int tid = tid_, wid = __builtin_amdgcn_readfirstlane(tid >> 6), lane = tid & 63, wr = wid >> 2, wc = wid & 3, fr = lane & 15, fq = lane >> 4;
    const int K = g.K;
    int ts_lo = 0, ts_hi = 0, nts = 0; const unsigned long long rt_entry = STAMP ? (unsigned long long)wall_clock64() : 0ull;
#define PG8_STAMP() do { if (STAMP && wid == 0 && nts < 64) { const unsigned long long _c = (unsigned long long)clock64(); \
        ts_lo = (lane == nts) ? (int)(unsigned)_c : ts_lo; ts_hi = (lane == nts) ? (int)(unsigned)(_c >> 32) : ts_hi; ++nts; } } while (0)
    PG8_STAMP();
    unsigned voffA[2], voffB[2];
#pragma unroll
    for (int i = 0; i < 2; ++i) { int R, C; stage_rc(tid * 16 + i * 8192, R, C); const int Rb = Epi::PERM ? ((R & ~31) + perm32(R & 31)) : R;
        voffA[i] = (unsigned)(R * K + C) * 2u; voffB[i] = (unsigned)(Rb * K + C) * 2u; }
    const size_t kstep = (size_t)(BK * 2);
    const size_t hstep = (size_t)HALF * K * 2;
    const size_t tstep = 2 * hstep;
    const unsigned ldsw = (unsigned)wid * 1024u;
    const int aoff = lds_byte(wr * 64 + fr, fq * 8), boff = lds_byte(wc * 32 + fr, fq * 8);
#define PG8_SA(b, h) (((b) * 2 + (h)) * HTB)
#define PG8_SB(b, h) ((4 + (b) * 2 + (h)) * HTB)
#define PG8_STAGE(bufoff, gbase, voff) do { _Pragma("unroll") for (int _i = 0; _i < 2; ++_i) \
        __builtin_amdgcn_global_load_lds((const unsigned*)((const char*)(gbase) + (voff)[_i]), (PG8_LAS unsigned*)(lds + (bufoff) + ldsw + _i * 8192), 16, 0, 0); } while (0)
#define PG8_LDA(dst, b, h) do { _Pragma("unroll") for (int m = 0; m < 4; ++m) _Pragma("unroll") for (int k = 0; k < 2; ++k) dst[m][k] = *(const PG8_LAS bf16x8*)(lds + PG8_SA(b, h) + aoff + m * 2048 + k * 1024); } while (0)
#define PG8_LDB(dst, b, h) do { _Pragma("unroll") for (int n = 0; n < 2; ++n) _Pragma("unroll") for (int k = 0; k < 2; ++k) dst[n][k] = *(const PG8_LAS bf16x8*)(lds + PG8_SB(b, h) + boff + n * 2048 + k * 1024); } while (0)
#define PG8_MMA(ai, bj, At, Bt) do { __builtin_amdgcn_s_setprio(1); _Pragma("unroll") for (int m = 0; m < 4; ++m) _Pragma("unroll") for (int n = 0; n < 2; ++n) _Pragma("unroll") for (int k = 0; k < 2; ++k) \
        acc[ai][bj][m][n] = __builtin_amdgcn_mfma_f32_16x16x32_bf16(Bt[n][k], At[m][k], acc[ai][bj][m][n], 0, 0, 0); __builtin_amdgcn_s_setprio(0); } while (0)
#define PG8_WAIT_V(n) asm volatile("s_waitcnt vmcnt(" #n ")" ::: "memory")
#define PG8_WAIT_L(n) asm volatile("s_waitcnt lgkmcnt(" #n ")" ::: "memory")
#define PG8_BAR __builtin_amdgcn_s_barrier()
#define PG8_SCHED __builtin_amdgcn_sched_barrier(0)
    Unit cur, nxt; int ui = 0;
    if (!S.next(0, cur)) return;
    f32x4 acc[2][2][4][2];
#pragma unroll
    for (int a = 0; a < 2; ++a)
#pragma unroll
        for (int b = 0; b < 2; ++b)
#pragma unroll
            for (int m = 0; m < 4; ++m)
#pragma unroll
                for (int n = 0; n < 2; ++n) acc[a][b][m][n] = (f32x4){0.f, 0.f, 0.f, 0.f};
    bf16x8 At[4][2], B0[2][2], B1[2][2];
    const char* cA = (const char*)g.A + (size_t)cur.pm * tstep + (size_t)cur.k0 * 2; const char* cB = (const char*)g.Bt + (size_t)cur.pn * tstep + (size_t)cur.k0 * 2;
    S.a_ready(cur);
    PG8_STAGE(PG8_SB(0, 0), cB, voffB); PG8_STAGE(PG8_SA(0, 0), cA, voffA); PG8_STAGE(PG8_SB(0, 1), cB + hstep, voffB); PG8_STAGE(PG8_SA(0, 1), cA + hstep, voffA);
    if (wr == 1) PG8_BAR;
    PG8_WAIT_V(4); PG8_BAR;
    PG8_STAGE(PG8_SB(1, 0), cB + kstep, voffB); PG8_STAGE(PG8_SA(1, 0), cA + kstep, voffA); PG8_STAGE(PG8_SB(1, 1), cB + hstep + kstep, voffB);
    PG8_WAIT_V(6); PG8_BAR;
    PG8_STAMP();
    for (;;) {
        const bool has_next = S.next(ui + 1, nxt);
        const char* nA = has_next ? (const char*)g.A + (size_t)nxt.pm * tstep + (size_t)nxt.k0 * 2 : cA; const char* nB = has_next ? (const char*)g.Bt + (size_t)nxt.pn * tstep + (size_t)nxt.k0 * 2 : cB;
        const int nt = cur.nt;
        for (int t = 0; t < nt; t += 2) {
            const bool last = (t == nt - 2);
            const char* a1 = cA + (size_t)(t + 1) * kstep;
            const char* a2 = last ? nA : cA + (size_t)(t + 2) * kstep; const char* b2 = last ? nB : cB + (size_t)(t + 2) * kstep;
            const char* a3 = a2 + kstep; const char* b3 = b2 + kstep;
            if (last && has_next) S.a_ready(nxt);
            PG8_LDB(B0, 0, 0); PG8_SCHED; PG8_LDA(At, 0, 0); PG8_STAGE(PG8_SA(1, 1), a1 + hstep, voffA);
            PG8_WAIT_L(8); PG8_BAR; PG8_WAIT_L(0); PG8_MMA(0, 0, At, B0); PG8_BAR; PG8_SCHED;
            PG8_LDB(B1, 0, 1); PG8_STAGE(PG8_SB(0, 0), b2, voffB);
            PG8_BAR; PG8_WAIT_L(0); PG8_MMA(0, 1, At, B1); PG8_BAR;
            PG8_LDA(At, 0, 1); PG8_STAGE(PG8_SA(0, 0), a2, voffA);
            PG8_BAR; PG8_WAIT_L(0); PG8_MMA(1, 0, At, B0); PG8_BAR; PG8_SCHED;
            PG8_STAGE(PG8_SB(0, 1), b2 + hstep, voffB);
            PG8_WAIT_V(6); PG8_BAR; PG8_MMA(1, 1, At, B1); PG8_BAR;
            PG8_LDB(B0, 1, 0); PG8_SCHED; PG8_LDA(At, 1, 0); PG8_STAGE(PG8_SA(0, 1), a2 + hstep, voffA);
            PG8_WAIT_L(8); PG8_BAR; PG8_WAIT_L(0); PG8_MMA(0, 0, At, B0); PG8_BAR; PG8_SCHED;
            PG8_LDB(B1, 1, 1); PG8_STAGE(PG8_SB(1, 0), b3, voffB);
            PG8_BAR; PG8_WAIT_L(0); PG8_MMA(0, 1, At, B1); PG8_BAR;
            PG8_LDA(At, 1, 1); PG8_STAGE(PG8_SA(1, 0), a3, voffA);
            PG8_BAR; PG8_WAIT_L(0); PG8_MMA(1, 0, At, B0); PG8_BAR; PG8_SCHED;
            PG8_STAGE(PG8_SB(1, 1), b3 + hstep, voffB);
            PG8_WAIT_V(6); PG8_BAR; PG8_MMA(1, 1, At, B1); PG8_BAR;
        }
        PG8_STAMP();
        if constexpr (!Epi::AFTER_DRAIN) { E(acc, cur, wr, wc, fr, fq); S.done(cur); }
        PG8_STAMP();
        if (!has_next) break;
#pragma unroll
        for (int a = 0; a < 2; ++a)
#pragma unroll
            for (int b = 0; b < 2; ++b)
#pragma unroll
                for (int m = 0; m < 4; ++m)
#pragma unroll
                    for (int n = 0; n < 2; ++n) acc[a][b][m][n] = (f32x4){0.f, 0.f, 0.f, 0.f};
        cur = nxt; cA = nA; cB = nB; ++ui;
    }
    PG8_WAIT_V(0);
    if (wr == 0) PG8_BAR;
    PG8_BAR;
    if constexpr (Epi::AFTER_DRAIN) { E.fused(acc, cur, wr, wc, fr, fq, lds, wid, lane); S.done(cur); }
    PG8_STAMP();
    if (STAMP && wid == 0) { stamps[lane] = lane < nts ? (((unsigned long long)(unsigned)ts_hi << 32) | (unsigned)ts_lo) : 0ull;
        if (lane == 62) stamps[62] = rt_entry; if (lane == 63) stamps[63] = (unsigned long long)wall_clock64(); }
#undef PG8_STAMP
#undef PG8_SA
#undef PG8_SB
#undef PG8_STAGE
#undef PG8_LDA
#undef PG8_LDB
#undef PG8_MMA
#undef PG8_WAIT_V
#undef PG8_WAIT_L
#undef PG8_BAR
#undef PG8_SCHED
}
}
using pg8::bf16_t; using pg8::bf16x8; using pg8::f32x4; using pg8::u32x4; using pg8::Unit; using pg8::cvt_pk_bf16;
#define LAS __attribute__((address_space(3)))
typedef unsigned u32x2 __attribute__((ext_vector_type(2)));
#define XB_TMO      128
#define XB_XCNT(j)  (256  + 64 * (j))
#define XB_XSUB(j)  (1280 + 64 * (j))
#define XB_XGEN(j)  (2304 + 64 * (j))
#define XB_TOP      3328
#define XB_TOPGEN   3392
#define XCD_BAR_WORDS 3456
#define XB_SPIN_CAP (1u << 18)

__device__ __forceinline__ unsigned xb_ld(unsigned* p)              { return __hip_atomic_load(p, __ATOMIC_RELAXED, __HIP_MEMORY_SCOPE_AGENT); }
__device__ __forceinline__ unsigned xb_add(unsigned* p, unsigned v) { return __hip_atomic_fetch_add(p, v, __ATOMIC_RELAXED, __HIP_MEMORY_SCOPE_AGENT); }
__device__ __forceinline__ unsigned xb_xcc_id() { return (unsigned)__builtin_amdgcn_s_getreg((3 << 11) | 20) & 0xFu; }
#define XB_SPIN(cond, bar) do { unsigned _sp = 0; while (cond) { __builtin_amdgcn_s_sleep(1); \
    if ((++_sp & 255u) == 0u) { if (xb_ld(&(bar)[XB_TMO])) break; if (_sp > XB_SPIN_CAP) { atomicAdd(&(bar)[XB_TMO], 1u); break; } } } } while (0)

struct XcdBarrier {
    unsigned* bar; unsigned x;
    volatile LAS unsigned* st;
};

__device__ __forceinline__ XcdBarrier xcd_barrier_post(unsigned* bar, volatile LAS unsigned* st) {
    XcdBarrier b; b.bar = bar; b.x = xb_xcc_id(); b.st = st;
    if (threadIdx.x == 0) (void)xb_add(&bar[XB_XCNT(b.x)], 1u);
    return b;
}
__device__ __forceinline__ void xcd_barrier_complete(unsigned* bar, unsigned x, unsigned& nloc, unsigned& nx) {
    const unsigned G = gridDim.x * gridDim.y * gridDim.z;
    unsigned sum, cnt, mine, sp = 0u;
    for (;;) {
        sum = 0u; cnt = 0u; mine = 0u;
#pragma unroll
        for (unsigned j = 0; j < 16; ++j) { const unsigned c = xb_ld(&bar[XB_XCNT(j)]); sum += c; cnt += (c > 0u) ? 1u : 0u; mine = (j == x) ? c : mine; }
        if (sum == G) break;
        __builtin_amdgcn_s_sleep(1);
        if ((++sp & 255u) == 0u) { if (xb_ld(&bar[XB_TMO])) break; if (sp > XB_SPIN_CAP) { atomicAdd(&bar[XB_TMO], 1u); break; } }
    }
    nloc = mine > 0u ? mine : 1u; nx = cnt > 0u ? cnt : 1u;
}

__device__ __forceinline__ void xcd_barrier(const XcdBarrier& b) {
    asm volatile("s_waitcnt vmcnt(0)" ::: "memory");
    __syncthreads();
    if (threadIdx.x == 0) {
        unsigned* bar = b.bar;
        __builtin_amdgcn_s_waitcnt(0);
        unsigned nloc = b.st[0], nx = b.st[1];
        if (nloc == 0u) { xcd_barrier_complete(bar, b.x, nloc, nx); b.st[0] = nloc; b.st[1] = nx; }
        const unsigned old = xb_add(&bar[XB_XSUB(b.x)], 1u);
        const unsigned gen = old / nloc;
        if (old + 1u == (gen + 1u) * nloc) {
            __builtin_amdgcn_fence(__ATOMIC_RELEASE, "agent");
            asm volatile("s_waitcnt vmcnt(0)" ::: "memory");
            const unsigned og = xb_add(&bar[XB_TOP], 1u);
            const unsigned tg = og / nx;
            if (og + 1u == (tg + 1u) * nx) xb_add(&bar[XB_TOPGEN], 1u);
            else XB_SPIN(xb_ld(&bar[XB_TOPGEN]) == tg, bar);
            __builtin_amdgcn_fence(__ATOMIC_ACQUIRE, "agent");
            xb_add(&bar[XB_XGEN(b.x)], 1u);
            asm volatile("s_waitcnt vmcnt(0)" ::: "memory");
        } else {
            XB_SPIN(xb_ld(&bar[XB_XGEN(b.x)]) == gen, bar);
            __builtin_amdgcn_fence(__ATOMIC_ACQUIRE, "agent");
            asm volatile("s_waitcnt vmcnt(0)" ::: "memory");
        }
    }
    __syncthreads();
}


constexpr int DM = 1024, NBATCH = 8, TT = 2064, NSAMP = 128, MP = NBATCH * TT  , MTOK = MP + NSAMP  ;
constexpr int DIN = 3584, DSSM = 512, DFF = 3072, NG = 32, NCHUNK = 129, NR = NBATCH * NCHUNK  ;
constexpr int C_US = 1024, C_GA = 1536, C_GB = 2560;
constexpr float ALPHA = 1.189207115002721f, LN_EPS = 1e-5f;
enum { I_XP = 0, I_XS, I_CCL, I_SL, I_SSR, I_SSI, I_CCF, I_META, I_EG, I_EB, I_WIN, I_BIN, I_CLW, I_CLB, I_WR, I_BR, I_WI, I_BI, I_LAM,
       I_SLRE, I_SLIM, I_SLDT, I_SBRE, I_SBIM, I_SCRE, I_SCIM, I_SD, I_WGLU, I_BGLU, I_WOUT, I_BOUT, I_L1G, I_L1B, I_WUP, I_BUP, I_FCW, I_FCB,
       I_WDOWN, I_BDOWN, I_L2G, I_L2B, N_IN };
constexpr size_t O_YP = 0, O_YS = 16777216, O_PCL = O_YS + 131072, O_PL = O_PCL + 24576, O_PSR = O_PL + 8192, O_PSI = O_PSR + 16384, O_PCF = O_PSI + 16384,
                 O_SCL = O_PCF + 49152, O_SL = O_SCL + 393216, O_SSR = O_SL + 131072, O_SSI = O_SSR + 262144, O_SCF = O_SSI + 262144, O_END = O_SCF + 786432;
constexpr size_t W_WTUP = 0, W_WTDOWN = W_WTUP + (size_t)6144 * 1024 * 2, W_XN = W_WTDOWN + (size_t)1024 * 3072 * 2, W_C = W_XN + (size_t)MTOK * 1024 * 2;
constexpr size_t W_PROJ = W_C, W_MIX = W_PROJ + (size_t)MTOK * DIN * 2, W_YSG = W_MIX + (size_t)MTOK * 1024 * 2, W_D = W_YSG + (size_t)MTOK * 512 * 2;
constexpr size_t W_WTGLU = W_D, W_WTOUT = W_WTGLU + (size_t)2048 * 512 * 2, W_WTR = W_WTOUT + (size_t)1024 * 1024 * 2, W_WTI = W_WTR + 262144, W_W1 = W_WTI + 262144,
                 W_W2 = W_W1 + (size_t)NG * 128 * 256 * 2, W_HPREV = W_W2 + (size_t)NG * 256 * 384 * 2, W_A1 = W_HPREV + (size_t)NR * NG * 128 * 2, W_A16 = W_A1 + 16384,
                 W_BBAR = W_A16 + 16384, W_LRUA = W_BBAR + 262144, W_LRUH = W_LRUA + 262144, W_LRUC = W_LRUH + 262144, W_S = W_LRUC + 262144, W_WTIN = W_S,
                 W_S_END = W_S + (size_t)NR * NG * 128 * 4;
constexpr size_t W_BAR = (W_S_END + 4095) / 4096 * 4096;
static_assert(W_BAR + (XCD_BAR_WORDS + 64 * 16) * 4 <= 268435456, "barrier words");
constexpr size_t W_PART = W_C + (size_t)MTOK * 1024 * 4;
constexpr size_t W_SBG = W_C, W_SBV = W_SBG + (size_t)260 * 4 * DFF * 4, W_SB_END = W_SBV + (size_t)260 * 2 * DFF * 4;
constexpr size_t W_PU = W_SB_END, W_PU_END = W_PU + (size_t)4 * 256 * 6144 * 4;
constexpr size_t W_PG = W_S;
constexpr size_t W_R1 = W_C, W_G = W_C, W_V = W_G + (size_t)MTOK * DFF * 2, W_V_END = W_V + (size_t)MTOK * DFF * 2, W_R2 = W_C;
static_assert(W_S_END <= 268435456 && W_V_END <= 268435456, "workspace map exceeds 256 MiB");
static_assert(W_SB_END <= W_V && W_PU_END <= W_V, "side buffers / up partials overlap H");
static_assert(W_PART + (size_t)12 * 256 * 1024 * 4 <= W_MIX && W_PART + (size_t)12 * 256 * 1024 * 4 <= W_V, "r1 / partials overlap mix or v");

constexpr int LDS_TOTAL = 147456;
struct P { const float* in[N_IN]; float* out; unsigned char* ws; };

__device__ __forceinline__ float bf2f(unsigned short b) { return __uint_as_float(((unsigned)b) << 16); }
__device__ __forceinline__ float bflo(unsigned u) { return __uint_as_float(u << 16); }
__device__ __forceinline__ float bfhi(unsigned u) { return __uint_as_float(u & 0xffff0000u); }
__device__ __forceinline__ unsigned short f2bf(float f) { return (unsigned short)(cvt_pk_bf16(f, 0.f) & 0xffffu); }
__device__ __forceinline__ float sigm(float x) { return __builtin_amdgcn_rcpf(1.f + __expf(-x)); }
__device__ __forceinline__ float gelu_tanh(float x) { return x * sigm(1.5957691216057308f * (x + 0.044715f * x * x * x)); }
__device__ __forceinline__ float wave_sum(float v) {
#pragma unroll
    for (int o = 1; o < 64; o <<= 1) v += __shfl_xor(v, o);
    return v;
}
#define LDS_WAIT() asm volatile("s_waitcnt lgkmcnt(0)" ::: "memory")
#define REPEAT(N) for (int rep_ = 0; rep_ < (N); ++rep_)
#define TIMED(N) const unsigned long long tq0_##N = (PROBE_PHASE == (N)) ? __builtin_amdgcn_s_memrealtime() : 0ull;
#define TIMED_END(N) if (PROBE_PHASE == (N)) { const unsigned long long tq1 = __builtin_amdgcn_s_memrealtime(); while (__builtin_amdgcn_s_memrealtime() - tq1 < tq1 - tq0_##N) __builtin_amdgcn_s_sleep(4); }

struct EpiProj {
    static constexpr bool PERM = true, AFTER_DRAIN = false;
    bf16_t* O; const float* bias; bf16_t* UT;
    __device__ __forceinline__ void operator()(const f32x4 (&acc)[2][2][4][2], const Unit& u, int wr, int wc, int fr, int fq) const {
        const int row0 = u.pm * 256 + wr * 64 + fr, col0 = u.pn * 256 + wc * 32 + 8 * fq;
        if (u.pn == 4 || u.pn == 5) {
#pragma unroll
            for (int bj = 0; bj < 2; ++bj) { const int col = col0 + bj * 128; const f32x4 b0 = *(const f32x4*)(bias + col), b1 = *(const f32x4*)(bias + col + 4); const int cu = col - C_US, g = cu >> 4, hh = cu & 15;
#pragma unroll
                for (int ai = 0; ai < 2; ++ai)
#pragma unroll
                    for (int m = 0; m < 4; ++m) { const int row = row0 + ai * 128 + m * 16; const f32x4 v0 = acc[ai][bj][m][0] + b0, v1 = acc[ai][bj][m][1] + b1; u32x4 w;
                        w.x = cvt_pk_bf16(v0[0], v0[1]); w.y = cvt_pk_bf16(v0[2], v0[3]); w.z = cvt_pk_bf16(v1[0], v1[1]); w.w = cvt_pk_bf16(v1[2], v1[3]);
                        size_t o; if (row < MP) { const int b = row / TT, t = row - b * TT; o = ((size_t)(b * NG + g) * TT + t) * 16 + hh; } else o = (size_t)MP * DSSM + ((size_t)(row - MP) * NG + g) * 16 + hh;
                        *(u32x4*)(UT + o) = w; } }
            return; }
#pragma unroll
        for (int bj = 0; bj < 2; ++bj) { const int col = col0 + bj * 128; const f32x4 b0 = *(const f32x4*)(bias + col), b1 = *(const f32x4*)(bias + col + 4);
#pragma unroll
            for (int ai = 0; ai < 2; ++ai)
#pragma unroll
                for (int m = 0; m < 4; ++m) { const f32x4 v0 = acc[ai][bj][m][0] + b0, v1 = acc[ai][bj][m][1] + b1; u32x4 w;
                    w.x = cvt_pk_bf16(v0[0], v0[1]); w.y = cvt_pk_bf16(v0[2], v0[3]); w.z = cvt_pk_bf16(v1[0], v1[1]); w.w = cvt_pk_bf16(v1[2], v1[3]);
                    *(u32x4*)(O + (size_t)(row0 + ai * 128 + m * 16) * DIN + col) = w; } }
    }
};
struct EpiGlu {
    static constexpr bool PERM = true, AFTER_DRAIN = false;
    bf16_t* mix; const bf16_t* m2; const float* carry; const bf16_t* proj; const float* bias;
    __device__ __forceinline__ void operator()(const f32x4 (&acc)[2][2][4][2], const Unit& u, int wr, int wc, int fr, int fq) const {
        const int row0 = u.pm * 256 + wr * 64 + fr, j = u.pn * 128 + wc * 32 + 8 * fq;
        const f32x4 bv0 = *(const f32x4*)(bias + j), bv1 = *(const f32x4*)(bias + j + 4), bg0 = *(const f32x4*)(bias + 1024 + j), bg1 = *(const f32x4*)(bias + 1024 + j + 4);
#pragma unroll
        for (int ai = 0; ai < 2; ++ai)
#pragma unroll
            for (int mp = 0; mp < 2; ++mp) { u32x4 gbw[2], mw[2], m2w[2]; f32x4 cv0[2], cv1[2];
#pragma unroll
                for (int mm = 0; mm < 2; ++mm) { const int rowi = row0 + ai * 128 + (2 * mp + mm) * 16; const size_t row = (size_t)rowi; int cidx = 0;
                    if (rowi < MP) { const int b = rowi / TT, t = rowi - b * TT; int kc = t >> 8; kc = kc > 7 ? 7 : kc; cidx = (b * 8 + kc) * 1024; }
                    cv0[mm] = *(const f32x4*)(carry + cidx + j); cv1[mm] = *(const f32x4*)(carry + cidx + j + 4);
                    gbw[mm] = *(const u32x4*)(proj + row * DIN + C_GB + j); mw[mm] = *(const u32x4*)(mix + row * 1024 + j); m2w[mm] = *(const u32x4*)(m2 + row * 1024 + j); }
#pragma unroll
                for (int mm = 0; mm < 2; ++mm) { const int m = 2 * mp + mm; const size_t row = (size_t)(row0 + ai * 128 + m * 16);
                    const f32x4 val0 = acc[ai][0][m][0] + bv0, val1 = acc[ai][0][m][1] + bv1, gate0 = acc[ai][1][m][0] + bg0, gate1 = acc[ai][1][m][1] + bg1;
                    const float o0 = bflo(mw[mm].x) + bflo(m2w[mm].x) * cv0[mm][0] + sigm(bflo(gbw[mm].x)) * val0[0] * sigm(gate0[0]), o1 = bfhi(mw[mm].x) + bfhi(m2w[mm].x) * cv0[mm][1] + sigm(bfhi(gbw[mm].x)) * val0[1] * sigm(gate0[1]);
                    const float o2 = bflo(mw[mm].y) + bflo(m2w[mm].y) * cv0[mm][2] + sigm(bflo(gbw[mm].y)) * val0[2] * sigm(gate0[2]), o3 = bfhi(mw[mm].y) + bfhi(m2w[mm].y) * cv0[mm][3] + sigm(bfhi(gbw[mm].y)) * val0[3] * sigm(gate0[3]);
                    const float o4 = bflo(mw[mm].z) + bflo(m2w[mm].z) * cv1[mm][0] + sigm(bflo(gbw[mm].z)) * val1[0] * sigm(gate1[0]), o5 = bfhi(mw[mm].z) + bfhi(m2w[mm].z) * cv1[mm][1] + sigm(bfhi(gbw[mm].z)) * val1[1] * sigm(gate1[1]);
                    const float o6 = bflo(mw[mm].w) + bflo(m2w[mm].w) * cv1[mm][2] + sigm(bflo(gbw[mm].w)) * val1[2] * sigm(gate1[2]), o7 = bfhi(mw[mm].w) + bfhi(m2w[mm].w) * cv1[mm][3] + sigm(bfhi(gbw[mm].w)) * val1[3] * sigm(gate1[3]);
                    u32x4 w; w.x = cvt_pk_bf16(o0, o1); w.y = cvt_pk_bf16(o2, o3); w.z = cvt_pk_bf16(o4, o5); w.w = cvt_pk_bf16(o6, o7); *(u32x4*)(mix + row * 1024 + j) = w; } }
    }
};
struct EpiRes {
    static constexpr bool PERM = true, AFTER_DRAIN = false;
    bf16_t* R; const bf16_t* X; const float* bias; float* part;
    __device__ __forceinline__ void operator()(const f32x4 (&acc)[2][2][4][2], const Unit& u, int wr, int wc, int fr, int fq) const {
        const int row0 = u.pm * 256 + wr * 64 + fr, col0 = u.pn * 256 + wc * 32 + 8 * fq;
        if (u.ks >= 0) { float* pp = part + ((size_t)u.ks * 256 - 16384) * 1024;
#pragma unroll
            for (int bj = 0; bj < 2; ++bj)
#pragma unroll
                for (int n = 0; n < 2; ++n)
#pragma unroll
                    for (int ai = 0; ai < 2; ++ai)
#pragma unroll
                        for (int m = 0; m < 4; ++m) *(f32x4*)(pp + (size_t)(row0 + ai * 128 + m * 16) * 1024 + col0 + bj * 128 + n * 4) = acc[ai][bj][m][n];
            return; }
#pragma unroll
        for (int bj = 0; bj < 2; ++bj) { const int col = col0 + bj * 128; const f32x4 b0 = *(const f32x4*)(bias + col), b1 = *(const f32x4*)(bias + col + 4);
            u32x4 xw[2][4];
#pragma unroll
            for (int ai = 0; ai < 2; ++ai)
#pragma unroll
                for (int m = 0; m < 4; ++m) xw[ai][m] = *(const u32x4*)(X + (size_t)(row0 + ai * 128 + m * 16) * 1024 + col);
#pragma unroll
            for (int ai = 0; ai < 2; ++ai)
#pragma unroll
                for (int m = 0; m < 4; ++m) { const size_t off = (size_t)(row0 + ai * 128 + m * 16) * 1024 + col; const u32x4 x = xw[ai][m];
                    f32x4 v0 = acc[ai][bj][m][0] + b0, v1 = acc[ai][bj][m][1] + b1;
                    v0[0] += ALPHA * bflo(x.x); v0[1] += ALPHA * bfhi(x.x); v0[2] += ALPHA * bflo(x.y); v0[3] += ALPHA * bfhi(x.y);
                    v1[0] += ALPHA * bflo(x.z); v1[1] += ALPHA * bfhi(x.z); v1[2] += ALPHA * bflo(x.w); v1[3] += ALPHA * bfhi(x.w);
                    u32x4 w; w.x = cvt_pk_bf16(v0[0], v0[1]); w.y = cvt_pk_bf16(v0[2], v0[3]); w.z = cvt_pk_bf16(v1[0], v1[1]); w.w = cvt_pk_bf16(v1[2], v1[3]); *(u32x4*)(R + off) = w; } }
    }
};
__device__ __forceinline__ float rot1(float x) { return __int_as_float(__builtin_amdgcn_update_dpp(0, __float_as_int(x), 0x121, 0xf, 0xf, false)); }
__device__ __forceinline__ float rot2(float x) { return __int_as_float(__builtin_amdgcn_update_dpp(0, __float_as_int(x), 0x122, 0xf, 0xf, false)); }
struct EpiUp {
    static constexpr bool PERM = true, AFTER_DRAIN = false;
    bf16_t* H; const float* bias; float* out; const float* cw; const float* cb; const float* cache; float* sbg; float* sbv;
    __device__ __forceinline__ void operator()(const f32x4 (&acc)[2][2][4][2], const Unit& u, int wr, int wc, int fr, int fq) const {
        const int c0 = u.pn * 128 + wc * 32 + 8 * fq;
        f32x4 bg[2], bv[2], w0[2], w1[2], w2[2], cbv[2];
#pragma unroll
        for (int n = 0; n < 2; ++n) { const int ch = c0 + 4 * n; bg[n] = *(const f32x4*)(bias + ch); bv[n] = *(const f32x4*)(bias + DFF + ch);
            w0[n] = *(const f32x4*)(cw + ch); w1[n] = *(const f32x4*)(cw + DFF + ch); w2[n] = *(const f32x4*)(cw + 2 * DFF + ch); cbv[n] = *(const f32x4*)(cb + ch); }
#pragma unroll
        for (int ai = 0; ai < 2; ++ai) { const int blk = u.pm * 4 + ai * 2 + wr, r0 = blk * 64;
            f32x4 gp1[2], gp2[2];
#pragma unroll
            for (int n = 0; n < 2; ++n) { gp1[n] = (f32x4){0.f, 0.f, 0.f, 0.f}; gp2[n] = (f32x4){0.f, 0.f, 0.f, 0.f}; }
#pragma unroll
            for (int m = 0; m < 4; ++m) { const int row = r0 + 16 * m + fr; const int b = row / TT, t = row - b * TT; float h[8];
#pragma unroll
                for (int n = 0; n < 2; ++n) { const int ch = c0 + 4 * n; const f32x4 g = acc[ai][0][m][n] + bg[n], v = acc[ai][1][m][n] + bv[n];
                    f32x4 a1, a2; a1[0] = rot1(g[0]); a1[1] = rot1(g[1]); a1[2] = rot1(g[2]); a1[3] = rot1(g[3]); a2[0] = rot2(g[0]); a2[1] = rot2(g[1]); a2[2] = rot2(g[2]); a2[3] = rot2(g[3]);
                    f32x4 g1 = (fr >= 1) ? a1 : gp1[n], g2 = (fr >= 2) ? a2 : gp2[n];
                    if (t == 0) g1 = (f32x4){0.f, 0.f, 0.f, 0.f}; if (t <= 1) g2 = (f32x4){0.f, 0.f, 0.f, 0.f};
                    if (t >= TT - 2) *(f32x4*)(out + O_PCF + ((size_t)b * 2 + (t - (TT - 2))) * DFF + ch) = g;
                    if (m == 0 && fr < 2) { *(f32x4*)(sbg + ((size_t)blk * 4 + fr) * DFF + ch) = g; *(f32x4*)(sbv + ((size_t)blk * 2 + fr) * DFF + ch) = v; }
                    if (m == 3 && fr >= 14) *(f32x4*)(sbg + ((size_t)blk * 4 + fr - 12) * DFF + ch) = g;
                    const f32x4 y = cbv[n] + w0[n] * g2 + w1[n] * g1 + w2[n] * g;
                    h[4 * n] = gelu_tanh(y[0]) * v[0]; h[4 * n + 1] = gelu_tanh(y[1]) * v[1]; h[4 * n + 2] = gelu_tanh(y[2]) * v[2]; h[4 * n + 3] = gelu_tanh(y[3]) * v[3];
                    gp1[n] = a1; gp2[n] = a2; }
                u32x4 w; w.x = cvt_pk_bf16(h[0], h[1]); w.y = cvt_pk_bf16(h[2], h[3]); w.z = cvt_pk_bf16(h[4], h[5]); w.w = cvt_pk_bf16(h[6], h[7]); *(u32x4*)(H + (size_t)row * DFF + c0) = w; } }
    }
};
struct EpiRaw {
    static constexpr bool PERM = false, AFTER_DRAIN = false;
    float* pu; int ld;
    __device__ __forceinline__ void operator()(const f32x4 (&acc)[2][2][4][2], const Unit& u, int wr, int wc, int fr, int fq) const {
        float* pp = pu + (size_t)u.ks * 256 * ld + (size_t)(wr * 64 + fr) * ld + u.pn * 256 + wc * 32 + 4 * fq;
#pragma unroll
        for (int ai = 0; ai < 2; ++ai)
#pragma unroll
            for (int m = 0; m < 4; ++m)
#pragma unroll
                for (int bj = 0; bj < 2; ++bj)
#pragma unroll
                    for (int n = 0; n < 2; ++n) *(f32x4*)(pp + (size_t)(ai * 128 + m * 16) * ld + bj * 128 + n * 16) = acc[ai][bj][m][n];
    }
};
template <class Epi> __device__ __forceinline__ void run_gemm(LAS unsigned char* lds, int vc, const bf16_t* A, const bf16_t* Bt, int N, int K, const Epi& E) {
    pg8::Gemm g; g.A = A; g.Bt = Bt; g.M = MTOK; g.N = N; g.K = K;
    pg8::StaticOrder S; S.init(MTOK, N, K, (int)gridDim.x, vc);
    pg8::gemm_phase<Epi, pg8::StaticOrder, false>(lds, g, S, E, nullptr);
}

template <class Epi> __device__ __forceinline__ void run_gemm_split(LAS unsigned char* lds, int vc, const bf16_t* A, const bf16_t* Bt, int N, int K, int nsplit, const Epi& E) {
    pg8::Gemm g; g.A = A; g.Bt = Bt; g.M = MTOK; g.N = N; g.K = K;
    pg8::SplitOrder S; S.init(N, K, nsplit, (int)gridDim.x, vc);
    pg8::gemm_phase<Epi, pg8::SplitOrder, false>(lds, g, S, E, nullptr);
}

template <class Epi> __device__ __forceinline__ void run_gemm_main64(LAS unsigned char* lds, int vc, const bf16_t* A, const bf16_t* Bt, int N, int K, const Epi& E) {
    pg8::Gemm g; g.A = A; g.Bt = Bt; g.M = 16384; g.N = N; g.K = K;
    pg8::StaticOrder S; S.init(16384, N, K, (int)gridDim.x, vc);
    pg8::gemm_phase<Epi, pg8::StaticOrder, false>(lds, g, S, E, nullptr);
}
__device__ __forceinline__ void run_gemm_tail(LAS unsigned char* lds, int vc, const bf16_t* A, const bf16_t* Bt, int N, int K, int nsplit, float* pu) {
    pg8::Gemm g; g.A = A; g.Bt = Bt; g.M = MTOK; g.N = N; g.K = K;
    pg8::TailOrder S; S.init(N, K, nsplit, (int)gridDim.x, vc);
    EpiRaw E; E.pu = pu; E.ld = N;
    pg8::gemm_phase<EpiRaw, pg8::TailOrder, false>(lds, g, S, E, nullptr);
}

__device__ __forceinline__ void transpose_item(const float* W, int N, bf16_t* WT, int K, int k0, int srcn0, int dstn0, LAS float* scr, int lane) {
    float tv[32];
#pragma unroll
    for (int i = 0; i < 32; ++i) tv[i] = W[(size_t)(k0 + 2 * i + (lane >> 5)) * N + srcn0 + (lane & 31)];
#pragma unroll
    for (int i = 0; i < 32; ++i) scr[(2 * i + (lane >> 5)) * 33 + (lane & 31)] = tv[i];
    LDS_WAIT();
    const int c = lane & 7;
#pragma unroll
    for (int j = 0; j < 4; ++j) { const int n = (lane >> 3) + 8 * j; const LAS float* s = scr + (8 * c) * 33 + n;
        u32x4 o; o.x = cvt_pk_bf16(s[0 * 33], s[1 * 33]); o.y = cvt_pk_bf16(s[2 * 33], s[3 * 33]); o.z = cvt_pk_bf16(s[4 * 33], s[5 * 33]); o.w = cvt_pk_bf16(s[6 * 33], s[7 * 33]);
        *(u32x4*)(WT + (size_t)(dstn0 + n) * K + k0 + 8 * c) = o; }
    LDS_WAIT();
}
__device__ __forceinline__ const float* src_row(const P& p, int r) {
    if (r < MP) { const int b = r / TT, t = r - b * TT; return t < 16 ? p.in[I_META] + (size_t)t * DM : p.in[I_XP] + ((size_t)b * 2048 + (t - 16)) * DM; }
    return p.in[I_XS] + (size_t)(r - MP) * DM;
}
template <bool OUT_BF16> __device__ __forceinline__ void ln_row(const float* xrow, const float* g, const float* bta, void* orow, int lane, int nsplit = 0, const bf16_t* xres = nullptr, const float* rbias = nullptr) {
    f32x4 v[4]; float s = 0.f;
#pragma unroll
    for (int j = 0; j < 4; ++j) { v[j] = *(const f32x4*)(xrow + 4 * lane + 256 * j);
        if (nsplit > 0) { for (int k = 1; k < nsplit; ++k) v[j] += *(const f32x4*)(xrow + (size_t)k * 256 * 1024 + 4 * lane + 256 * j);
            const u32x2 xw = *(const u32x2*)(xres + 4 * lane + 256 * j); const f32x4 bv = *(const f32x4*)(rbias + 4 * lane + 256 * j);
            v[j][0] += ALPHA * bflo(xw.x) + bv[0]; v[j][1] += ALPHA * bfhi(xw.x) + bv[1]; v[j][2] += ALPHA * bflo(xw.y) + bv[2]; v[j][3] += ALPHA * bfhi(xw.y) + bv[3]; }
        s += (v[j][0] + v[j][1]) + (v[j][2] + v[j][3]); }
    const float mean = wave_sum(s) * (1.f / DM); float s2 = 0.f;
#pragma unroll
    for (int j = 0; j < 4; ++j) { v[j] = v[j] - mean; s2 += (v[j][0] * v[j][0] + v[j][1] * v[j][1]) + (v[j][2] * v[j][2] + v[j][3] * v[j][3]); }
    const float rstd = 1.f / sqrtf(wave_sum(s2) * (1.f / DM) + LN_EPS);
#pragma unroll
    for (int j = 0; j < 4; ++j) { const f32x4 gg = *(const f32x4*)(g + 4 * lane + 256 * j), bb = *(const f32x4*)(bta + 4 * lane + 256 * j);
        const f32x4 o = (v[j] * rstd) * gg + bb;
        if (OUT_BF16) { u32x2 w; w.x = cvt_pk_bf16(o[0], o[1]); w.y = cvt_pk_bf16(o[2], o[3]); *(u32x2*)((bf16_t*)orow + 4 * lane + 256 * j) = w; }
        else *(f32x4*)((float*)orow + 4 * lane + 256 * j) = o; }
}
template <bool OUT_BF16> __device__ __forceinline__ void ln_rows2(const float* xa, const float* xb, const float* g, const float* bta, void* oa, void* ob, int lane, bool vb) {
    f32x4 va[4], vbv[4]; float sa = 0.f, sb = 0.f;
#pragma unroll
    for (int j = 0; j < 4; ++j) { va[j] = *(const f32x4*)(xa + 4 * lane + 256 * j); vbv[j] = *(const f32x4*)(xb + 4 * lane + 256 * j); }
#pragma unroll
    for (int j = 0; j < 4; ++j) { sa += (va[j][0] + va[j][1]) + (va[j][2] + va[j][3]); sb += (vbv[j][0] + vbv[j][1]) + (vbv[j][2] + vbv[j][3]); }
#pragma unroll
    for (int o = 1; o < 64; o <<= 1) { sa += __shfl_xor(sa, o); sb += __shfl_xor(sb, o); }
    const float ma = sa * (1.f / DM), mb = sb * (1.f / DM); float qa = 0.f, qb = 0.f;
#pragma unroll
    for (int j = 0; j < 4; ++j) { va[j] = va[j] - ma; vbv[j] = vbv[j] - mb; qa += (va[j][0] * va[j][0] + va[j][1] * va[j][1]) + (va[j][2] * va[j][2] + va[j][3] * va[j][3]);
        qb += (vbv[j][0] * vbv[j][0] + vbv[j][1] * vbv[j][1]) + (vbv[j][2] * vbv[j][2] + vbv[j][3] * vbv[j][3]); }
#pragma unroll
    for (int o = 1; o < 64; o <<= 1) { qa += __shfl_xor(qa, o); qb += __shfl_xor(qb, o); }
    const float ra = 1.f / sqrtf(qa * (1.f / DM) + LN_EPS), rb = 1.f / sqrtf(qb * (1.f / DM) + LN_EPS);
#pragma unroll
    for (int j = 0; j < 4; ++j) { const f32x4 gg = *(const f32x4*)(g + 4 * lane + 256 * j), bb = *(const f32x4*)(bta + 4 * lane + 256 * j);
        const f32x4 o1 = (va[j] * ra) * gg + bb, o2 = (vbv[j] * rb) * gg + bb;
        if (OUT_BF16) { u32x2 w; w.x = cvt_pk_bf16(o1[0], o1[1]); w.y = cvt_pk_bf16(o1[2], o1[3]); *(u32x2*)((bf16_t*)oa + 4 * lane + 256 * j) = w;
            if (vb) { w.x = cvt_pk_bf16(o2[0], o2[1]); w.y = cvt_pk_bf16(o2[2], o2[3]); *(u32x2*)((bf16_t*)ob + 4 * lane + 256 * j) = w; } }
        else { *(f32x4*)((float*)oa + 4 * lane + 256 * j) = o1; if (vb) *(f32x4*)((float*)ob + 4 * lane + 256 * j) = o2; } }
}
template <bool OUT_BF16> __device__ __forceinline__ void ln_rows2_bf(const bf16_t* xa, const bf16_t* xb, const float* g, const float* bta, void* oa, void* ob, int lane, bool vb) {
    float va[16], vq[16]; float sa = 0.f, sb = 0.f;
    { u32x4 ra[2], rb[2];
#pragma unroll
      for (int j = 0; j < 2; ++j) { ra[j] = *(const u32x4*)(xa + 8 * lane + 512 * j); rb[j] = *(const u32x4*)(xb + 8 * lane + 512 * j); }
#pragma unroll
      for (int j = 0; j < 2; ++j) { va[8 * j] = bflo(ra[j].x); va[8 * j + 1] = bfhi(ra[j].x); va[8 * j + 2] = bflo(ra[j].y); va[8 * j + 3] = bfhi(ra[j].y); va[8 * j + 4] = bflo(ra[j].z); va[8 * j + 5] = bfhi(ra[j].z); va[8 * j + 6] = bflo(ra[j].w); va[8 * j + 7] = bfhi(ra[j].w);
          vq[8 * j] = bflo(rb[j].x); vq[8 * j + 1] = bfhi(rb[j].x); vq[8 * j + 2] = bflo(rb[j].y); vq[8 * j + 3] = bfhi(rb[j].y); vq[8 * j + 4] = bflo(rb[j].z); vq[8 * j + 5] = bfhi(rb[j].z); vq[8 * j + 6] = bflo(rb[j].w); vq[8 * j + 7] = bfhi(rb[j].w); } }
#pragma unroll
    for (int e = 0; e < 16; ++e) { sa += va[e]; sb += vq[e]; }
#pragma unroll
    for (int o = 1; o < 64; o <<= 1) { sa += __shfl_xor(sa, o); sb += __shfl_xor(sb, o); }
    const float ma = sa * (1.f / DM), mb = sb * (1.f / DM); float qa = 0.f, qb = 0.f;
#pragma unroll
    for (int e = 0; e < 16; ++e) { va[e] -= ma; vq[e] -= mb; qa += va[e] * va[e]; qb += vq[e] * vq[e]; }
#pragma unroll
    for (int o = 1; o < 64; o <<= 1) { qa += __shfl_xor(qa, o); qb += __shfl_xor(qb, o); }
    const float ra_ = 1.f / sqrtf(qa * (1.f / DM) + LN_EPS), rb_ = 1.f / sqrtf(qb * (1.f / DM) + LN_EPS);
#pragma unroll
    for (int j = 0; j < 2; ++j) { const int c = 8 * lane + 512 * j; const f32x4 g0 = *(const f32x4*)(g + c), g1 = *(const f32x4*)(g + c + 4), b0 = *(const f32x4*)(bta + c), b1 = *(const f32x4*)(bta + c + 4);
        float o1[8], o2[8];
#pragma unroll
        for (int e = 0; e < 4; ++e) { o1[e] = va[8 * j + e] * ra_ * g0[e] + b0[e]; o1[4 + e] = va[8 * j + 4 + e] * ra_ * g1[e] + b1[e]; o2[e] = vq[8 * j + e] * rb_ * g0[e] + b0[e]; o2[4 + e] = vq[8 * j + 4 + e] * rb_ * g1[e] + b1[e]; }
        if (OUT_BF16) { u32x4 w; w.x = cvt_pk_bf16(o1[0], o1[1]); w.y = cvt_pk_bf16(o1[2], o1[3]); w.z = cvt_pk_bf16(o1[4], o1[5]); w.w = cvt_pk_bf16(o1[6], o1[7]); *(u32x4*)((bf16_t*)oa + c) = w;
            if (vb) { w.x = cvt_pk_bf16(o2[0], o2[1]); w.y = cvt_pk_bf16(o2[2], o2[3]); w.z = cvt_pk_bf16(o2[4], o2[5]); w.w = cvt_pk_bf16(o2[6], o2[7]); *(u32x4*)((bf16_t*)ob + c) = w; } }
        else { *(f32x4*)((float*)oa + c) = (f32x4){o1[0], o1[1], o1[2], o1[3]}; *(f32x4*)((float*)oa + c + 4) = (f32x4){o1[4], o1[5], o1[6], o1[7]};
            if (vb) { *(f32x4*)((float*)ob + c) = (f32x4){o2[0], o2[1], o2[2], o2[3]}; *(f32x4*)((float*)ob + c + 4) = (f32x4){o2[4], o2[5], o2[6], o2[7]}; } } }
}
__device__ __forceinline__ void s5_precompute(const P& p, LAS unsigned char* lds, int g) {
    LAS float* apr = (LAS float*)lds;
    LAS float* api = apr + 17 * 64;
    LAS float* bbr = api + 17 * 64;
    LAS float* bbi = bbr + 1024;
    LAS float* cr = bbi + 1024;
    LAS float* ci = cr + 1024;
    LAS float* Kl = ci + 1024;
    int tid_ = threadIdx.x; asm volatile("" : "+v"(tid_)); const int tid = tid_;
    if (tid < 64) { const int pp = tid;
        const float dt = expf(p.in[I_SLDT][g]); const float lre = p.in[I_SLRE][g * 64 + pp], lim = p.in[I_SLIM][g * 64 + pp];
        const float mag = expf(lre * dt); const float ang = lim * dt; const float abr = mag * cosf(ang), abi = mag * sinf(ang);
        const float den = lre * lre + lim * lim, nr = abr - 1.0f, ni = abi; const float fre = (nr * lre + ni * lim) / den, fim = (ni * lre - nr * lim) / den;
        float pr = 1.f, pi = 0.f;
        for (int j = 0; j <= 16; ++j) { apr[j * 64 + pp] = pr; api[j * 64 + pp] = pi; const float nr2 = pr * abr - pi * abi, ni2 = pr * abi + pi * abr; pr = nr2; pi = ni2; }
        float* a1 = (float*)(p.ws + W_A1); float* a16 = (float*)(p.ws + W_A16); float* bbar = (float*)(p.ws + W_BBAR);
        a1[(g * 64 + pp) * 2] = abr; a1[(g * 64 + pp) * 2 + 1] = abi; a16[(g * 64 + pp) * 2] = apr[16 * 64 + pp]; a16[(g * 64 + pp) * 2 + 1] = api[16 * 64 + pp];
        for (int c = 0; c < 16; ++c) { const float br = p.in[I_SBRE][(g * 64 + pp) * 16 + c], bi = p.in[I_SBIM][(g * 64 + pp) * 16 + c];
            const float xr = fre * br - fim * bi, xi = fre * bi + fim * br; bbr[pp * 16 + c] = xr; bbi[pp * 16 + c] = xi;
            bbar[((g * 64 + pp) * 16 + c) * 2] = xr; bbar[((g * 64 + pp) * 16 + c) * 2 + 1] = xi; }
    }
    for (int i = tid; i < 1024; i += 512) { cr[i] = p.in[I_SCRE][g * 1024 + i]; ci[i] = p.in[I_SCIM][g * 1024 + i]; }
    __syncthreads();
    { const int j = tid >> 5, c1 = (tid >> 1) & 15, c0 = 8 * (tid & 1); float acc8[8];
#pragma unroll
      for (int e = 0; e < 8; ++e) acc8[e] = 0.f;
      for (int pp = 0; pp < 64; ++pp) { const float xr = cr[c1 * 64 + pp], xi = ci[c1 * 64 + pp], ar = apr[j * 64 + pp], ai = api[j * 64 + pp]; const float car = xr * ar - xi * ai, cai = xr * ai + xi * ar;
          const f32x4 r0 = *(const LAS f32x4*)(bbr + pp * 16 + c0), r1 = *(const LAS f32x4*)(bbr + pp * 16 + c0 + 4), i0 = *(const LAS f32x4*)(bbi + pp * 16 + c0), i1 = *(const LAS f32x4*)(bbi + pp * 16 + c0 + 4);
          acc8[0] += car * r0[0] - cai * i0[0]; acc8[1] += car * r0[1] - cai * i0[1]; acc8[2] += car * r0[2] - cai * i0[2]; acc8[3] += car * r0[3] - cai * i0[3];
          acc8[4] += car * r1[0] - cai * i1[0]; acc8[5] += car * r1[1] - cai * i1[1]; acc8[6] += car * r1[2] - cai * i1[2]; acc8[7] += car * r1[3] - cai * i1[3]; }
#pragma unroll
      for (int e = 0; e < 8; ++e) { float v = acc8[e]; if (j == 0 && c1 == c0 + e) v += p.in[I_SD][g * 16 + c1]; Kl[(j * 16 + c1) * 16 + c0 + e] = v; } }
    __syncthreads();
    bf16_t* W1 = (bf16_t*)(p.ws + W_W1) + (size_t)g * 128 * 256; bf16_t* W2 = (bf16_t*)(p.ws + W_W2) + (size_t)g * 256 * 384;
    for (int i = tid; i < 128 * 32; i += 512) { const int n = i >> 5, ch = i & 31, s = ch >> 1, c0 = 8 * (ch & 1), pp = n & 63; const bool im = n >= 64; float v[8];
        const float ar = apr[(15 - s) * 64 + pp], ai = api[(15 - s) * 64 + pp];
#pragma unroll
        for (int e = 0; e < 8; ++e) { const float xr = bbr[pp * 16 + c0 + e], xi = bbi[pp * 16 + c0 + e]; v[e] = im ? (ar * xi + ai * xr) : (ar * xr - ai * xi); }
        u32x4 o; o.x = cvt_pk_bf16(v[0], v[1]); o.y = cvt_pk_bf16(v[2], v[3]); o.z = cvt_pk_bf16(v[4], v[5]); o.w = cvt_pk_bf16(v[6], v[7]);
        *(u32x4*)(W1 + (size_t)n * 256 + 8 * ch) = o; }
    for (int i = tid; i < 256 * 48; i += 512) { const int n = i / 48, ch = i - n * 48, t = n >> 4, c1 = n & 15; float v[8];
        if (ch < 32) { const int s = ch >> 1, c0 = 8 * (ch & 1);
#pragma unroll
            for (int e = 0; e < 8; ++e) v[e] = (s <= t) ? Kl[((t - s) * 16 + c1) * 16 + c0 + e] : 0.f; }
        else { const bool im = ch >= 40; const int p0 = 8 * (ch - (im ? 40 : 32));
#pragma unroll
            for (int e = 0; e < 8; ++e) { const int pp = p0 + e; const float ar = apr[(t + 1) * 64 + pp], ai = api[(t + 1) * 64 + pp], xr = cr[c1 * 64 + pp], xi = ci[c1 * 64 + pp];
                v[e] = im ? -(xr * ai + xi * ar) : (xr * ar - xi * ai); } }
        u32x4 o; o.x = cvt_pk_bf16(v[0], v[1]); o.y = cvt_pk_bf16(v[2], v[3]); o.z = cvt_pk_bf16(v[4], v[5]); o.w = cvt_pk_bf16(v[6], v[7]);
        *(u32x4*)(W2 + (size_t)n * 384 + 8 * ch) = o; }
    __syncthreads();
}
template <int CLS> __device__ __forceinline__ void transposes(const P& p, LAS float* scr, int lane, int gw, int NGW) {
    constexpr int I_UP = 16 * 192, I_DN = 48 * 32, I_IN = 16 * 112, I_GL = 8 * 64, I_OU = 16 * 32, I_LR = 16 * 8;
    constexpr int NITEMS = CLS == 0 ? I_IN + I_LR : I_UP + I_DN + I_GL + I_OU;
    for (int it = gw; it < NITEMS; it += NGW) { int r = it;
        if (CLS == 0) {
            if (r < I_IN) { const int kb = r / 112, nb = r % 112; transpose_item(p.in[I_WIN], DIN, (bf16_t*)(p.ws + W_WTIN), 1024, 64 * kb, 32 * nb, 32 * nb, scr, lane); continue; } r -= I_IN;
            { const int which = r >> 6, blk = (r >> 3) & 7, kb = (r >> 2) & 1, nb = r & 3;
              transpose_item(p.in[which ? I_WI : I_WR] + blk * 16384, 128, (bf16_t*)(p.ws + (which ? W_WTI : W_WTR)) + blk * 16384, 128, 64 * kb, 32 * nb, 32 * nb, scr, lane); }
        } else {
            if (r < I_UP) { const int kb = r / 192, nb = r % 192, d0 = 32 * nb, s0 = ((d0 >> 7) & 1) * DFF + (d0 >> 8) * 128 + (d0 & 127);
                transpose_item(p.in[I_WUP], 6144, (bf16_t*)(p.ws + W_WTUP), 1024, 64 * kb, s0, d0, scr, lane); continue; } r -= I_UP;
            if (r < I_DN) { const int kb = r / 32, nb = r % 32; transpose_item(p.in[I_WDOWN], 1024, (bf16_t*)(p.ws + W_WTDOWN), 3072, 64 * kb, 32 * nb, 32 * nb, scr, lane); continue; } r -= I_DN;
            if (r < I_GL) { const int kb = r / 64, nb = r % 64, d0 = 32 * nb, s0 = ((d0 >> 7) & 1) * 1024 + (d0 >> 8) * 128 + (d0 & 127);
                transpose_item(p.in[I_WGLU], 2048, (bf16_t*)(p.ws + W_WTGLU), 512, 64 * kb, s0, d0, scr, lane); continue; } r -= I_GL;
            { const int kb = r / 32, nb = r % 32; transpose_item(p.in[I_WOUT], 1024, (bf16_t*)(p.ws + W_WTOUT), 1024, 64 * kb, 32 * nb, 32 * nb, scr, lane); }
        }
    }
}
__device__ __forceinline__ void phase0(const P& p, LAS unsigned char* lds) {
    int tid_ = threadIdx.x; asm volatile("" : "+v"(tid_)); const int tid = tid_, lane = tid & 63, wid = tid >> 6;
    REPEAT(REP_P0A) for (int g = blockIdx.x; g < NG; g += gridDim.x) s5_precompute(p, lds, g);
    LAS float* scr = (LAS float*)(lds + wid * 8704);
    const int gw = blockIdx.x * 8 + wid, NGW = gridDim.x * 8;
    { const int skip = ((int)gridDim.x >= 64) ? NG : 0;
      if ((int)blockIdx.x >= skip) REPEAT(REP_P0B) transposes<0>(p, scr, lane, ((int)blockIdx.x - skip) * 8 + wid, ((int)gridDim.x - skip) * 8); }
    { const int skip = ((int)gridDim.x >= 64) ? NG : 0;
      if ((int)blockIdx.x >= skip) { const int gw2 = ((int)blockIdx.x - skip) * 8 + wid, NGW2 = ((int)gridDim.x - skip) * 8;
        REPEAT(REP_P0C) for (int r = gw2; r < MTOK; r += 2 * NGW2) { const int r2 = r + NGW2; const bool vb = r2 < MTOK; const int rb = vb ? r2 : r;
          ln_rows2<true>(src_row(p, r), src_row(p, rb), p.in[I_EG], p.in[I_EB], (bf16_t*)(p.ws + W_XN) + (size_t)r * DM, (bf16_t*)(p.ws + W_XN) + (size_t)rb * DM, lane, vb); } } }
}

template <int MODE> __device__ __forceinline__ void lru_unit(const P& p, LAS unsigned char* lds, int b, int kc, int nb) {
    int tid_ = threadIdx.x; asm volatile("" : "+v"(tid_)); const int tid = tid_, lane = tid & 63, wid = tid >> 6, q = lane >> 4, n = lane & 15;
    int mt0, nmt, rowbase;
    if (MODE == 2) { mt0 = kc; nmt = 1; rowbase = MP; } else { mt0 = (NCHUNK * kc) >> 3; nmt = ((NCHUNK * (kc + 1)) >> 3) - mt0; rowbase = b * TT; }
    const int t0 = 16 * mt0, ntok = 16 * nmt;
    const bf16_t* proj = (const bf16_t*)(p.ws + W_PROJ);
    LAS bf16_t* xcs = (LAS bf16_t*)lds;
    LAS bf16_t* gas = (LAS bf16_t*)(lds + 73984);
    if (MODE == 2) {
        for (int it = tid; it < ntok * 16; it += 512) { const int i = it >> 4, cg8 = it & 15, c0 = nb * 128 + cg8 * 8; float a[8];
            { const f32x4 b0 = *(const f32x4*)(p.in[I_CLB] + c0), b1 = *(const f32x4*)(p.in[I_CLB] + c0 + 4); a[0] = b0[0]; a[1] = b0[1]; a[2] = b0[2]; a[3] = b0[3]; a[4] = b1[0]; a[5] = b1[1]; a[6] = b1[2]; a[7] = b1[3]; }
#pragma unroll
            for (int j = 0; j < 4; ++j) { const f32x4 w0 = *(const f32x4*)(p.in[I_CLW] + j * 1024 + c0), w1 = *(const f32x4*)(p.in[I_CLW] + j * 1024 + c0 + 4); float x[8];
                if (j < 3) { const float* cp = p.in[I_CCL] + ((size_t)(t0 + i) * 3 + j) * 1024 + c0; const f32x4 x0 = *(const f32x4*)cp, x1 = *(const f32x4*)(cp + 4);
                    x[0] = x0[0]; x[1] = x0[1]; x[2] = x0[2]; x[3] = x0[3]; x[4] = x1[0]; x[5] = x1[1]; x[6] = x1[2]; x[7] = x1[3]; }
                else { const u32x4 xv = *(const u32x4*)(proj + (size_t)(rowbase + t0 + i) * DIN + c0);
                    x[0] = bflo(xv.x); x[1] = bfhi(xv.x); x[2] = bflo(xv.y); x[3] = bfhi(xv.y); x[4] = bflo(xv.z); x[5] = bfhi(xv.z); x[6] = bflo(xv.w); x[7] = bfhi(xv.w); }
                a[0] += w0[0] * x[0]; a[1] += w0[1] * x[1]; a[2] += w0[2] * x[2]; a[3] += w0[3] * x[3]; a[4] += w1[0] * x[4]; a[5] += w1[1] * x[5]; a[6] += w1[2] * x[6]; a[7] += w1[3] * x[7]; }
            u32x4 o; o.x = cvt_pk_bf16(a[0], a[1]); o.y = cvt_pk_bf16(a[2], a[3]); o.z = cvt_pk_bf16(a[4], a[5]); o.w = cvt_pk_bf16(a[6], a[7]);
            *(LAS u32x4*)(xcs + i * 136 + cg8 * 8) = o;
            *(LAS u32x4*)(gas + i * 128 + cg8 * 8) = *(const u32x4*)(proj + (size_t)(rowbase + t0 + i) * DIN + C_GA + c0); }
    } else {
        const int cg8 = tid & 15, tr = tid >> 4, c0 = nb * 128 + cg8 * 8; float w[4][8], bs[8];
        { const f32x4 b0 = *(const f32x4*)(p.in[I_CLB] + c0), b1 = *(const f32x4*)(p.in[I_CLB] + c0 + 4); bs[0] = b0[0]; bs[1] = b0[1]; bs[2] = b0[2]; bs[3] = b0[3]; bs[4] = b1[0]; bs[5] = b1[1]; bs[6] = b1[2]; bs[7] = b1[3]; }
#pragma unroll
        for (int j = 0; j < 4; ++j) { const f32x4 w0 = *(const f32x4*)(p.in[I_CLW] + j * 1024 + c0), w1 = *(const f32x4*)(p.in[I_CLW] + j * 1024 + c0 + 4);
            w[j][0] = w0[0]; w[j][1] = w0[1]; w[j][2] = w0[2]; w[j][3] = w0[3]; w[j][4] = w1[0]; w[j][5] = w1[1]; w[j][6] = w1[2]; w[j][7] = w1[3]; }
        const int i0 = tr * 9; int i1 = i0 + 9; if (i1 > ntok) i1 = ntok;
        u32x4 xr[12], gr[9];
#pragma unroll
        for (int k = 0; k < 12; ++k) { const int i = i0 - 3 + k, t = t0 + i; xr[k] = (u32x4){0u, 0u, 0u, 0u}; if (t >= 0 && i < i1) xr[k] = *(const u32x4*)(proj + (size_t)(rowbase + t) * DIN + c0); }
#pragma unroll
        for (int k = 0; k < 9; ++k) { gr[k] = (u32x4){0u, 0u, 0u, 0u}; if (i0 + k < i1) gr[k] = *(const u32x4*)(proj + (size_t)(rowbase + t0 + i0 + k) * DIN + C_GA + c0); }
#pragma unroll
        for (int k = 0; k < 9; ++k) { if (i0 + k < i1) { float a[8];
#pragma unroll
            for (int e = 0; e < 8; ++e) a[e] = bs[e];
#pragma unroll
            for (int j = 0; j < 4; ++j) { const u32x4 xv = xr[k + j];
                a[0] += w[j][0] * bflo(xv.x); a[1] += w[j][1] * bfhi(xv.x); a[2] += w[j][2] * bflo(xv.y); a[3] += w[j][3] * bfhi(xv.y);
                a[4] += w[j][4] * bflo(xv.z); a[5] += w[j][5] * bfhi(xv.z); a[6] += w[j][6] * bflo(xv.w); a[7] += w[j][7] * bfhi(xv.w); }
            u32x4 o; o.x = cvt_pk_bf16(a[0], a[1]); o.y = cvt_pk_bf16(a[2], a[3]); o.z = cvt_pk_bf16(a[4], a[5]); o.w = cvt_pk_bf16(a[6], a[7]);
            *(LAS u32x4*)(xcs + (i0 + k) * 136 + cg8 * 8) = o; *(LAS u32x4*)(gas + (i0 + k) * 128 + cg8 * 8) = gr[k]; } }
    }
    __syncthreads();
    const int c = nb * 128 + wid * 16 + n;
    bf16x8 Br[4], Bi[4];
    { const bf16_t* wr_ = (const bf16_t*)(p.ws + W_WTR) + (size_t)c * 128 + q * 8; const bf16_t* wi_ = (const bf16_t*)(p.ws + W_WTI) + (size_t)c * 128 + q * 8;
#pragma unroll
      for (int kk = 0; kk < 4; ++kk) { Br[kk] = *(const bf16x8*)(wr_ + 32 * kk); Bi[kk] = *(const bf16x8*)(wi_ + 32 * kk); } }
    const float br = p.in[I_BR][c], bi = p.in[I_BI][c]; const float c8 = -8.0f * log1pf(expf(-p.in[I_LAM][c]));
    bf16_t* M1 = (bf16_t*)(p.ws + W_MIX); bf16_t* M2 = (bf16_t*)(p.out + O_YP);
    float h_run = 0.f, A_run = 1.f;
    for (int mt = 0; mt < nmt; ++mt) {
        f32x4 accr = {0.f, 0.f, 0.f, 0.f}, acci = {0.f, 0.f, 0.f, 0.f};
#pragma unroll
        for (int kk = 0; kk < 4; ++kk) { const bf16x8 Af = *(const LAS bf16x8*)(xcs + (16 * mt + n) * 136 + 32 * kk + 8 * q);
            accr = __builtin_amdgcn_mfma_f32_16x16x32_bf16(Af, Br[kk], accr, 0, 0, 0); acci = __builtin_amdgcn_mfma_f32_16x16x32_bf16(Af, Bi[kk], acci, 0, 0, 0); }
        float a[4], bx[4], ga[4];
#pragma unroll
        for (int j = 0; j < 4; ++j) { const int tok = 16 * mt + 4 * q + j; const float xcv = bf2f(xcs[tok * 136 + wid * 16 + n]);
            ga[j] = bf2f(gas[tok * 128 + wid * 16 + n]);
            const float r = sigm(accr[j] + br), ig = sigm(acci[j] + bi), la = c8 * r; a[j] = __expf(la); bx[j] = __builtin_amdgcn_sqrtf(fmaf(-a[j], a[j], 1.0f)) * (ig * xcv); }
        float h[4], Ac[4];
        if (MODE == 2) {
#pragma unroll
            for (int j = 0; j < 4; ++j) { const int s = t0 + 16 * mt + 4 * q + j; h[j] = a[j] * p.in[I_SL][(size_t)s * 1024 + c] + bx[j]; p.out[O_SL + (size_t)s * 1024 + c] = h[j]; Ac[j] = 0.f; }
        } else {
            float Ap[4]; h[0] = bx[0]; Ap[0] = a[0];
#pragma unroll
            for (int j = 1; j < 4; ++j) { h[j] = a[j] * h[j - 1] + bx[j]; Ap[j] = a[j] * Ap[j - 1]; }
            float PA = Ap[3], PH = h[3];
            float tA = __shfl_up(PA, 16), tH = __shfl_up(PH, 16); if (q >= 1) { PH = PA * tH + PH; PA = PA * tA; }
            tA = __shfl_up(PA, 32); tH = __shfl_up(PH, 32); if (q >= 2) { PH = PA * tH + PH; PA = PA * tA; }
            const float h_end = PA * h_run + PH; const float hin_s = __shfl_up(h_end, 16), pae_s = __shfl_up(PA, 16);
            const float h_in = (q == 0) ? h_run : hin_s; const float a_in = A_run * ((q == 0) ? 1.0f : pae_s);
#pragma unroll
            for (int j = 0; j < 4; ++j) { h[j] += Ap[j] * h_in; Ac[j] = Ap[j] * a_in; }
            h_run = __shfl(h_end, 48 + n); A_run *= __shfl(PA, 48 + n);
        }
#pragma unroll
        for (int j = 0; j < 4; ++j) { const size_t row = (size_t)(rowbase + t0 + 16 * mt + 4 * q + j); const float sg = sigm(ga[j]);
            M1[row * 1024 + c] = f2bf(sg * h[j]); M2[row * 1024 + c] = f2bf(sg * Ac[j]); }
    }
    if (MODE == 0 && q == 0) { ((float*)(p.ws + W_LRUA))[(size_t)(b * 8 + kc) * 1024 + c] = A_run; ((float*)(p.ws + W_LRUH))[(size_t)(b * 8 + kc) * 1024 + c] = h_run; }
    __syncthreads();
}

__device__ __forceinline__ void s5_fused(const P& p, LAS unsigned char* lds, int g, int b) {
    int tid_ = threadIdx.x; asm volatile("" : "+v"(tid_)); const int tid = tid_, lane = tid & 63, wid = tid >> 6, n = lane & 15, q = lane >> 4;
    LAS bf16_t* Us = (LAS bf16_t*)lds;
    LAS float* Ssm = (LAS float*)(lds + 68112);
    LAS bf16_t* Hs = (LAS bf16_t*)(lds + 68112);
    const bf16_t* proj = (const bf16_t*)(p.ws + W_PROJ); const bf16x8 zero = {0, 0, 0, 0, 0, 0, 0, 0};
    TIMED(231) { const bf16_t* ub = (const bf16_t*)(p.out + O_YP) + (size_t)MTOK * 1024 + (size_t)(b * NG + g) * TT * 16;
      u32x4 tv[9];
#pragma unroll
      for (int i = 0; i < 9; ++i) { const int it = tid + 512 * i; tv[i] = (u32x4){0u, 0u, 0u, 0u}; if (it < TT * 2) tv[i] = *(const u32x4*)(ub + (size_t)it * 8); }
#pragma unroll
      for (int i = 0; i < 9; ++i) { const int it = tid + 512 * i; if (it < TT * 2) { const int t = it >> 1; *(LAS u32x4*)(Us + (t >> 4) * 264 + (t & 15) * 16 + 8 * (it & 1)) = tv[i]; } } }
    __syncthreads();
    TIMED_END(231)
    TIMED(232) { const bf16_t* W = (const bf16_t*)(p.ws + W_W1) + (size_t)g * 128 * 256; bf16x8 Bf[8];
#pragma unroll
      for (int kk = 0; kk < 8; ++kk) Bf[kk] = *(const bf16x8*)(W + (size_t)(16 * wid + n) * 256 + 32 * kk + 8 * q);
#pragma unroll 1
      for (int rt = 0; rt < 9; ++rt) { const int k = 16 * rt + n; const bool valid = k < NCHUNK; const int kc = valid ? k : 0; f32x4 acc = {0.f, 0.f, 0.f, 0.f};
#pragma unroll
          for (int kk = 0; kk < 8; ++kk) { const bf16x8 uv = *(const LAS bf16x8*)(Us + kc * 264 + 32 * kk + 8 * q); const bf16x8 Af = valid ? uv : zero;
              acc = __builtin_amdgcn_mfma_f32_16x16x32_bf16(Af, Bf[kk], acc, 0, 0, 0); }
#pragma unroll
          for (int j = 0; j < 4; ++j) Ssm[(16 * rt + 4 * q + j) * 128 + 16 * wid + n] = acc[j]; } }
    __syncthreads();
    TIMED_END(232)
    bf16x8 Bw[2][12];
    { const bf16_t* W = (const bf16_t*)(p.ws + W_W2) + (size_t)g * 256 * 384;
#pragma unroll
      for (int i = 0; i < 2; ++i)
#pragma unroll
          for (int kk = 0; kk < 12; ++kk) Bw[i][kk] = *(const bf16x8*)(W + (size_t)(16 * (2 * wid + i) + n) * 384 + 32 * kk + 8 * q); }
    TIMED(233) if (wid == 0) { const float* a16 = (const float*)(p.ws + W_A16) + (g * 64 + lane) * 2; const float ar = a16[0], ai = a16[1]; float hr = 0.f, hi = 0.f;
#pragma unroll 1
        for (int kb = 0; kb < 132; kb += 4) { float sr[4], si[4];
#pragma unroll
            for (int u = 0; u < 4; ++u) { sr[u] = Ssm[(kb + u) * 128 + lane]; si[u] = Ssm[(kb + u) * 128 + 64 + lane]; }
            LDS_WAIT();
#pragma unroll
            for (int u = 0; u < 4; ++u) { const int k = kb + u; if (k < NCHUNK) { Hs[k * 136 + lane] = f2bf(hr); Hs[k * 136 + 64 + lane] = f2bf(hi);
                const float nr = ar * hr - ai * hi + sr[u], ni = ar * hi + ai * hr + si[u]; hr = nr; hi = ni; } } }
        p.out[O_PSR + ((size_t)b * NG + g) * 64 + lane] = hr; p.out[O_PSI + ((size_t)b * NG + g) * 64 + lane] = hi; }
    __syncthreads();
    TIMED_END(233)
    TIMED(234)
    {
#pragma unroll 1
      for (int rt = 0; rt < 9; ++rt) { const int k = 16 * rt + n; const bool valid = k < NCHUNK; const int kc = valid ? k : 0; f32x4 acc0 = {0.f, 0.f, 0.f, 0.f}, acc1 = {0.f, 0.f, 0.f, 0.f};
#pragma unroll
          for (int kk = 0; kk < 8; ++kk) { const bf16x8 uv = *(const LAS bf16x8*)(Us + kc * 264 + 32 * kk + 8 * q); const bf16x8 af = valid ? uv : zero;
              acc0 = __builtin_amdgcn_mfma_f32_16x16x32_bf16(af, Bw[0][kk], acc0, 0, 0, 0); acc1 = __builtin_amdgcn_mfma_f32_16x16x32_bf16(af, Bw[1][kk], acc1, 0, 0, 0); }
#pragma unroll
          for (int kk = 8; kk < 12; ++kk) { const bf16x8 hv = *(const LAS bf16x8*)(Hs + kc * 136 + 32 * (kk - 8) + 8 * q); const bf16x8 af = valid ? hv : zero;
              acc0 = __builtin_amdgcn_mfma_f32_16x16x32_bf16(af, Bw[0][kk], acc0, 0, 0, 0); acc1 = __builtin_amdgcn_mfma_f32_16x16x32_bf16(af, Bw[1][kk], acc1, 0, 0, 0); }
#pragma unroll
          for (int j = 0; j < 4; ++j) { const int k2 = 16 * rt + 4 * q + j; if (k2 < NCHUNK) { bf16_t* Y = (bf16_t*)(p.ws + W_YSG) + (size_t)(b * TT + 16 * k2 + 2 * wid) * DSSM + 16 * g + n;
              Y[0] = f2bf(gelu_tanh(acc0[j])); Y[DSSM] = f2bf(gelu_tanh(acc1[j])); } } } }
    TIMED_END(234)
}
__device__ __forceinline__ void s5_sample(const P& p, int s, int g, int lane) {
    const bf16_t* up = (const bf16_t*)(p.out + O_YP) + (size_t)MTOK * 1024 + (size_t)MP * DSSM + ((size_t)s * NG + g) * 16;
    const u32x4 u0 = *(const u32x4*)up, u1 = *(const u32x4*)(up + 8); float u[16];
    u[0] = bflo(u0.x); u[1] = bfhi(u0.x); u[2] = bflo(u0.y); u[3] = bfhi(u0.y); u[4] = bflo(u0.z); u[5] = bfhi(u0.z); u[6] = bflo(u0.w); u[7] = bfhi(u0.w);
    u[8] = bflo(u1.x); u[9] = bfhi(u1.x); u[10] = bflo(u1.y); u[11] = bfhi(u1.y); u[12] = bflo(u1.z); u[13] = bfhi(u1.z); u[14] = bflo(u1.w); u[15] = bfhi(u1.w);
    const float* a1 = (const float*)(p.ws + W_A1) + (g * 64 + lane) * 2; const float ar = a1[0], ai = a1[1];
    const float* bb = (const float*)(p.ws + W_BBAR) + (size_t)(g * 64 + lane) * 32; float bur = 0.f, bui = 0.f;
#pragma unroll
    for (int c = 0; c < 16; ++c) { bur += bb[2 * c] * u[c]; bui += bb[2 * c + 1] * u[c]; }
    const size_t si = ((size_t)s * NG + g) * 64 + lane; const float h0r = p.in[I_SSR][si], h0i = p.in[I_SSI][si];
    const float hr = ar * h0r - ai * h0i + bur, hi = ar * h0i + ai * h0r + bui;
    p.out[O_SSR + si] = hr; p.out[O_SSI + si] = hi;
    float v16[16];
#pragma unroll
    for (int c1 = 0; c1 < 16; ++c1) v16[c1] = p.in[I_SCRE][(g * 16 + c1) * 64 + lane] * hr - p.in[I_SCIM][(g * 16 + c1) * 64 + lane] * hi;
    float v8[8], v4[4], v2[2], v1;
    { const bool hi32 = (lane & 32) != 0;
#pragma unroll
      for (int i = 0; i < 8; ++i) { const float keep = hi32 ? v16[i + 8] : v16[i], send = hi32 ? v16[i] : v16[i + 8]; v8[i] = keep + __shfl_xor(send, 32); } }
    { const bool hb = (lane & 16) != 0;
#pragma unroll
      for (int i = 0; i < 4; ++i) { const float keep = hb ? v8[i + 4] : v8[i], send = hb ? v8[i] : v8[i + 4]; v4[i] = keep + __shfl_xor(send, 16); } }
    { const bool hb = (lane & 8) != 0;
#pragma unroll
      for (int i = 0; i < 2; ++i) { const float keep = hb ? v4[i + 2] : v4[i], send = hb ? v4[i] : v4[i + 2]; v2[i] = keep + __shfl_xor(send, 8); } }
    { const bool hb = (lane & 4) != 0; const float keep = hb ? v2[1] : v2[0], send = hb ? v2[0] : v2[1]; v1 = keep + __shfl_xor(send, 4); }
    v1 += __shfl_xor(v1, 1); v1 += __shfl_xor(v1, 2);
    const int c1 = ((lane >> 5) & 1) * 8 + ((lane >> 4) & 1) * 4 + ((lane >> 3) & 1) * 2 + ((lane >> 2) & 1);
    if ((lane & 3) == 0) { const float uc = bf2f(up[c1]); const float yv = v1 + p.in[I_SD][g * 16 + c1] * uc;
        ((bf16_t*)(p.ws + W_YSG))[(size_t)(MP + s) * DSSM + 16 * g + c1] = f2bf(gelu_tanh(yv)); }
}
__device__ __forceinline__ void phase2a(const P& p, LAS unsigned char* lds) {
    TIMED(22) for (int u = blockIdx.x; u < 512; u += gridDim.x) lru_unit<0>(p, lds, (u >> 3) & 7, u >> 6, u & 7); TIMED_END(22)
    TIMED(23) for (int it = blockIdx.x; it < NG * NBATCH; it += gridDim.x) s5_fused(p, lds, it & 31, it >> 5); TIMED_END(23)
}
__device__ __forceinline__ void phase2b(const P& p, LAS unsigned char* lds) {
    int tid_ = threadIdx.x; asm volatile("" : "+v"(tid_)); const int tid = tid_, lane = tid & 63, wid = tid >> 6;
    const size_t gt = (size_t)blockIdx.x * 512 + tid, GT = (size_t)gridDim.x * 512;
    for (size_t i = gt; i < (size_t)NBATCH * 1024; i += GT) { const int b = (int)(i >> 10), c = (int)(i & 1023); float h = 0.f;
        const float* A = (const float*)(p.ws + W_LRUA); const float* Hh = (const float*)(p.ws + W_LRUH); float* Cc = (float*)(p.ws + W_LRUC);
        for (int kc = 0; kc < 8; ++kc) { const size_t o = (size_t)(b * 8 + kc) * 1024 + c; Cc[o] = h; h = A[o] * h + Hh[o]; }
        p.out[O_PL + i] = h; }
    for (int u = (int)gridDim.x - 1 - (int)blockIdx.x; u < 64; u += gridDim.x) lru_unit<2>(p, lds, 0, u >> 3, u & 7);
    for (int it = blockIdx.x * 8 + wid; it < NSAMP * NG; it += gridDim.x * 8) s5_sample(p, it >> 5, it & 31, lane);
    const bf16_t* proj = (const bf16_t*)(p.ws + W_PROJ);
    for (size_t i = gt; i < (size_t)NBATCH * 3 * 1024; i += GT) { const int c = (int)(i & 1023), j = (int)((i >> 10) % 3), b = (int)(i / 3072);
        p.out[O_PCL + i] = bf2f(proj[(size_t)(b * TT + TT - 3 + j) * DIN + c]); }
    for (size_t i = gt; i < (size_t)NSAMP * 3 * 1024; i += GT) { const int c = (int)(i & 1023), j = (int)((i >> 10) % 3), s = (int)(i / 3072);
        p.out[O_SCL + i] = (j < 2) ? p.in[I_CCL][((size_t)s * 3 + j + 1) * 1024 + c] : bf2f(proj[(size_t)(MP + s) * DIN + c]); }
    for (size_t i = gt; i < (size_t)NSAMP * DFF; i += GT) { const int ch = (int)(i % DFF), s = (int)(i / DFF);
        p.out[O_SCF + ((size_t)s * 2) * DFF + ch] = p.in[I_CCF][((size_t)s * 2 + 1) * DFF + ch]; }
}
__device__ __forceinline__ void phase_glutail(const P& p) {
    const size_t gt = (size_t)blockIdx.x * 512 + threadIdx.x, GT = (size_t)gridDim.x * 512;
    const float* pg = (const float*)(p.ws + W_PG); const float* bias = p.in[I_BGLU]; const bf16_t* proj = (const bf16_t*)(p.ws + W_PROJ);
    bf16_t* mix = (bf16_t*)(p.ws + W_MIX); const bf16_t* m2 = (const bf16_t*)(p.out + O_YP); const float* carry = (const float*)(p.ws + W_LRUC);
    for (size_t it = gt; it < (size_t)256 * 256; it += GT) { const int rl = (int)(it >> 8), j = (int)(it & 255) * 4, rowi = 16384 + rl; const size_t row = (size_t)rowi; const int col = 256 * (j >> 7) + (j & 127);
        f32x4 val = *(const f32x4*)(bias + j), gate = *(const f32x4*)(bias + 1024 + j);
#pragma unroll
        for (int ks = 0; ks < 2; ++ks) { val += *(const f32x4*)(pg + (size_t)ks * 256 * 2048 + (size_t)rl * 2048 + col); gate += *(const f32x4*)(pg + (size_t)ks * 256 * 2048 + (size_t)rl * 2048 + col + 128); }
        int cidx = 0; if (rowi < MP) { const int b = rowi / TT, t = rowi - b * TT; int kc = t >> 8; kc = kc > 7 ? 7 : kc; cidx = (b * 8 + kc) * 1024; }
        const f32x4 cv = *(const f32x4*)(carry + cidx + j); const u32x2 gbw = *(const u32x2*)(proj + row * DIN + C_GB + j), mw = *(const u32x2*)(mix + row * 1024 + j), m2w = *(const u32x2*)(m2 + row * 1024 + j);
        const float o0 = bflo(mw.x) + bflo(m2w.x) * cv[0] + sigm(bflo(gbw.x)) * val[0] * sigm(gate[0]), o1 = bfhi(mw.x) + bfhi(m2w.x) * cv[1] + sigm(bfhi(gbw.x)) * val[1] * sigm(gate[1]);
        const float o2 = bflo(mw.y) + bflo(m2w.y) * cv[2] + sigm(bflo(gbw.y)) * val[2] * sigm(gate[2]), o3 = bfhi(mw.y) + bfhi(m2w.y) * cv[3] + sigm(bfhi(gbw.y)) * val[3] * sigm(gate[3]);
        u32x2 w; w.x = cvt_pk_bf16(o0, o1); w.y = cvt_pk_bf16(o2, o3); *(u32x2*)(mix + row * 1024 + j) = w; }
}
__device__ __forceinline__ void phase_ln1(const P& p) {
    const int lane = threadIdx.x & 63, wid = threadIdx.x >> 6; const int gw = blockIdx.x * 8 + wid, NGW = gridDim.x * 8;
    const bf16_t* R = (const bf16_t*)(p.ws + W_R1); bf16_t* X = (bf16_t*)(p.ws + W_XN);
    for (int r = gw; r < 16384; r += 2 * NGW) { const int r2 = r + NGW; const bool vb = r2 < 16384; const int rb = vb ? r2 : r;
        ln_rows2_bf<true>(R + (size_t)r * DM, R + (size_t)rb * DM, p.in[I_L1G], p.in[I_L1B], X + (size_t)r * DM, X + (size_t)rb * DM, lane, vb); }
    for (int r = 16384 + gw; r < MTOK; r += NGW) { bf16_t* xr = X + (size_t)r * DM;
        ln_row<true>((const float*)(p.ws + W_PART) + (size_t)(r - 16384) * DM, p.in[I_L1G], p.in[I_L1B], xr, lane, 4, xr, p.in[I_BOUT]); }
}
__device__ __forceinline__ void phase_ffnfix(const P& p) {
    const size_t gt = (size_t)blockIdx.x * 512 + threadIdx.x, GT = (size_t)gridDim.x * 512;
    const float* sbg = (const float*)(p.ws + W_SBG); const float* sbv = (const float*)(p.ws + W_SBV); bf16_t* H = (bf16_t*)(p.ws + W_V);
    for (size_t it = gt; it < (size_t)256 * 2 * 384; it += GT) { const int cg8 = (int)(it % 384), rr = (int)((it / 384) & 1), blk = (int)(it / 768), ch = cg8 * 8, row = blk * 64 + rr; const int t = row % TT;
        float o[8];
#pragma unroll
        for (int hh = 0; hh < 2; ++hh) { const int c = ch + 4 * hh; const f32x4 z = {0.f, 0.f, 0.f, 0.f};
            const f32x4 g0 = *(const f32x4*)(sbg + ((size_t)blk * 4 + rr) * DFF + c), v = *(const f32x4*)(sbv + ((size_t)blk * 2 + rr) * DFF + c);
            f32x4 g1, g2;
            if (rr == 0) { g1 = (blk > 0 && t >= 1) ? *(const f32x4*)(sbg + ((size_t)(blk - 1) * 4 + 3) * DFF + c) : z; g2 = (blk > 0 && t >= 2) ? *(const f32x4*)(sbg + ((size_t)(blk - 1) * 4 + 2) * DFF + c) : z; }
            else { g1 = (t >= 1) ? *(const f32x4*)(sbg + ((size_t)blk * 4) * DFF + c) : z; g2 = (blk > 0 && t >= 2) ? *(const f32x4*)(sbg + ((size_t)(blk - 1) * 4 + 3) * DFF + c) : z; }
            const f32x4 w0 = *(const f32x4*)(p.in[I_FCW] + c), w1 = *(const f32x4*)(p.in[I_FCW] + DFF + c), w2 = *(const f32x4*)(p.in[I_FCW] + 2 * DFF + c), cbv = *(const f32x4*)(p.in[I_FCB] + c);
            const f32x4 y = cbv + w0 * g2 + w1 * g1 + w2 * g0;
            o[4 * hh] = gelu_tanh(y[0]) * v[0]; o[4 * hh + 1] = gelu_tanh(y[1]) * v[1]; o[4 * hh + 2] = gelu_tanh(y[2]) * v[2]; o[4 * hh + 3] = gelu_tanh(y[3]) * v[3]; }
        u32x4 w; w.x = cvt_pk_bf16(o[0], o[1]); w.y = cvt_pk_bf16(o[2], o[3]); w.z = cvt_pk_bf16(o[4], o[5]); w.w = cvt_pk_bf16(o[6], o[7]);
        *(u32x4*)(H + (size_t)row * DFF + ch) = w; }
}
__device__ __forceinline__ f32x4 up_tail_sum(const float* pu, const float* bias, int rl, int col, int bcol) {
    f32x4 v = *(const f32x4*)(bias + bcol);
#pragma unroll
    for (int ks = 0; ks < 4; ++ks) v += *(const f32x4*)(pu + (size_t)ks * 256 * 6144 + (size_t)rl * 6144 + col);
    return v;
}
__device__ __forceinline__ void phase_ffntail(const P& p) {
    const size_t gt = (size_t)blockIdx.x * 512 + threadIdx.x, GT = (size_t)gridDim.x * 512;
    const float* pu = (const float*)(p.ws + W_PU); const float* sbg = (const float*)(p.ws + W_SBG); bf16_t* H = (bf16_t*)(p.ws + W_V); const float* bias = p.in[I_BUP];
    for (size_t it = gt; it < (size_t)256 * 768; it += GT) { const int rl = (int)(it / 768), ch = (int)(it - (size_t)rl * 768) * 4, row = 16384 + rl; const int colg = 256 * (ch >> 7) + (ch & 127);
        const f32x4 g0 = up_tail_sum(pu, bias, rl, colg, ch), v = up_tail_sum(pu, bias, rl, colg + 128, DFF + ch); f32x4 g1, g2;
        if (row >= MP) { const int s_ = row - MP; g2 = *(const f32x4*)(p.in[I_CCF] + ((size_t)s_ * 2) * DFF + ch); g1 = *(const f32x4*)(p.in[I_CCF] + ((size_t)s_ * 2 + 1) * DFF + ch);
            *(f32x4*)(p.out + O_SCF + ((size_t)s_ * 2 + 1) * DFF + ch) = g0; }
        else {
            g1 = (rl >= 1) ? up_tail_sum(pu, bias, rl - 1, colg, ch) : *(const f32x4*)(sbg + ((size_t)255 * 4 + 3) * DFF + ch);
            g2 = (rl >= 2) ? up_tail_sum(pu, bias, rl - 2, colg, ch) : *(const f32x4*)(sbg + ((size_t)255 * 4 + 2 + rl) * DFF + ch);
            const int t = row - 7 * TT; if (t >= TT - 2) *(f32x4*)(p.out + O_PCF + ((size_t)7 * 2 + (t - (TT - 2))) * DFF + ch) = g0; }
        const f32x4 w0 = *(const f32x4*)(p.in[I_FCW] + ch), w1 = *(const f32x4*)(p.in[I_FCW] + DFF + ch), w2 = *(const f32x4*)(p.in[I_FCW] + 2 * DFF + ch), cbv = *(const f32x4*)(p.in[I_FCB] + ch);
        const f32x4 y = cbv + w0 * g2 + w1 * g1 + w2 * g0;
        u32x2 w; w.x = cvt_pk_bf16(gelu_tanh(y[0]) * v[0], gelu_tanh(y[1]) * v[1]); w.y = cvt_pk_bf16(gelu_tanh(y[2]) * v[2], gelu_tanh(y[3]) * v[3]);
        *(u32x2*)(H + (size_t)row * DFF + ch) = w; }
}
__device__ __forceinline__ float* y_row(const P& p, int r) {
    if (r >= MP) return p.out + O_YS + (size_t)(r - MP) * DM;
    const int b = r / TT, t = r - b * TT; return t < 16 ? nullptr : p.out + O_YP + ((size_t)b * 2048 + (t - 16)) * DM;
}
__device__ __forceinline__ void phase_ln2(const P& p) {
    const int lane = threadIdx.x & 63, wid = threadIdx.x >> 6; const int gw = blockIdx.x * 8 + wid, NGW = gridDim.x * 8;
    const bf16_t* R = (const bf16_t*)(p.ws + W_R2);
    for (int r = gw; r < 16384; r += 2 * NGW) { const int r2 = r + NGW; float* oa = y_row(p, r); float* ob = (r2 < 16384) ? y_row(p, r2) : nullptr;
        if (oa && ob) ln_rows2_bf<false>(R + (size_t)r * DM, R + (size_t)r2 * DM, p.in[I_L2G], p.in[I_L2B], oa, ob, lane, true);
        else if (oa) ln_rows2_bf<false>(R + (size_t)r * DM, R + (size_t)r * DM, p.in[I_L2G], p.in[I_L2B], oa, oa, lane, false);
        else if (ob) ln_rows2_bf<false>(R + (size_t)r2 * DM, R + (size_t)r2 * DM, p.in[I_L2G], p.in[I_L2B], ob, ob, lane, false); }
    for (int r = 16384 + gw; r < MTOK; r += NGW) { float* o = y_row(p, r);
        if (o) ln_row<false>((const float*)(p.ws + W_PART) + (size_t)(r - 16384) * DM, p.in[I_L2G], p.in[I_L2B], o, lane, 12, (const bf16_t*)(p.ws + W_XN) + (size_t)r * DM, p.in[I_BDOWN]); }
}

__global__ __launch_bounds__(512, 2) void hawk_fwd(P p) {
    extern __shared__ __attribute__((aligned(16))) unsigned char shm[];
    LAS unsigned char* lds = (LAS unsigned char*)shm;
    cg::grid_group grid = cg::this_grid();
    volatile LAS unsigned* xst = (volatile LAS unsigned*)(lds + LDS_TOTAL - 16);
    if (threadIdx.x < 4) xst[threadIdx.x] = 0u;
    __syncthreads();
    XcdBarrier xb = xcd_barrier_post((unsigned*)(p.ws + W_BAR), xst);
    if (threadIdx.x == 0) xst[2] = xb_add((unsigned*)(p.ws + W_BAR) + XCD_BAR_WORDS + 64 * xb.x, 1u);
#define GSYNC() xcd_barrier(xb)
    if (p.ws == nullptr) grid.sync();
    TIMED(0) REPEAT(REP_P0) { phase0(p, lds); GSYNC(); } TIMED_END(0)
    if (threadIdx.x == 0) { unsigned* bar = (unsigned*)(p.ws + W_BAR); bool ok = (gridDim.x % 8u) == 0u;
        for (unsigned j = 0; j < 16; ++j) { const unsigned cnt = xb_ld(&bar[XB_XCNT(j)]); if (cnt != (j < 8 ? gridDim.x / 8u : 0u)) ok = false; }
        xst[3] = ok ? (xst[2] * 8u + xb.x) : blockIdx.x; }
    __syncthreads();
    const int vc = (int)xst[3];
    TIMED(1) REPEAT(REP_P1) { EpiProj E; E.O = (bf16_t*)(p.ws + W_PROJ); E.bias = p.in[I_BIN]; E.UT = (bf16_t*)(p.out + O_YP) + (size_t)MTOK * 1024; run_gemm(lds, vc, (const bf16_t*)(p.ws + W_XN), (const bf16_t*)(p.ws + W_WTIN), DIN, 1024, E);
        { const int G = (int)gridDim.x, nun = (MTOK / 256) * (DIN / 256), rem = nun % G; const int c = vc;
          if (c >= rem) transposes<1>(p, (LAS float*)(lds + (threadIdx.x >> 6) * 8704), threadIdx.x & 63, (c - rem) * 8 + (int)(threadIdx.x >> 6), (G - rem) * 8); }
        GSYNC(); } TIMED_END(1)
    TIMED(20) REPEAT(REP_P2A) { phase2a(p, lds); GSYNC(); } TIMED_END(20)
    TIMED(21) REPEAT(REP_P2B) { phase2b(p, lds); GSYNC(); } TIMED_END(21)
    TIMED(3) { EpiGlu E; E.mix = (bf16_t*)(p.ws + W_MIX); E.m2 = (const bf16_t*)(p.out + O_YP); E.carry = (const float*)(p.ws + W_LRUC); E.proj = (const bf16_t*)(p.ws + W_PROJ); E.bias = p.in[I_BGLU]; run_gemm_main64(lds, vc, (const bf16_t*)(p.ws + W_YSG), (const bf16_t*)(p.ws + W_WTGLU), 2048, 512, E);
        run_gemm_tail(lds, vc, (const bf16_t*)(p.ws + W_YSG), (const bf16_t*)(p.ws + W_WTGLU), 2048, 512, 2, (float*)(p.ws + W_PG)); GSYNC();
        phase_glutail(p); GSYNC(); } TIMED_END(3)
    TIMED(4) REPEAT(REP_P4) { EpiRes E; E.R = (bf16_t*)(p.ws + W_R1); E.X = (const bf16_t*)(p.ws + W_XN); E.bias = p.in[I_BOUT]; E.part = (float*)(p.ws + W_PART); run_gemm_split(lds, vc, (const bf16_t*)(p.ws + W_MIX), (const bf16_t*)(p.ws + W_WTOUT), 1024, 1024, 4, E); GSYNC(); } TIMED_END(4)
    TIMED(5) REPEAT(REP_P5) { phase_ln1(p); GSYNC(); } TIMED_END(5)
    TIMED(6) REPEAT(REP_P6) { EpiUp E; E.H = (bf16_t*)(p.ws + W_V); E.bias = p.in[I_BUP]; E.out = p.out; E.cw = p.in[I_FCW]; E.cb = p.in[I_FCB]; E.cache = p.in[I_CCF]; E.sbg = (float*)(p.ws + W_SBG); E.sbv = (float*)(p.ws + W_SBV); run_gemm_main64(lds, vc, (const bf16_t*)(p.ws + W_XN), (const bf16_t*)(p.ws + W_WTUP), 6144, 1024, E);
        run_gemm_tail(lds, vc, (const bf16_t*)(p.ws + W_XN), (const bf16_t*)(p.ws + W_WTUP), 6144, 1024, 4, (float*)(p.ws + W_PU)); GSYNC(); } TIMED_END(6)
    TIMED(7) phase_ffnfix(p); phase_ffntail(p);
    GSYNC(); TIMED_END(7)
    TIMED(8) REPEAT(REP_P8) { EpiRes E; E.R = (bf16_t*)(p.ws + W_R2); E.X = (const bf16_t*)(p.ws + W_XN); E.bias = p.in[I_BDOWN]; E.part = (float*)(p.ws + W_PART); run_gemm_split(lds, vc, (const bf16_t*)(p.ws + W_V), (const bf16_t*)(p.ws + W_WTDOWN), 1024, 3072, 12, E); GSYNC(); } TIMED_END(8)
    TIMED(9) REPEAT(REP_P9) phase_ln2(p); TIMED_END(9)
}

extern "C" void kernel_launch(void* const* d_in, const int* in_sizes, int n_in, void* d_out, int out_size, void* d_ws, size_t ws_size, hipStream_t stream) {
    constexpr int LDS_BYTES = LDS_TOTAL;
    static int grid = 0;
    if (grid == 0) {
        if (n_in != N_IN || (size_t)out_size != O_END || ws_size < 268435456ull) { fprintf(stderr, "kernel_launch: unexpected shapes (n_in %d out %d ws %zu)\n", n_in, out_size, ws_size); grid = -1; return; }
        int dev = 0, cus = 0, per_cu = 0;
        if (hipGetDevice(&dev) != hipSuccess || hipDeviceGetAttribute(&cus, hipDeviceAttributeMultiprocessorCount, dev) != hipSuccess) { grid = -1; return; }
        if (hipFuncSetAttribute((const void*)hawk_fwd, hipFuncAttributeMaxDynamicSharedMemorySize, LDS_BYTES) != hipSuccess) { fprintf(stderr, "kernel_launch: hipFuncSetAttribute failed\n"); grid = -1; return; }
        if (hipOccupancyMaxActiveBlocksPerMultiprocessor(&per_cu, (const void*)hawk_fwd, 512, LDS_BYTES) != hipSuccess || per_cu < 1) { fprintf(stderr, "kernel_launch: occupancy query failed (%d)\n", per_cu); grid = -1; (void)hipGetLastError(); return; }
        grid = cus * per_cu;
    }
    if (grid < 0) return;
    if (hipMemsetAsync((char*)d_ws + W_BAR, 0, (XCD_BAR_WORDS + 64 * 16) * 4, stream) != hipSuccess) { fprintf(stderr, "kernel_launch: memset failed\n"); return; }
    P p{};
    for (int i = 0; i < N_IN; ++i) p.in[i] = (const float*)d_in[i];
    p.out = (float*)d_out; p.ws = (unsigned char*)d_ws;
    void* args[] = {&p};
    hipError_t e = hipLaunchCooperativeKernel((const void*)hawk_fwd, dim3(grid), dim3(512), args, LDS_BYTES, stream);
    if (e != hipSuccess) fprintf(stderr, "cooperative launch failed: %s (grid %d)\n", hipGetErrorString(e), grid);
}
```

```cpp
#include <hip/hip_runtime.h>
#include <hip/hip_cooperative_groups.h>
#include <cstdio>
#include <cstdint>
namespace cg = cooperative_groups;
#define REP_P0 1
#define REP_P0A 1
#define REP_P0B 1
#define REP_P0C 1
#define REP_P1 1
#define REP_P3 1
#define REP_P2A 1
#define REP_P2B 1
#define REP_P2C 1
#define REP_P4 1
#define REP_P5 1
#define REP_P6 1
#define REP_P8 1
#define REP_P9 1
#define PROBE_PHASE -1
namespace pg8 {
#define PG8_LAS __attribute__((address_space(3)))
typedef unsigned short bf16_t;
typedef short bf16x8 __attribute__((ext_vector_type(8)));
typedef float f32x4 __attribute__((ext_vector_type(4)));
typedef unsigned u32x4 __attribute__((ext_vector_type(4)));
constexpr int BM = 256, BK = 64, HALF = 128, HTB = HALF * BK * 2  , STAGE_BYTES = 8 * HTB, NXCD = 8, WGM = 8;

__host__ __device__ __forceinline__ int lds_byte(int r, int c) { const int st = (r >> 4) * 2 + (c >> 5), rr = r & 15, cc = c & 31, ob = rr * 64 + cc * 2; return st * 1024 + (ob ^ (((ob >> 9) & 1) << 5)); }
__host__ __device__ __forceinline__ void stage_rc(int b, int& R, int& C) { const int st = b / 1024, sb = b % 1024, swz = sb ^ (((sb >> 9) & 1) << 5); R = (st >> 1) * 16 + swz / 64; C = (st & 1) * 32 + (swz % 64) / 2; }
__host__ __device__ __forceinline__ int perm32(int rho) { const int n = rho >> 4, i = rho & 15; return 8 * (i >> 2) + 4 * n + (i & 3); }

struct Unit { int pm, pn, k0, nt, ks; };
struct Gemm { const bf16_t* A; const bf16_t* Bt; int M, N, K; };

struct StaticOrder {
    int nM, nN, nwg, G, c, ntk;
    __host__ __device__ void init(int M, int N, int K, int G_, int c_) { nM = M / BM; nN = N / BM; nwg = nM * nN; G = G_; c = c_; ntk = K / BK; }
    __host__ __device__ bool next(int i, Unit& u) const {
        const long L = (long)i * G + c; if (L >= nwg) return false;
        int wgid = (int)L; { const int q = nwg / NXCD, r = nwg % NXCD, xcd = wgid % NXCD, off = wgid / NXCD; wgid = (xcd < r ? xcd * (q + 1) : r * (q + 1) + (xcd - r) * q) + off; }
        const int nig = WGM * nN, gid = wgid / nig, fm = gid * WGM, gsz = (nM - fm) < WGM ? (nM - fm) : WGM;
        u.pm = fm + ((wgid % nig) % gsz); u.pn = (wgid % nig) / gsz; u.k0 = 0; u.nt = ntk; u.ks = -1; return true;
    }
    __device__ __forceinline__ void a_ready(const Unit&) const {}
    __device__ __forceinline__ void done(const Unit&) const {}
};
struct TailOrder {
    int nN, ntk, nsplit, G, c;
    __host__ __device__ void init(int N, int K, int nsplit_, int G_, int c_) { nN = N / BM; ntk = K / BK; nsplit = nsplit_; G = G_; c = c_; }
    __host__ __device__ bool next(int i, Unit& u) const {
        const long L = (long)i * G + c; const bool ok = L < (long)nN * nsplit; const int ks = (int)(L / nN), ntp = ntk / nsplit;
        u.pm = 64; u.pn = (int)(L % nN); u.ks = ks; u.nt = ntp; u.k0 = ks * ntp * BK; return ok;
    }
    __device__ __forceinline__ void a_ready(const Unit&) const {}
    __device__ __forceinline__ void done(const Unit&) const {}
};
struct SplitOrder {
    StaticOrder base; int nsplit;
    __host__ __device__ void init(int N, int K, int nsplit_, int G_, int c_) { base.init(64 * BM, N, K, G_, c_); nsplit = nsplit_; }
    __host__ __device__ bool next(int i, Unit& u) const {
        Unit t; t.pm = 0; t.pn = 0; t.k0 = 0; t.nt = base.ntk; t.ks = -1;
        const bool ok = base.next(i, t);
        const long L = (long)i * base.G + base.c - base.nwg; const bool sp = (!ok) && L >= 0 && L < (long)base.nN * nsplit;
        const int ks = (int)(L / base.nN), pn = (int)(L % base.nN), ntp = base.ntk / nsplit;
        u.pm = sp ? 64 : t.pm; u.pn = sp ? pn : t.pn; u.ks = sp ? ks : -1; u.nt = sp ? ntp : t.nt; u.k0 = sp ? ks * ntp * BK : 0;
        return ok || sp;
    }
    __device__ __forceinline__ void a_ready(const Unit&) const {}
    __device__ __forceinline__ void done(const Unit&) const {}
};
__device__ __forceinline__ unsigned cvt_pk_bf16(float lo, float hi) { unsigned r; asm volatile("v_cvt_pk_bf16_f32 %0, %1, %2" : "=v"(r) : "v"(lo), "v"(hi)); return r; }
template <class Epi, class Sched, bool STAMP = false>
__device__ __forceinline__ void gemm_phase(PG8_LAS unsigned char* lds, const Gemm g, const Sched& S, const Epi& E, unsigned long long* stamps) {
    int tid_ = threadIdx.x; asm volatile("" : "+v"(tid_)); const int tid = tid_, wid = __builtin_amdgcn_readfirstlane(tid >> 6), lane = tid & 63, wr = wid >> 2, wc = wid & 3, fr = lane & 15, fq = lane >> 4;
    const int K = g.K;
    int ts_lo = 0, ts_hi = 0, nts = 0; const unsigned long long rt_entry = STAMP ? (unsigned long long)wall_clock64() : 0ull;
#define PG8_STAMP() do { if (STAMP && wid == 0 && nts < 64) { const unsigned long long _c = (unsigned long long)clock64(); \
        ts_lo = (lane == nts) ? (int)(unsigned)_c : ts_lo; ts_hi = (lane == nts) ? (int)(unsigned)(_c >> 32) : ts_hi; ++nts; } } while (0)
    PG8_STAMP();
    unsigned voffA[2], voffB[2];
#pragma unroll
    for (int i = 0; i < 2; ++i) { int R, C; stage_rc(tid * 16 + i * 8192, R, C); const int Rb = Epi::PERM ? ((R & ~31) + perm32(R & 31)) : R;
        voffA[i] = (unsigned)(R * K + C) * 2u; voffB[i] = (unsigned)(Rb * K + C) * 2u; }
    const size_t kstep = (size_t)(BK * 2);
    const size_t hstep = (size_t)HALF * K * 2;
    const size_t tstep = 2 * hstep;
    const unsigned ldsw = (unsigned)wid * 1024u;
    const int aoff = lds_byte(wr * 64 + fr, fq * 8), boff = lds_byte(wc * 32 + fr, fq * 8);
#define PG8_SA(b, h) (((b) * 2 + (h)) * HTB)
#define PG8_SB(b, h) ((4 + (b) * 2 + (h)) * HTB)
#define PG8_STAGE(bufoff, gbase, voff) do { _Pragma("unroll") for (int _i = 0; _i < 2; ++_i) \
        __builtin_amdgcn_global_load_lds((const unsigned*)((const char*)(gbase) + (voff)[_i]), (PG8_LAS unsigned*)(lds + (bufoff) + ldsw + _i * 8192), 16, 0, 0); } while (0)
#define PG8_LDA(dst, b, h) do { _Pragma("unroll") for (int m = 0; m < 4; ++m) _Pragma("unroll") for (int k = 0; k < 2; ++k) dst[m][k] = *(const PG8_LAS bf16x8*)(lds + PG8_SA(b, h) + aoff + m * 2048 + k * 1024); } while (0)
#define PG8_LDB(dst, b, h) do { _Pragma("unroll") for (int n = 0; n < 2; ++n) _Pragma("unroll") for (int k = 0; k < 2; ++k) dst[n][k] = *(const PG8_LAS bf16x8*)(lds + PG8_SB(b, h) + boff + n * 2048 + k * 1024); } while (0)
#define PG8_MMA(ai, bj, At, Bt) do { __builtin_amdgcn_s_setprio(1); _Pragma("unroll") for (int m = 0; m < 4; ++m) _Pragma("unroll") for (int n = 0; n < 2; ++n) _Pragma("unroll") for (int k = 0; k < 2; ++k) \
        acc[ai][bj][m][n] = __builtin_amdgcn_mfma_f32_16x16x32_bf16(Bt[n][k], At[m][k], acc[ai][bj][m][n], 0, 0, 0); __builtin_amdgcn_s_setprio(0); } while (0)
#define PG8_WAIT_V(n) asm volatile("s_waitcnt vmcnt(" #n ")" ::: "memory")
#define PG8_WAIT_L(n) asm volatile("s_waitcnt lgkmcnt(" #n ")" ::: "memory")
#define PG8_BAR __builtin_amdgcn_s_barrier()
#define PG8_SCHED __builtin_amdgcn_sched_barrier(0)
    Unit cur, nxt; int ui = 0;
    if (!S.next(0, cur)) return;
    f32x4 acc[2][2][4][2];
#pragma unroll
    for (int a = 0; a < 2; ++a)
#pragma unroll
        for (int b = 0; b < 2; ++b)
#pragma unroll
            for (int m = 0; m < 4; ++m)
#pragma unroll
                for (int n = 0; n < 2; ++n) acc[a][b][m][n] = (f32x4){0.f, 0.f, 0.f, 0.f};
    bf16x8 At[4][2], B0[2][2], B1[2][2];
    const char* cA = (const char*)g.A + (size_t)cur.pm * tstep + (size_t)cur.k0 * 2; const char* cB = (const char*)g.Bt + (size_t)cur.pn * tstep + (size_t)cur.k0 * 2;
    S.a_ready(cur);
    PG8_STAGE(PG8_SB(0, 0), cB, voffB); PG8_STAGE(PG8_SA(0, 0), cA, voffA); PG8_STAGE(PG8_SB(0, 1), cB + hstep, voffB); PG8_STAGE(PG8_SA(0, 1), cA + hstep, voffA);
    if (wr == 1) PG8_BAR;
    PG8_WAIT_V(4); PG8_BAR;
    PG8_STAGE(PG8_SB(1, 0), cB + kstep, voffB); PG8_STAGE(PG8_SA(1, 0), cA + kstep, voffA); PG8_STAGE(PG8_SB(1, 1), cB + hstep + kstep, voffB);
    PG8_WAIT_V(6); PG8_BAR;
    PG8_STAMP();
    for (;;) {
        const bool has_next = S.next(ui + 1, nxt);
        const char* nA = has_next ? (const char*)g.A + (size_t)nxt.pm * tstep + (size_t)nxt.k0 * 2 : cA; const char* nB = has_next ? (const char*)g.Bt + (size_t)nxt.pn * tstep + (size_t)nxt.k0 * 2 : cB;
        const int nt = cur.nt;
        for (int t = 0; t < nt; t += 2) {
            const bool last = (t == nt - 2);
            const char* a1 = cA + (size_t)(t + 1) * kstep;
            const char* a2 = last ? nA : cA + (size_t)(t + 2) * kstep; const char* b2 = last ? nB : cB + (size_t)(t + 2) * kstep;
            const char* a3 = a2 + kstep; const char* b3 = b2 + kstep;
            if (last && has_next) S.a_ready(nxt);
            PG8_LDB(B0, 0, 0); PG8_SCHED; PG8_LDA(At, 0, 0); PG8_STAGE(PG8_SA(1, 1), a1 + hstep, voffA);
            PG8_WAIT_L(8); PG8_BAR; PG8_WAIT_L(0); PG8_MMA(0, 0, At, B0); PG8_BAR; PG8_SCHED;
            PG8_LDB(B1, 0, 1); PG8_STAGE(PG8_SB(0, 0), b2, voffB);
            PG8_BAR; PG8_WAIT_L(0); PG8_MMA(0, 1, At, B1); PG8_BAR;
            PG8_LDA(At, 0, 1); PG8_STAGE(PG8_SA(0, 0), a2, voffA);
            PG8_BAR; PG8_WAIT_L(0); PG8_MMA(1, 0, At, B0); PG8_BAR; PG8_SCHED;
            PG8_STAGE(PG8_SB(0, 1), b2 + hstep, voffB);
            PG8_WAIT_V(6); PG8_BAR; PG8_MMA(1, 1, At, B1); PG8_BAR;
            PG8_LDB(B0, 1, 0); PG8_SCHED; PG8_LDA(At, 1, 0); PG8_STAGE(PG8_SA(0, 1), a2 + hstep, voffA);
            PG8_WAIT_L(8); PG8_BAR; PG8_WAIT_L(0); PG8_MMA(0, 0, At, B0); PG8_BAR; PG8_SCHED;
            PG8_LDB(B1, 1, 1); PG8_STAGE(PG8_SB(1, 0), b3, voffB);
            PG8_BAR; PG8_WAIT_L(0); PG8_MMA(0, 1, At, B1); PG8_BAR;
            PG8_LDA(At, 1, 1); PG8_STAGE(PG8_SA(1, 0), a3, voffA);
            PG8_BAR; PG8_WAIT_L(0); PG8_MMA(1, 0, At, B0); PG8_BAR; PG8_SCHED;
            PG8_STAGE(PG8_SB(1, 1), b3 + hstep, voffB);
            PG8_WAIT_V(6); PG8_BAR; PG8_MMA(1, 1, At, B1); PG8_BAR;
        }
        PG8_STAMP();
        if constexpr (!Epi::AFTER_DRAIN) { E(acc, cur, wr, wc, fr, fq); S.done(cur); }
        PG8_STAMP();
        if (!has_next) break;
#pragma unroll
        for (int a = 0; a < 2; ++a)
#pragma unroll
            for (int b = 0; b < 2; ++b)
#pragma unroll
                for (int m = 0; m < 4; ++m)
#pragma unroll
                    for (int n = 0; n < 2; ++n) acc[a][b][m][n] = (f32x4){0.f, 0.f, 0.f, 0.f};
        cur = nxt; cA = nA; cB = nB; ++ui;
    }
    PG8_WAIT_V(0);
    if (wr == 0) PG8_BAR;
    PG8_BAR;
    if constexpr (Epi::AFTER_DRAIN) { E.fused(acc, cur, wr, wc, fr, fq, lds, wid, lane); S.done(cur); }
    PG8_STAMP();
    if (STAMP && wid == 0) { stamps[lane] = lane < nts ? (((unsigned long long)(unsigned)ts_hi << 32) | (unsigned)ts_lo) : 0ull;
        if (lane == 62) stamps[62] = rt_entry; if (lane == 63) stamps[63] = (unsigned long long)wall_clock64(); }
#undef PG8_STAMP
#undef PG8_SA
#undef PG8_SB
#undef PG8_STAGE
#undef PG8_LDA
#undef PG8_LDB
#undef PG8_MMA
#undef PG8_WAIT_V
#undef PG8_WAIT_L
#undef PG8_BAR
#undef PG8_SCHED
}
}
using pg8::bf16_t; using pg8::bf16x8; using pg8::f32x4; using pg8::u32x4; using pg8::Unit; using pg8::cvt_pk_bf16;
#define LAS __attribute__((address_space(3)))
typedef unsigned u32x2 __attribute__((ext_vector_type(2)));
#define XB_TMO      128
#define XB_XCNT(j)  (256  + 64 * (j))
#define XB_XSUB(j)  (1280 + 64 * (j))
#define XB_XGEN(j)  (2304 + 64 * (j))
#define XB_TOP      3328
#define XB_TOPGEN   3392
#define XCD_BAR_WORDS 3456
#define XB_SPIN_CAP (1u << 18)

__device__ __forceinline__ unsigned xb_ld(unsigned* p)              { return __hip_atomic_load(p, __ATOMIC_RELAXED, __HIP_MEMORY_SCOPE_AGENT); }
__device__ __forceinline__ unsigned xb_add(unsigned* p, unsigned v) { return __hip_atomic_fetch_add(p, v, __ATOMIC_RELAXED, __HIP_MEMORY_SCOPE_AGENT); }
__device__ __forceinline__ unsigned xb_xcc_id() { return (unsigned)__builtin_amdgcn_s_getreg((3 << 11) | 20) & 0xFu; }
#define XB_SPIN(cond, bar) do { unsigned _sp = 0; while (cond) { __builtin_amdgcn_s_sleep(1); \
    if ((++_sp & 255u) == 0u) { if (xb_ld(&(bar)[XB_TMO])) break; if (_sp > XB_SPIN_CAP) { atomicAdd(&(bar)[XB_TMO], 1u); break; } } } } while (0)

struct XcdBarrier {
    unsigned* bar; unsigned x;
    volatile LAS unsigned* st;
};

__device__ __forceinline__ XcdBarrier xcd_barrier_post(unsigned* bar, volatile LAS unsigned* st) {
    XcdBarrier b; b.bar = bar; b.x = xb_xcc_id(); b.st = st;
    if (threadIdx.x == 0) (void)xb_add(&bar[XB_XCNT(b.x)], 1u);
    return b;
}
__device__ __forceinline__ void xcd_barrier_complete(unsigned* bar, unsigned x, unsigned& nloc, unsigned& nx) {
    const unsigned G = gridDim.x * gridDim.y * gridDim.z;
    unsigned sum, cnt, mine, sp = 0u;
    for (;;) {
        sum = 0u; cnt = 0u; mine = 0u;
#pragma unroll
        for (unsigned j = 0; j < 16; ++j) { const unsigned c = xb_ld(&bar[XB_XCNT(j)]); sum += c; cnt += (c > 0u) ? 1u : 0u; mine = (j == x) ? c : mine; }
        if (sum == G) break;
        __builtin_amdgcn_s_sleep(1);
        if ((++sp & 255u) == 0u) { if (xb_ld(&bar[XB_TMO])) break; if (sp > XB_SPIN_CAP) { atomicAdd(&bar[XB_TMO], 1u); break; } }
    }
    nloc = mine > 0u ? mine : 1u; nx = cnt > 0u ? cnt : 1u;
}

__device__ __forceinline__ void xcd_barrier(const XcdBarrier& b) {
    asm volatile("s_waitcnt vmcnt(0)" ::: "memory");
    __syncthreads();
    if (threadIdx.x == 0) {
        unsigned* bar = b.bar;
        __builtin_amdgcn_s_waitcnt(0);
        unsigned nloc = b.st[0], nx = b.st[1];
        if (nloc == 0u) { xcd_barrier_complete(bar, b.x, nloc, nx); b.st[0] = nloc; b.st[1] = nx; }
        const unsigned old = xb_add(&bar[XB_XSUB(b.x)], 1u);
        const unsigned gen = old / nloc;
        if (old + 1u == (gen + 1u) * nloc) {
            __builtin_amdgcn_fence(__ATOMIC_RELEASE, "agent");
            asm volatile("s_waitcnt vmcnt(0)" ::: "memory");
            const unsigned og = xb_add(&bar[XB_TOP], 1u);
            const unsigned tg = og / nx;
            if (og + 1u == (tg + 1u) * nx) xb_add(&bar[XB_TOPGEN], 1u);
            else XB_SPIN(xb_ld(&bar[XB_TOPGEN]) == tg, bar);
            __builtin_amdgcn_fence(__ATOMIC_ACQUIRE, "agent");
            xb_add(&bar[XB_XGEN(b.x)], 1u);
            asm volatile("s_waitcnt vmcnt(0)" ::: "memory");
        } else {
            XB_SPIN(xb_ld(&bar[XB_XGEN(b.x)]) == gen, bar);
            __builtin_amdgcn_fence(__ATOMIC_ACQUIRE, "agent");
            asm volatile("s_waitcnt vmcnt(0)" ::: "memory");
        }
    }
    __syncthreads();
}


constexpr int DM = 1024, NBATCH = 8, TT = 2064, NSAMP = 128, MP = NBATCH * TT  , MTOK = MP + NSAMP  ;
constexpr int DIN = 3584, DSSM = 512, DFF = 3072, NG = 32, NCHUNK = 129, NR = NBATCH * NCHUNK  ;
constexpr int C_US = 1024, C_GA = 1536, C_GB = 2560;
constexpr float ALPHA = 1.189207115002721f, LN_EPS = 1e-5f;
enum { I_XP = 0, I_XS, I_CCL, I_SL, I_SSR, I_SSI, I_CCF, I_META, I_EG, I_EB, I_WIN, I_BIN, I_CLW, I_CLB, I_WR, I_BR, I_WI, I_BI, I_LAM,
       I_SLRE, I_SLIM, I_SLDT, I_SBRE, I_SBIM, I_SCRE, I_SCIM, I_SD, I_WGLU, I_BGLU, I_WOUT, I_BOUT, I_L1G, I_L1B, I_WUP, I_BUP, I_FCW, I_FCB,
       I_WDOWN, I_BDOWN, I_L2G, I_L2B, N_IN };
constexpr size_t O_YP = 0, O_YS = 16777216, O_PCL = O_YS + 131072, O_PL = O_PCL + 24576, O_PSR = O_PL + 8192, O_PSI = O_PSR + 16384, O_PCF = O_PSI + 16384,
                 O_SCL = O_PCF + 49152, O_SL = O_SCL + 393216, O_SSR = O_SL + 131072, O_SSI = O_SSR + 262144, O_SCF = O_SSI + 262144, O_END = O_SCF + 786432;
constexpr size_t W_WTUP = 0, W_WTDOWN = W_WTUP + (size_t)6144 * 1024 * 2, W_XN = W_WTDOWN + (size_t)1024 * 3072 * 2, W_C = W_XN + (size_t)MTOK * 1024 * 2;
constexpr size_t W_PROJ = W_C, W_MIX = W_PROJ + (size_t)MTOK * DIN * 2, W_YSG = W_MIX + (size_t)MTOK * 1024 * 2, W_D = W_YSG + (size_t)MTOK * 512 * 2;
constexpr size_t W_WTGLU = W_D, W_WTOUT = W_WTGLU + (size_t)2048 * 512 * 2, W_WTR = W_WTOUT + (size_t)1024 * 1024 * 2, W_WTI = W_WTR + 262144, W_W1 = W_WTI + 262144,
                 W_W2 = W_W1 + (size_t)NG * 128 * 256 * 2, W_HPREV = W_W2 + (size_t)NG * 256 * 384 * 2, W_A1 = W_HPREV + (size_t)NR * NG * 128 * 2, W_A16 = W_A1 + 16384,
                 W_BBAR = W_A16 + 16384, W_LRUA = W_BBAR + 262144, W_LRUH = W_LRUA + 262144, W_LRUC = W_LRUH + 262144, W_S = W_LRUC + 262144, W_WTIN = W_S,
                 W_S_END = W_S + (size_t)NR * NG * 128 * 4;
constexpr size_t W_BAR = (W_S_END + 4095) / 4096 * 4096;
static_assert(W_BAR + (XCD_BAR_WORDS + 64 * 16) * 4 <= 268435456, "barrier words");
constexpr size_t W_PART = W_C + (size_t)MTOK * 1024 * 4;
constexpr size_t W_SBG = W_C, W_SBV = W_SBG + (size_t)260 * 4 * DFF * 4, W_SB_END = W_SBV + (size_t)260 * 2 * DFF * 4;
constexpr size_t W_PU = W_SB_END, W_PU_END = W_PU + (size_t)4 * 256 * 6144 * 4;
constexpr size_t W_PG = W_S;
constexpr size_t W_R1 = W_C, W_G = W_C, W_V = W_G + (size_t)MTOK * DFF * 2, W_V_END = W_V + (size_t)MTOK * DFF * 2, W_R2 = W_C;
static_assert(W_S_END <= 268435456 && W_V_END <= 268435456, "workspace map exceeds 256 MiB");
static_assert(W_SB_END <= W_V && W_PU_END <= W_V, "side buffers / up partials overlap H");
static_assert(W_PART + (size_t)12 * 256 * 1024 * 4 <= W_MIX && W_PART + (size_t)12 * 256 * 1024 * 4 <= W_V, "r1 / partials overlap mix or v");

constexpr int LDS_TOTAL = 147456;
struct P { const float* in[N_IN]; float* out; unsigned char* ws; };

__device__ __forceinline__ float bf2f(unsigned short b) { return __uint_as_float(((unsigned)b) << 16); }
__device__ __forceinline__ float bflo(unsigned u) { return __uint_as_float(u << 16); }
__device__ __forceinline__ float bfhi(unsigned u) { return __uint_as_float(u & 0xffff0000u); }
__device__ __forceinline__ unsigned short f2bf(float f) { return (unsigned short)(cvt_pk_bf16(f, 0.f) & 0xffffu); }
__device__ __forceinline__ float sigm(float x) { return __builtin_amdgcn_rcpf(1.f + __expf(-x)); }
__device__ __forceinline__ float gelu_tanh(float x) { return x * sigm(1.5957691216057308f * (x + 0.044715f * x * x * x)); }
__device__ __forceinline__ float wave_sum(float v) {
#pragma unroll
    for (int o = 1; o < 64; o <<= 1) v += __shfl_xor(v, o);
    return v;
}
#define LDS_WAIT() asm volatile("s_waitcnt lgkmcnt(0)" ::: "memory")
#define REPEAT(N) for (int rep_ = 0; rep_ < (N); ++rep_)
#define TIMED(N) const unsigned long long tq0_##N = (PROBE_PHASE == (N)) ? __builtin_amdgcn_s_memrealtime() : 0ull;
#define TIMED_END(N) if (PROBE_PHASE == (N)) { const unsigned long long tq1 = __builtin_amdgcn_s_memrealtime(); while (__builtin_amdgcn_s_memrealtime() - tq1 < tq1 - tq0_##N) __builtin_amdgcn_s_sleep(4); }

struct EpiProj {
    static constexpr bool PERM = true, AFTER_DRAIN = false;
    bf16_t* O; const float* bias; bf16_t* UT;
    __device__ __forceinline__ void operator()(const f32x4 (&acc)[2][2][4][2], const Unit& u, int wr, int wc, int fr, int fq) const {
        const int row0 = u.pm * 256 + wr * 64 + fr, col0 = u.pn * 256 + wc * 32 + 8 * fq;
        if (u.pn == 4 || u.pn == 5) {
#pragma unroll
            for (int bj = 0; bj < 2; ++bj) { const int col = col0 + bj * 128; const f32x4 b0 = *(const f32x4*)(bias + col), b1 = *(const f32x4*)(bias + col + 4); const int cu = col - C_US, g = cu >> 4, hh = cu & 15;
#pragma unroll
                for (int ai = 0; ai < 2; ++ai)
#pragma unroll
                    for (int m = 0; m < 4; ++m) { const int row = row0 + ai * 128 + m * 16; const f32x4 v0 = acc[ai][bj][m][0] + b0, v1 = acc[ai][bj][m][1] + b1; u32x4 w;
                        w.x = cvt_pk_bf16(v0[0], v0[1]); w.y = cvt_pk_bf16(v0[2], v0[3]); w.z = cvt_pk_bf16(v1[0], v1[1]); w.w = cvt_pk_bf16(v1[2], v1[3]);
                        size_t o; if (row < MP) { const int b = row / TT, t = row - b * TT; o = ((size_t)(b * NG + g) * TT + t) * 16 + hh; } else o = (size_t)MP * DSSM + ((size_t)(row - MP) * NG + g) * 16 + hh;
                        *(u32x4*)(UT + o) = w; } }
            return; }
#pragma unroll
        for (int bj = 0; bj < 2; ++bj) { const int col = col0 + bj * 128; const f32x4 b0 = *(const f32x4*)(bias + col), b1 = *(const f32x4*)(bias + col + 4);
#pragma unroll
            for (int ai = 0; ai < 2; ++ai)
#pragma unroll
                for (int m = 0; m < 4; ++m) { const f32x4 v0 = acc[ai][bj][m][0] + b0, v1 = acc[ai][bj][m][1] + b1; u32x4 w;
                    w.x = cvt_pk_bf16(v0[0], v0[1]); w.y = cvt_pk_bf16(v0[2], v0[3]); w.z = cvt_pk_bf16(v1[0], v1[1]); w.w = cvt_pk_bf16(v1[2], v1[3]);
                    *(u32x4*)(O + (size_t)(row0 + ai * 128 + m * 16) * DIN + col) = w; } }
    }
};
struct EpiGlu {
    static constexpr bool PERM = true, AFTER_DRAIN = false;
    bf16_t* mix; const bf16_t* m2; const float* carry; const bf16_t* proj; const float* bias;
    __device__ __forceinline__ void operator()(const f32x4 (&acc)[2][2][4][2], const Unit& u, int wr, int wc, int fr, int fq) const {
        const int row0 = u.pm * 256 + wr * 64 + fr, j = u.pn * 128 + wc * 32 + 8 * fq;
        const f32x4 bv0 = *(const f32x4*)(bias + j), bv1 = *(const f32x4*)(bias + j + 4), bg0 = *(const f32x4*)(bias + 1024 + j), bg1 = *(const f32x4*)(bias + 1024 + j + 4);
#pragma unroll
        for (int ai = 0; ai < 2; ++ai)
#pragma unroll
            for (int mp = 0; mp < 2; ++mp) { u32x4 gbw[2], mw[2], m2w[2]; f32x4 cv0[2], cv1[2];
#pragma unroll
                for (int mm = 0; mm < 2; ++mm) { const int rowi = row0 + ai * 128 + (2 * mp + mm) * 16; const size_t row = (size_t)rowi; int cidx = 0;
                    if (rowi < MP) { const int b = rowi / TT, t = rowi - b * TT; int kc = t >> 8; kc = kc > 7 ? 7 : kc; cidx = (b * 8 + kc) * 1024; }
                    cv0[mm] = *(const f32x4*)(carry + cidx + j); cv1[mm] = *(const f32x4*)(carry + cidx + j + 4);
                    gbw[mm] = *(const u32x4*)(proj + row * DIN + C_GB + j); mw[mm] = *(const u32x4*)(mix + row * 1024 + j); m2w[mm] = *(const u32x4*)(m2 + row * 1024 + j); }
#pragma unroll
                for (int mm = 0; mm < 2; ++mm) { const int m = 2 * mp + mm; const size_t row = (size_t)(row0 + ai * 128 + m * 16);
                    const f32x4 val0 = acc[ai][0][m][0] + bv0, val1 = acc[ai][0][m][1] + bv1, gate0 = acc[ai][1][m][0] + bg0, gate1 = acc[ai][1][m][1] + bg1;
                    const float o0 = bflo(mw[mm].x) + bflo(m2w[mm].x) * cv0[mm][0] + sigm(bflo(gbw[mm].x)) * val0[0] * sigm(gate0[0]), o1 = bfhi(mw[mm].x) + bfhi(m2w[mm].x) * cv0[mm][1] + sigm(bfhi(gbw[mm].x)) * val0[1] * sigm(gate0[1]);
                    const float o2 = bflo(mw[mm].y) + bflo(m2w[mm].y) * cv0[mm][2] + sigm(bflo(gbw[mm].y)) * val0[2] * sigm(gate0[2]), o3 = bfhi(mw[mm].y) + bfhi(m2w[mm].y) * cv0[mm][3] + sigm(bfhi(gbw[mm].y)) * val0[3] * sigm(gate0[3]);
                    const float o4 = bflo(mw[mm].z) + bflo(m2w[mm].z) * cv1[mm][0] + sigm(bflo(gbw[mm].z)) * val1[0] * sigm(gate1[0]), o5 = bfhi(mw[mm].z) + bfhi(m2w[mm].z) * cv1[mm][1] + sigm(bfhi(gbw[mm].z)) * val1[1] * sigm(gate1[1]);
                    const float o6 = bflo(mw[mm].w) + bflo(m2w[mm].w) * cv1[mm][2] + sigm(bflo(gbw[mm].w)) * val1[2] * sigm(gate1[2]), o7 = bfhi(mw[mm].w) + bfhi(m2w[mm].w) * cv1[mm][3] + sigm(bfhi(gbw[mm].w)) * val1[3] * sigm(gate1[3]);
                    u32x4 w; w.x = cvt_pk_bf16(o0, o1); w.y = cvt_pk_bf16(o2, o3); w.z = cvt_pk_bf16(o4, o5); w.w = cvt_pk_bf16(o6, o7); *(u32x4*)(mix + row * 1024 + j) = w; } }
    }
};
struct EpiRes {
    static constexpr bool PERM = true, AFTER_DRAIN = false;
    bf16_t* R; const bf16_t* X; const float* bias; float* part;
    __device__ __forceinline__ void operator()(const f32x4 (&acc)[2][2][4][2], const Unit& u, int wr, int wc, int fr, int fq) const {
        const int row0 = u.pm * 256 + wr * 64 + fr, col0 = u.pn * 256 + wc * 32 + 8 * fq;
        if (u.ks >= 0) { float* pp = part + ((size_t)u.ks * 256 - 16384) * 1024;
#pragma unroll
            for (int bj = 0; bj < 2; ++bj)
#pragma unroll
                for (int n = 0; n < 2; ++n)
#pragma unroll
                    for (int ai = 0; ai < 2; ++ai)
#pragma unroll
                        for (int m = 0; m < 4; ++m) *(f32x4*)(pp + (size_t)(row0 + ai * 128 + m * 16) * 1024 + col0 + bj * 128 + n * 4) = acc[ai][bj][m][n];
            return; }
#pragma unroll
        for (int bj = 0; bj < 2; ++bj) { const int col = col0 + bj * 128; const f32x4 b0 = *(const f32x4*)(bias + col), b1 = *(const f32x4*)(bias + col + 4);
            u32x4 xw[2][4];
#pragma unroll
            for (int ai = 0; ai < 2; ++ai)
#pragma unroll
                for (int m = 0; m < 4; ++m) xw[ai][m] = *(const u32x4*)(X + (size_t)(row0 + ai * 128 + m * 16) * 1024 + col);
#pragma unroll
            for (int ai = 0; ai < 2; ++ai)
#pragma unroll
                for (int m = 0; m < 4; ++m) { const size_t off = (size_t)(row0 + ai * 128 + m * 16) * 1024 + col; const u32x4 x = xw[ai][m];
                    f32x4 v0 = acc[ai][bj][m][0] + b0, v1 = acc[ai][bj][m][1] + b1;
                    v0[0] += ALPHA * bflo(x.x); v0[1] += ALPHA * bfhi(x.x); v0[2] += ALPHA * bflo(x.y); v0[3] += ALPHA * bfhi(x.y);
                    v1[0] += ALPHA * bflo(x.z); v1[1] += ALPHA * bfhi(x.z); v1[2] += ALPHA * bflo(x.w); v1[3] += ALPHA * bfhi(x.w);
                    u32x4 w; w.x = cvt_pk_bf16(v0[0], v0[1]); w.y = cvt_pk_bf16(v0[2], v0[3]); w.z = cvt_pk_bf16(v1[0], v1[1]); w.w = cvt_pk_bf16(v1[2], v1[3]); *(u32x4*)(R + off) = w; } }
    }
};
__device__ __forceinline__ float rot1(float x) { return __int_as_float(__builtin_amdgcn_update_dpp(0, __float_as_int(x), 0x121, 0xf, 0xf, false)); }
__device__ __forceinline__ float rot2(float x) { return __int_as_float(__builtin_amdgcn_update_dpp(0, __float_as_int(x), 0x122, 0xf, 0xf, false)); }
struct EpiUp {
    static constexpr bool PERM = true, AFTER_DRAIN = false;
    bf16_t* H; const float* bias; float* out; const float* cw; const float* cb; const float* cache; float* sbg; float* sbv;
    __device__ __forceinline__ void operator()(const f32x4 (&acc)[2][2][4][2], const Unit& u, int wr, int wc, int fr, int fq) const {
        const int c0 = u.pn * 128 + wc * 32 + 8 * fq;
        f32x4 bg[2], bv[2], w0[2], w1[2], w2[2], cbv[2];
#pragma unroll
        for (int n = 0; n < 2; ++n) { const int ch = c0 + 4 * n; bg[n] = *(const f32x4*)(bias + ch); bv[n] = *(const f32x4*)(bias + DFF + ch);
            w0[n] = *(const f32x4*)(cw + ch); w1[n] = *(const f32x4*)(cw + DFF + ch); w2[n] = *(const f32x4*)(cw + 2 * DFF + ch); cbv[n] = *(const f32x4*)(cb + ch); }
#pragma unroll
        for (int ai = 0; ai < 2; ++ai) { const int blk = u.pm * 4 + ai * 2 + wr, r0 = blk * 64;
            f32x4 gp1[2], gp2[2];
#pragma unroll
            for (int n = 0; n < 2; ++n) { gp1[n] = (f32x4){0.f, 0.f, 0.f, 0.f}; gp2[n] = (f32x4){0.f, 0.f, 0.f, 0.f}; }
#pragma unroll
            for (int m = 0; m < 4; ++m) { const int row = r0 + 16 * m + fr; const int b = row / TT, t = row - b * TT; float h[8];
#pragma unroll
                for (int n = 0; n < 2; ++n) { const int ch = c0 + 4 * n; const f32x4 g = acc[ai][0][m][n] + bg[n], v = acc[ai][1][m][n] + bv[n];
                    f32x4 a1, a2; a1[0] = rot1(g[0]); a1[1] = rot1(g[1]); a1[2] = rot1(g[2]); a1[3] = rot1(g[3]); a2[0] = rot2(g[0]); a2[1] = rot2(g[1]); a2[2] = rot2(g[2]); a2[3] = rot2(g[3]);
                    f32x4 g1 = (fr >= 1) ? a1 : gp1[n], g2 = (fr >= 2) ? a2 : gp2[n];
                    if (t == 0) g1 = (f32x4){0.f, 0.f, 0.f, 0.f}; if (t <= 1) g2 = (f32x4){0.f, 0.f, 0.f, 0.f};
                    if (t >= TT - 2) *(f32x4*)(out + O_PCF + ((size_t)b * 2 + (t - (TT - 2))) * DFF + ch) = g;
                    if (m == 0 && fr < 2) { *(f32x4*)(sbg + ((size_t)blk * 4 + fr) * DFF + ch) = g; *(f32x4*)(sbv + ((size_t)blk * 2 + fr) * DFF + ch) = v; }
                    if (m == 3 && fr >= 14) *(f32x4*)(sbg + ((size_t)blk * 4 + fr - 12) * DFF + ch) = g;
                    const f32x4 y = cbv[n] + w0[n] * g2 + w1[n] * g1 + w2[n] * g;
                    h[4 * n] = gelu_tanh(y[0]) * v[0]; h[4 * n + 1] = gelu_tanh(y[1]) * v[1]; h[4 * n + 2] = gelu_tanh(y[2]) * v[2]; h[4 * n + 3] = gelu_tanh(y[3]) * v[3];
                    gp1[n] = a1; gp2[n] = a2; }
                u32x4 w; w.x = cvt_pk_bf16(h[0], h[1]); w.y = cvt_pk_bf16(h[2], h[3]); w.z = cvt_pk_bf16(h[4], h[5]); w.w = cvt_pk_bf16(h[6], h[7]); *(u32x4*)(H + (size_t)row * DFF + c0) = w; } }
    }
};
struct EpiRaw {
    static constexpr bool PERM = false, AFTER_DRAIN = false;
    float* pu; int ld;
    __device__ __forceinline__ void operator()(const f32x4 (&acc)[2][2][4][2], const Unit& u, int wr, int wc, int fr, int fq) const {
        float* pp = pu + (size_t)u.ks * 256 * ld + (size_t)(wr * 64 + fr) * ld + u.pn * 256 + wc * 32 + 4 * fq;
#pragma unroll
        for (int ai = 0; ai < 2; ++ai)
#pragma unroll
            for (int m = 0; m < 4; ++m)
#pragma unroll
                for (int bj = 0; bj < 2; ++bj)
#pragma unroll
                    for (int n = 0; n < 2; ++n) *(f32x4*)(pp + (size_t)(ai * 128 + m * 16) * ld + bj * 128 + n * 16) = acc[ai][bj][m][n];
    }
};
template <class Epi> __device__ __forceinline__ void run_gemm(LAS unsigned char* lds, int vc, const bf16_t* A, const bf16_t* Bt, int N, int K, const Epi& E) {
    pg8::Gemm g; g.A = A; g.Bt = Bt; g.M = MTOK; g.N = N; g.K = K;
    pg8::StaticOrder S; S.init(MTOK, N, K, (int)gridDim.x, vc);
    pg8::gemm_phase<Epi, pg8::StaticOrder, false>(lds, g, S, E, nullptr);
}

template <class Epi> __device__ __forceinline__ void run_gemm_split(LAS unsigned char* lds, int vc, const bf16_t* A, const bf16_t* Bt, int N, int K, int nsplit, const Epi& E) {
    pg8::Gemm g; g.A = A; g.Bt = Bt; g.M = MTOK; g.N = N; g.K = K;
    pg8::SplitOrder S; S.init(N, K, nsplit, (int)gridDim.x, vc);
    pg8::gemm_phase<Epi, pg8::SplitOrder, false>(lds, g, S, E, nullptr);
}

template <class Epi> __device__ __forceinline__ void run_gemm_main64(LAS unsigned char* lds, int vc, const bf16_t* A, const bf16_t* Bt, int N, int K, const Epi& E) {
    pg8::Gemm g; g.A = A; g.Bt = Bt; g.M = 16384; g.N = N; g.K = K;
    pg8::StaticOrder S; S.init(16384, N, K, (int)gridDim.x, vc);
    pg8::gemm_phase<Epi, pg8::StaticOrder, false>(lds, g, S, E, nullptr);
}
__device__ __forceinline__ void run_gemm_tail(LAS unsigned char* lds, int vc, const bf16_t* A, const bf16_t* Bt, int N, int K, int nsplit, float* pu) {
    pg8::Gemm g; g.A = A; g.Bt = Bt; g.M = MTOK; g.N = N; g.K = K;
    pg8::TailOrder S; S.init(N, K, nsplit, (int)gridDim.x, vc);
    EpiRaw E; E.pu = pu; E.ld = N;
    pg8::gemm_phase<EpiRaw, pg8::TailOrder, false>(lds, g, S, E, nullptr);
}

__device__ __forceinline__ void transpose_item(const float* W, int N, bf16_t* WT, int K, int k0, int srcn0, int dstn0, LAS float* scr, int lane) {
    float tv[32];
#pragma unroll
    for (int i = 0; i < 32; ++i) tv[i] = W[(size_t)(k0 + 2 * i + (lane >> 5)) * N + srcn0 + (lane & 31)];
#pragma unroll
    for (int i = 0; i < 32; ++i) scr[(2 * i + (lane >> 5)) * 33 + (lane & 31)] = tv[i];
    LDS_WAIT();
    const int c = lane & 7;
#pragma unroll
    for (int j = 0; j < 4; ++j) { const int n = (lane >> 3) + 8 * j; const LAS float* s = scr + (8 * c) * 33 + n;
        u32x4 o; o.x = cvt_pk_bf16(s[0 * 33], s[1 * 33]); o.y = cvt_pk_bf16(s[2 * 33], s[3 * 33]); o.z = cvt_pk_bf16(s[4 * 33], s[5 * 33]); o.w = cvt_pk_bf16(s[6 * 33], s[7 * 33]);
        *(u32x4*)(WT + (size_t)(dstn0 + n) * K + k0 + 8 * c) = o; }
    LDS_WAIT();
}
__device__ __forceinline__ const float* src_row(const P& p, int r) {
    if (r < MP) { const int b = r / TT, t = r - b * TT; return t < 16 ? p.in[I_META] + (size_t)t * DM : p.in[I_XP] + ((size_t)b * 2048 + (t - 16)) * DM; }
    return p.in[I_XS] + (size_t)(r - MP) * DM;
}
template <bool OUT_BF16> __device__ __forceinline__ void ln_row(const float* xrow, const float* g, const float* bta, void* orow, int lane, int nsplit = 0, const bf16_t* xres = nullptr, const float* rbias = nullptr) {
    f32x4 v[4]; float s = 0.f;
#pragma unroll
    for (int j = 0; j < 4; ++j) { v[j] = *(const f32x4*)(xrow + 4 * lane + 256 * j);
        if (nsplit > 0) { for (int k = 1; k < nsplit; ++k) v[j] += *(const f32x4*)(xrow + (size_t)k * 256 * 1024 + 4 * lane + 256 * j);
            const u32x2 xw = *(const u32x2*)(xres + 4 * lane + 256 * j); const f32x4 bv = *(const f32x4*)(rbias + 4 * lane + 256 * j);
            v[j][0] += ALPHA * bflo(xw.x) + bv[0]; v[j][1] += ALPHA * bfhi(xw.x) + bv[1]; v[j][2] += ALPHA * bflo(xw.y) + bv[2]; v[j][3] += ALPHA * bfhi(xw.y) + bv[3]; }
        s += (v[j][0] + v[j][1]) + (v[j][2] + v[j][3]); }
    const float mean = wave_sum(s) * (1.f / DM); float s2 = 0.f;
#pragma unroll
    for (int j = 0; j < 4; ++j) { v[j] = v[j] - mean; s2 += (v[j][0] * v[j][0] + v[j][1] * v[j][1]) + (v[j][2] * v[j][2] + v[j][3] * v[j][3]); }
    const float rstd = 1.f / sqrtf(wave_sum(s2) * (1.f / DM) + LN_EPS);
#pragma unroll
    for (int j = 0; j < 4; ++j) { const f32x4 gg = *(const f32x4*)(g + 4 * lane + 256 * j), bb = *(const f32x4*)(bta + 4 * lane + 256 * j);
        const f32x4 o = (v[j] * rstd) * gg + bb;
        if (OUT_BF16) { u32x2 w; w.x = cvt_pk_bf16(o[0], o[1]); w.y = cvt_pk_bf16(o[2], o[3]); *(u32x2*)((bf16_t*)orow + 4 * lane + 256 * j) = w; }
        else *(f32x4*)((float*)orow + 4 * lane + 256 * j) = o; }
}
template <bool OUT_BF16> __device__ __forceinline__ void ln_rows2(const float* xa, const float* xb, const float* g, const float* bta, void* oa, void* ob, int lane, bool vb) {
    f32x4 va[4], vbv[4]; float sa = 0.f, sb = 0.f;
#pragma unroll
    for (int j = 0; j < 4; ++j) { va[j] = *(const f32x4*)(xa + 4 * lane + 256 * j); vbv[j] = *(const f32x4*)(xb + 4 * lane + 256 * j); }
#pragma unroll
    for (int j = 0; j < 4; ++j) { sa += (va[j][0] + va[j][1]) + (va[j][2] + va[j][3]); sb += (vbv[j][0] + vbv[j][1]) + (vbv[j][2] + vbv[j][3]); }
#pragma unroll
    for (int o = 1; o < 64; o <<= 1) { sa += __shfl_xor(sa, o); sb += __shfl_xor(sb, o); }
    const float ma = sa * (1.f / DM), mb = sb * (1.f / DM); float qa = 0.f, qb = 0.f;
#pragma unroll
    for (int j = 0; j < 4; ++j) { va[j] = va[j] - ma; vbv[j] = vbv[j] - mb; qa += (va[j][0] * va[j][0] + va[j][1] * va[j][1]) + (va[j][2] * va[j][2] + va[j][3] * va[j][3]);
        qb += (vbv[j][0] * vbv[j][0] + vbv[j][1] * vbv[j][1]) + (vbv[j][2] * vbv[j][2] + vbv[j][3] * vbv[j][3]); }
#pragma unroll
    for (int o = 1; o < 64; o <<= 1) { qa += __shfl_xor(qa, o); qb += __shfl_xor(qb, o); }
    const float ra = 1.f / sqrtf(qa * (1.f / DM) + LN_EPS), rb = 1.f / sqrtf(qb * (1.f / DM) + LN_EPS);
#pragma unroll
    for (int j = 0; j < 4; ++j) { const f32x4 gg = *(const f32x4*)(g + 4 * lane + 256 * j), bb = *(const f32x4*)(bta + 4 * lane + 256 * j);
        const f32x4 o1 = (va[j] * ra) * gg + bb, o2 = (vbv[j] * rb) * gg + bb;
        if (OUT_BF16) { u32x2 w; w.x = cvt_pk_bf16(o1[0], o1[1]); w.y = cvt_pk_bf16(o1[2], o1[3]); *(u32x2*)((bf16_t*)oa + 4 * lane + 256 * j) = w;
            if (vb) { w.x = cvt_pk_bf16(o2[0], o2[1]); w.y = cvt_pk_bf16(o2[2], o2[3]); *(u32x2*)((bf16_t*)ob + 4 * lane + 256 * j) = w; } }
        else { *(f32x4*)((float*)oa + 4 * lane + 256 * j) = o1; if (vb) *(f32x4*)((float*)ob + 4 * lane + 256 * j) = o2; } }
}
template <bool OUT_BF16> __device__ __forceinline__ void ln_rows2_bf(const bf16_t* xa, const bf16_t* xb, const float* g, const float* bta, void* oa, void* ob, int lane, bool vb) {
    float va[16], vq[16]; float sa = 0.f, sb = 0.f;
    { u32x4 ra[2], rb[2];
#pragma unroll
      for (int j = 0; j < 2; ++j) { ra[j] = *(const u32x4*)(xa + 8 * lane + 512 * j); rb[j] = *(const u32x4*)(xb + 8 * lane + 512 * j); }
#pragma unroll
      for (int j = 0; j < 2; ++j) { va[8 * j] = bflo(ra[j].x); va[8 * j + 1] = bfhi(ra[j].x); va[8 * j + 2] = bflo(ra[j].y); va[8 * j + 3] = bfhi(ra[j].y); va[8 * j + 4] = bflo(ra[j].z); va[8 * j + 5] = bfhi(ra[j].z); va[8 * j + 6] = bflo(ra[j].w); va[8 * j + 7] = bfhi(ra[j].w);
          vq[8 * j] = bflo(rb[j].x); vq[8 * j + 1] = bfhi(rb[j].x); vq[8 * j + 2] = bflo(rb[j].y); vq[8 * j + 3] = bfhi(rb[j].y); vq[8 * j + 4] = bflo(rb[j].z); vq[8 * j + 5] = bfhi(rb[j].z); vq[8 * j + 6] = bflo(rb[j].w); vq[8 * j + 7] = bfhi(rb[j].w); } }
#pragma unroll
    for (int e = 0; e < 16; ++e) { sa += va[e]; sb += vq[e]; }
#pragma unroll
    for (int o = 1; o < 64; o <<= 1) { sa += __shfl_xor(sa, o); sb += __shfl_xor(sb, o); }
    const float ma = sa * (1.f / DM), mb = sb * (1.f / DM); float qa = 0.f, qb = 0.f;
#pragma unroll
    for (int e = 0; e < 16; ++e) { va[e] -= ma; vq[e] -= mb; qa += va[e] * va[e]; qb += vq[e] * vq[e]; }
#pragma unroll
    for (int o = 1; o < 64; o <<= 1) { qa += __shfl_xor(qa, o); qb += __shfl_xor(qb, o); }
    const float ra_ = 1.f / sqrtf(qa * (1.f / DM) + LN_EPS), rb_ = 1.f / sqrtf(qb * (1.f / DM) + LN_EPS);
#pragma unroll
    for (int j = 0; j < 2; ++j) { const int c = 8 * lane + 512 * j; const f32x4 g0 = *(const f32x4*)(g + c), g1 = *(const f32x4*)(g + c + 4), b0 = *(const f32x4*)(bta + c), b1 = *(const f32x4*)(bta + c + 4);
        float o1[8], o2[8];
#pragma unroll
        for (int e = 0; e < 4; ++e) { o1[e] = va[8 * j + e] * ra_ * g0[e] + b0[e]; o1[4 + e] = va[8 * j + 4 + e] * ra_ * g1[e] + b1[e]; o2[e] = vq[8 * j + e] * rb_ * g0[e] + b0[e]; o2[4 + e] = vq[8 * j + 4 + e] * rb_ * g1[e] + b1[e]; }
        if (OUT_BF16) { u32x4 w; w.x = cvt_pk_bf16(o1[0], o1[1]); w.y = cvt_pk_bf16(o1[2], o1[3]); w.z = cvt_pk_bf16(o1[4], o1[5]); w.w = cvt_pk_bf16(o1[6], o1[7]); *(u32x4*)((bf16_t*)oa + c) = w;
            if (vb) { w.x = cvt_pk_bf16(o2[0], o2[1]); w.y = cvt_pk_bf16(o2[2], o2[3]); w.z = cvt_pk_bf16(o2[4], o2[5]); w.w = cvt_pk_bf16(o2[6], o2[7]); *(u32x4*)((bf16_t*)ob + c) = w; } }
        else { *(f32x4*)((float*)oa + c) = (f32x4){o1[0], o1[1], o1[2], o1[3]}; *(f32x4*)((float*)oa + c + 4) = (f32x4){o1[4], o1[5], o1[6], o1[7]};
            if (vb) { *(f32x4*)((float*)ob + c) = (f32x4){o2[0], o2[1], o2[2], o2[3]}; *(f32x4*)((float*)ob + c + 4) = (f32x4){o2[4], o2[5], o2[6], o2[7]}; } } }
}
__device__ __forceinline__ void s5_precompute(const P& p, LAS unsigned char* lds, int g) {
    LAS float* apr = (LAS float*)lds;
    LAS float* api = apr + 17 * 64;
    LAS float* bbr = api + 17 * 64;
    LAS float* bbi = bbr + 1024;
    LAS float* cr = bbi + 1024;
    LAS float* ci = cr + 1024;
    LAS float* Kl = ci + 1024;
    int tid_ = threadIdx.x; asm volatile("" : "+v"(tid_)); const int tid = tid_;
    if (tid < 64) { const int pp = tid;
        const float dt = expf(p.in[I_SLDT][g]); const float lre = p.in[I_SLRE][g * 64 + pp], lim = p.in[I_SLIM][g * 64 + pp];
        const float mag = expf(lre * dt); const float ang = lim * dt; const float abr = mag * cosf(ang), abi = mag * sinf(ang);
        const float den = lre * lre + lim * lim, nr = abr - 1.0f, ni = abi; const float fre = (nr * lre + ni * lim) / den, fim = (ni * lre - nr * lim) / den;
        float pr = 1.f, pi = 0.f;
        for (int j = 0; j <= 16; ++j) { apr[j * 64 + pp] = pr; api[j * 64 + pp] = pi; const float nr2 = pr * abr - pi * abi, ni2 = pr * abi + pi * abr; pr = nr2; pi = ni2; }
        float* a1 = (float*)(p.ws + W_A1); float* a16 = (float*)(p.ws + W_A16); float* bbar = (float*)(p.ws + W_BBAR);
        a1[(g * 64 + pp) * 2] = abr; a1[(g * 64 + pp) * 2 + 1] = abi; a16[(g * 64 + pp) * 2] = apr[16 * 64 + pp]; a16[(g * 64 + pp) * 2 + 1] = api[16 * 64 + pp];
        for (int c = 0; c < 16; ++c) { const float br = p.in[I_SBRE][(g * 64 + pp) * 16 + c], bi = p.in[I_SBIM][(g * 64 + pp) * 16 + c];
            const float xr = fre * br - fim * bi, xi = fre * bi + fim * br; bbr[pp * 16 + c] = xr; bbi[pp * 16 + c] = xi;
            bbar[((g * 64 + pp) * 16 + c) * 2] = xr; bbar[((g * 64 + pp) * 16 + c) * 2 + 1] = xi; }
    }
    for (int i = tid; i < 1024; i += 512) { cr[i] = p.in[I_SCRE][g * 1024 + i]; ci[i] = p.in[I_SCIM][g * 1024 + i]; }
    __syncthreads();
    { const int j = tid >> 5, c1 = (tid >> 1) & 15, c0 = 8 * (tid & 1); float acc8[8];
#pragma unroll
      for (int e = 0; e < 8; ++e) acc8[e] = 0.f;
      for (int pp = 0; pp < 64; ++pp) { const float xr = cr[c1 * 64 + pp], xi = ci[c1 * 64 + pp], ar = apr[j * 64 + pp], ai = api[j * 64 + pp]; const float car = xr * ar - xi * ai, cai = xr * ai + xi * ar;
          const f32x4 r0 = *(const LAS f32x4*)(bbr + pp * 16 + c0), r1 = *(const LAS f32x4*)(bbr + pp * 16 + c0 + 4), i0 = *(const LAS f32x4*)(bbi + pp * 16 + c0), i1 = *(const LAS f32x4*)(bbi + pp * 16 + c0 + 4);
          acc8[0] += car * r0[0] - cai * i0[0]; acc8[1] += car * r0[1] - cai * i0[1]; acc8[2] += car * r0[2] - cai * i0[2]; acc8[3] += car * r0[3] - cai * i0[3];
          acc8[4] += car * r1[0] - cai * i1[0]; acc8[5] += car * r1[1] - cai * i1[1]; acc8[6] += car * r1[2] - cai * i1[2]; acc8[7] += car * r1[3] - cai * i1[3]; }
#pragma unroll
      for (int e = 0; e < 8; ++e) { float v = acc8[e]; if (j == 0 && c1 == c0 + e) v += p.in[I_SD][g * 16 + c1]; Kl[(j * 16 + c1) * 16 + c0 + e] = v; } }
    __syncthreads();
    bf16_t* W1 = (bf16_t*)(p.ws + W_W1) + (size_t)g * 128 * 256; bf16_t* W2 = (bf16_t*)(p.ws + W_W2) + (size_t)g * 256 * 384;
    for (int i = tid; i < 128 * 32; i += 512) { const int n = i >> 5, ch = i & 31, s = ch >> 1, c0 = 8 * (ch & 1), pp = n & 63; const bool im = n >= 64; float v[8];
        const float ar = apr[(15 - s) * 64 + pp], ai = api[(15 - s) * 64 + pp];
#pragma unroll
        for (int e = 0; e < 8; ++e) { const float xr = bbr[pp * 16 + c0 + e], xi = bbi[pp * 16 + c0 + e]; v[e] = im ? (ar * xi + ai * xr) : (ar * xr - ai * xi); }
        u32x4 o; o.x = cvt_pk_bf16(v[0], v[1]); o.y = cvt_pk_bf16(v[2], v[3]); o.z = cvt_pk_bf16(v[4], v[5]); o.w = cvt_pk_bf16(v[6], v[7]);
        *(u32x4*)(W1 + (size_t)n * 256 + 8 * ch) = o; }
    for (int i = tid; i < 256 * 48; i += 512) { const int n = i / 48, ch = i - n * 48, t = n >> 4, c1 = n & 15; float v[8];
        if (ch < 32) { const int s = ch >> 1, c0 = 8 * (ch & 1);
#pragma unroll
            for (int e = 0; e < 8; ++e) v[e] = (s <= t) ? Kl[((t - s) * 16 + c1) * 16 + c0 + e] : 0.f; }
        else { const bool im = ch >= 40; const int p0 = 8 * (ch - (im ? 40 : 32));
#pragma unroll
            for (int e = 0; e < 8; ++e) { const int pp = p0 + e; const float ar = apr[(t + 1) * 64 + pp], ai = api[(t + 1) * 64 + pp], xr = cr[c1 * 64 + pp], xi = ci[c1 * 64 + pp];
                v[e] = im ? -(xr * ai + xi * ar) : (xr * ar - xi * ai); } }
        u32x4 o; o.x = cvt_pk_bf16(v[0], v[1]); o.y = cvt_pk_bf16(v[2], v[3]); o.z = cvt_pk_bf16(v[4], v[5]); o.w = cvt_pk_bf16(v[6], v[7]);
        *(u32x4*)(W2 + (size_t)n * 384 + 8 * ch) = o; }
    __syncthreads();
}
template <int CLS> __device__ __forceinline__ void transposes(const P& p, LAS float* scr, int lane, int gw, int NGW) {
    constexpr int I_UP = 16 * 192, I_DN = 48 * 32, I_IN = 16 * 112, I_GL = 8 * 64, I_OU = 16 * 32, I_LR = 16 * 8;
    constexpr int NITEMS = CLS == 0 ? I_IN + I_LR : I_UP + I_DN + I_GL + I_OU;
    for (int it = gw; it < NITEMS; it += NGW) { int r = it;
        if (CLS == 0) {
            if (r < I_IN) { const int kb = r / 112, nb = r % 112; transpose_item(p.in[I_WIN], DIN, (bf16_t*)(p.ws + W_WTIN), 1024, 64 * kb, 32 * nb, 32 * nb, scr, lane); continue; } r -= I_IN;
            { const int which = r >> 6, blk = (r >> 3) & 7, kb = (r >> 2) & 1, nb = r & 3;
              transpose_item(p.in[which ? I_WI : I_WR] + blk * 16384, 128, (bf16_t*)(p.ws + (which ? W_WTI : W_WTR)) + blk * 16384, 128, 64 * kb, 32 * nb, 32 * nb, scr, lane); }
        } else {
            if (r < I_UP) { const int kb = r / 192, nb = r % 192, d0 = 32 * nb, s0 = ((d0 >> 7) & 1) * DFF + (d0 >> 8) * 128 + (d0 & 127);
                transpose_item(p.in[I_WUP], 6144, (bf16_t*)(p.ws + W_WTUP), 1024, 64 * kb, s0, d0, scr, lane); continue; } r -= I_UP;
            if (r < I_DN) { const int kb = r / 32, nb = r % 32; transpose_item(p.in[I_WDOWN], 1024, (bf16_t*)(p.ws + W_WTDOWN), 3072, 64 * kb, 32 * nb, 32 * nb, scr, lane); continue; } r -= I_DN;
            if (r < I_GL) { const int kb = r / 64, nb = r % 64, d0 = 32 * nb, s0 = ((d0 >> 7) & 1) * 1024 + (d0 >> 8) * 128 + (d0 & 127);
                transpose_item(p.in[I_WGLU], 2048, (bf16_t*)(p.ws + W_WTGLU), 512, 64 * kb, s0, d0, scr, lane); continue; } r -= I_GL;
            { const int kb = r / 32, nb = r % 32; transpose_item(p.in[I_WOUT], 1024, (bf16_t*)(p.ws + W_WTOUT), 1024, 64 * kb, 32 * nb, 32 * nb, scr, lane); }
        }
    }
}
__device__ __forceinline__ void phase0(const P& p, LAS unsigned char* lds) {
    int tid_ = threadIdx.x; asm volatile("" : "+v"(tid_)); const int tid = tid_, lane = tid & 63, wid = tid >> 6;
    REPEAT(REP_P0A) for (int g = blockIdx.x; g < NG; g += gridDim.x) s5_precompute(p, lds, g);
    LAS float* scr = (LAS float*)(lds + wid * 8704);
    const int gw = blockIdx.x * 8 + wid, NGW = gridDim.x * 8;
    { const int skip = ((int)gridDim.x >= 64) ? NG : 0;
      if ((int)blockIdx.x >= skip) REPEAT(REP_P0B) transposes<0>(p, scr, lane, ((int)blockIdx.x - skip) * 8 + wid, ((int)gridDim.x - skip) * 8); }
    { const int skip = ((int)gridDim.x >= 64) ? NG : 0;
      if ((int)blockIdx.x >= skip) { const int gw2 = ((int)blockIdx.x - skip) * 8 + wid, NGW2 = ((int)gridDim.x - skip) * 8;
        REPEAT(REP_P0C) for (int r = gw2; r < MTOK; r += 2 * NGW2) { const int r2 = r + NGW2; const bool vb = r2 < MTOK; const int rb = vb ? r2 : r;
          ln_rows2<true>(src_row(p, r), src_row(p, rb), p.in[I_EG], p.in[I_EB], (bf16_t*)(p.ws + W_XN) + (size_t)r * DM, (bf16_t*)(p.ws + W_XN) + (size_t)rb * DM, lane, vb); } } }
}

template <int MODE> __device__ __forceinline__ void lru_unit(const P& p, LAS unsigned char* lds, int b, int kc, int nb) {
    int tid_ = threadIdx.x; asm volatile("" : "+v"(tid_)); const int tid = tid_, lane = tid & 63, wid = tid >> 6, q = lane >> 4, n = lane & 15;
    int mt0, nmt, rowbase;
    if (MODE == 2) { mt0 = kc; nmt = 1; rowbase = MP; } else { mt0 = (NCHUNK * kc) >> 3; nmt = ((NCHUNK * (kc + 1)) >> 3) - mt0; rowbase = b * TT; }
    const int t0 = 16 * mt0, ntok = 16 * nmt;
    const bf16_t* proj = (const bf16_t*)(p.ws + W_PROJ);
    LAS bf16_t* xcs = (LAS bf16_t*)lds;
    LAS bf16_t* gas = (LAS bf16_t*)(lds + 73984);
    if (MODE == 2) {
        for (int it = tid; it < ntok * 16; it += 512) { const int i = it >> 4, cg8 = it & 15, c0 = nb * 128 + cg8 * 8; float a[8];
            { const f32x4 b0 = *(const f32x4*)(p.in[I_CLB] + c0), b1 = *(const f32x4*)(p.in[I_CLB] + c0 + 4); a[0] = b0[0]; a[1] = b0[1]; a[2] = b0[2]; a[3] = b0[3]; a[4] = b1[0]; a[5] = b1[1]; a[6] = b1[2]; a[7] = b1[3]; }
#pragma unroll
            for (int j = 0; j < 4; ++j) { const f32x4 w0 = *(const f32x4*)(p.in[I_CLW] + j * 1024 + c0), w1 = *(const f32x4*)(p.in[I_CLW] + j * 1024 + c0 + 4); float x[8];
                if (j < 3) { const float* cp = p.in[I_CCL] + ((size_t)(t0 + i) * 3 + j) * 1024 + c0; const f32x4 x0 = *(const f32x4*)cp, x1 = *(const f32x4*)(cp + 4);
                    x[0] = x0[0]; x[1] = x0[1]; x[2] = x0[2]; x[3] = x0[3]; x[4] = x1[0]; x[5] = x1[1]; x[6] = x1[2]; x[7] = x1[3]; }
                else { const u32x4 xv = *(const u32x4*)(proj + (size_t)(rowbase + t0 + i) * DIN + c0);
                    x[0] = bflo(xv.x); x[1] = bfhi(xv.x); x[2] = bflo(xv.y); x[3] = bfhi(xv.y); x[4] = bflo(xv.z); x[5] = bfhi(xv.z); x[6] = bflo(xv.w); x[7] = bfhi(xv.w); }
                a[0] += w0[0] * x[0]; a[1] += w0[1] * x[1]; a[2] += w0[2] * x[2]; a[3] += w0[3] * x[3]; a[4] += w1[0] * x[4]; a[5] += w1[1] * x[5]; a[6] += w1[2] * x[6]; a[7] += w1[3] * x[7]; }
            u32x4 o; o.x = cvt_pk_bf16(a[0], a[1]); o.y = cvt_pk_bf16(a[2], a[3]); o.z = cvt_pk_bf16(a[4], a[5]); o.w = cvt_pk_bf16(a[6], a[7]);
            *(LAS u32x4*)(xcs + i * 136 + cg8 * 8) = o;
            *(LAS u32x4*)(gas + i * 128 + cg8 * 8) = *(const u32x4*)(proj + (size_t)(rowbase + t0 + i) * DIN + C_GA + c0); }
    } else {
        const int cg8 = tid & 15, tr = tid >> 4, c0 = nb * 128 + cg8 * 8; float w[4][8], bs[8];
        { const f32x4 b0 = *(const f32x4*)(p.in[I_CLB] + c0), b1 = *(const f32x4*)(p.in[I_CLB] + c0 + 4); bs[0] = b0[0]; bs[1] = b0[1]; bs[2] = b0[2]; bs[3] = b0[3]; bs[4] = b1[0]; bs[5] = b1[1]; bs[6] = b1[2]; bs[7] = b1[3]; }
#pragma unroll
        for (int j = 0; j < 4; ++j) { const f32x4 w0 = *(const f32x4*)(p.in[I_CLW] + j * 1024 + c0), w1 = *(const f32x4*)(p.in[I_CLW] + j * 1024 + c0 + 4);
            w[j][0] = w0[0]; w[j][1] = w0[1]; w[j][2] = w0[2]; w[j][3] = w0[3]; w[j][4] = w1[0]; w[j][5] = w1[1]; w[j][6] = w1[2]; w[j][7] = w1[3]; }
        const int i0 = tr * 9; int i1 = i0 + 9; if (i1 > ntok) i1 = ntok;
        u32x4 xr[12], gr[9];
#pragma unroll
        for (int k = 0; k < 12; ++k) { const int i = i0 - 3 + k, t = t0 + i; xr[k] = (u32x4){0u, 0u, 0u, 0u}; if (t >= 0 && i < i1) xr[k] = *(const u32x4*)(proj + (size_t)(rowbase + t) * DIN + c0); }
#pragma unroll
        for (int k = 0; k < 9; ++k) { gr[k] = (u32x4){0u, 0u, 0u, 0u}; if (i0 + k < i1) gr[k] = *(const u32x4*)(proj + (size_t)(rowbase + t0 + i0 + k) * DIN + C_GA + c0); }
#pragma unroll
        for (int k = 0; k < 9; ++k) { if (i0 + k < i1) { float a[8];
#pragma unroll
            for (int e = 0; e < 8; ++e) a[e] = bs[e];
#pragma unroll
            for (int j = 0; j < 4; ++j) { const u32x4 xv = xr[k + j];
                a[0] += w[j][0] * bflo(xv.x); a[1] += w[j][1] * bfhi(xv.x); a[2] += w[j][2] * bflo(xv.y); a[3] += w[j][3] * bfhi(xv.y);
                a[4] += w[j][4] * bflo(xv.z); a[5] += w[j][5] * bfhi(xv.z); a[6] += w[j][6] * bflo(xv.w); a[7] += w[j][7] * bfhi(xv.w); }
            u32x4 o; o.x = cvt_pk_bf16(a[0], a[1]); o.y = cvt_pk_bf16(a[2], a[3]); o.z = cvt_pk_bf16(a[4], a[5]); o.w = cvt_pk_bf16(a[6], a[7]);
            *(LAS u32x4*)(xcs + (i0 + k) * 136 + cg8 * 8) = o; *(LAS u32x4*)(gas + (i0 + k) * 128 + cg8 * 8) = gr[k]; } }
    }
    __syncthreads();
    const int c = nb * 128 + wid * 16 + n;
    bf16x8 Br[4], Bi[4];
    { const bf16_t* wr_ = (const bf16_t*)(p.ws + W_WTR) + (size_t)c * 128 + q * 8; const bf16_t* wi_ = (const bf16_t*)(p.ws + W_WTI) + (size_t)c * 128 + q * 8;
#pragma unroll
      for (int kk = 0; kk < 4; ++kk) { Br[kk] = *(const bf16x8*)(wr_ + 32 * kk); Bi[kk] = *(const bf16x8*)(wi_ + 32 * kk); } }
    const float br = p.in[I_BR][c], bi = p.in[I_BI][c]; const float c8 = -8.0f * log1pf(expf(-p.in[I_LAM][c]));
    bf16_t* M1 = (bf16_t*)(p.ws + W_MIX); bf16_t* M2 = (bf16_t*)(p.out + O_YP);
    float h_run = 0.f, A_run = 1.f;
    for (int mt = 0; mt < nmt; ++mt) {
        f32x4 accr = {0.f, 0.f, 0.f, 0.f}, acci = {0.f, 0.f, 0.f, 0.f};
#pragma unroll
        for (int kk = 0; kk < 4; ++kk) { const bf16x8 Af = *(const LAS bf16x8*)(xcs + (16 * mt + n) * 136 + 32 * kk + 8 * q);
            accr = __builtin_amdgcn_mfma_f32_16x16x32_bf16(Af, Br[kk], accr, 0, 0, 0); acci = __builtin_amdgcn_mfma_f32_16x16x32_bf16(Af, Bi[kk], acci, 0, 0, 0); }
        float a[4], bx[4], ga[4];
#pragma unroll
        for (int j = 0; j < 4; ++j) { const int tok = 16 * mt + 4 * q + j; const float xcv = bf2f(xcs[tok * 136 + wid * 16 + n]);
            ga[j] = bf2f(gas[tok * 128 + wid * 16 + n]);
            const float r = sigm(accr[j] + br), ig = sigm(acci[j] + bi), la = c8 * r; a[j] = __expf(la); bx[j] = __builtin_amdgcn_sqrtf(fmaf(-a[j], a[j], 1.0f)) * (ig * xcv); }
        float h[4], Ac[4];
        if (MODE == 2) {
#pragma unroll
            for (int j = 0; j < 4; ++j) { const int s = t0 + 16 * mt + 4 * q + j; h[j] = a[j] * p.in[I_SL][(size_t)s * 1024 + c] + bx[j]; p.out[O_SL + (size_t)s * 1024 + c] = h[j]; Ac[j] = 0.f; }
        } else {
            float Ap[4]; h[0] = bx[0]; Ap[0] = a[0];
#pragma unroll
            for (int j = 1; j < 4; ++j) { h[j] = a[j] * h[j - 1] + bx[j]; Ap[j] = a[j] * Ap[j - 1]; }
            float PA = Ap[3], PH = h[3];
            float tA = __shfl_up(PA, 16), tH = __shfl_up(PH, 16); if (q >= 1) { PH = PA * tH + PH; PA = PA * tA; }
            tA = __shfl_up(PA, 32); tH = __shfl_up(PH, 32); if (q >= 2) { PH = PA * tH + PH; PA = PA * tA; }
            const float h_end = PA * h_run + PH; const float hin_s = __shfl_up(h_end, 16), pae_s = __shfl_up(PA, 16);
            const float h_in = (q == 0) ? h_run : hin_s; const float a_in = A_run * ((q == 0) ? 1.0f : pae_s);
#pragma unroll
            for (int j = 0; j < 4; ++j) { h[j] += Ap[j] * h_in; Ac[j] = Ap[j] * a_in; }
            h_run = __shfl(h_end, 48 + n); A_run *= __shfl(PA, 48 + n);
        }
#pragma unroll
        for (int j = 0; j < 4; ++j) { const size_t row = (size_t)(rowbase + t0 + 16 * mt + 4 * q + j); const float sg = sigm(ga[j]);
            M1[row * 1024 + c] = f2bf(sg * h[j]); M2[row * 1024 + c] = f2bf(sg * Ac[j]); }
    }
    if (MODE == 0 && q == 0) { ((float*)(p.ws + W_LRUA))[(size_t)(b * 8 + kc) * 1024 + c] = A_run; ((float*)(p.ws + W_LRUH))[(size_t)(b * 8 + kc) * 1024 + c] = h_run; }
    __syncthreads();
}

__device__ __forceinline__ void s5_fused(const P& p, LAS unsigned char* lds, int g, int b) {
    int tid_ = threadIdx.x; asm volatile("" : "+v"(tid_)); const int tid = tid_, lane = tid & 63, wid = tid >> 6, n = lane & 15, q = lane >> 4;
    LAS bf16_t* Us = (LAS bf16_t*)lds;
    LAS float* Ssm = (LAS float*)(lds + 68112);
    LAS bf16_t* Hs = (LAS bf16_t*)(lds + 68112);
    const bf16_t* proj = (const bf16_t*)(p.ws + W_PROJ); const bf16x8 zero = {0, 0, 0, 0, 0, 0, 0, 0};
    bf16x8 Bf1[8];
    { const bf16_t* W = (const bf16_t*)(p.ws + W_W1) + (size_t)g * 128 * 256;
#pragma unroll
      for (int kk = 0; kk < 8; ++kk) Bf1[kk] = *(const bf16x8*)(W + (size_t)(16 * wid + n) * 256 + 32 * kk + 8 * q); }
    TIMED(231) { const bf16_t* ub = (const bf16_t*)(p.out + O_YP) + (size_t)MTOK * 1024 + (size_t)(b * NG + g) * TT * 16;
      u32x4 tv[9];
#pragma unroll
      for (int i = 0; i < 9; ++i) { const int it = tid + 512 * i; tv[i] = (u32x4){0u, 0u, 0u, 0u}; if (it < TT * 2) tv[i] = *(const u32x4*)(ub + (size_t)it * 8); }
#pragma unroll
      for (int i = 0; i < 9; ++i) { const int it = tid + 512 * i; if (it < TT * 2) { const int t = it >> 1; *(LAS u32x4*)(Us + (t >> 4) * 264 + (t & 15) * 16 + 8 * (it & 1)) = tv[i]; } } }
    __syncthreads();
    TIMED_END(231)
    TIMED(232) {
#pragma unroll 1
      for (int rt = 0; rt < 9; ++rt) { const int k = 16 * rt + n; f32x4 acc = {0.f, 0.f, 0.f, 0.f};
#pragma unroll
          for (int kk = 0; kk < 8; ++kk) { const bf16x8 Af = *(const LAS bf16x8*)(Us + k * 264 + 32 * kk + 8 * q);
              acc = __builtin_amdgcn_mfma_f32_16x16x32_bf16(Af, Bf1[kk], acc, 0, 0, 0); }
#pragma unroll
          for (int j = 0; j < 4; ++j) Ssm[(16 * rt + 4 * q + j) * 128 + 16 * wid + n] = acc[j]; } }
    __syncthreads();
    TIMED_END(232)
    bf16x8 Bw[2][12];
    { const bf16_t* W = (const bf16_t*)(p.ws + W_W2) + (size_t)g * 256 * 384;
#pragma unroll
      for (int i = 0; i < 2; ++i)
#pragma unroll
          for (int kk = 0; kk < 12; ++kk) Bw[i][kk] = *(const bf16x8*)(W + (size_t)(16 * (2 * wid + i) + n) * 384 + 32 * kk + 8 * q); }
    TIMED(233) if (wid == 0) { const float* a16 = (const float*)(p.ws + W_A16) + (g * 64 + lane) * 2; const float ar = a16[0], ai = a16[1]; float hr = 0.f, hi = 0.f;
#pragma unroll 1
        for (int kb = 0; kb < 132; kb += 4) { float sr[4], si[4];
#pragma unroll
            for (int u = 0; u < 4; ++u) { sr[u] = Ssm[(kb + u) * 128 + lane]; si[u] = Ssm[(kb + u) * 128 + 64 + lane]; }
            LDS_WAIT();
#pragma unroll
            for (int u = 0; u < 4; ++u) { const int k = kb + u; if (k < NCHUNK) { Hs[k * 136 + lane] = f2bf(hr); Hs[k * 136 + 64 + lane] = f2bf(hi);
                const float nr = ar * hr - ai * hi + sr[u], ni = ar * hi + ai * hr + si[u]; hr = nr; hi = ni; } } }
        p.out[O_PSR + ((size_t)b * NG + g) * 64 + lane] = hr; p.out[O_PSI + ((size_t)b * NG + g) * 64 + lane] = hi; }
    __syncthreads();
    TIMED_END(233)
    TIMED(234)
    {
#pragma unroll 1
      for (int rt = 0; rt < 9; ++rt) { const int k = 16 * rt + n; f32x4 acc0 = {0.f, 0.f, 0.f, 0.f}, acc1 = {0.f, 0.f, 0.f, 0.f};
#pragma unroll
          for (int kk = 0; kk < 8; ++kk) { const bf16x8 af = *(const LAS bf16x8*)(Us + k * 264 + 32 * kk + 8 * q);
              acc0 = __builtin_amdgcn_mfma_f32_16x16x32_bf16(af, Bw[0][kk], acc0, 0, 0, 0); acc1 = __builtin_amdgcn_mfma_f32_16x16x32_bf16(af, Bw[1][kk], acc1, 0, 0, 0); }
#pragma unroll
          for (int kk = 8; kk < 12; ++kk) { const bf16x8 af = *(const LAS bf16x8*)(Hs + k * 136 + 32 * (kk - 8) + 8 * q);
              acc0 = __builtin_amdgcn_mfma_f32_16x16x32_bf16(af, Bw[0][kk], acc0, 0, 0, 0); acc1 = __builtin_amdgcn_mfma_f32_16x16x32_bf16(af, Bw[1][kk], acc1, 0, 0, 0); }
          bf16_t* Y = (bf16_t*)(p.ws + W_YSG) + (size_t)(b * TT + 16 * (16 * rt + 4 * q) + 2 * wid) * DSSM + 16 * g + n;
#pragma unroll
          for (int j = 0; j < 4; ++j) { if (16 * rt + 4 * q + j < NCHUNK) { Y[(size_t)j * 16 * DSSM] = f2bf(gelu_tanh(acc0[j])); Y[(size_t)j * 16 * DSSM + DSSM] = f2bf(gelu_tanh(acc1[j])); } } } }
    TIMED_END(234)
}
__device__ __forceinline__ void s5_sample(const P& p, int s, int g, int lane) {
    const bf16_t* up = (const bf16_t*)(p.out + O_YP) + (size_t)MTOK * 1024 + (size_t)MP * DSSM + ((size_t)s * NG + g) * 16;
    const u32x4 u0 = *(const u32x4*)up, u1 = *(const u32x4*)(up + 8); float u[16];
    u[0] = bflo(u0.x); u[1] = bfhi(u0.x); u[2] = bflo(u0.y); u[3] = bfhi(u0.y); u[4] = bflo(u0.z); u[5] = bfhi(u0.z); u[6] = bflo(u0.w); u[7] = bfhi(u0.w);
    u[8] = bflo(u1.x); u[9] = bfhi(u1.x); u[10] = bflo(u1.y); u[11] = bfhi(u1.y); u[12] = bflo(u1.z); u[13] = bfhi(u1.z); u[14] = bflo(u1.w); u[15] = bfhi(u1.w);
    const float* a1 = (const float*)(p.ws + W_A1) + (g * 64 + lane) * 2; const float ar = a1[0], ai = a1[1];
    const float* bb = (const float*)(p.ws + W_BBAR) + (size_t)(g * 64 + lane) * 32; float bur = 0.f, bui = 0.f;
#pragma unroll
    for (int c = 0; c < 16; ++c) { bur += bb[2 * c] * u[c]; bui += bb[2 * c + 1] * u[c]; }
    const size_t si = ((size_t)s * NG + g) * 64 + lane; const float h0r = p.in[I_SSR][si], h0i = p.in[I_SSI][si];
    const float hr = ar * h0r - ai * h0i + bur, hi = ar * h0i + ai * h0r + bui;
    p.out[O_SSR + si] = hr; p.out[O_SSI + si] = hi;
    float v16[16];
#pragma unroll
    for (int c1 = 0; c1 < 16; ++c1) v16[c1] = p.in[I_SCRE][(g * 16 + c1) * 64 + lane] * hr - p.in[I_SCIM][(g * 16 + c1) * 64 + lane] * hi;
    float v8[8], v4[4], v2[2], v1;
    { const bool hi32 = (lane & 32) != 0;
#pragma unroll
      for (int i = 0; i < 8; ++i) { const float keep = hi32 ? v16[i + 8] : v16[i], send = hi32 ? v16[i] : v16[i + 8]; v8[i] = keep + __shfl_xor(send, 32); } }
    { const bool hb = (lane & 16) != 0;
#pragma unroll
      for (int i = 0; i < 4; ++i) { const float keep = hb ? v8[i + 4] : v8[i], send = hb ? v8[i] : v8[i + 4]; v4[i] = keep + __shfl_xor(send, 16); } }
    { const bool hb = (lane & 8) != 0;
#pragma unroll
      for (int i = 0; i < 2; ++i) { const float keep = hb ? v4[i + 2] : v4[i], send = hb ? v4[i] : v4[i + 2]; v2[i] = keep + __shfl_xor(send, 8); } }
    { const bool hb = (lane & 4) != 0; const float keep = hb ? v2[1] : v2[0], send = hb ? v2[0] : v2[1]; v1 = keep + __shfl_xor(send, 4); }
    v1 += __shfl_xor(v1, 1); v1 += __shfl_xor(v1, 2);
    const int c1 = ((lane >> 5) & 1) * 8 + ((lane >> 4) & 1) * 4 + ((lane >> 3) & 1) * 2 + ((lane >> 2) & 1);
    if ((lane & 3) == 0) { const float uc = bf2f(up[c1]); const float yv = v1 + p.in[I_SD][g * 16 + c1] * uc;
        ((bf16_t*)(p.ws + W_YSG))[(size_t)(MP + s) * DSSM + 16 * g + c1] = f2bf(gelu_tanh(yv)); }
}
__device__ __forceinline__ void phase2a(const P& p, LAS unsigned char* lds) {
    TIMED(22) for (int u = blockIdx.x; u < 512; u += gridDim.x) lru_unit<0>(p, lds, (u >> 3) & 7, u >> 6, u & 7); TIMED_END(22)
    TIMED(23) for (int it = blockIdx.x; it < NG * NBATCH; it += gridDim.x) s5_fused(p, lds, it & 31, it >> 5); TIMED_END(23)
}
__device__ __forceinline__ void phase2b(const P& p, LAS unsigned char* lds) {
    int tid_ = threadIdx.x; asm volatile("" : "+v"(tid_)); const int tid = tid_, lane = tid & 63, wid = tid >> 6;
    const size_t gt = (size_t)blockIdx.x * 512 + tid, GT = (size_t)gridDim.x * 512;
    for (size_t i = gt; i < (size_t)NBATCH * 1024; i += GT) { const int b = (int)(i >> 10), c = (int)(i & 1023); float h = 0.f;
        const float* A = (const float*)(p.ws + W_LRUA); const float* Hh = (const float*)(p.ws + W_LRUH); float* Cc = (float*)(p.ws + W_LRUC);
        for (int kc = 0; kc < 8; ++kc) { const size_t o = (size_t)(b * 8 + kc) * 1024 + c; Cc[o] = h; h = A[o] * h + Hh[o]; }
        p.out[O_PL + i] = h; }
    for (int u = (int)gridDim.x - 1 - (int)blockIdx.x; u < 64; u += gridDim.x) lru_unit<2>(p, lds, 0, u >> 3, u & 7);
    for (int it = blockIdx.x * 8 + wid; it < NSAMP * NG; it += gridDim.x * 8) s5_sample(p, it >> 5, it & 31, lane);
    const bf16_t* proj = (const bf16_t*)(p.ws + W_PROJ);
    for (size_t i = gt; i < (size_t)NBATCH * 3 * 1024; i += GT) { const int c = (int)(i & 1023), j = (int)((i >> 10) % 3), b = (int)(i / 3072);
        p.out[O_PCL + i] = bf2f(proj[(size_t)(b * TT + TT - 3 + j) * DIN + c]); }
    for (size_t i = gt; i < (size_t)NSAMP * 3 * 1024; i += GT) { const int c = (int)(i & 1023), j = (int)((i >> 10) % 3), s = (int)(i / 3072);
        p.out[O_SCL + i] = (j < 2) ? p.in[I_CCL][((size_t)s * 3 + j + 1) * 1024 + c] : bf2f(proj[(size_t)(MP + s) * DIN + c]); }
    for (size_t i = gt; i < (size_t)NSAMP * DFF; i += GT) { const int ch = (int)(i % DFF), s = (int)(i / DFF);
        p.out[O_SCF + ((size_t)s * 2) * DFF + ch] = p.in[I_CCF][((size_t)s * 2 + 1) * DFF + ch]; }
}
__device__ __forceinline__ void phase_glutail(const P& p) {
    const size_t gt = (size_t)blockIdx.x * 512 + threadIdx.x, GT = (size_t)gridDim.x * 512;
    const float* pg = (const float*)(p.ws + W_PG); const float* bias = p.in[I_BGLU]; const bf16_t* proj = (const bf16_t*)(p.ws + W_PROJ);
    bf16_t* mix = (bf16_t*)(p.ws + W_MIX); const bf16_t* m2 = (const bf16_t*)(p.out + O_YP); const float* carry = (const float*)(p.ws + W_LRUC);
    for (size_t it = gt; it < (size_t)256 * 256; it += GT) { const int rl = (int)(it >> 8), j = (int)(it & 255) * 4, rowi = 16384 + rl; const size_t row = (size_t)rowi; const int col = 256 * (j >> 7) + (j & 127);
        f32x4 val = *(const f32x4*)(bias + j), gate = *(const f32x4*)(bias + 1024 + j);
#pragma unroll
        for (int ks = 0; ks < 2; ++ks) { val += *(const f32x4*)(pg + (size_t)ks * 256 * 2048 + (size_t)rl * 2048 + col); gate += *(const f32x4*)(pg + (size_t)ks * 256 * 2048 + (size_t)rl * 2048 + col + 128); }
        int cidx = 0; if (rowi < MP) { const int b = rowi / TT, t = rowi - b * TT; int kc = t >> 8; kc = kc > 7 ? 7 : kc; cidx = (b * 8 + kc) * 1024; }
        const f32x4 cv = *(const f32x4*)(carry + cidx + j); const u32x2 gbw = *(const u32x2*)(proj + row * DIN + C_GB + j), mw = *(const u32x2*)(mix + row * 1024 + j), m2w = *(const u32x2*)(m2 + row * 1024 + j);
        const float o0 = bflo(mw.x) + bflo(m2w.x) * cv[0] + sigm(bflo(gbw.x)) * val[0] * sigm(gate[0]), o1 = bfhi(mw.x) + bfhi(m2w.x) * cv[1] + sigm(bfhi(gbw.x)) * val[1] * sigm(gate[1]);
        const float o2 = bflo(mw.y) + bflo(m2w.y) * cv[2] + sigm(bflo(gbw.y)) * val[2] * sigm(gate[2]), o3 = bfhi(mw.y) + bfhi(m2w.y) * cv[3] + sigm(bfhi(gbw.y)) * val[3] * sigm(gate[3]);
        u32x2 w; w.x = cvt_pk_bf16(o0, o1); w.y = cvt_pk_bf16(o2, o3); *(u32x2*)(mix + row * 1024 + j) = w; }
}
__device__ __forceinline__ void phase_ln1(const P& p) {
    const int lane = threadIdx.x & 63, wid = threadIdx.x >> 6; const int gw = blockIdx.x * 8 + wid, NGW = gridDim.x * 8;
    const bf16_t* R = (const bf16_t*)(p.ws + W_R1); bf16_t* X = (bf16_t*)(p.ws + W_XN);
    for (int r = gw; r < 16384; r += 2 * NGW) { const int r2 = r + NGW; const bool vb = r2 < 16384; const int rb = vb ? r2 : r;
        ln_rows2_bf<true>(R + (size_t)r * DM, R + (size_t)rb * DM, p.in[I_L1G], p.in[I_L1B], X + (size_t)r * DM, X + (size_t)rb * DM, lane, vb); }
    for (int r = 16384 + gw; r < MTOK; r += NGW) { bf16_t* xr = X + (size_t)r * DM;
        ln_row<true>((const float*)(p.ws + W_PART) + (size_t)(r - 16384) * DM, p.in[I_L1G], p.in[I_L1B], xr, lane, 4, xr, p.in[I_BOUT]); }
}
__device__ __forceinline__ void phase_ffnfix(const P& p) {
    const size_t gt = (size_t)blockIdx.x * 512 + threadIdx.x, GT = (size_t)gridDim.x * 512;
    const float* sbg = (const float*)(p.ws + W_SBG); const float* sbv = (const float*)(p.ws + W_SBV); bf16_t* H = (bf16_t*)(p.ws + W_V);
    for (size_t it = gt; it < (size_t)256 * 2 * 384; it += GT) { const int cg8 = (int)(it % 384), rr = (int)((it / 384) & 1), blk = (int)(it / 768), ch = cg8 * 8, row = blk * 64 + rr; const int t = row % TT;
        float o[8];
#pragma unroll
        for (int hh = 0; hh < 2; ++hh) { const int c = ch + 4 * hh; const f32x4 z = {0.f, 0.f, 0.f, 0.f};
            const f32x4 g0 = *(const f32x4*)(sbg + ((size_t)blk * 4 + rr) * DFF + c), v = *(const f32x4*)(sbv + ((size_t)blk * 2 + rr) * DFF + c);
            f32x4 g1, g2;
            if (rr == 0) { g1 = (blk > 0 && t >= 1) ? *(const f32x4*)(sbg + ((size_t)(blk - 1) * 4 + 3) * DFF + c) : z; g2 = (blk > 0 && t >= 2) ? *(const f32x4*)(sbg + ((size_t)(blk - 1) * 4 + 2) * DFF + c) : z; }
            else { g1 = (t >= 1) ? *(const f32x4*)(sbg + ((size_t)blk * 4) * DFF + c) : z; g2 = (blk > 0 && t >= 2) ? *(const f32x4*)(sbg + ((size_t)(blk - 1) * 4 + 3) * DFF + c) : z; }
            const f32x4 w0 = *(const f32x4*)(p.in[I_FCW] + c), w1 = *(const f32x4*)(p.in[I_FCW] + DFF + c), w2 = *(const f32x4*)(p.in[I_FCW] + 2 * DFF + c), cbv = *(const f32x4*)(p.in[I_FCB] + c);
            const f32x4 y = cbv + w0 * g2 + w1 * g1 + w2 * g0;
            o[4 * hh] = gelu_tanh(y[0]) * v[0]; o[4 * hh + 1] = gelu_tanh(y[1]) * v[1]; o[4 * hh + 2] = gelu_tanh(y[2]) * v[2]; o[4 * hh + 3] = gelu_tanh(y[3]) * v[3]; }
        u32x4 w; w.x = cvt_pk_bf16(o[0], o[1]); w.y = cvt_pk_bf16(o[2], o[3]); w.z = cvt_pk_bf16(o[4], o[5]); w.w = cvt_pk_bf16(o[6], o[7]);
        *(u32x4*)(H + (size_t)row * DFF + ch) = w; }
}
__device__ __forceinline__ f32x4 up_tail_sum(const float* pu, const float* bias, int rl, int col, int bcol) {
    f32x4 v = *(const f32x4*)(bias + bcol);
#pragma unroll
    for (int ks = 0; ks < 4; ++ks) v += *(const f32x4*)(pu + (size_t)ks * 256 * 6144 + (size_t)rl * 6144 + col);
    return v;
}
__device__ __forceinline__ void phase_ffntail(const P& p) {
    const size_t gt = (size_t)blockIdx.x * 512 + threadIdx.x, GT = (size_t)gridDim.x * 512;
    const float* pu = (const float*)(p.ws + W_PU); const float* sbg = (const float*)(p.ws + W_SBG); bf16_t* H = (bf16_t*)(p.ws + W_V); const float* bias = p.in[I_BUP];
    for (size_t it = gt; it < (size_t)256 * 768; it += GT) { const int rl = (int)(it / 768), ch = (int)(it - (size_t)rl * 768) * 4, row = 16384 + rl; const int colg = 256 * (ch >> 7) + (ch & 127);
        const f32x4 g0 = up_tail_sum(pu, bias, rl, colg, ch), v = up_tail_sum(pu, bias, rl, colg + 128, DFF + ch); f32x4 g1, g2;
        if (row >= MP) { const int s_ = row - MP; g2 = *(const f32x4*)(p.in[I_CCF] + ((size_t)s_ * 2) * DFF + ch); g1 = *(const f32x4*)(p.in[I_CCF] + ((size_t)s_ * 2 + 1) * DFF + ch);
            *(f32x4*)(p.out + O_SCF + ((size_t)s_ * 2 + 1) * DFF + ch) = g0; }
        else {
            g1 = (rl >= 1) ? up_tail_sum(pu, bias, rl - 1, colg, ch) : *(const f32x4*)(sbg + ((size_t)255 * 4 + 3) * DFF + ch);
            g2 = (rl >= 2) ? up_tail_sum(pu, bias, rl - 2, colg, ch) : *(const f32x4*)(sbg + ((size_t)255 * 4 + 2 + rl) * DFF + ch);
            const int t = row - 7 * TT; if (t >= TT - 2) *(f32x4*)(p.out + O_PCF + ((size_t)7 * 2 + (t - (TT - 2))) * DFF + ch) = g0; }
        const f32x4 w0 = *(const f32x4*)(p.in[I_FCW] + ch), w1 = *(const f32x4*)(p.in[I_FCW] + DFF + ch), w2 = *(const f32x4*)(p.in[I_FCW] + 2 * DFF + ch), cbv = *(const f32x4*)(p.in[I_FCB] + ch);
        const f32x4 y = cbv + w0 * g2 + w1 * g1 + w2 * g0;
        u32x2 w; w.x = cvt_pk_bf16(gelu_tanh(y[0]) * v[0], gelu_tanh(y[1]) * v[1]); w.y = cvt_pk_bf16(gelu_tanh(y[2]) * v[2], gelu_tanh(y[3]) * v[3]);
        *(u32x2*)(H + (size_t)row * DFF + ch) = w; }
}
__device__ __forceinline__ float* y_row(const P& p, int r) {
    if (r >= MP) return p.out + O_YS + (size_t)(r - MP) * DM;
    const int b = r / TT, t = r - b * TT; return t < 16 ? nullptr : p.out + O_YP + ((size_t)b * 2048 + (t - 16)) * DM;
}
__device__ __forceinline__ void phase_ln2(const P& p) {
    const int lane = threadIdx.x & 63, wid = threadIdx.x >> 6; const int gw = blockIdx.x * 8 + wid, NGW = gridDim.x * 8;
    const bf16_t* R = (const bf16_t*)(p.ws + W_R2);
    for (int r = gw; r < 16384; r += 2 * NGW) { const int r2 = r + NGW; float* oa = y_row(p, r); float* ob = (r2 < 16384) ? y_row(p, r2) : nullptr;
        if (oa && ob) ln_rows2_bf<false>(R + (size_t)r * DM, R + (size_t)r2 * DM, p.in[I_L2G], p.in[I_L2B], oa, ob, lane, true);
        else if (oa) ln_rows2_bf<false>(R + (size_t)r * DM, R + (size_t)r * DM, p.in[I_L2G], p.in[I_L2B], oa, oa, lane, false);
        else if (ob) ln_rows2_bf<false>(R + (size_t)r2 * DM, R + (size_t)r2 * DM, p.in[I_L2G], p.in[I_L2B], ob, ob, lane, false); }
    for (int r = 16384 + gw; r < MTOK; r += NGW) { float* o = y_row(p, r);
        if (o) ln_row<false>((const float*)(p.ws + W_PART) + (size_t)(r - 16384) * DM, p.in[I_L2G], p.in[I_L2B], o, lane, 12, (const bf16_t*)(p.ws + W_XN) + (size_t)r * DM, p.in[I_BDOWN]); }
}

__global__ __launch_bounds__(512, 2) void hawk_fwd(P p) {
    extern __shared__ __attribute__((aligned(16))) unsigned char shm[];
    LAS unsigned char* lds = (LAS unsigned char*)shm;
    cg::grid_group grid = cg::this_grid();
    volatile LAS unsigned* xst = (volatile LAS unsigned*)(lds + LDS_TOTAL - 16);
    if (threadIdx.x < 4) xst[threadIdx.x] = 0u;
    __syncthreads();
    XcdBarrier xb = xcd_barrier_post((unsigned*)(p.ws + W_BAR), xst);
    if (threadIdx.x == 0) xst[2] = xb_add((unsigned*)(p.ws + W_BAR) + XCD_BAR_WORDS + 64 * xb.x, 1u);
#define GSYNC() xcd_barrier(xb)
    if (p.ws == nullptr) grid.sync();
    TIMED(0) REPEAT(REP_P0) { phase0(p, lds); GSYNC(); } TIMED_END(0)
    if (threadIdx.x == 0) { unsigned* bar = (unsigned*)(p.ws + W_BAR); bool ok = (gridDim.x % 8u) == 0u;
        for (unsigned j = 0; j < 16; ++j) { const unsigned cnt = xb_ld(&bar[XB_XCNT(j)]); if (cnt != (j < 8 ? gridDim.x / 8u : 0u)) ok = false; }
        xst[3] = ok ? (xst[2] * 8u + xb.x) : blockIdx.x; }
    __syncthreads();
    const int vc = (int)xst[3];
    TIMED(1) REPEAT(REP_P1) { EpiProj E; E.O = (bf16_t*)(p.ws + W_PROJ); E.bias = p.in[I_BIN]; E.UT = (bf16_t*)(p.out + O_YP) + (size_t)MTOK * 1024; run_gemm(lds, vc, (const bf16_t*)(p.ws + W_XN), (const bf16_t*)(p.ws + W_WTIN), DIN, 1024, E);
        { const int G = (int)gridDim.x, nun = (MTOK / 256) * (DIN / 256), rem = nun % G; const int c = vc;
          if (c >= rem) transposes<1>(p, (LAS float*)(lds + (threadIdx.x >> 6) * 8704), threadIdx.x & 63, (c - rem) * 8 + (int)(threadIdx.x >> 6), (G - rem) * 8); }
        GSYNC(); } TIMED_END(1)
    TIMED(20) REPEAT(REP_P2A) { phase2a(p, lds); GSYNC(); } TIMED_END(20)
    TIMED(21) REPEAT(REP_P2B) { phase2b(p, lds); GSYNC(); } TIMED_END(21)
    TIMED(3) { EpiGlu E; E.mix = (bf16_t*)(p.ws + W_MIX); E.m2 = (const bf16_t*)(p.out + O_YP); E.carry = (const float*)(p.ws + W_LRUC); E.proj = (const bf16_t*)(p.ws + W_PROJ); E.bias = p.in[I_BGLU]; run_gemm_main64(lds, vc, (const bf16_t*)(p.ws + W_YSG), (const bf16_t*)(p.ws + W_WTGLU), 2048, 512, E);
        run_gemm_tail(lds, vc, (const bf16_t*)(p.ws + W_YSG), (const bf16_t*)(p.ws + W_WTGLU), 2048, 512, 2, (float*)(p.ws + W_PG)); GSYNC();
        phase_glutail(p); GSYNC(); } TIMED_END(3)
    TIMED(4) REPEAT(REP_P4) { EpiRes E; E.R = (bf16_t*)(p.ws + W_R1); E.X = (const bf16_t*)(p.ws + W_XN); E.bias = p.in[I_BOUT]; E.part = (float*)(p.ws + W_PART); run_gemm_split(lds, vc, (const bf16_t*)(p.ws + W_MIX), (const bf16_t*)(p.ws + W_WTOUT), 1024, 1024, 4, E); GSYNC(); } TIMED_END(4)
    TIMED(5) REPEAT(REP_P5) { phase_ln1(p); GSYNC(); } TIMED_END(5)
    TIMED(6) REPEAT(REP_P6) { EpiUp E; E.H = (bf16_t*)(p.ws + W_V); E.bias = p.in[I_BUP]; E.out = p.out; E.cw = p.in[I_FCW]; E.cb = p.in[I_FCB]; E.cache = p.in[I_CCF]; E.sbg = (float*)(p.ws + W_SBG); E.sbv = (float*)(p.ws + W_SBV); run_gemm_main64(lds, vc, (const bf16_t*)(p.ws + W_XN), (const bf16_t*)(p.ws + W_WTUP), 6144, 1024, E);
        run_gemm_tail(lds, vc, (const bf16_t*)(p.ws + W_XN), (const bf16_t*)(p.ws + W_WTUP), 6144, 1024, 4, (float*)(p.ws + W_PU)); GSYNC(); } TIMED_END(6)
    TIMED(7) phase_ffnfix(p); phase_ffntail(p);
    GSYNC(); TIMED_END(7)
    TIMED(8) REPEAT(REP_P8) { EpiRes E; E.R = (bf16_t*)(p.ws + W_R2); E.X = (const bf16_t*)(p.ws + W_XN); E.bias = p.in[I_BDOWN]; E.part = (float*)(p.ws + W_PART); run_gemm_split(lds, vc, (const bf16_t*)(p.ws + W_V), (const bf16_t*)(p.ws + W_WTDOWN), 1024, 3072, 12, E); GSYNC(); } TIMED_END(8)
    TIMED(9) REPEAT(REP_P9) phase_ln2(p); TIMED_END(9)
}

extern "C" void kernel_launch(void* const* d_in, const int* in_sizes, int n_in, void* d_out, int out_size, void* d_ws, size_t ws_size, hipStream_t stream) {
    constexpr int LDS_BYTES = LDS_TOTAL;
    static int grid = 0;
    if (grid == 0) {
        if (n_in != N_IN || (size_t)out_size != O_END || ws_size < 268435456ull) { fprintf(stderr, "kernel_launch: unexpected shapes (n_in %d out %d ws %zu)\n", n_in, out_size, ws_size); grid = -1; return; }
        int dev = 0, cus = 0, per_cu = 0;
        if (hipGetDevice(&dev) != hipSuccess || hipDeviceGetAttribute(&cus, hipDeviceAttributeMultiprocessorCount, dev) != hipSuccess) { grid = -1; return; }
        if (hipFuncSetAttribute((const void*)hawk_fwd, hipFuncAttributeMaxDynamicSharedMemorySize, LDS_BYTES) != hipSuccess) { fprintf(stderr, "kernel_launch: hipFuncSetAttribute failed\n"); grid = -1; return; }
        if (hipOccupancyMaxActiveBlocksPerMultiprocessor(&per_cu, (const void*)hawk_fwd, 512, LDS_BYTES) != hipSuccess || per_cu < 1) { fprintf(stderr, "kernel_launch: occupancy query failed (%d)\n", per_cu); grid = -1; (void)hipGetLastError(); return; }
        grid = cus * per_cu;
    }
    if (grid < 0) return;
    if (hipMemsetAsync((char*)d_ws + W_BAR, 0, (XCD_BAR_WORDS + 64 * 16) * 4, stream) != hipSuccess) { fprintf(stderr, "kernel_launch: memset failed\n"); return; }
    P p{};
    for (int i = 0; i < N_IN; ++i) p.in[i] = (const float*)d_in[i];
    p.out = (float*)d_out; p.ws = (unsigned char*)d_ws;
    void* args[] = {&p};
    hipError_t e = hipLaunchCooperativeKernel((const void*)hawk_fwd, dim3(grid), dim3(512), args, LDS_BYTES, stream);
    if (e != hipSuccess) fprintf(stderr, "cooperative launch failed: %s (grid %d)\n", hipGetErrorString(e), grid);
}
```

```cpp
#include <hip/hip_runtime.h>
#include <hip/hip_cooperative_groups.h>
#include <cstdio>
#include <cstdint>
namespace cg = cooperative_groups;
#define REP_P0 1
#define REP_P0A 1
#define REP_P0B 1
#define REP_P0C 1
#define REP_P1 1
#define REP_P3 1
#define REP_P2A 1
#define REP_P2B 1
#define REP_P2C 1
#define REP_P4 1
#define REP_P5 1
#define REP_P6 1
#define REP_P8 1
#define REP_P9 1
#define PROBE_PHASE -1
namespace pg8 {
#define PG8_LAS __attribute__((address_space(3)))
typedef unsigned short bf16_t;
typedef short bf16x8 __attribute__((ext_vector_type(8)));
typedef float f32x4 __attribute__((ext_vector_type(4)));
typedef unsigned u32x4 __attribute__((ext_vector_type(4)));
constexpr int BM = 256, BK = 64, HALF = 128, HTB = HALF * BK * 2  , STAGE_BYTES = 8 * HTB, NXCD = 8, WGM = 8;

__host__ __device__ __forceinline__ int lds_byte(int r, int c) { const int st = (r >> 4) * 2 + (c >> 5), rr = r & 15, cc = c & 31, ob = rr * 64 + cc * 2; return st * 1024 + (ob ^ (((ob >> 9) & 1) << 5)); }
__host__ __device__ __forceinline__ void stage_rc(int b, int& R, int& C) { const int st = b / 1024, sb = b % 1024, swz = sb ^ (((sb >> 9) & 1) << 5); R = (st >> 1) * 16 + swz / 64; C = (st & 1) * 32 + (swz % 64) / 2; }
__host__ __device__ __forceinline__ int perm32(int rho) { const int n = rho >> 4, i = rho & 15; return 8 * (i >> 2) + 4 * n + (i & 3); }

struct Unit { int pm, pn, k0, nt, ks; };
struct Gemm { const bf16_t* A; const bf16_t* Bt; int M, N, K; };

struct StaticOrder {
    int nM, nN, nwg, G, c, ntk;
    __host__ __device__ void init(int M, int N, int K, int G_, int c_) { nM = M / BM; nN = N / BM; nwg = nM * nN; G = G_; c = c_; ntk = K / BK; }
    __host__ __device__ bool next(int i, Unit& u) const {
        const long L = (long)i * G + c; if (L >= nwg) return false;
        int wgid = (int)L; { const int q = nwg / NXCD, r = nwg % NXCD, xcd = wgid % NXCD, off = wgid / NXCD; wgid = (xcd < r ? xcd * (q + 1) : r * (q + 1) + (xcd - r) * q) + off; }
        const int nig = WGM * nN, gid = wgid / nig, fm = gid * WGM, gsz = (nM - fm) < WGM ? (nM - fm) : WGM;
        u.pm = fm + ((wgid % nig) % gsz); u.pn = (wgid % nig) / gsz; u.k0 = 0; u.nt = ntk; u.ks = -1; return true;
    }
    __device__ __forceinline__ void a_ready(const Unit&) const {}
    __device__ __forceinline__ void done(const Unit&) const {}
};
struct TailOrder {
    int nN, ntk, nsplit, G, c;
    __host__ __device__ void init(int N, int K, int nsplit_, int G_, int c_) { nN = N / BM; ntk = K / BK; nsplit = nsplit_; G = G_; c = c_; }
    __host__ __device__ bool next(int i, Unit& u) const {
        const long L = (long)i * G + c; const bool ok = L < (long)nN * nsplit; const int ks = (int)(L / nN), ntp = ntk / nsplit;
        u.pm = 64; u.pn = (int)(L % nN); u.ks = ks; u.nt = ntp; u.k0 = ks * ntp * BK; return ok;
    }
    __device__ __forceinline__ void a_ready(const Unit&) const {}
    __device__ __forceinline__ void done(const Unit&) const {}
};
struct SplitOrder {
    StaticOrder base; int nsplit;
    __host__ __device__ void init(int N, int K, int nsplit_, int G_, int c_) { base.init(64 * BM, N, K, G_, c_); nsplit = nsplit_; }
    __host__ __device__ bool next(int i, Unit& u) const {
        Unit t; t.pm = 0; t.pn = 0; t.k0 = 0; t.nt = base.ntk; t.ks = -1;
        const bool ok = base.next(i, t);
        const long L = (long)i * base.G + base.c - base.nwg; const bool sp = (!ok) && L >= 0 && L < (long)base.nN * nsplit;
        const int ks = (int)(L / base.nN), pn = (int)(L % base.nN), ntp = base.ntk / nsplit;
        u.pm = sp ? 64 : t.pm; u.pn = sp ? pn : t.pn; u.ks = sp ? ks : -1; u.nt = sp ? ntp : t.nt; u.k0 = sp ? ks * ntp * BK : 0;
        return ok || sp;
    }
    __device__ __forceinline__ void a_ready(const Unit&) const {}
    __device__ __forceinline__ void done(const Unit&) const {}
};
__device__ __forceinline__ unsigned cvt_pk_bf16(float lo, float hi) { unsigned r; asm volatile("v_cvt_pk_bf16_f32 %0, %1, %2" : "=v"(r) : "v"(lo), "v"(hi)); return r; }
template <class Epi, class Sched, bool STAMP = false>
__device__ __forceinline__ void gemm_phase(PG8_LAS unsigned char* lds, const Gemm g, const Sched& S, const Epi& E, unsigned long long* stamps) {
    int tid_ = threadIdx.x; asm volatile("" : "+v"(tid_)); const int tid = tid_, wid = __builtin_amdgcn_readfirstlane(tid >> 6), lane = tid & 63, wr = wid >> 2, wc = wid & 3, fr = lane & 15, fq = lane >> 4;
    const int K = g.K;
    int ts_lo = 0, ts_hi = 0, nts = 0; const unsigned long long rt_entry = STAMP ? (unsigned long long)wall_clock64() : 0ull;
#define PG8_STAMP() do { if (STAMP && wid == 0 && nts < 64) { const unsigned long long _c = (unsigned long long)clock64(); \
        ts_lo = (lane == nts) ? (int)(unsigned)_c : ts_lo; ts_hi = (lane == nts) ? (int)(unsigned)(_c >> 32) : ts_hi; ++nts; } } while (0)
    PG8_STAMP();
    unsigned voffA[2], voffB[2];
#pragma unroll
    for (int i = 0; i < 2; ++i) { int R, C; stage_rc(tid * 16 + i * 8192, R, C); const int Rb = Epi::PERM ? ((R & ~31) + perm32(R & 31)) : R;
        voffA[i] = (unsigned)(R * K + C) * 2u; voffB[i] = (unsigned)(Rb * K + C) * 2u; }
    const size_t kstep = (size_t)(BK * 2);
    const size_t hstep = (size_t)HALF * K * 2;
    const size_t tstep = 2 * hstep;
    const unsigned ldsw = (unsigned)wid * 1024u;
    const int aoff = lds_byte(wr * 64 + fr, fq * 8), boff = lds_byte(wc * 32 + fr, fq * 8);
#define PG8_SA(b, h) (((b) * 2 + (h)) * HTB)
#define PG8_SB(b, h) ((4 + (b) * 2 + (h)) * HTB)
#define PG8_STAGE(bufoff, gbase, voff) do { _Pragma("unroll") for (int _i = 0; _i < 2; ++_i) \
        __builtin_amdgcn_global_load_lds((const unsigned*)((const char*)(gbase) + (voff)[_i]), (PG8_LAS unsigned*)(lds + (bufoff) + ldsw + _i * 8192), 16, 0, 0); } while (0)
#define PG8_LDA(dst, b, h) do { _Pragma("unroll") for (int m = 0; m < 4; ++m) _Pragma("unroll") for (int k = 0; k < 2; ++k) dst[m][k] = *(const PG8_LAS bf16x8*)(lds + PG8_SA(b, h) + aoff + m * 2048 + k * 1024); } while (0)
#define PG8_LDB(dst, b, h) do { _Pragma("unroll") for (int n = 0; n < 2; ++n) _Pragma("unroll") for (int k = 0; k < 2; ++k) dst[n][k] = *(const PG8_LAS bf16x8*)(lds + PG8_SB(b, h) + boff + n * 2048 + k * 1024); } while (0)
#define PG8_MMA(ai, bj, At, Bt) do { __builtin_amdgcn_s_setprio(1); _Pragma("unroll") for (int m = 0; m < 4; ++m) _Pragma("unroll") for (int n = 0; n < 2; ++n) _Pragma("unroll") for (int k = 0; k < 2; ++k) \
        acc[ai][bj][m][n] = __builtin_amdgcn_mfma_f32_16x16x32_bf16(Bt[n][k], At[m][k], acc[ai][bj][m][n], 0, 0, 0); __builtin_amdgcn_s_setprio(0); } while (0)
#define PG8_WAIT_V(n) asm volatile("s_waitcnt vmcnt(" #n ")" ::: "memory")
#define PG8_WAIT_L(n) asm volatile("s_waitcnt lgkmcnt(" #n ")" ::: "memory")
#define PG8_BAR __builtin_amdgcn_s_barrier()
#define PG8_SCHED __builtin_amdgcn_sched_barrier(0)
    Unit cur, nxt; int ui = 0;
    if (!S.next(0, cur)) return;
    f32x4 acc[2][2][4][2];
#pragma unroll
    for (int a = 0; a < 2; ++a)
#pragma unroll
        for (int b = 0; b < 2; ++b)
#pragma unroll
            for (int m = 0; m < 4; ++m)
#pragma unroll
                for (int n = 0; n < 2; ++n) acc[a][b][m][n] = (f32x4){0.f, 0.f, 0.f, 0.f};
    bf16x8 At[4][2], B0[2][2], B1[2][2];
    const char* cA = (const char*)g.A + (size_t)cur.pm * tstep + (size_t)cur.k0 * 2; const char* cB = (const char*)g.Bt + (size_t)cur.pn * tstep + (size_t)cur.k0 * 2;
    S.a_ready(cur);
    PG8_STAGE(PG8_SB(0, 0), cB, voffB); PG8_STAGE(PG8_SB(0, 1), cB + hstep, voffB); PG8_STAGE(PG8_SA(0, 0), cA, voffA); PG8_STAGE(PG8_SA(0, 1), cA + hstep, voffA);
    if (wr == 1) PG8_BAR;
    PG8_WAIT_V(2); PG8_BAR;
    PG8_STAGE(PG8_SB(1, 0), cB + kstep, voffB); PG8_STAGE(PG8_SA(1, 0), cA + kstep, voffA); PG8_STAGE(PG8_SB(1, 1), cB + hstep + kstep, voffB);
    PG8_WAIT_V(6); PG8_BAR;
    PG8_STAMP();
    for (;;) {
        const bool has_next = S.next(ui + 1, nxt);
        const char* nA = has_next ? (const char*)g.A + (size_t)nxt.pm * tstep + (size_t)nxt.k0 * 2 : cA; const char* nB = has_next ? (const char*)g.Bt + (size_t)nxt.pn * tstep + (size_t)nxt.k0 * 2 : cB;
        const int nt = cur.nt;
        for (int t = 0; t < nt; t += 2) {
            const bool last = (t == nt - 2);
            const char* a1 = cA + (size_t)(t + 1) * kstep;
            const char* a2 = last ? nA : cA + (size_t)(t + 2) * kstep; const char* b2 = last ? nB : cB + (size_t)(t + 2) * kstep;
            const char* a3 = a2 + kstep; const char* b3 = b2 + kstep;
            if (last && has_next) S.a_ready(nxt);
            PG8_LDB(B0, 0, 0); PG8_LDB(B1, 0, 1); PG8_SCHED; PG8_LDA(At, 0, 0); PG8_STAGE(PG8_SA(1, 1), a1 + hstep, voffA);
            PG8_WAIT_V(8); PG8_WAIT_L(0); PG8_BAR; PG8_MMA(0, 0, At, B0); PG8_MMA(0, 1, At, B1); PG8_BAR; PG8_SCHED;
            PG8_LDA(At, 0, 1); PG8_STAGE(PG8_SB(0, 0), b2, voffB); PG8_STAGE(PG8_SB(0, 1), b2 + hstep, voffB); PG8_STAGE(PG8_SA(0, 0), a2, voffA);
            PG8_WAIT_V(8); PG8_WAIT_L(0); PG8_BAR; PG8_MMA(1, 0, At, B0); PG8_MMA(1, 1, At, B1); PG8_BAR; PG8_SCHED;
            PG8_LDB(B0, 1, 0); PG8_LDB(B1, 1, 1); PG8_SCHED; PG8_LDA(At, 1, 0); PG8_STAGE(PG8_SA(0, 1), a2 + hstep, voffA);
            PG8_WAIT_V(8); PG8_WAIT_L(0); PG8_BAR; PG8_MMA(0, 0, At, B0); PG8_MMA(0, 1, At, B1); PG8_BAR; PG8_SCHED;
            PG8_LDA(At, 1, 1); PG8_STAGE(PG8_SB(1, 0), b3, voffB); PG8_STAGE(PG8_SB(1, 1), b3 + hstep, voffB); PG8_STAGE(PG8_SA(1, 0), a3, voffA);
            PG8_WAIT_V(8); PG8_WAIT_L(0); PG8_BAR; PG8_MMA(1, 0, At, B0); PG8_MMA(1, 1, At, B1); PG8_BAR; PG8_SCHED;
        }
        PG8_STAMP();
        if (wr == 0) PG8_BAR;
        if constexpr (!Epi::AFTER_DRAIN) { E(acc, cur, wr, wc, fr, fq); S.done(cur); }
        PG8_STAMP();
        if (!has_next) break;
#pragma unroll
        for (int a = 0; a < 2; ++a)
#pragma unroll
            for (int b = 0; b < 2; ++b)
#pragma unroll
                for (int m = 0; m < 4; ++m)
#pragma unroll
                    for (int n = 0; n < 2; ++n) acc[a][b][m][n] = (f32x4){0.f, 0.f, 0.f, 0.f};
        cur = nxt; cA = nA; cB = nB; ++ui;
        if (wr == 1) PG8_BAR;
    }
    PG8_WAIT_V(0);
    PG8_BAR;
    if constexpr (Epi::AFTER_DRAIN) { E.fused(acc, cur, wr, wc, fr, fq, lds, wid, lane); S.done(cur); }
    PG8_STAMP();
    if (STAMP && wid == 0) { stamps[lane] = lane < nts ? (((unsigned long long)(unsigned)ts_hi << 32) | (unsigned)ts_lo) : 0ull;
        if (lane == 62) stamps[62] = rt_entry; if (lane == 63) stamps[63] = (unsigned long long)wall_clock64(); }
#undef PG8_STAMP
#undef PG8_SA
#undef PG8_SB
#undef PG8_STAGE
#undef PG8_LDA
#undef PG8_LDB
#undef PG8_MMA
#undef PG8_WAIT_V
#undef PG8_WAIT_L
#undef PG8_BAR
#undef PG8_SCHED
}
}
using pg8::bf16_t; using pg8::bf16x8; using pg8::f32x4; using pg8::u32x4; using pg8::Unit; using pg8::cvt_pk_bf16;
#define LAS __attribute__((address_space(3)))
typedef unsigned u32x2 __attribute__((ext_vector_type(2)));
#define XB_TMO      128
#define XB_XCNT(j)  (256  + 64 * (j))
#define XB_XSUB(j)  (1280 + 64 * (j))
#define XB_XGEN(j)  (2304 + 64 * (j))
#define XB_TOP      3328
#define XB_TOPGEN   3392
#define XCD_BAR_WORDS 3456
#define XB_SPIN_CAP (1u << 18)

__device__ __forceinline__ unsigned xb_ld(unsigned* p)              { return __hip_atomic_load(p, __ATOMIC_RELAXED, __HIP_MEMORY_SCOPE_AGENT); }
__device__ __forceinline__ unsigned xb_add(unsigned* p, unsigned v) { return __hip_atomic_fetch_add(p, v, __ATOMIC_RELAXED, __HIP_MEMORY_SCOPE_AGENT); }
__device__ __forceinline__ unsigned xb_xcc_id() { return (unsigned)__builtin_amdgcn_s_getreg((3 << 11) | 20) & 0xFu; }
#define XB_SPIN(cond, bar) do { unsigned _sp = 0; while (cond) { __builtin_amdgcn_s_sleep(1); \
    if ((++_sp & 255u) == 0u) { if (xb_ld(&(bar)[XB_TMO])) break; if (_sp > XB_SPIN_CAP) { atomicAdd(&(bar)[XB_TMO], 1u); break; } } } } while (0)

struct XcdBarrier {
    unsigned* bar; unsigned x;
    volatile LAS unsigned* st;
};

__device__ __forceinline__ XcdBarrier xcd_barrier_post(unsigned* bar, volatile LAS unsigned* st) {
    XcdBarrier b; b.bar = bar; b.x = xb_xcc_id(); b.st = st;
    if (threadIdx.x == 0) (void)xb_add(&bar[XB_XCNT(b.x)], 1u);
    return b;
}
__device__ __forceinline__ void xcd_barrier_complete(unsigned* bar, unsigned x, unsigned& nloc, unsigned& nx) {
    const unsigned G = gridDim.x * gridDim.y * gridDim.z;
    unsigned sum, cnt, mine, sp = 0u;
    for (;;) {
        sum = 0u; cnt = 0u; mine = 0u;
#pragma unroll
        for (unsigned j = 0; j < 16; ++j) { const unsigned c = xb_ld(&bar[XB_XCNT(j)]); sum += c; cnt += (c > 0u) ? 1u : 0u; mine = (j == x) ? c : mine; }
        if (sum == G) break;
        __builtin_amdgcn_s_sleep(1);
        if ((++sp & 255u) == 0u) { if (xb_ld(&bar[XB_TMO])) break; if (sp > XB_SPIN_CAP) { atomicAdd(&bar[XB_TMO], 1u); break; } }
    }
    nloc = mine > 0u ? mine : 1u; nx = cnt > 0u ? cnt : 1u;
}

__device__ __forceinline__ void xcd_barrier(const XcdBarrier& b) {
    asm volatile("s_waitcnt vmcnt(0)" ::: "memory");
    __syncthreads();
    if (threadIdx.x == 0) {
        unsigned* bar = b.bar;
        __builtin_amdgcn_s_waitcnt(0);
        unsigned nloc = b.st[0], nx = b.st[1];
        if (nloc == 0u) { xcd_barrier_complete(bar, b.x, nloc, nx); b.st[0] = nloc; b.st[1] = nx; }
        const unsigned old = xb_add(&bar[XB_XSUB(b.x)], 1u);
        const unsigned gen = old / nloc;
        if (old + 1u == (gen + 1u) * nloc) {
            __builtin_amdgcn_fence(__ATOMIC_RELEASE, "agent");
            asm volatile("s_waitcnt vmcnt(0)" ::: "memory");
            const unsigned og = xb_add(&bar[XB_TOP], 1u);
            const unsigned tg = og / nx;
            if (og + 1u == (tg + 1u) * nx) xb_add(&bar[XB_TOPGEN], 1u);
            else XB_SPIN(xb_ld(&bar[XB_TOPGEN]) == tg, bar);
            __builtin_amdgcn_fence(__ATOMIC_ACQUIRE, "agent");
            xb_add(&bar[XB_XGEN(b.x)], 1u);
            asm volatile("s_waitcnt vmcnt(0)" ::: "memory");
        } else {
            XB_SPIN(xb_ld(&bar[XB_XGEN(b.x)]) == gen, bar);
            __builtin_amdgcn_fence(__ATOMIC_ACQUIRE, "agent");
            asm volatile("s_waitcnt vmcnt(0)" ::: "memory");
        }
    }
    __syncthreads();
}


constexpr int DM = 1024, NBATCH = 8, TT = 2064, NSAMP = 128, MP = NBATCH * TT  , MTOK = MP + NSAMP  ;
constexpr int DIN = 3584, DSSM = 512, DFF = 3072, NG = 32, NCHUNK = 129, NR = NBATCH * NCHUNK  ;
constexpr int C_US = 1024, C_GA = 1536, C_GB = 2560;
constexpr float ALPHA = 1.189207115002721f, LN_EPS = 1e-5f;
enum { I_XP = 0, I_XS, I_CCL, I_SL, I_SSR, I_SSI, I_CCF, I_META, I_EG, I_EB, I_WIN, I_BIN, I_CLW, I_CLB, I_WR, I_BR, I_WI, I_BI, I_LAM,
       I_SLRE, I_SLIM, I_SLDT, I_SBRE, I_SBIM, I_SCRE, I_SCIM, I_SD, I_WGLU, I_BGLU, I_WOUT, I_BOUT, I_L1G, I_L1B, I_WUP, I_BUP, I_FCW, I_FCB,
       I_WDOWN, I_BDOWN, I_L2G, I_L2B, N_IN };
constexpr size_t O_YP = 0, O_YS = 16777216, O_PCL = O_YS + 131072, O_PL = O_PCL + 24576, O_PSR = O_PL + 8192, O_PSI = O_PSR + 16384, O_PCF = O_PSI + 16384,
                 O_SCL = O_PCF + 49152, O_SL = O_SCL + 393216, O_SSR = O_SL + 131072, O_SSI = O_SSR + 262144, O_SCF = O_SSI + 262144, O_END = O_SCF + 786432;
constexpr size_t W_WTUP = 0, W_WTDOWN = W_WTUP + (size_t)6144 * 1024 * 2, W_XN = W_WTDOWN + (size_t)1024 * 3072 * 2, W_C = W_XN + (size_t)MTOK * 1024 * 2;
constexpr size_t W_PROJ = W_C, W_MIX = W_PROJ + (size_t)MTOK * DIN * 2, W_YSG = W_MIX + (size_t)MTOK * 1024 * 2, W_D = W_YSG + (size_t)MTOK * 512 * 2;
constexpr size_t W_WTGLU = W_D, W_WTOUT = W_WTGLU + (size_t)2048 * 512 * 2, W_WTR = W_WTOUT + (size_t)1024 * 1024 * 2, W_WTI = W_WTR + 262144, W_W1 = W_WTI + 262144,
                 W_W2 = W_W1 + (size_t)NG * 128 * 256 * 2, W_HPREV = W_W2 + (size_t)NG * 256 * 384 * 2, W_A1 = W_HPREV + (size_t)NR * NG * 128 * 2, W_A16 = W_A1 + 16384,
                 W_BBAR = W_A16 + 16384, W_LRUA = W_BBAR + 262144, W_LRUH = W_LRUA + 262144, W_LRUC = W_LRUH + 262144, W_S = W_LRUC + 262144, W_WTIN = W_S,
                 W_S_END = W_S + (size_t)NR * NG * 128 * 4;
constexpr size_t W_BAR = (W_S_END + 4095) / 4096 * 4096;
static_assert(W_BAR + (XCD_BAR_WORDS + 64 * 16) * 4 <= 268435456, "barrier words");
constexpr size_t W_PART = W_C + (size_t)MTOK * 1024 * 4;
constexpr size_t W_SBG = W_C, W_SBV = W_SBG + (size_t)260 * 4 * DFF * 4, W_SB_END = W_SBV + (size_t)260 * 2 * DFF * 4;
constexpr size_t W_PU = W_SB_END, W_PU_END = W_PU + (size_t)4 * 256 * 6144 * 4;
constexpr size_t W_PG = W_S;
constexpr size_t W_R1 = W_C, W_G = W_C, W_V = W_G + (size_t)MTOK * DFF * 2, W_V_END = W_V + (size_t)MTOK * DFF * 2, W_R2 = W_C;
static_assert(W_S_END <= 268435456 && W_V_END <= 268435456, "workspace map exceeds 256 MiB");
static_assert(W_SB_END <= W_V && W_PU_END <= W_V, "side buffers / up partials overlap H");
static_assert(W_PART + (size_t)12 * 256 * 1024 * 4 <= W_MIX && W_PART + (size_t)12 * 256 * 1024 * 4 <= W_V, "r1 / partials overlap mix or v");

constexpr int LDS_TOTAL = 147456;
struct P { const float* in[N_IN]; float* out; unsigned char* ws; };

__device__ __forceinline__ float bf2f(unsigned short b) { return __uint_as_float(((unsigned)b) << 16); }
__device__ __forceinline__ float bflo(unsigned u) { return __uint_as_float(u << 16); }
__device__ __forceinline__ float bfhi(unsigned u) { return __uint_as_float(u & 0xffff0000u); }
__device__ __forceinline__ unsigned short f2bf(float f) { return (unsigned short)(cvt_pk_bf16(f, 0.f) & 0xffffu); }
__device__ __forceinline__ float sigm(float x) { return __builtin_amdgcn_rcpf(1.f + __expf(-x)); }
__device__ __forceinline__ float gelu_tanh(float x) { return x * sigm(1.5957691216057308f * (x + 0.044715f * x * x * x)); }
__device__ __forceinline__ float wave_sum(float v) {
#pragma unroll
    for (int o = 1; o < 64; o <<= 1) v += __shfl_xor(v, o);
    return v;
}
#define LDS_WAIT() asm volatile("s_waitcnt lgkmcnt(0)" ::: "memory")
#define REPEAT(N) for (int rep_ = 0; rep_ < (N); ++rep_)
#define TIMED(N) const unsigned long long tq0_##N = (PROBE_PHASE == (N)) ? __builtin_amdgcn_s_memrealtime() : 0ull;
#define TIMED_END(N) if (PROBE_PHASE == (N)) { const unsigned long long tq1 = __builtin_amdgcn_s_memrealtime(); while (__builtin_amdgcn_s_memrealtime() - tq1 < tq1 - tq0_##N) __builtin_amdgcn_s_sleep(4); }

struct EpiProj {
    static constexpr bool PERM = true, AFTER_DRAIN = false;
    bf16_t* O; const float* bias; bf16_t* UT;
    __device__ __forceinline__ void operator()(const f32x4 (&acc)[2][2][4][2], const Unit& u, int wr, int wc, int fr, int fq) const {
        const int row0 = u.pm * 256 + wr * 64 + fr, col0 = u.pn * 256 + wc * 32 + 8 * fq;
        if (u.pn == 4 || u.pn == 5) {
#pragma unroll
            for (int bj = 0; bj < 2; ++bj) { const int col = col0 + bj * 128; const f32x4 b0 = *(const f32x4*)(bias + col), b1 = *(const f32x4*)(bias + col + 4); const int cu = col - C_US, g = cu >> 4, hh = cu & 15;
#pragma unroll
                for (int ai = 0; ai < 2; ++ai)
#pragma unroll
                    for (int m = 0; m < 4; ++m) { const int row = row0 + ai * 128 + m * 16; const f32x4 v0 = acc[ai][bj][m][0] + b0, v1 = acc[ai][bj][m][1] + b1; u32x4 w;
                        w.x = cvt_pk_bf16(v0[0], v0[1]); w.y = cvt_pk_bf16(v0[2], v0[3]); w.z = cvt_pk_bf16(v1[0], v1[1]); w.w = cvt_pk_bf16(v1[2], v1[3]);
                        size_t o; if (row < MP) { const int b = row / TT, t = row - b * TT; o = ((size_t)(b * NG + g) * TT + t) * 16 + hh; } else o = (size_t)MP * DSSM + ((size_t)(row - MP) * NG + g) * 16 + hh;
                        *(u32x4*)(UT + o) = w; } }
            return; }
#pragma unroll
        for (int bj = 0; bj < 2; ++bj) { const int col = col0 + bj * 128; const f32x4 b0 = *(const f32x4*)(bias + col), b1 = *(const f32x4*)(bias + col + 4);
#pragma unroll
            for (int ai = 0; ai < 2; ++ai)
#pragma unroll
                for (int m = 0; m < 4; ++m) { const f32x4 v0 = acc[ai][bj][m][0] + b0, v1 = acc[ai][bj][m][1] + b1; u32x4 w;
                    w.x = cvt_pk_bf16(v0[0], v0[1]); w.y = cvt_pk_bf16(v0[2], v0[3]); w.z = cvt_pk_bf16(v1[0], v1[1]); w.w = cvt_pk_bf16(v1[2], v1[3]);
                    *(u32x4*)(O + (size_t)(row0 + ai * 128 + m * 16) * DIN + col) = w; } }
    }
};
struct EpiGlu {
    static constexpr bool PERM = true, AFTER_DRAIN = false;
    bf16_t* mix; const bf16_t* m2; const float* carry; const bf16_t* proj; const float* bias;
    __device__ __forceinline__ void operator()(const f32x4 (&acc)[2][2][4][2], const Unit& u, int wr, int wc, int fr, int fq) const {
        const int row0 = u.pm * 256 + wr * 64 + fr, j = u.pn * 128 + wc * 32 + 8 * fq;
        const f32x4 bv0 = *(const f32x4*)(bias + j), bv1 = *(const f32x4*)(bias + j + 4), bg0 = *(const f32x4*)(bias + 1024 + j), bg1 = *(const f32x4*)(bias + 1024 + j + 4);
#pragma unroll
        for (int ai = 0; ai < 2; ++ai)
#pragma unroll
            for (int mp = 0; mp < 2; ++mp) { u32x4 gbw[2], mw[2], m2w[2]; f32x4 cv0[2], cv1[2];
#pragma unroll
                for (int mm = 0; mm < 2; ++mm) { const int rowi = row0 + ai * 128 + (2 * mp + mm) * 16; const size_t row = (size_t)rowi; int cidx = 0;
                    if (rowi < MP) { const int b = rowi / TT, t = rowi - b * TT; int kc = t >> 8; kc = kc > 7 ? 7 : kc; cidx = (b * 8 + kc) * 1024; }
                    cv0[mm] = *(const f32x4*)(carry + cidx + j); cv1[mm] = *(const f32x4*)(carry + cidx + j + 4);
                    gbw[mm] = *(const u32x4*)(proj + row * DIN + C_GB + j); mw[mm] = *(const u32x4*)(mix + row * 1024 + j); m2w[mm] = *(const u32x4*)(m2 + row * 1024 + j); }
#pragma unroll
                for (int mm = 0; mm < 2; ++mm) { const int m = 2 * mp + mm; const size_t row = (size_t)(row0 + ai * 128 + m * 16);
                    const f32x4 val0 = acc[ai][0][m][0] + bv0, val1 = acc[ai][0][m][1] + bv1, gate0 = acc[ai][1][m][0] + bg0, gate1 = acc[ai][1][m][1] + bg1;
                    const float o0 = bflo(mw[mm].x) + bflo(m2w[mm].x) * cv0[mm][0] + sigm(bflo(gbw[mm].x)) * val0[0] * sigm(gate0[0]), o1 = bfhi(mw[mm].x) + bfhi(m2w[mm].x) * cv0[mm][1] + sigm(bfhi(gbw[mm].x)) * val0[1] * sigm(gate0[1]);
                    const float o2 = bflo(mw[mm].y) + bflo(m2w[mm].y) * cv0[mm][2] + sigm(bflo(gbw[mm].y)) * val0[2] * sigm(gate0[2]), o3 = bfhi(mw[mm].y) + bfhi(m2w[mm].y) * cv0[mm][3] + sigm(bfhi(gbw[mm].y)) * val0[3] * sigm(gate0[3]);
                    const float o4 = bflo(mw[mm].z) + bflo(m2w[mm].z) * cv1[mm][0] + sigm(bflo(gbw[mm].z)) * val1[0] * sigm(gate1[0]), o5 = bfhi(mw[mm].z) + bfhi(m2w[mm].z) * cv1[mm][1] + sigm(bfhi(gbw[mm].z)) * val1[1] * sigm(gate1[1]);
                    const float o6 = bflo(mw[mm].w) + bflo(m2w[mm].w) * cv1[mm][2] + sigm(bflo(gbw[mm].w)) * val1[2] * sigm(gate1[2]), o7 = bfhi(mw[mm].w) + bfhi(m2w[mm].w) * cv1[mm][3] + sigm(bfhi(gbw[mm].w)) * val1[3] * sigm(gate1[3]);
                    u32x4 w; w.x = cvt_pk_bf16(o0, o1); w.y = cvt_pk_bf16(o2, o3); w.z = cvt_pk_bf16(o4, o5); w.w = cvt_pk_bf16(o6, o7); *(u32x4*)(mix + row * 1024 + j) = w; } }
    }
};
struct EpiRes {
    static constexpr bool PERM = true, AFTER_DRAIN = false;
    bf16_t* R; const bf16_t* X; const float* bias; float* part;
    __device__ __forceinline__ void operator()(const f32x4 (&acc)[2][2][4][2], const Unit& u, int wr, int wc, int fr, int fq) const {
        const int row0 = u.pm * 256 + wr * 64 + fr, col0 = u.pn * 256 + wc * 32 + 8 * fq;
        if (u.ks >= 0) { float* pp = part + ((size_t)u.ks * 256 - 16384) * 1024;
#pragma unroll
            for (int bj = 0; bj < 2; ++bj)
#pragma unroll
                for (int n = 0; n < 2; ++n)
#pragma unroll
                    for (int ai = 0; ai < 2; ++ai)
#pragma unroll
                        for (int m = 0; m < 4; ++m) *(f32x4*)(pp + (size_t)(row0 + ai * 128 + m * 16) * 1024 + col0 + bj * 128 + n * 4) = acc[ai][bj][m][n];
            return; }
#pragma unroll
        for (int bj = 0; bj < 2; ++bj) { const int col = col0 + bj * 128; const f32x4 b0 = *(const f32x4*)(bias + col), b1 = *(const f32x4*)(bias + col + 4);
            u32x4 xw[2][4];
#pragma unroll
            for (int ai = 0; ai < 2; ++ai)
#pragma unroll
                for (int m = 0; m < 4; ++m) xw[ai][m] = *(const u32x4*)(X + (size_t)(row0 + ai * 128 + m * 16) * 1024 + col);
#pragma unroll
            for (int ai = 0; ai < 2; ++ai)
#pragma unroll
                for (int m = 0; m < 4; ++m) { const size_t off = (size_t)(row0 + ai * 128 + m * 16) * 1024 + col; const u32x4 x = xw[ai][m];
                    f32x4 v0 = acc[ai][bj][m][0] + b0, v1 = acc[ai][bj][m][1] + b1;
                    v0[0] += ALPHA * bflo(x.x); v0[1] += ALPHA * bfhi(x.x); v0[2] += ALPHA * bflo(x.y); v0[3] += ALPHA * bfhi(x.y);
                    v1[0] += ALPHA * bflo(x.z); v1[1] += ALPHA * bfhi(x.z); v1[2] += ALPHA * bflo(x.w); v1[3] += ALPHA * bfhi(x.w);
                    u32x4 w; w.x = cvt_pk_bf16(v0[0], v0[1]); w.y = cvt_pk_bf16(v0[2], v0[3]); w.z = cvt_pk_bf16(v1[0], v1[1]); w.w = cvt_pk_bf16(v1[2], v1[3]); *(u32x4*)(R + off) = w; } }
    }
};
__device__ __forceinline__ float rot1(float x) { return __int_as_float(__builtin_amdgcn_update_dpp(0, __float_as_int(x), 0x121, 0xf, 0xf, false)); }
__device__ __forceinline__ float rot2(float x) { return __int_as_float(__builtin_amdgcn_update_dpp(0, __float_as_int(x), 0x122, 0xf, 0xf, false)); }
struct EpiUp {
    static constexpr bool PERM = true, AFTER_DRAIN = false;
    bf16_t* H; const float* bias; float* out; const float* cw; const float* cb; const float* cache; float* sbg; float* sbv;
    __device__ __forceinline__ void operator()(const f32x4 (&acc)[2][2][4][2], const Unit& u, int wr, int wc, int fr, int fq) const {
        const int c0 = u.pn * 128 + wc * 32 + 8 * fq;
        f32x4 bg[2], bv[2], w0[2], w1[2], w2[2], cbv[2];
#pragma unroll
        for (int n = 0; n < 2; ++n) { const int ch = c0 + 4 * n; bg[n] = *(const f32x4*)(bias + ch); bv[n] = *(const f32x4*)(bias + DFF + ch);
            w0[n] = *(const f32x4*)(cw + ch); w1[n] = *(const f32x4*)(cw + DFF + ch); w2[n] = *(const f32x4*)(cw + 2 * DFF + ch); cbv[n] = *(const f32x4*)(cb + ch); }
#pragma unroll
        for (int ai = 0; ai < 2; ++ai) { const int blk = u.pm * 4 + ai * 2 + wr, r0 = blk * 64;
            f32x4 gp1[2], gp2[2];
#pragma unroll
            for (int n = 0; n < 2; ++n) { gp1[n] = (f32x4){0.f, 0.f, 0.f, 0.f}; gp2[n] = (f32x4){0.f, 0.f, 0.f, 0.f}; }
#pragma unroll
            for (int m = 0; m < 4; ++m) { const int row = r0 + 16 * m + fr; const int b = row / TT, t = row - b * TT; float h[8];
#pragma unroll
                for (int n = 0; n < 2; ++n) { const int ch = c0 + 4 * n; const f32x4 g = acc[ai][0][m][n] + bg[n], v = acc[ai][1][m][n] + bv[n];
                    f32x4 a1, a2; a1[0] = rot1(g[0]); a1[1] = rot1(g[1]); a1[2] = rot1(g[2]); a1[3] = rot1(g[3]); a2[0] = rot2(g[0]); a2[1] = rot2(g[1]); a2[2] = rot2(g[2]); a2[3] = rot2(g[3]);
                    f32x4 g1 = (fr >= 1) ? a1 : gp1[n], g2 = (fr >= 2) ? a2 : gp2[n];
                    if (t == 0) g1 = (f32x4){0.f, 0.f, 0.f, 0.f}; if (t <= 1) g2 = (f32x4){0.f, 0.f, 0.f, 0.f};
                    if (t >= TT - 2) *(f32x4*)(out + O_PCF + ((size_t)b * 2 + (t - (TT - 2))) * DFF + ch) = g;
                    if (m == 0 && fr < 2) { *(f32x4*)(sbg + ((size_t)blk * 4 + fr) * DFF + ch) = g; *(f32x4*)(sbv + ((size_t)blk * 2 + fr) * DFF + ch) = v; }
                    if (m == 3 && fr >= 14) *(f32x4*)(sbg + ((size_t)blk * 4 + fr - 12) * DFF + ch) = g;
                    const f32x4 y = cbv[n] + w0[n] * g2 + w1[n] * g1 + w2[n] * g;
                    h[4 * n] = gelu_tanh(y[0]) * v[0]; h[4 * n + 1] = gelu_tanh(y[1]) * v[1]; h[4 * n + 2] = gelu_tanh(y[2]) * v[2]; h[4 * n + 3] = gelu_tanh(y[3]) * v[3];
                    gp1[n] = a1; gp2[n] = a2; }
                u32x4 w; w.x = cvt_pk_bf16(h[0], h[1]); w.y = cvt_pk_bf16(h[2], h[3]); w.z = cvt_pk_bf16(h[4], h[5]); w.w = cvt_pk_bf16(h[6], h[7]); *(u32x4*)(H + (size_t)row * DFF + c0) = w; } }
    }
};
struct EpiRaw {
    static constexpr bool PERM = false, AFTER_DRAIN = false;
    float* pu; int ld;
    __device__ __forceinline__ void operator()(const f32x4 (&acc)[2][2][4][2], const Unit& u, int wr, int wc, int fr, int fq) const {
        float* pp = pu + (size_t)u.ks * 256 * ld + (size_t)(wr * 64 + fr) * ld + u.pn * 256 + wc * 32 + 4 * fq;
#pragma unroll
        for (int ai = 0; ai < 2; ++ai)
#pragma unroll
            for (int m = 0; m < 4; ++m)
#pragma unroll
                for (int bj = 0; bj < 2; ++bj)
#pragma unroll
                    for (int n = 0; n < 2; ++n) *(f32x4*)(pp + (size_t)(ai * 128 + m * 16) * ld + bj * 128 + n * 16) = acc[ai][bj][m][n];
    }
};
template <class Epi> __device__ __forceinline__ void run_gemm(LAS unsigned char* lds, int vc, const bf16_t* A, const bf16_t* Bt, int N, int K, const Epi& E) {
    pg8::Gemm g; g.A = A; g.Bt = Bt; g.M = MTOK; g.N = N; g.K = K;
    pg8::StaticOrder S; S.init(MTOK, N, K, (int)gridDim.x, vc);
    pg8::gemm_phase<Epi, pg8::StaticOrder, false>(lds, g, S, E, nullptr);
}

template <class Epi> __device__ __forceinline__ void run_gemm_split(LAS unsigned char* lds, int vc, const bf16_t* A, const bf16_t* Bt, int N, int K, int nsplit, const Epi& E) {
    pg8::Gemm g; g.A = A; g.Bt = Bt; g.M = MTOK; g.N = N; g.K = K;
    pg8::SplitOrder S; S.init(N, K, nsplit, (int)gridDim.x, vc);
    pg8::gemm_phase<Epi, pg8::SplitOrder, false>(lds, g, S, E, nullptr);
}

template <class Epi> __device__ __forceinline__ void run_gemm_main64(LAS unsigned char* lds, int vc, const bf16_t* A, const bf16_t* Bt, int N, int K, const Epi& E) {
    pg8::Gemm g; g.A = A; g.Bt = Bt; g.M = 16384; g.N = N; g.K = K;
    pg8::StaticOrder S; S.init(16384, N, K, (int)gridDim.x, vc);
    pg8::gemm_phase<Epi, pg8::StaticOrder, false>(lds, g, S, E, nullptr);
}
__device__ __forceinline__ void run_gemm_tail(LAS unsigned char* lds, int vc, const bf16_t* A, const bf16_t* Bt, int N, int K, int nsplit, float* pu) {
    pg8::Gemm g; g.A = A; g.Bt = Bt; g.M = MTOK; g.N = N; g.K = K;
    pg8::TailOrder S; S.init(N, K, nsplit, (int)gridDim.x, vc);
    EpiRaw E; E.pu = pu; E.ld = N;
    pg8::gemm_phase<EpiRaw, pg8::TailOrder, false>(lds, g, S, E, nullptr);
}

__device__ __forceinline__ void transpose_item(const float* W, int N, bf16_t* WT, int K, int k0, int srcn0, int dstn0, LAS float* scr, int lane) {
    float tv[32];
#pragma unroll
    for (int i = 0; i < 32; ++i) tv[i] = W[(size_t)(k0 + 2 * i + (lane >> 5)) * N + srcn0 + (lane & 31)];
#pragma unroll
    for (int i = 0; i < 32; ++i) scr[(2 * i + (lane >> 5)) * 33 + (lane & 31)] = tv[i];
    LDS_WAIT();
    const int c = lane & 7;
#pragma unroll
    for (int j = 0; j < 4; ++j) { const int n = (lane >> 3) + 8 * j; const LAS float* s = scr + (8 * c) * 33 + n;
        u32x4 o; o.x = cvt_pk_bf16(s[0 * 33], s[1 * 33]); o.y = cvt_pk_bf16(s[2 * 33], s[3 * 33]); o.z = cvt_pk_bf16(s[4 * 33], s[5 * 33]); o.w = cvt_pk_bf16(s[6 * 33], s[7 * 33]);
        *(u32x4*)(WT + (size_t)(dstn0 + n) * K + k0 + 8 * c) = o; }
    LDS_WAIT();
}
__device__ __forceinline__ const float* src_row(const P& p, int r) {
    if (r < MP) { const int b = r / TT, t = r - b * TT; return t < 16 ? p.in[I_META] + (size_t)t * DM : p.in[I_XP] + ((size_t)b * 2048 + (t - 16)) * DM; }
    return p.in[I_XS] + (size_t)(r - MP) * DM;
}
template <bool OUT_BF16> __device__ __forceinline__ void ln_row(const float* xrow, const float* g, const float* bta, void* orow, int lane, int nsplit = 0, const bf16_t* xres = nullptr, const float* rbias = nullptr) {
    f32x4 v[4]; float s = 0.f;
#pragma unroll
    for (int j = 0; j < 4; ++j) { v[j] = *(const f32x4*)(xrow + 4 * lane + 256 * j);
        if (nsplit > 0) { for (int k = 1; k < nsplit; ++k) v[j] += *(const f32x4*)(xrow + (size_t)k * 256 * 1024 + 4 * lane + 256 * j);
            const u32x2 xw = *(const u32x2*)(xres + 4 * lane + 256 * j); const f32x4 bv = *(const f32x4*)(rbias + 4 * lane + 256 * j);
            v[j][0] += ALPHA * bflo(xw.x) + bv[0]; v[j][1] += ALPHA * bfhi(xw.x) + bv[1]; v[j][2] += ALPHA * bflo(xw.y) + bv[2]; v[j][3] += ALPHA * bfhi(xw.y) + bv[3]; }
        s += (v[j][0] + v[j][1]) + (v[j][2] + v[j][3]); }
    const float mean = wave_sum(s) * (1.f / DM); float s2 = 0.f;
#pragma unroll
    for (int j = 0; j < 4; ++j) { v[j] = v[j] - mean; s2 += (v[j][0] * v[j][0] + v[j][1] * v[j][1]) + (v[j][2] * v[j][2] + v[j][3] * v[j][3]); }
    const float rstd = 1.f / sqrtf(wave_sum(s2) * (1.f / DM) + LN_EPS);
#pragma unroll
    for (int j = 0; j < 4; ++j) { const f32x4 gg = *(const f32x4*)(g + 4 * lane + 256 * j), bb = *(const f32x4*)(bta + 4 * lane + 256 * j);
        const f32x4 o = (v[j] * rstd) * gg + bb;
        if (OUT_BF16) { u32x2 w; w.x = cvt_pk_bf16(o[0], o[1]); w.y = cvt_pk_bf16(o[2], o[3]); *(u32x2*)((bf16_t*)orow + 4 * lane + 256 * j) = w; }
        else *(f32x4*)((float*)orow + 4 * lane + 256 * j) = o; }
}
template <bool OUT_BF16> __device__ __forceinline__ void ln_rows2(const float* xa, const float* xb, const float* g, const float* bta, void* oa, void* ob, int lane, bool vb) {
    f32x4 va[4], vbv[4]; float sa = 0.f, sb = 0.f;
#pragma unroll
    for (int j = 0; j < 4; ++j) { va[j] = *(const f32x4*)(xa + 4 * lane + 256 * j); vbv[j] = *(const f32x4*)(xb + 4 * lane + 256 * j); }
#pragma unroll
    for (int j = 0; j < 4; ++j) { sa += (va[j][0] + va[j][1]) + (va[j][2] + va[j][3]); sb += (vbv[j][0] + vbv[j][1]) + (vbv[j][2] + vbv[j][3]); }
#pragma unroll
    for (int o = 1; o < 64; o <<= 1) { sa += __shfl_xor(sa, o); sb += __shfl_xor(sb, o); }
    const float ma = sa * (1.f / DM), mb = sb * (1.f / DM); float qa = 0.f, qb = 0.f;
#pragma unroll
    for (int j = 0; j < 4; ++j) { va[j] = va[j] - ma; vbv[j] = vbv[j] - mb; qa += (va[j][0] * va[j][0] + va[j][1] * va[j][1]) + (va[j][2] * va[j][2] + va[j][3] * va[j][3]);
        qb += (vbv[j][0] * vbv[j][0] + vbv[j][1] * vbv[j][1]) + (vbv[j][2] * vbv[j][2] + vbv[j][3] * vbv[j][3]); }
#pragma unroll
    for (int o = 1; o < 64; o <<= 1) { qa += __shfl_xor(qa, o); qb += __shfl_xor(qb, o); }
    const float ra = 1.f / sqrtf(qa * (1.f / DM) + LN_EPS), rb = 1.f / sqrtf(qb * (1.f / DM) + LN_EPS);
#pragma unroll
    for (int j = 0; j < 4; ++j) { const f32x4 gg = *(const f32x4*)(g + 4 * lane + 256 * j), bb = *(const f32x4*)(bta + 4 * lane + 256 * j);
        const f32x4 o1 = (va[j] * ra) * gg + bb, o2 = (vbv[j] * rb) * gg + bb;
        if (OUT_BF16) { u32x2 w; w.x = cvt_pk_bf16(o1[0], o1[1]); w.y = cvt_pk_bf16(o1[2], o1[3]); *(u32x2*)((bf16_t*)oa + 4 * lane + 256 * j) = w;
            if (vb) { w.x = cvt_pk_bf16(o2[0], o2[1]); w.y = cvt_pk_bf16(o2[2], o2[3]); *(u32x2*)((bf16_t*)ob + 4 * lane + 256 * j) = w; } }
        else { *(f32x4*)((float*)oa + 4 * lane + 256 * j) = o1; if (vb) *(f32x4*)((float*)ob + 4 * lane + 256 * j) = o2; } }
}
template <bool OUT_BF16> __device__ __forceinline__ void ln_rows2_bf(const bf16_t* xa, const bf16_t* xb, const float* g, const float* bta, void* oa, void* ob, int lane, bool vb) {
    float va[16], vq[16]; float sa = 0.f, sb = 0.f;
    { u32x4 ra[2], rb[2];
#pragma unroll
      for (int j = 0; j < 2; ++j) { ra[j] = *(const u32x4*)(xa + 8 * lane + 512 * j); rb[j] = *(const u32x4*)(xb + 8 * lane + 512 * j); }
#pragma unroll
      for (int j = 0; j < 2; ++j) { va[8 * j] = bflo(ra[j].x); va[8 * j + 1] = bfhi(ra[j].x); va[8 * j + 2] = bflo(ra[j].y); va[8 * j + 3] = bfhi(ra[j].y); va[8 * j + 4] = bflo(ra[j].z); va[8 * j + 5] = bfhi(ra[j].z); va[8 * j + 6] = bflo(ra[j].w); va[8 * j + 7] = bfhi(ra[j].w);
          vq[8 * j] = bflo(rb[j].x); vq[8 * j + 1] = bfhi(rb[j].x); vq[8 * j + 2] = bflo(rb[j].y); vq[8 * j + 3] = bfhi(rb[j].y); vq[8 * j + 4] = bflo(rb[j].z); vq[8 * j + 5] = bfhi(rb[j].z); vq[8 * j + 6] = bflo(rb[j].w); vq[8 * j + 7] = bfhi(rb[j].w); } }
#pragma unroll
    for (int e = 0; e < 16; ++e) { sa += va[e]; sb += vq[e]; }
#pragma unroll
    for (int o = 1; o < 64; o <<= 1) { sa += __shfl_xor(sa, o); sb += __shfl_xor(sb, o); }
    const float ma = sa * (1.f / DM), mb = sb * (1.f / DM); float qa = 0.f, qb = 0.f;
#pragma unroll
    for (int e = 0; e < 16; ++e) { va[e] -= ma; vq[e] -= mb; qa += va[e] * va[e]; qb += vq[e] * vq[e]; }
#pragma unroll
    for (int o = 1; o < 64; o <<= 1) { qa += __shfl_xor(qa, o); qb += __shfl_xor(qb, o); }
    const float ra_ = 1.f / sqrtf(qa * (1.f / DM) + LN_EPS), rb_ = 1.f / sqrtf(qb * (1.f / DM) + LN_EPS);
#pragma unroll
    for (int j = 0; j < 2; ++j) { const int c = 8 * lane + 512 * j; const f32x4 g0 = *(const f32x4*)(g + c), g1 = *(const f32x4*)(g + c + 4), b0 = *(const f32x4*)(bta + c), b1 = *(const f32x4*)(bta + c + 4);
        float o1[8], o2[8];
#pragma unroll
        for (int e = 0; e < 4; ++e) { o1[e] = va[8 * j + e] * ra_ * g0[e] + b0[e]; o1[4 + e] = va[8 * j + 4 + e] * ra_ * g1[e] + b1[e]; o2[e] = vq[8 * j + e] * rb_ * g0[e] + b0[e]; o2[4 + e] = vq[8 * j + 4 + e] * rb_ * g1[e] + b1[e]; }
        if (OUT_BF16) { u32x4 w; w.x = cvt_pk_bf16(o1[0], o1[1]); w.y = cvt_pk_bf16(o1[2], o1[3]); w.z = cvt_pk_bf16(o1[4], o1[5]); w.w = cvt_pk_bf16(o1[6], o1[7]); *(u32x4*)((bf16_t*)oa + c) = w;
            if (vb) { w.x = cvt_pk_bf16(o2[0], o2[1]); w.y = cvt_pk_bf16(o2[2], o2[3]); w.z = cvt_pk_bf16(o2[4], o2[5]); w.w = cvt_pk_bf16(o2[6], o2[7]); *(u32x4*)((bf16_t*)ob + c) = w; } }
        else { *(f32x4*)((float*)oa + c) = (f32x4){o1[0], o1[1], o1[2], o1[3]}; *(f32x4*)((float*)oa + c + 4) = (f32x4){o1[4], o1[5], o1[6], o1[7]};
            if (vb) { *(f32x4*)((float*)ob + c) = (f32x4){o2[0], o2[1], o2[2], o2[3]}; *(f32x4*)((float*)ob + c + 4) = (f32x4){o2[4], o2[5], o2[6], o2[7]}; } } }
}
__device__ __forceinline__ void s5_precompute(const P& p, LAS unsigned char* lds, int g) {
    LAS float* apr = (LAS float*)lds;
    LAS float* api = apr + 17 * 64;
    LAS float* bbr = api + 17 * 64;
    LAS float* bbi = bbr + 1024;
    LAS float* cr = bbi + 1024;
    LAS float* ci = cr + 1024;
    LAS float* Kl = ci + 1024;
    int tid_ = threadIdx.x; asm volatile("" : "+v"(tid_)); const int tid = tid_;
    if (tid < 64) { const int pp = tid;
        const float dt = expf(p.in[I_SLDT][g]); const float lre = p.in[I_SLRE][g * 64 + pp], lim = p.in[I_SLIM][g * 64 + pp];
        const float mag = expf(lre * dt); const float ang = lim * dt; const float abr = mag * cosf(ang), abi = mag * sinf(ang);
        const float den = lre * lre + lim * lim, nr = abr - 1.0f, ni = abi; const float fre = (nr * lre + ni * lim) / den, fim = (ni * lre - nr * lim) / den;
        float pr = 1.f, pi = 0.f;
        for (int j = 0; j <= 16; ++j) { apr[j * 64 + pp] = pr; api[j * 64 + pp] = pi; const float nr2 = pr * abr - pi * abi, ni2 = pr * abi + pi * abr; pr = nr2; pi = ni2; }
        float* a1 = (float*)(p.ws + W_A1); float* a16 = (float*)(p.ws + W_A16); float* bbar = (float*)(p.ws + W_BBAR);
        a1[(g * 64 + pp) * 2] = abr; a1[(g * 64 + pp) * 2 + 1] = abi; a16[(g * 64 + pp) * 2] = apr[16 * 64 + pp]; a16[(g * 64 + pp) * 2 + 1] = api[16 * 64 + pp];
        for (int c = 0; c < 16; ++c) { const float br = p.in[I_SBRE][(g * 64 + pp) * 16 + c], bi = p.in[I_SBIM][(g * 64 + pp) * 16 + c];
            const float xr = fre * br - fim * bi, xi = fre * bi + fim * br; bbr[pp * 16 + c] = xr; bbi[pp * 16 + c] = xi;
            bbar[((g * 64 + pp) * 16 + c) * 2] = xr; bbar[((g * 64 + pp) * 16 + c) * 2 + 1] = xi; }
    }
    for (int i = tid; i < 1024; i += 512) { cr[i] = p.in[I_SCRE][g * 1024 + i]; ci[i] = p.in[I_SCIM][g * 1024 + i]; }
    __syncthreads();
    { const int j = tid >> 5, c1 = (tid >> 1) & 15, c0 = 8 * (tid & 1); float acc8[8];
#pragma unroll
      for (int e = 0; e < 8; ++e) acc8[e] = 0.f;
      for (int pp = 0; pp < 64; ++pp) { const float xr = cr[c1 * 64 + pp], xi = ci[c1 * 64 + pp], ar = apr[j * 64 + pp], ai = api[j * 64 + pp]; const float car = xr * ar - xi * ai, cai = xr * ai + xi * ar;
          const f32x4 r0 = *(const LAS f32x4*)(bbr + pp * 16 + c0), r1 = *(const LAS f32x4*)(bbr + pp * 16 + c0 + 4), i0 = *(const LAS f32x4*)(bbi + pp * 16 + c0), i1 = *(const LAS f32x4*)(bbi + pp * 16 + c0 + 4);
          acc8[0] += car * r0[0] - cai * i0[0]; acc8[1] += car * r0[1] - cai * i0[1]; acc8[2] += car * r0[2] - cai * i0[2]; acc8[3] += car * r0[3] - cai * i0[3];
          acc8[4] += car * r1[0] - cai * i1[0]; acc8[5] += car * r1[1] - cai * i1[1]; acc8[6] += car * r1[2] - cai * i1[2]; acc8[7] += car * r1[3] - cai * i1[3]; }
#pragma unroll
      for (int e = 0; e < 8; ++e) { float v = acc8[e]; if (j == 0 && c1 == c0 + e) v += p.in[I_SD][g * 16 + c1]; Kl[(j * 16 + c1) * 16 + c0 + e] = v; } }
    __syncthreads();
    bf16_t* W1 = (bf16_t*)(p.ws + W_W1) + (size_t)g * 128 * 256; bf16_t* W2 = (bf16_t*)(p.ws + W_W2) + (size_t)g * 256 * 384;
    for (int i = tid; i < 128 * 32; i += 512) { const int n = i >> 5, ch = i & 31, s = ch >> 1, c0 = 8 * (ch & 1), pp = n & 63; const bool im = n >= 64; float v[8];
        const float ar = apr[(15 - s) * 64 + pp], ai = api[(15 - s) * 64 + pp];
#pragma unroll
        for (int e = 0; e < 8; ++e) { const float xr = bbr[pp * 16 + c0 + e], xi = bbi[pp * 16 + c0 + e]; v[e] = im ? (ar * xi + ai * xr) : (ar * xr - ai * xi); }
        u32x4 o; o.x = cvt_pk_bf16(v[0], v[1]); o.y = cvt_pk_bf16(v[2], v[3]); o.z = cvt_pk_bf16(v[4], v[5]); o.w = cvt_pk_bf16(v[6], v[7]);
        *(u32x4*)(W1 + (size_t)n * 256 + 8 * ch) = o; }
    for (int i = tid; i < 256 * 48; i += 512) { const int n = i / 48, ch = i - n * 48, t = n >> 4, c1 = n & 15; float v[8];
        if (ch < 32) { const int s = ch >> 1, c0 = 8 * (ch & 1);
#pragma unroll
            for (int e = 0; e < 8; ++e) v[e] = (s <= t) ? Kl[((t - s) * 16 + c1) * 16 + c0 + e] : 0.f; }
        else { const bool im = ch >= 40; const int p0 = 8 * (ch - (im ? 40 : 32));
#pragma unroll
            for (int e = 0; e < 8; ++e) { const int pp = p0 + e; const float ar = apr[(t + 1) * 64 + pp], ai = api[(t + 1) * 64 + pp], xr = cr[c1 * 64 + pp], xi = ci[c1 * 64 + pp];
                v[e] = im ? -(xr * ai + xi * ar) : (xr * ar - xi * ai); } }
        u32x4 o; o.x = cvt_pk_bf16(v[0], v[1]); o.y = cvt_pk_bf16(v[2], v[3]); o.z = cvt_pk_bf16(v[4], v[5]); o.w = cvt_pk_bf16(v[6], v[7]);
        *(u32x4*)(W2 + (size_t)n * 384 + 8 * ch) = o; }
    __syncthreads();
}
template <int CLS> __device__ __forceinline__ void transposes(const P& p, LAS float* scr, int lane, int gw, int NGW) {
    constexpr int I_UP = 16 * 192, I_DN = 48 * 32, I_IN = 16 * 112, I_GL = 8 * 64, I_OU = 16 * 32, I_LR = 16 * 8;
    constexpr int NITEMS = CLS == 0 ? I_IN + I_LR : I_UP + I_DN + I_GL + I_OU;
    for (int it = gw; it < NITEMS; it += NGW) { int r = it;
        if (CLS == 0) {
            if (r < I_IN) { const int kb = r / 112, nb = r % 112; transpose_item(p.in[I_WIN], DIN, (bf16_t*)(p.ws + W_WTIN), 1024, 64 * kb, 32 * nb, 32 * nb, scr, lane); continue; } r -= I_IN;
            { const int which = r >> 6, blk = (r >> 3) & 7, kb = (r >> 2) & 1, nb = r & 3;
              transpose_item(p.in[which ? I_WI : I_WR] + blk * 16384, 128, (bf16_t*)(p.ws + (which ? W_WTI : W_WTR)) + blk * 16384, 128, 64 * kb, 32 * nb, 32 * nb, scr, lane); }
        } else {
            if (r < I_UP) { const int kb = r / 192, nb = r % 192, d0 = 32 * nb, s0 = ((d0 >> 7) & 1) * DFF + (d0 >> 8) * 128 + (d0 & 127);
                transpose_item(p.in[I_WUP], 6144, (bf16_t*)(p.ws + W_WTUP), 1024, 64 * kb, s0, d0, scr, lane); continue; } r -= I_UP;
            if (r < I_DN) { const int kb = r / 32, nb = r % 32; transpose_item(p.in[I_WDOWN], 1024, (bf16_t*)(p.ws + W_WTDOWN), 3072, 64 * kb, 32 * nb, 32 * nb, scr, lane); continue; } r -= I_DN;
            if (r < I_GL) { const int kb = r / 64, nb = r % 64, d0 = 32 * nb, s0 = ((d0 >> 7) & 1) * 1024 + (d0 >> 8) * 128 + (d0 & 127);
                transpose_item(p.in[I_WGLU], 2048, (bf16_t*)(p.ws + W_WTGLU), 512, 64 * kb, s0, d0, scr, lane); continue; } r -= I_GL;
            { const int kb = r / 32, nb = r % 32; transpose_item(p.in[I_WOUT], 1024, (bf16_t*)(p.ws + W_WTOUT), 1024, 64 * kb, 32 * nb, 32 * nb, scr, lane); }
        }
    }
}
__device__ __forceinline__ void phase0(const P& p, LAS unsigned char* lds) {
    int tid_ = threadIdx.x; asm volatile("" : "+v"(tid_)); const int tid = tid_, lane = tid & 63, wid = tid >> 6;
    REPEAT(REP_P0A) for (int g = blockIdx.x; g < NG; g += gridDim.x) s5_precompute(p, lds, g);
    LAS float* scr = (LAS float*)(lds + wid * 8704);
    const int gw = blockIdx.x * 8 + wid, NGW = gridDim.x * 8;
    { const int skip = ((int)gridDim.x >= 64) ? NG : 0;
      if ((int)blockIdx.x >= skip) REPEAT(REP_P0B) transposes<0>(p, scr, lane, ((int)blockIdx.x - skip) * 8 + wid, ((int)gridDim.x - skip) * 8); }
    { const int skip = ((int)gridDim.x >= 64) ? NG : 0;
      if ((int)blockIdx.x >= skip) { const int gw2 = ((int)blockIdx.x - skip) * 8 + wid, NGW2 = ((int)gridDim.x - skip) * 8;
        REPEAT(REP_P0C) for (int r = gw2; r < MTOK; r += 2 * NGW2) { const int r2 = r + NGW2; const bool vb = r2 < MTOK; const int rb = vb ? r2 : r;
          ln_rows2<true>(src_row(p, r), src_row(p, rb), p.in[I_EG], p.in[I_EB], (bf16_t*)(p.ws + W_XN) + (size_t)r * DM, (bf16_t*)(p.ws + W_XN) + (size_t)rb * DM, lane, vb); } } }
}

template <int MODE> __device__ __forceinline__ void lru_unit(const P& p, LAS unsigned char* lds, int b, int kc, int nb) {
    int tid_ = threadIdx.x; asm volatile("" : "+v"(tid_)); const int tid = tid_, lane = tid & 63, wid = tid >> 6, q = lane >> 4, n = lane & 15;
    int mt0, nmt, rowbase;
    if (MODE == 2) { mt0 = kc; nmt = 1; rowbase = MP; } else { mt0 = (NCHUNK * kc) >> 3; nmt = ((NCHUNK * (kc + 1)) >> 3) - mt0; rowbase = b * TT; }
    const int t0 = 16 * mt0, ntok = 16 * nmt;
    const bf16_t* proj = (const bf16_t*)(p.ws + W_PROJ);
    LAS bf16_t* xcs = (LAS bf16_t*)lds;
    LAS bf16_t* gas = (LAS bf16_t*)(lds + 73984);
    if (MODE == 2) {
        for (int it = tid; it < ntok * 16; it += 512) { const int i = it >> 4, cg8 = it & 15, c0 = nb * 128 + cg8 * 8; float a[8];
            { const f32x4 b0 = *(const f32x4*)(p.in[I_CLB] + c0), b1 = *(const f32x4*)(p.in[I_CLB] + c0 + 4); a[0] = b0[0]; a[1] = b0[1]; a[2] = b0[2]; a[3] = b0[3]; a[4] = b1[0]; a[5] = b1[1]; a[6] = b1[2]; a[7] = b1[3]; }
#pragma unroll
            for (int j = 0; j < 4; ++j) { const f32x4 w0 = *(const f32x4*)(p.in[I_CLW] + j * 1024 + c0), w1 = *(const f32x4*)(p.in[I_CLW] + j * 1024 + c0 + 4); float x[8];
                if (j < 3) { const float* cp = p.in[I_CCL] + ((size_t)(t0 + i) * 3 + j) * 1024 + c0; const f32x4 x0 = *(const f32x4*)cp, x1 = *(const f32x4*)(cp + 4);
                    x[0] = x0[0]; x[1] = x0[1]; x[2] = x0[2]; x[3] = x0[3]; x[4] = x1[0]; x[5] = x1[1]; x[6] = x1[2]; x[7] = x1[3]; }
                else { const u32x4 xv = *(const u32x4*)(proj + (size_t)(rowbase + t0 + i) * DIN + c0);
                    x[0] = bflo(xv.x); x[1] = bfhi(xv.x); x[2] = bflo(xv.y); x[3] = bfhi(xv.y); x[4] = bflo(xv.z); x[5] = bfhi(xv.z); x[6] = bflo(xv.w); x[7] = bfhi(xv.w); }
                a[0] += w0[0] * x[0]; a[1] += w0[1] * x[1]; a[2] += w0[2] * x[2]; a[3] += w0[3] * x[3]; a[4] += w1[0] * x[4]; a[5] += w1[1] * x[5]; a[6] += w1[2] * x[6]; a[7] += w1[3] * x[7]; }
            u32x4 o; o.x = cvt_pk_bf16(a[0], a[1]); o.y = cvt_pk_bf16(a[2], a[3]); o.z = cvt_pk_bf16(a[4], a[5]); o.w = cvt_pk_bf16(a[6], a[7]);
            *(LAS u32x4*)(xcs + i * 136 + cg8 * 8) = o;
            *(LAS u32x4*)(gas + i * 128 + cg8 * 8) = *(const u32x4*)(proj + (size_t)(rowbase + t0 + i) * DIN + C_GA + c0); }
    } else {
        const int cg8 = tid & 15, tr = tid >> 4, c0 = nb * 128 + cg8 * 8; float w[4][8], bs[8];
        { const f32x4 b0 = *(const f32x4*)(p.in[I_CLB] + c0), b1 = *(const f32x4*)(p.in[I_CLB] + c0 + 4); bs[0] = b0[0]; bs[1] = b0[1]; bs[2] = b0[2]; bs[3] = b0[3]; bs[4] = b1[0]; bs[5] = b1[1]; bs[6] = b1[2]; bs[7] = b1[3]; }
#pragma unroll
        for (int j = 0; j < 4; ++j) { const f32x4 w0 = *(const f32x4*)(p.in[I_CLW] + j * 1024 + c0), w1 = *(const f32x4*)(p.in[I_CLW] + j * 1024 + c0 + 4);
            w[j][0] = w0[0]; w[j][1] = w0[1]; w[j][2] = w0[2]; w[j][3] = w0[3]; w[j][4] = w1[0]; w[j][5] = w1[1]; w[j][6] = w1[2]; w[j][7] = w1[3]; }
        const int i0 = tr * 9; int i1 = i0 + 9; if (i1 > ntok) i1 = ntok;
        u32x4 xr[12], gr[9];
#pragma unroll
        for (int k = 0; k < 12; ++k) { const int i = i0 - 3 + k, t = t0 + i; xr[k] = (u32x4){0u, 0u, 0u, 0u}; if (t >= 0 && i < i1) xr[k] = *(const u32x4*)(proj + (size_t)(rowbase + t) * DIN + c0); }
#pragma unroll
        for (int k = 0; k < 9; ++k) { gr[k] = (u32x4){0u, 0u, 0u, 0u}; if (i0 + k < i1) gr[k] = *(const u32x4*)(proj + (size_t)(rowbase + t0 + i0 + k) * DIN + C_GA + c0); }
#pragma unroll
        for (int k = 0; k < 9; ++k) { if (i0 + k < i1) { float a[8];
#pragma unroll
            for (int e = 0; e < 8; ++e) a[e] = bs[e];
#pragma unroll
            for (int j = 0; j < 4; ++j) { const u32x4 xv = xr[k + j];
                a[0] += w[j][0] * bflo(xv.x); a[1] += w[j][1] * bfhi(xv.x); a[2] += w[j][2] * bflo(xv.y); a[3] += w[j][3] * bfhi(xv.y);
                a[4] += w[j][4] * bflo(xv.z); a[5] += w[j][5] * bfhi(xv.z); a[6] += w[j][6] * bflo(xv.w); a[7] += w[j][7] * bfhi(xv.w); }
            u32x4 o; o.x = cvt_pk_bf16(a[0], a[1]); o.y = cvt_pk_bf16(a[2], a[3]); o.z = cvt_pk_bf16(a[4], a[5]); o.w = cvt_pk_bf16(a[6], a[7]);
            *(LAS u32x4*)(xcs + (i0 + k) * 136 + cg8 * 8) = o; *(LAS u32x4*)(gas + (i0 + k) * 128 + cg8 * 8) = gr[k]; } }
    }
    __syncthreads();
    const int c = nb * 128 + wid * 16 + n;
    bf16x8 Br[4], Bi[4];
    { const bf16_t* wr_ = (const bf16_t*)(p.ws + W_WTR) + (size_t)c * 128 + q * 8; const bf16_t* wi_ = (const bf16_t*)(p.ws + W_WTI) + (size_t)c * 128 + q * 8;
#pragma unroll
      for (int kk = 0; kk < 4; ++kk) { Br[kk] = *(const bf16x8*)(wr_ + 32 * kk); Bi[kk] = *(const bf16x8*)(wi_ + 32 * kk); } }
    const float br = p.in[I_BR][c], bi = p.in[I_BI][c]; const float c8 = -8.0f * log1pf(expf(-p.in[I_LAM][c]));
    bf16_t* M1 = (bf16_t*)(p.ws + W_MIX); bf16_t* M2 = (bf16_t*)(p.out + O_YP);
    float h_run = 0.f, A_run = 1.f;
    for (int mt = 0; mt < nmt; ++mt) {
        f32x4 accr = {0.f, 0.f, 0.f, 0.f}, acci = {0.f, 0.f, 0.f, 0.f};
#pragma unroll
        for (int kk = 0; kk < 4; ++kk) { const bf16x8 Af = *(const LAS bf16x8*)(xcs + (16 * mt + n) * 136 + 32 * kk + 8 * q);
            accr = __builtin_amdgcn_mfma_f32_16x16x32_bf16(Af, Br[kk], accr, 0, 0, 0); acci = __builtin_amdgcn_mfma_f32_16x16x32_bf16(Af, Bi[kk], acci, 0, 0, 0); }
        float a[4], bx[4], ga[4];
#pragma unroll
        for (int j = 0; j < 4; ++j) { const int tok = 16 * mt + 4 * q + j; const float xcv = bf2f(xcs[tok * 136 + wid * 16 + n]);
            ga[j] = bf2f(gas[tok * 128 + wid * 16 + n]);
            const float r = sigm(accr[j] + br), ig = sigm(acci[j] + bi), la = c8 * r; a[j] = __expf(la); bx[j] = __builtin_amdgcn_sqrtf(fmaf(-a[j], a[j], 1.0f)) * (ig * xcv); }
        float h[4], Ac[4];
        if (MODE == 2) {
#pragma unroll
            for (int j = 0; j < 4; ++j) { const int s = t0 + 16 * mt + 4 * q + j; h[j] = a[j] * p.in[I_SL][(size_t)s * 1024 + c] + bx[j]; p.out[O_SL + (size_t)s * 1024 + c] = h[j]; Ac[j] = 0.f; }
        } else {
            float Ap[4]; h[0] = bx[0]; Ap[0] = a[0];
#pragma unroll
            for (int j = 1; j < 4; ++j) { h[j] = a[j] * h[j - 1] + bx[j]; Ap[j] = a[j] * Ap[j - 1]; }
            float PA = Ap[3], PH = h[3];
            float tA = __shfl_up(PA, 16), tH = __shfl_up(PH, 16); if (q >= 1) { PH = PA * tH + PH; PA = PA * tA; }
            tA = __shfl_up(PA, 32); tH = __shfl_up(PH, 32); if (q >= 2) { PH = PA * tH + PH; PA = PA * tA; }
            const float h_end = PA * h_run + PH; const float hin_s = __shfl_up(h_end, 16), pae_s = __shfl_up(PA, 16);
            const float h_in = (q == 0) ? h_run : hin_s; const float a_in = A_run * ((q == 0) ? 1.0f : pae_s);
#pragma unroll
            for (int j = 0; j < 4; ++j) { h[j] += Ap[j] * h_in; Ac[j] = Ap[j] * a_in; }
            h_run = __shfl(h_end, 48 + n); A_run *= __shfl(PA, 48 + n);
        }
#pragma unroll
        for (int j = 0; j < 4; ++j) { const size_t row = (size_t)(rowbase + t0 + 16 * mt + 4 * q + j); const float sg = sigm(ga[j]);
            M1[row * 1024 + c] = f2bf(sg * h[j]); M2[row * 1024 + c] = f2bf(sg * Ac[j]); }
    }
    if (MODE == 0 && q == 0) { ((float*)(p.ws + W_LRUA))[(size_t)(b * 8 + kc) * 1024 + c] = A_run; ((float*)(p.ws + W_LRUH))[(size_t)(b * 8 + kc) * 1024 + c] = h_run; }
    __syncthreads();
}

__device__ __forceinline__ void s5_fused(const P& p, LAS unsigned char* lds, int g, int b) {
    int tid_ = threadIdx.x; asm volatile("" : "+v"(tid_)); const int tid = tid_, lane = tid & 63, wid = tid >> 6, n = lane & 15, q = lane >> 4;
    LAS bf16_t* Us = (LAS bf16_t*)lds;
    LAS float* Ssm = (LAS float*)(lds + 68112);
    LAS bf16_t* Hs = (LAS bf16_t*)(lds + 68112);
    const bf16_t* proj = (const bf16_t*)(p.ws + W_PROJ); const bf16x8 zero = {0, 0, 0, 0, 0, 0, 0, 0};
    bf16x8 Bf1[8];
    { const bf16_t* W = (const bf16_t*)(p.ws + W_W1) + (size_t)g * 128 * 256;
#pragma unroll
      for (int kk = 0; kk < 8; ++kk) Bf1[kk] = *(const bf16x8*)(W + (size_t)(16 * wid + n) * 256 + 32 * kk + 8 * q); }
    TIMED(231) { const bf16_t* ub = (const bf16_t*)(p.out + O_YP) + (size_t)MTOK * 1024 + (size_t)(b * NG + g) * TT * 16;
      u32x4 tv[9];
#pragma unroll
      for (int i = 0; i < 9; ++i) { const int it = tid + 512 * i; tv[i] = (u32x4){0u, 0u, 0u, 0u}; if (it < TT * 2) tv[i] = *(const u32x4*)(ub + (size_t)it * 8); }
#pragma unroll
      for (int i = 0; i < 9; ++i) { const int it = tid + 512 * i; if (it < TT * 2) { const int t = it >> 1; *(LAS u32x4*)(Us + (t >> 4) * 264 + (t & 15) * 16 + 8 * (it & 1)) = tv[i]; } } }
    __syncthreads();
    TIMED_END(231)
    TIMED(232) {
#pragma unroll 1
      for (int rt = 0; rt < 9; ++rt) { const int k = 16 * rt + n; f32x4 acc = {0.f, 0.f, 0.f, 0.f};
#pragma unroll
          for (int kk = 0; kk < 8; ++kk) { const bf16x8 Af = *(const LAS bf16x8*)(Us + k * 264 + 32 * kk + 8 * q);
              acc = __builtin_amdgcn_mfma_f32_16x16x32_bf16(Af, Bf1[kk], acc, 0, 0, 0); }
#pragma unroll
          for (int j = 0; j < 4; ++j) Ssm[(16 * rt + 4 * q + j) * 128 + 16 * wid + n] = acc[j]; } }
    __syncthreads();
    TIMED_END(232)
    bf16x8 Bw[2][12];
    { const bf16_t* W = (const bf16_t*)(p.ws + W_W2) + (size_t)g * 256 * 384;
#pragma unroll
      for (int i = 0; i < 2; ++i)
#pragma unroll
          for (int kk = 0; kk < 12; ++kk) Bw[i][kk] = *(const bf16x8*)(W + (size_t)(16 * (2 * wid + i) + n) * 384 + 32 * kk + 8 * q); }
    TIMED(233) if (wid == 0) { const float* a16 = (const float*)(p.ws + W_A16) + (g * 64 + lane) * 2; const float ar = a16[0], ai = a16[1]; float hr = 0.f, hi = 0.f;
#pragma unroll 1
        for (int kb = 0; kb < 132; kb += 4) { float sr[4], si[4];
#pragma unroll
            for (int u = 0; u < 4; ++u) { sr[u] = Ssm[(kb + u) * 128 + lane]; si[u] = Ssm[(kb + u) * 128 + 64 + lane]; }
            LDS_WAIT();
#pragma unroll
            for (int u = 0; u < 4; ++u) { const int k = kb + u; if (k < NCHUNK) { Hs[k * 136 + lane] = f2bf(hr); Hs[k * 136 + 64 + lane] = f2bf(hi);
                const float nr = ar * hr - ai * hi + sr[u], ni = ar * hi + ai * hr + si[u]; hr = nr; hi = ni; } } }
        p.out[O_PSR + ((size_t)b * NG + g) * 64 + lane] = hr; p.out[O_PSI + ((size_t)b * NG + g) * 64 + lane] = hi; }
    __syncthreads();
    TIMED_END(233)
    TIMED(234)
    {
#pragma unroll 1
      for (int rt = 0; rt < 9; ++rt) { const int k = 16 * rt + n; f32x4 acc0 = {0.f, 0.f, 0.f, 0.f}, acc1 = {0.f, 0.f, 0.f, 0.f};
#pragma unroll
          for (int kk = 0; kk < 8; ++kk) { const bf16x8 af = *(const LAS bf16x8*)(Us + k * 264 + 32 * kk + 8 * q);
              acc0 = __builtin_amdgcn_mfma_f32_16x16x32_bf16(af, Bw[0][kk], acc0, 0, 0, 0); acc1 = __builtin_amdgcn_mfma_f32_16x16x32_bf16(af, Bw[1][kk], acc1, 0, 0, 0); }
#pragma unroll
          for (int kk = 8; kk < 12; ++kk) { const bf16x8 af = *(const LAS bf16x8*)(Hs + k * 136 + 32 * (kk - 8) + 8 * q);
              acc0 = __builtin_amdgcn_mfma_f32_16x16x32_bf16(af, Bw[0][kk], acc0, 0, 0, 0); acc1 = __builtin_amdgcn_mfma_f32_16x16x32_bf16(af, Bw[1][kk], acc1, 0, 0, 0); }
          bf16_t* Y = (bf16_t*)(p.ws + W_YSG) + (size_t)(b * TT + 16 * (16 * rt + 4 * q) + 2 * wid) * DSSM + 16 * g + n;
#pragma unroll
          for (int j = 0; j < 4; ++j) { if (16 * rt + 4 * q + j < NCHUNK) { Y[(size_t)j * 16 * DSSM] = f2bf(gelu_tanh(acc0[j])); Y[(size_t)j * 16 * DSSM + DSSM] = f2bf(gelu_tanh(acc1[j])); } } } }
    TIMED_END(234)
}
__device__ __forceinline__ void s5_sample(const P& p, int s, int g, int lane) {
    const bf16_t* up = (const bf16_t*)(p.out + O_YP) + (size_t)MTOK * 1024 + (size_t)MP * DSSM + ((size_t)s * NG + g) * 16;
    const u32x4 u0 = *(const u32x4*)up, u1 = *(const u32x4*)(up + 8); float u[16];
    u[0] = bflo(u0.x); u[1] = bfhi(u0.x); u[2] = bflo(u0.y); u[3] = bfhi(u0.y); u[4] = bflo(u0.z); u[5] = bfhi(u0.z); u[6] = bflo(u0.w); u[7] = bfhi(u0.w);
    u[8] = bflo(u1.x); u[9] = bfhi(u1.x); u[10] = bflo(u1.y); u[11] = bfhi(u1.y); u[12] = bflo(u1.z); u[13] = bfhi(u1.z); u[14] = bflo(u1.w); u[15] = bfhi(u1.w);
    const float* a1 = (const float*)(p.ws + W_A1) + (g * 64 + lane) * 2; const float ar = a1[0], ai = a1[1];
    const float* bb = (const float*)(p.ws + W_BBAR) + (size_t)(g * 64 + lane) * 32; float bur = 0.f, bui = 0.f;
#pragma unroll
    for (int c = 0; c < 16; ++c) { bur += bb[2 * c] * u[c]; bui += bb[2 * c + 1] * u[c]; }
    const size_t si = ((size_t)s * NG + g) * 64 + lane; const float h0r = p.in[I_SSR][si], h0i = p.in[I_SSI][si];
    const float hr = ar * h0r - ai * h0i + bur, hi = ar * h0i + ai * h0r + bui;
    p.out[O_SSR + si] = hr; p.out[O_SSI + si] = hi;
    float v16[16];
#pragma unroll
    for (int c1 = 0; c1 < 16; ++c1) v16[c1] = p.in[I_SCRE][(g * 16 + c1) * 64 + lane] * hr - p.in[I_SCIM][(g * 16 + c1) * 64 + lane] * hi;
    float v8[8], v4[4], v2[2], v1;
    { const bool hi32 = (lane & 32) != 0;
#pragma unroll
      for (int i = 0; i < 8; ++i) { const float keep = hi32 ? v16[i + 8] : v16[i], send = hi32 ? v16[i] : v16[i + 8]; v8[i] = keep + __shfl_xor(send, 32); } }
    { const bool hb = (lane & 16) != 0;
#pragma unroll
      for (int i = 0; i < 4; ++i) { const float keep = hb ? v8[i + 4] : v8[i], send = hb ? v8[i] : v8[i + 4]; v4[i] = keep + __shfl_xor(send, 16); } }
    { const bool hb = (lane & 8) != 0;
#pragma unroll
      for (int i = 0; i < 2; ++i) { const float keep = hb ? v4[i + 2] : v4[i], send = hb ? v4[i] : v4[i + 2]; v2[i] = keep + __shfl_xor(send, 8); } }
    { const bool hb = (lane & 4) != 0; const float keep = hb ? v2[1] : v2[0], send = hb ? v2[0] : v2[1]; v1 = keep + __shfl_xor(send, 4); }
    v1 += __shfl_xor(v1, 1); v1 += __shfl_xor(v1, 2);
    const int c1 = ((lane >> 5) & 1) * 8 + ((lane >> 4) & 1) * 4 + ((lane >> 3) & 1) * 2 + ((lane >> 2) & 1);
    if ((lane & 3) == 0) { const float uc = bf2f(up[c1]); const float yv = v1 + p.in[I_SD][g * 16 + c1] * uc;
        ((bf16_t*)(p.ws + W_YSG))[(size_t)(MP + s) * DSSM + 16 * g + c1] = f2bf(gelu_tanh(yv)); }
}
__device__ __forceinline__ void phase2a(const P& p, LAS unsigned char* lds) {
    TIMED(22) for (int u = blockIdx.x; u < 512; u += gridDim.x) lru_unit<0>(p, lds, (u >> 3) & 7, u >> 6, u & 7); TIMED_END(22)
    TIMED(23) for (int it = blockIdx.x; it < NG * NBATCH; it += gridDim.x) s5_fused(p, lds, it & 31, it >> 5); TIMED_END(23)
}
__device__ __forceinline__ void phase2b(const P& p, LAS unsigned char* lds) {
    int tid_ = threadIdx.x; asm volatile("" : "+v"(tid_)); const int tid = tid_, lane = tid & 63, wid = tid >> 6;
    const size_t gt = (size_t)blockIdx.x * 512 + tid, GT = (size_t)gridDim.x * 512;
    for (size_t i = gt; i < (size_t)NBATCH * 1024; i += GT) { const int b = (int)(i >> 10), c = (int)(i & 1023); float h = 0.f;
        const float* A = (const float*)(p.ws + W_LRUA); const float* Hh = (const float*)(p.ws + W_LRUH); float* Cc = (float*)(p.ws + W_LRUC);
        for (int kc = 0; kc < 8; ++kc) { const size_t o = (size_t)(b * 8 + kc) * 1024 + c; Cc[o] = h; h = A[o] * h + Hh[o]; }
        p.out[O_PL + i] = h; }
    for (int u = (int)gridDim.x - 1 - (int)blockIdx.x; u < 64; u += gridDim.x) lru_unit<2>(p, lds, 0, u >> 3, u & 7);
    for (int it = blockIdx.x * 8 + wid; it < NSAMP * NG; it += gridDim.x * 8) s5_sample(p, it >> 5, it & 31, lane);
    const bf16_t* proj = (const bf16_t*)(p.ws + W_PROJ);
    for (size_t i = gt; i < (size_t)NBATCH * 3 * 1024; i += GT) { const int c = (int)(i & 1023), j = (int)((i >> 10) % 3), b = (int)(i / 3072);
        p.out[O_PCL + i] = bf2f(proj[(size_t)(b * TT + TT - 3 + j) * DIN + c]); }
    for (size_t i = gt; i < (size_t)NSAMP * 3 * 1024; i += GT) { const int c = (int)(i & 1023), j = (int)((i >> 10) % 3), s = (int)(i / 3072);
        p.out[O_SCL + i] = (j < 2) ? p.in[I_CCL][((size_t)s * 3 + j + 1) * 1024 + c] : bf2f(proj[(size_t)(MP + s) * DIN + c]); }
    for (size_t i = gt; i < (size_t)NSAMP * DFF; i += GT) { const int ch = (int)(i % DFF), s = (int)(i / DFF);
        p.out[O_SCF + ((size_t)s * 2) * DFF + ch] = p.in[I_CCF][((size_t)s * 2 + 1) * DFF + ch]; }
}
__device__ __forceinline__ void phase_glutail(const P& p) {
    const size_t gt = (size_t)blockIdx.x * 512 + threadIdx.x, GT = (size_t)gridDim.x * 512;
    const float* pg = (const float*)(p.ws + W_PG); const float* bias = p.in[I_BGLU]; const bf16_t* proj = (const bf16_t*)(p.ws + W_PROJ);
    bf16_t* mix = (bf16_t*)(p.ws + W_MIX); const bf16_t* m2 = (const bf16_t*)(p.out + O_YP); const float* carry = (const float*)(p.ws + W_LRUC);
    for (size_t it = gt; it < (size_t)256 * 256; it += GT) { const int rl = (int)(it >> 8), j = (int)(it & 255) * 4, rowi = 16384 + rl; const size_t row = (size_t)rowi; const int col = 256 * (j >> 7) + (j & 127);
        f32x4 val = *(const f32x4*)(bias + j), gate = *(const f32x4*)(bias + 1024 + j);
#pragma unroll
        for (int ks = 0; ks < 2; ++ks) { val += *(const f32x4*)(pg + (size_t)ks * 256 * 2048 + (size_t)rl * 2048 + col); gate += *(const f32x4*)(pg + (size_t)ks * 256 * 2048 + (size_t)rl * 2048 + col + 128); }
        int cidx = 0; if (rowi < MP) { const int b = rowi / TT, t = rowi - b * TT; int kc = t >> 8; kc = kc > 7 ? 7 : kc; cidx = (b * 8 + kc) * 1024; }
        const f32x4 cv = *(const f32x4*)(carry + cidx + j); const u32x2 gbw = *(const u32x2*)(proj + row * DIN + C_GB + j), mw = *(const u32x2*)(mix + row * 1024 + j), m2w = *(const u32x2*)(m2 + row * 1024 + j);
        const float o0 = bflo(mw.x) + bflo(m2w.x) * cv[0] + sigm(bflo(gbw.x)) * val[0] * sigm(gate[0]), o1 = bfhi(mw.x) + bfhi(m2w.x) * cv[1] + sigm(bfhi(gbw.x)) * val[1] * sigm(gate[1]);
        const float o2 = bflo(mw.y) + bflo(m2w.y) * cv[2] + sigm(bflo(gbw.y)) * val[2] * sigm(gate[2]), o3 = bfhi(mw.y) + bfhi(m2w.y) * cv[3] + sigm(bfhi(gbw.y)) * val[3] * sigm(gate[3]);
        u32x2 w; w.x = cvt_pk_bf16(o0, o1); w.y = cvt_pk_bf16(o2, o3); *(u32x2*)(mix + row * 1024 + j) = w; }
}
__device__ __forceinline__ void phase_ln1(const P& p) {
    const int lane = threadIdx.x & 63, wid = threadIdx.x >> 6; const int gw = blockIdx.x * 8 + wid, NGW = gridDim.x * 8;
    const bf16_t* R = (const bf16_t*)(p.ws + W_R1); bf16_t* X = (bf16_t*)(p.ws + W_XN);
    for (int r = gw; r < 16384; r += 2 * NGW) { const int r2 = r + NGW; const bool vb = r2 < 16384; const int rb = vb ? r2 : r;
        ln_rows2_bf<true>(R + (size_t)r * DM, R + (size_t)rb * DM, p.in[I_L1G], p.in[I_L1B], X + (size_t)r * DM, X + (size_t)rb * DM, lane, vb); }
    for (int r = 16384 + gw; r < MTOK; r += NGW) { bf16_t* xr = X + (size_t)r * DM;
        ln_row<true>((const float*)(p.ws + W_PART) + (size_t)(r - 16384) * DM, p.in[I_L1G], p.in[I_L1B], xr, lane, 4, xr, p.in[I_BOUT]); }
}
__device__ __forceinline__ void phase_ffnfix(const P& p) {
    const size_t gt = (size_t)blockIdx.x * 512 + threadIdx.x, GT = (size_t)gridDim.x * 512;
    const float* sbg = (const float*)(p.ws + W_SBG); const float* sbv = (const float*)(p.ws + W_SBV); bf16_t* H = (bf16_t*)(p.ws + W_V);
    for (size_t it = gt; it < (size_t)256 * 2 * 384; it += GT) { const int cg8 = (int)(it % 384), rr = (int)((it / 384) & 1), blk = (int)(it / 768), ch = cg8 * 8, row = blk * 64 + rr; const int t = row % TT;
        float o[8];
#pragma unroll
        for (int hh = 0; hh < 2; ++hh) { const int c = ch + 4 * hh; const f32x4 z = {0.f, 0.f, 0.f, 0.f};
            const f32x4 g0 = *(const f32x4*)(sbg + ((size_t)blk * 4 + rr) * DFF + c), v = *(const f32x4*)(sbv + ((size_t)blk * 2 + rr) * DFF + c);
            f32x4 g1, g2;
            if (rr == 0) { g1 = (blk > 0 && t >= 1) ? *(const f32x4*)(sbg + ((size_t)(blk - 1) * 4 + 3) * DFF + c) : z; g2 = (blk > 0 && t >= 2) ? *(const f32x4*)(sbg + ((size_t)(blk - 1) * 4 + 2) * DFF + c) : z; }
            else { g1 = (t >= 1) ? *(const f32x4*)(sbg + ((size_t)blk * 4) * DFF + c) : z; g2 = (blk > 0 && t >= 2) ? *(const f32x4*)(sbg + ((size_t)(blk - 1) * 4 + 3) * DFF + c) : z; }
            const f32x4 w0 = *(const f32x4*)(p.in[I_FCW] + c), w1 = *(const f32x4*)(p.in[I_FCW] + DFF + c), w2 = *(const f32x4*)(p.in[I_FCW] + 2 * DFF + c), cbv = *(const f32x4*)(p.in[I_FCB] + c);
            const f32x4 y = cbv + w0 * g2 + w1 * g1 + w2 * g0;
            o[4 * hh] = gelu_tanh(y[0]) * v[0]; o[4 * hh + 1] = gelu_tanh(y[1]) * v[1]; o[4 * hh + 2] = gelu_tanh(y[2]) * v[2]; o[4 * hh + 3] = gelu_tanh(y[3]) * v[3]; }
        u32x4 w; w.x = cvt_pk_bf16(o[0], o[1]); w.y = cvt_pk_bf16(o[2], o[3]); w.z = cvt_pk_bf16(o[4], o[5]); w.w = cvt_pk_bf16(o[6], o[7]);
        *(u32x4*)(H + (size_t)row * DFF + ch) = w; }
}
__device__ __forceinline__ f32x4 up_tail_sum(const float* pu, const float* bias, int rl, int col, int bcol) {
    f32x4 v = *(const f32x4*)(bias + bcol);
#pragma unroll
    for (int ks = 0; ks < 4; ++ks) v += *(const f32x4*)(pu + (size_t)ks * 256 * 6144 + (size_t)rl * 6144 + col);
    return v;
}
__device__ __forceinline__ void phase_ffntail(const P& p) {
    const size_t gt = (size_t)blockIdx.x * 512 + threadIdx.x, GT = (size_t)gridDim.x * 512;
    const float* pu = (const float*)(p.ws + W_PU); const float* sbg = (const float*)(p.ws + W_SBG); bf16_t* H = (bf16_t*)(p.ws + W_V); const float* bias = p.in[I_BUP];
    for (size_t it = gt; it < (size_t)256 * 768; it += GT) { const int rl = (int)(it / 768), ch = (int)(it - (size_t)rl * 768) * 4, row = 16384 + rl; const int colg = 256 * (ch >> 7) + (ch & 127);
        const f32x4 g0 = up_tail_sum(pu, bias, rl, colg, ch), v = up_tail_sum(pu, bias, rl, colg + 128, DFF + ch); f32x4 g1, g2;
        if (row >= MP) { const int s_ = row - MP; g2 = *(const f32x4*)(p.in[I_CCF] + ((size_t)s_ * 2) * DFF + ch); g1 = *(const f32x4*)(p.in[I_CCF] + ((size_t)s_ * 2 + 1) * DFF + ch);
            *(f32x4*)(p.out + O_SCF + ((size_t)s_ * 2 + 1) * DFF + ch) = g0; }
        else {
            g1 = (rl >= 1) ? up_tail_sum(pu, bias, rl - 1, colg, ch) : *(const f32x4*)(sbg + ((size_t)255 * 4 + 3) * DFF + ch);
            g2 = (rl >= 2) ? up_tail_sum(pu, bias, rl - 2, colg, ch) : *(const f32x4*)(sbg + ((size_t)255 * 4 + 2 + rl) * DFF + ch);
            const int t = row - 7 * TT; if (t >= TT - 2) *(f32x4*)(p.out + O_PCF + ((size_t)7 * 2 + (t - (TT - 2))) * DFF + ch) = g0; }
        const f32x4 w0 = *(const f32x4*)(p.in[I_FCW] + ch), w1 = *(const f32x4*)(p.in[I_FCW] + DFF + ch), w2 = *(const f32x4*)(p.in[I_FCW] + 2 * DFF + ch), cbv = *(const f32x4*)(p.in[I_FCB] + ch);
        const f32x4 y = cbv + w0 * g2 + w1 * g1 + w2 * g0;
        u32x2 w; w.x = cvt_pk_bf16(gelu_tanh(y[0]) * v[0], gelu_tanh(y[1]) * v[1]); w.y = cvt_pk_bf16(gelu_tanh(y[2]) * v[2], gelu_tanh(y[3]) * v[3]);
        *(u32x2*)(H + (size_t)row * DFF + ch) = w; }
}
__device__ __forceinline__ float* y_row(const P& p, int r) {
    if (r >= MP) return p.out + O_YS + (size_t)(r - MP) * DM;
    const int b = r / TT, t = r - b * TT; return t < 16 ? nullptr : p.out + O_YP + ((size_t)b * 2048 + (t - 16)) * DM;
}
__device__ __forceinline__ void phase_ln2(const P& p) {
    const int lane = threadIdx.x & 63, wid = threadIdx.x >> 6; const int gw = blockIdx.x * 8 + wid, NGW = gridDim.x * 8;
    const bf16_t* R = (const bf16_t*)(p.ws + W_R2);
    for (int r = gw; r < 16384; r += 2 * NGW) { const int r2 = r + NGW; float* oa = y_row(p, r); float* ob = (r2 < 16384) ? y_row(p, r2) : nullptr;
        if (oa && ob) ln_rows2_bf<false>(R + (size_t)r * DM, R + (size_t)r2 * DM, p.in[I_L2G], p.in[I_L2B], oa, ob, lane, true);
        else if (oa) ln_rows2_bf<false>(R + (size_t)r * DM, R + (size_t)r * DM, p.in[I_L2G], p.in[I_L2B], oa, oa, lane, false);
        else if (ob) ln_rows2_bf<false>(R + (size_t)r2 * DM, R + (size_t)r2 * DM, p.in[I_L2G], p.in[I_L2B], ob, ob, lane, false); }
    for (int r = 16384 + gw; r < MTOK; r += NGW) { float* o = y_row(p, r);
        if (o) ln_row<false>((const float*)(p.ws + W_PART) + (size_t)(r - 16384) * DM, p.in[I_L2G], p.in[I_L2B], o, lane, 12, (const bf16_t*)(p.ws + W_XN) + (size_t)r * DM, p.in[I_BDOWN]); }
}

__global__ __launch_bounds__(512, 2) void hawk_fwd(P p) {
    extern __shared__ __attribute__((aligned(16))) unsigned char shm[];
    LAS unsigned char* lds = (LAS unsigned char*)shm;
    cg::grid_group grid = cg::this_grid();
    volatile LAS unsigned* xst = (volatile LAS unsigned*)(lds + LDS_TOTAL - 16);
    if (threadIdx.x < 4) xst[threadIdx.x] = 0u;
    __syncthreads();
    XcdBarrier xb = xcd_barrier_post((unsigned*)(p.ws + W_BAR), xst);
    if (threadIdx.x == 0) xst[2] = xb_add((unsigned*)(p.ws + W_BAR) + XCD_BAR_WORDS + 64 * xb.x, 1u);
#define GSYNC() xcd_barrier(xb)
    if (p.ws == nullptr) grid.sync();
    TIMED(0) REPEAT(REP_P0) { phase0(p, lds); GSYNC(); } TIMED_END(0)
    if (threadIdx.x == 0) { unsigned* bar = (unsigned*)(p.ws + W_BAR); bool ok = (gridDim.x % 8u) == 0u;
        for (unsigned j = 0; j < 16; ++j) { const unsigned cnt = xb_ld(&bar[XB_XCNT(j)]); if (cnt != (j < 8 ? gridDim.x / 8u : 0u)) ok = false; }
        xst[3] = ok ? (xst[2] * 8u + xb.x) : blockIdx.x; }
    __syncthreads();
    const int vc = (int)xst[3];
    TIMED(1) REPEAT(REP_P1) { EpiProj E; E.O = (bf16_t*)(p.ws + W_PROJ); E.bias = p.in[I_BIN]; E.UT = (bf16_t*)(p.out + O_YP) + (size_t)MTOK * 1024; run_gemm(lds, vc, (const bf16_t*)(p.ws + W_XN), (const bf16_t*)(p.ws + W_WTIN), DIN, 1024, E);
        { const int G = (int)gridDim.x, nun = (MTOK / 256) * (DIN / 256), rem = nun % G; const int c = vc;
          if (c >= rem) transposes<1>(p, (LAS float*)(lds + (threadIdx.x >> 6) * 8704), threadIdx.x & 63, (c - rem) * 8 + (int)(threadIdx.x >> 6), (G - rem) * 8); }
        GSYNC(); } TIMED_END(1)
    TIMED(20) REPEAT(REP_P2A) { phase2a(p, lds); GSYNC(); } TIMED_END(20)
    TIMED(21) REPEAT(REP_P2B) { phase2b(p, lds); GSYNC(); } TIMED_END(21)
    TIMED(3) { EpiGlu E; E.mix = (bf16_t*)(p.ws + W_MIX); E.m2 = (const bf16_t*)(p.out + O_YP); E.carry = (const float*)(p.ws + W_LRUC); E.proj = (const bf16_t*)(p.ws + W_PROJ); E.bias = p.in[I_BGLU]; run_gemm_main64(lds, vc, (const bf16_t*)(p.ws + W_YSG), (const bf16_t*)(p.ws + W_WTGLU), 2048, 512, E);
        run_gemm_tail(lds, vc, (const bf16_t*)(p.ws + W_YSG), (const bf16_t*)(p.ws + W_WTGLU), 2048, 512, 2, (float*)(p.ws + W_PG)); GSYNC();
        phase_glutail(p); GSYNC(); } TIMED_END(3)
    TIMED(4) REPEAT(REP_P4) { EpiRes E; E.R = (bf16_t*)(p.ws + W_R1); E.X = (const bf16_t*)(p.ws + W_XN); E.bias = p.in[I_BOUT]; E.part = (float*)(p.ws + W_PART); run_gemm_split(lds, vc, (const bf16_t*)(p.ws + W_MIX), (const bf16_t*)(p.ws + W_WTOUT), 1024, 1024, 4, E); GSYNC(); } TIMED_END(4)
    TIMED(5) REPEAT(REP_P5) { phase_ln1(p); GSYNC(); } TIMED_END(5)
    TIMED(6) REPEAT(REP_P6) { EpiUp E; E.H = (bf16_t*)(p.ws + W_V); E.bias = p.in[I_BUP]; E.out = p.out; E.cw = p.in[I_FCW]; E.cb = p.in[I_FCB]; E.cache = p.in[I_CCF]; E.sbg = (float*)(p.ws + W_SBG); E.sbv = (float*)(p.ws + W_SBV); run_gemm_main64(lds, vc, (const bf16_t*)(p.ws + W_XN), (const bf16_t*)(p.ws + W_WTUP), 6144, 1024, E);
        run_gemm_tail(lds, vc, (const bf16_t*)(p.ws + W_XN), (const bf16_t*)(p.ws + W_WTUP), 6144, 1024, 4, (float*)(p.ws + W_PU)); GSYNC(); } TIMED_END(6)
    TIMED(7) phase_ffnfix(p); phase_ffntail(p);
    GSYNC(); TIMED_END(7)
    TIMED(8) REPEAT(REP_P8) { EpiRes E; E.R = (bf16_t*)(p.ws + W_R2); E.X = (const bf16_t*)(p.ws + W_XN); E.bias = p.in[I_BDOWN]; E.part = (float*)(p.ws + W_PART); run_gemm_split(lds, vc, (const bf16_t*)(p.ws + W_V), (const bf16_t*)(p.ws + W_WTDOWN), 1024, 3072, 12, E); GSYNC(); } TIMED_END(8)
    TIMED(9) REPEAT(REP_P9) phase_ln2(p); TIMED_END(9)
}

extern "C" void kernel_launch(void* const* d_in, const int* in_sizes, int n_in, void* d_out, int out_size, void* d_ws, size_t ws_size, hipStream_t stream) {
    constexpr int LDS_BYTES = LDS_TOTAL;
    static int grid = 0;
    if (grid == 0) {
        if (n_in != N_IN || (size_t)out_size != O_END || ws_size < 268435456ull) { fprintf(stderr, "kernel_launch: unexpected shapes (n_in %d out %d ws %zu)\n", n_in, out_size, ws_size); grid = -1; return; }
        int dev = 0, cus = 0, per_cu = 0;
        if (hipGetDevice(&dev) != hipSuccess || hipDeviceGetAttribute(&cus, hipDeviceAttributeMultiprocessorCount, dev) != hipSuccess) { grid = -1; return; }
        if (hipFuncSetAttribute((const void*)hawk_fwd, hipFuncAttributeMaxDynamicSharedMemorySize, LDS_BYTES) != hipSuccess) { fprintf(stderr, "kernel_launch: hipFuncSetAttribute failed\n"); grid = -1; return; }
        if (hipOccupancyMaxActiveBlocksPerMultiprocessor(&per_cu, (const void*)hawk_fwd, 512, LDS_BYTES) != hipSuccess || per_cu < 1) { fprintf(stderr, "kernel_launch: occupancy query failed (%d)\n", per_cu); grid = -1; (void)hipGetLastError(); return; }
        grid = cus * per_cu;
    }
    if (grid < 0) return;
    if (hipMemsetAsync((char*)d_ws + W_BAR, 0, (XCD_BAR_WORDS + 64 * 16) * 4, stream) != hipSuccess) { fprintf(stderr, "kernel_launch: memset failed\n"); return; }
    P p{};
    for (int i = 0; i < N_IN; ++i) p.in[i] = (const float*)d_in[i];
    p.out = (float*)d_out; p.ws = (unsigned char*)d_ws;
    void* args[] = {&p};
    hipError_t e = hipLaunchCooperativeKernel((const void*)hawk_fwd, dim3(grid), dim3(512), args, LDS_BYTES, stream);
    if (e != hipSuccess) fprintf(stderr, "cooperative launch failed: %s (grid %d)\n", hipGetErrorString(e), grid);
}
```

```cpp
#include <hip/hip_runtime.h>
#include <hip/hip_cooperative_groups.h>
#include <cstdio>
#include <cstdint>
namespace cg = cooperative_groups;
#define REP_P0 1
#define REP_P0A 1
#define REP_P0B 1
#define REP_P0C 1
#define REP_P1 1
#define REP_P3 1
#define REP_P2A 1
#define REP_P2B 1
#define REP_P2C 1
#define REP_P4 1
#define REP_P5 1
#define REP_P6 1
#define REP_P8 1
#define REP_P9 1
#define PROBE_PHASE -1
namespace pg8 {
#define PG8_LAS __attribute__((address_space(3)))
typedef unsigned short bf16_t;
typedef short bf16x8 __attribute__((ext_vector_type(8)));
typedef float f32x4 __attribute__((ext_vector_type(4)));
typedef unsigned u32x4 __attribute__((ext_vector_type(4)));
constexpr int BM = 256, BK = 64, HALF = 128, HTB = HALF * BK * 2  , STAGE_BYTES = 8 * HTB, NXCD = 8, WGM = 8;

__host__ __device__ __forceinline__ int lds_byte(int r, int c) { const int st = (r >> 4) * 2 + (c >> 5), rr = r & 15, cc = c & 31, ob = rr * 64 + cc * 2; return st * 1024 + (ob ^ (((ob >> 9) & 1) << 5)); }
__host__ __device__ __forceinline__ void stage_rc(int b, int& R, int& C) { const int st = b / 1024, sb = b % 1024, swz = sb ^ (((sb >> 9) & 1) << 5); R = (st >> 1) * 16 + swz / 64; C = (st & 1) * 32 + (swz % 64) / 2; }
__host__ __device__ __forceinline__ int perm32(int rho) { const int n = rho >> 4, i = rho & 15; return 8 * (i >> 2) + 4 * n + (i & 3); }

struct Unit { int pm, pn, k0, nt, ks; };
struct Gemm { const bf16_t* A; const bf16_t* Bt; int M, N, K; };

struct StaticOrder {
    int nM, nN, nwg, G, c, ntk;
    __host__ __device__ void init(int M, int N, int K, int G_, int c_) { nM = M / BM; nN = N / BM; nwg = nM * nN; G = G_; c = c_; ntk = K / BK; }
    __host__ __device__ bool next(int i, Unit& u) const {
        const long L = (long)i * G + c; if (L >= nwg) return false;
        int wgid = (int)L; { const int q = nwg / NXCD, r = nwg % NXCD, xcd = wgid % NXCD, off = wgid / NXCD; wgid = (xcd < r ? xcd * (q + 1) : r * (q + 1) + (xcd - r) * q) + off; }
        const int nig = WGM * nN, gid = wgid / nig, fm = gid * WGM, gsz = (nM - fm) < WGM ? (nM - fm) : WGM;
        u.pm = fm + ((wgid % nig) % gsz); u.pn = (wgid % nig) / gsz; u.k0 = 0; u.nt = ntk; u.ks = -1; return true;
    }
    __device__ __forceinline__ void a_ready(const Unit&) const {}
    __device__ __forceinline__ void done(const Unit&) const {}
};
struct TailOrder {
    int nN, ntk, nsplit, G, c;
    __host__ __device__ void init(int N, int K, int nsplit_, int G_, int c_) { nN = N / BM; ntk = K / BK; nsplit = nsplit_; G = G_; c = c_; }
    __host__ __device__ bool next(int i, Unit& u) const {
        const long L = (long)i * G + c; const bool ok = L < (long)nN * nsplit; const int ks = (int)(L / nN), ntp = ntk / nsplit;
        u.pm = 64; u.pn = (int)(L % nN); u.ks = ks; u.nt = ntp; u.k0 = ks * ntp * BK; return ok;
    }
    __device__ __forceinline__ void a_ready(const Unit&) const {}
    __device__ __forceinline__ void done(const Unit&) const {}
};
struct SplitOrder {
    StaticOrder base; int nsplit;
    __host__ __device__ void init(int N, int K, int nsplit_, int G_, int c_) { base.init(64 * BM, N, K, G_, c_); nsplit = nsplit_; }
    __host__ __device__ bool next(int i, Unit& u) const {
        Unit t; t.pm = 0; t.pn = 0; t.k0 = 0; t.nt = base.ntk; t.ks = -1;
        const bool ok = base.next(i, t);
        const long L = (long)i * base.G + base.c - base.nwg; const bool sp = (!ok) && L >= 0 && L < (long)base.nN * nsplit;
        const int ks = (int)(L / base.nN), pn = (int)(L % base.nN), ntp = base.ntk / nsplit;
        u.pm = sp ? 64 : t.pm; u.pn = sp ? pn : t.pn; u.ks = sp ? ks : -1; u.nt = sp ? ntp : t.nt; u.k0 = sp ? ks * ntp * BK : 0;
        return ok || sp;
    }
    __device__ __forceinline__ void a_ready(const Unit&) const {}
    __device__ __forceinline__ void done(const Unit&) const {}
};
__device__ __forceinline__ unsigned cvt_pk_bf16(float lo, float hi) { unsigned r; asm volatile("v_cvt_pk_bf16_f32 %0, %1, %2" : "=v"(r) : "v"(lo), "v"(hi)); return r; }
template <class Epi, class Sched, bool STAMP = false>
__device__ __forceinline__ void gemm_phase(PG8_LAS unsigned char* lds, const Gemm g, const Sched& S, const Epi& E, unsigned long long* stamps) {
    int tid_ = threadIdx.x; asm volatile("" : "+v"(tid_)); const int tid = tid_, wid = __builtin_amdgcn_readfirstlane(tid >> 6), lane = tid & 63, wr = wid >> 2, wc = wid & 3, fr = lane & 15, fq = lane >> 4;
    const int K = g.K;
    int ts_lo = 0, ts_hi = 0, nts = 0; const unsigned long long rt_entry = STAMP ? (unsigned long long)wall_clock64() : 0ull;
#define PG8_STAMP() do { if (STAMP && wid == 0 && nts < 64) { const unsigned long long _c = (unsigned long long)clock64(); \
        ts_lo = (lane == nts) ? (int)(unsigned)_c : ts_lo; ts_hi = (lane == nts) ? (int)(unsigned)(_c >> 32) : ts_hi; ++nts; } } while (0)
    PG8_STAMP();
    unsigned voffA[2], voffB[2];
#pragma unroll
    for (int i = 0; i < 2; ++i) { int R, C; stage_rc(tid * 16 + i * 8192, R, C); const int Rb = Epi::PERM ? ((R & ~31) + perm32(R & 31)) : R;
        voffA[i] = (unsigned)(R * K + C) * 2u; voffB[i] = (unsigned)(Rb * K + C) * 2u; }
    const size_t kstep = (size_t)(BK * 2);
    const size_t hstep = (size_t)HALF * K * 2;
    const size_t tstep = 2 * hstep;
    const unsigned ldsw = (unsigned)wid * 1024u;
    const int aoff = lds_byte(wr * 64 + fr, fq * 8), boff = lds_byte(wc * 32 + fr, fq * 8);
#define PG8_SA(b, h) (((b) * 2 + (h)) * HTB)
#define PG8_SB(b, h) ((4 + (b) * 2 + (h)) * HTB)
#define PG8_STAGE(bufoff, gbase, voff) do { _Pragma("unroll") for (int _i = 0; _i < 2; ++_i) \
        __builtin_amdgcn_global_load_lds((const unsigned*)((const char*)(gbase) + (voff)[_i]), (PG8_LAS unsigned*)(lds + (bufoff) + ldsw + _i * 8192), 16, 0, 0); } while (0)
#define PG8_LDA(dst, b, h) do { _Pragma("unroll") for (int m = 0; m < 4; ++m) _Pragma("unroll") for (int k = 0; k < 2; ++k) dst[m][k] = *(const PG8_LAS bf16x8*)(lds + PG8_SA(b, h) + aoff + m * 2048 + k * 1024); } while (0)
#define PG8_LDB(dst, b, h) do { _Pragma("unroll") for (int n = 0; n < 2; ++n) _Pragma("unroll") for (int k = 0; k < 2; ++k) dst[n][k] = *(const PG8_LAS bf16x8*)(lds + PG8_SB(b, h) + boff + n * 2048 + k * 1024); } while (0)
#define PG8_MMA(ai, bj, At, Bt) do { __builtin_amdgcn_s_setprio(1); _Pragma("unroll") for (int m = 0; m < 4; ++m) _Pragma("unroll") for (int n = 0; n < 2; ++n) _Pragma("unroll") for (int k = 0; k < 2; ++k) \
        acc[ai][bj][m][n] = __builtin_amdgcn_mfma_f32_16x16x32_bf16(Bt[n][k], At[m][k], acc[ai][bj][m][n], 0, 0, 0); __builtin_amdgcn_s_setprio(0); } while (0)
#define PG8_WAIT_V(n) asm volatile("s_waitcnt vmcnt(" #n ")" ::: "memory")
#define PG8_WAIT_L(n) asm volatile("s_waitcnt lgkmcnt(" #n ")" ::: "memory")
#define PG8_BAR __builtin_amdgcn_s_barrier()
#define PG8_SCHED __builtin_amdgcn_sched_barrier(0)
    Unit cur, nxt; int ui = 0;
    if (!S.next(0, cur)) return;
    f32x4 acc[2][2][4][2];
#pragma unroll
    for (int a = 0; a < 2; ++a)
#pragma unroll
        for (int b = 0; b < 2; ++b)
#pragma unroll
            for (int m = 0; m < 4; ++m)
#pragma unroll
                for (int n = 0; n < 2; ++n) acc[a][b][m][n] = (f32x4){0.f, 0.f, 0.f, 0.f};
    bf16x8 At[4][2], B0[2][2], B1[2][2];
    const char* cA = (const char*)g.A + (size_t)cur.pm * tstep + (size_t)cur.k0 * 2; const char* cB = (const char*)g.Bt + (size_t)cur.pn * tstep + (size_t)cur.k0 * 2;
    S.a_ready(cur);
    PG8_STAGE(PG8_SB(0, 0), cB, voffB); PG8_STAGE(PG8_SB(0, 1), cB + hstep, voffB); PG8_STAGE(PG8_SA(0, 0), cA, voffA); PG8_STAGE(PG8_SA(0, 1), cA + hstep, voffA);
    if (wr == 1) PG8_BAR;
    PG8_WAIT_V(2); PG8_BAR;
    PG8_STAGE(PG8_SB(1, 0), cB + kstep, voffB); PG8_STAGE(PG8_SA(1, 0), cA + kstep, voffA); PG8_STAGE(PG8_SB(1, 1), cB + hstep + kstep, voffB);
    PG8_WAIT_V(6); PG8_BAR;
    PG8_STAMP();
    for (;;) {
        const bool has_next = S.next(ui + 1, nxt);
        const char* nA = has_next ? (const char*)g.A + (size_t)nxt.pm * tstep + (size_t)nxt.k0 * 2 : cA; const char* nB = has_next ? (const char*)g.Bt + (size_t)nxt.pn * tstep + (size_t)nxt.k0 * 2 : cB;
        const int nt = cur.nt;
        for (int t = 0; t < nt; t += 2) {
            const bool last = (t == nt - 2);
            const char* a1 = cA + (size_t)(t + 1) * kstep;
            const char* a2 = last ? nA : cA + (size_t)(t + 2) * kstep; const char* b2 = last ? nB : cB + (size_t)(t + 2) * kstep;
            const char* a3 = a2 + kstep; const char* b3 = b2 + kstep;
            if (last && has_next) S.a_ready(nxt);
            PG8_LDB(B0, 0, 0); PG8_LDB(B1, 0, 1); PG8_SCHED; PG8_LDA(At, 0, 0); PG8_STAGE(PG8_SA(1, 1), a1 + hstep, voffA);
            PG8_WAIT_V(8); PG8_WAIT_L(0); PG8_BAR; PG8_MMA(0, 0, At, B0); PG8_MMA(0, 1, At, B1); PG8_BAR; PG8_SCHED;
            PG8_LDA(At, 0, 1); PG8_STAGE(PG8_SB(0, 0), b2, voffB); PG8_STAGE(PG8_SB(0, 1), b2 + hstep, voffB); PG8_STAGE(PG8_SA(0, 0), a2, voffA);
            PG8_WAIT_V(8); PG8_WAIT_L(0); PG8_BAR; PG8_MMA(1, 0, At, B0); PG8_MMA(1, 1, At, B1); PG8_BAR; PG8_SCHED;
            PG8_LDB(B0, 1, 0); PG8_LDB(B1, 1, 1); PG8_SCHED; PG8_LDA(At, 1, 0); PG8_STAGE(PG8_SA(0, 1), a2 + hstep, voffA);
            PG8_WAIT_V(8); PG8_WAIT_L(0); PG8_BAR; PG8_MMA(0, 0, At, B0); PG8_MMA(0, 1, At, B1); PG8_BAR; PG8_SCHED;
            PG8_LDA(At, 1, 1); PG8_STAGE(PG8_SB(1, 0), b3, voffB); PG8_STAGE(PG8_SB(1, 1), b3 + hstep, voffB); PG8_STAGE(PG8_SA(1, 0), a3, voffA);
            PG8_WAIT_V(8); PG8_WAIT_L(0); PG8_BAR; PG8_MMA(1, 0, At, B0); PG8_MMA(1, 1, At, B1); PG8_BAR; PG8_SCHED;
        }
        PG8_STAMP();
        if (wr == 0) PG8_BAR;
        if constexpr (!Epi::AFTER_DRAIN) { E(acc, cur, wr, wc, fr, fq); S.done(cur); }
        PG8_STAMP();
        if (!has_next) break;
#pragma unroll
        for (int a = 0; a < 2; ++a)
#pragma unroll
            for (int b = 0; b < 2; ++b)
#pragma unroll
                for (int m = 0; m < 4; ++m)
#pragma unroll
                    for (int n = 0; n < 2; ++n) acc[a][b][m][n] = (f32x4){0.f, 0.f, 0.f, 0.f};
        cur = nxt; cA = nA; cB = nB; ++ui;
        if (wr == 1) PG8_BAR;
    }
    PG8_WAIT_V(0);
    PG8_BAR;
    if constexpr (Epi::AFTER_DRAIN) { E.fused(acc, cur, wr, wc, fr, fq, lds, wid, lane); S.done(cur); }
    PG8_STAMP();
    if (STAMP && wid == 0) { stamps[lane] = lane < nts ? (((unsigned long long)(unsigned)ts_hi << 32) | (unsigned)ts_lo) : 0ull;
        if (lane == 62) stamps[62] = rt_entry; if (lane == 63) stamps[63] = (unsigned long long)wall_clock64(); }
#undef PG8_STAMP
#undef PG8_SA
#undef PG8_SB
#undef PG8_STAGE
#undef PG8_LDA
#undef PG8_LDB
#undef PG8_MMA
#undef PG8_WAIT_V
#undef PG8_WAIT_L
#undef PG8_BAR
#undef PG8_SCHED
}
}
using pg8::bf16_t; using pg8::bf16x8; using pg8::f32x4; using pg8::u32x4; using pg8::Unit; using pg8::cvt_pk_bf16;
#define LAS __attribute__((address_space(3)))
typedef unsigned u32x2 __attribute__((ext_vector_type(2)));
#define XB_TMO      128
#define XB_XCNT(j)  (256  + 64 * (j))
#define XB_XSUB(j)  (1280 + 64 * (j))
#define XB_XGEN(j)  (2304 + 64 * (j))
#define XB_TOP      3328
#define XB_TOPGEN   3392
#define XCD_BAR_WORDS 3456
#define XB_SPIN_CAP (1u << 18)

__device__ __forceinline__ unsigned xb_ld(unsigned* p)              { return __hip_atomic_load(p, __ATOMIC_RELAXED, __HIP_MEMORY_SCOPE_AGENT); }
__device__ __forceinline__ unsigned xb_add(unsigned* p, unsigned v) { return __hip_atomic_fetch_add(p, v, __ATOMIC_RELAXED, __HIP_MEMORY_SCOPE_AGENT); }
__device__ __forceinline__ unsigned xb_xcc_id() { return (unsigned)__builtin_amdgcn_s_getreg((3 << 11) | 20) & 0xFu; }
#define XB_SPIN(cond, bar) do { unsigned _sp = 0; while (cond) { __builtin_amdgcn_s_sleep(1); \
    if ((++_sp & 255u) == 0u) { if (xb_ld(&(bar)[XB_TMO])) break; if (_sp > XB_SPIN_CAP) { atomicAdd(&(bar)[XB_TMO], 1u); break; } } } } while (0)

struct XcdBarrier {
    unsigned* bar; unsigned x;
    volatile LAS unsigned* st;
};

__device__ __forceinline__ XcdBarrier xcd_barrier_post(unsigned* bar, volatile LAS unsigned* st) {
    XcdBarrier b; b.bar = bar; b.x = xb_xcc_id(); b.st = st;
    if (threadIdx.x == 0) (void)xb_add(&bar[XB_XCNT(b.x)], 1u);
    return b;
}
__device__ __forceinline__ void xcd_barrier_complete(unsigned* bar, unsigned x, unsigned& nloc, unsigned& nx) {
    const unsigned G = gridDim.x * gridDim.y * gridDim.z;
    unsigned sum, cnt, mine, sp = 0u;
    for (;;) {
        sum = 0u; cnt = 0u; mine = 0u;
#pragma unroll
        for (unsigned j = 0; j < 16; ++j) { const unsigned c = xb_ld(&bar[XB_XCNT(j)]); sum += c; cnt += (c > 0u) ? 1u : 0u; mine = (j == x) ? c : mine; }
        if (sum == G) break;
        __builtin_amdgcn_s_sleep(1);
        if ((++sp & 255u) == 0u) { if (xb_ld(&bar[XB_TMO])) break; if (sp > XB_SPIN_CAP) { atomicAdd(&bar[XB_TMO], 1u); break; } }
    }
    nloc = mine > 0u ? mine : 1u; nx = cnt > 0u ? cnt : 1u;
}

__device__ __forceinline__ void xcd_barrier(const XcdBarrier& b) {
    asm volatile("s_waitcnt vmcnt(0)" ::: "memory");
    __syncthreads();
    if (threadIdx.x == 0) {
        unsigned* bar = b.bar;
        __builtin_amdgcn_s_waitcnt(0);
        unsigned nloc = b.st[0], nx = b.st[1];
        if (nloc == 0u) { xcd_barrier_complete(bar, b.x, nloc, nx); b.st[0] = nloc; b.st[1] = nx; }
        const unsigned old = xb_add(&bar[XB_XSUB(b.x)], 1u);
        const unsigned gen = old / nloc;
        if (old + 1u == (gen + 1u) * nloc) {
            __builtin_amdgcn_fence(__ATOMIC_RELEASE, "agent");
            asm volatile("s_waitcnt vmcnt(0)" ::: "memory");
            const unsigned og = xb_add(&bar[XB_TOP], 1u);
            const unsigned tg = og / nx;
            if (og + 1u == (tg + 1u) * nx) xb_add(&bar[XB_TOPGEN], 1u);
            else XB_SPIN(xb_ld(&bar[XB_TOPGEN]) == tg, bar);
            __builtin_amdgcn_fence(__ATOMIC_ACQUIRE, "agent");
            xb_add(&bar[XB_XGEN(b.x)], 1u);
            asm volatile("s_waitcnt vmcnt(0)" ::: "memory");
        } else {
            XB_SPIN(xb_ld(&bar[XB_XGEN(b.x)]) == gen, bar);
            __builtin_amdgcn_fence(__ATOMIC_ACQUIRE, "agent");
            asm volatile("s_waitcnt vmcnt(0)" ::: "memory");
        }
    }
    __syncthreads();
}


constexpr int DM = 1024, NBATCH = 8, TT = 2064, NSAMP = 128, MP = NBATCH * TT  , MTOK = MP + NSAMP  ;
constexpr int DIN = 3584, DSSM = 512, DFF = 3072, NG = 32, NCHUNK = 129, NR = NBATCH * NCHUNK  ;
constexpr int C_US = 1024, C_GA = 1536, C_GB = 2560;
constexpr float ALPHA = 1.189207115002721f, LN_EPS = 1e-5f;
enum { I_XP = 0, I_XS, I_CCL, I_SL, I_SSR, I_SSI, I_CCF, I_META, I_EG, I_EB, I_WIN, I_BIN, I_CLW, I_CLB, I_WR, I_BR, I_WI, I_BI, I_LAM,
       I_SLRE, I_SLIM, I_SLDT, I_SBRE, I_SBIM, I_SCRE, I_SCIM, I_SD, I_WGLU, I_BGLU, I_WOUT, I_BOUT, I_L1G, I_L1B, I_WUP, I_BUP, I_FCW, I_FCB,
       I_WDOWN, I_BDOWN, I_L2G, I_L2B, N_IN };
constexpr size_t O_YP = 0, O_YS = 16777216, O_PCL = O_YS + 131072, O_PL = O_PCL + 24576, O_PSR = O_PL + 8192, O_PSI = O_PSR + 16384, O_PCF = O_PSI + 16384,
                 O_SCL = O_PCF + 49152, O_SL = O_SCL + 393216, O_SSR = O_SL + 131072, O_SSI = O_SSR + 262144, O_SCF = O_SSI + 262144, O_END = O_SCF + 786432;
constexpr size_t W_WTUP = 0, W_WTDOWN = W_WTUP + (size_t)6144 * 1024 * 2, W_XN = W_WTDOWN + (size_t)1024 * 3072 * 2, W_C = W_XN + (size_t)MTOK * 1024 * 2;
constexpr size_t W_PROJ = W_C, W_MIX = W_PROJ + (size_t)MTOK * DIN * 2, W_YSG = W_MIX + (size_t)MTOK * 1024 * 2, W_D = W_YSG + (size_t)MTOK * 512 * 2;
constexpr size_t W_WTGLU = W_D, W_WTOUT = W_WTGLU + (size_t)2048 * 512 * 2, W_WTR = W_WTOUT + (size_t)1024 * 1024 * 2, W_WTI = W_WTR + 262144, W_W1 = W_WTI + 262144,
                 W_W2 = W_W1 + (size_t)NG * 128 * 256 * 2, W_HPREV = W_W2 + (size_t)NG * 256 * 384 * 2, W_A1 = W_HPREV + (size_t)NR * NG * 128 * 2, W_A16 = W_A1 + 16384,
                 W_BBAR = W_A16 + 16384, W_LRUA = W_BBAR + 262144, W_LRUH = W_LRUA + 262144, W_LRUC = W_LRUH + 262144, W_S = W_LRUC + 262144, W_WTIN = W_S,
                 W_S_END = W_S + (size_t)NR * NG * 128 * 4;
constexpr size_t W_BAR = (W_S_END + 4095) / 4096 * 4096;
static_assert(W_BAR + (XCD_BAR_WORDS + 64 * 16) * 4 <= 268435456, "barrier words");
constexpr size_t W_PART = W_C + (size_t)MTOK * 1024 * 4;
constexpr size_t W_SBG = W_C, W_SBV = W_SBG + (size_t)260 * 4 * DFF * 4, W_SB_END = W_SBV + (size_t)260 * 2 * DFF * 4;
constexpr size_t W_PU = W_SB_END, W_PU_END = W_PU + (size_t)4 * 256 * 6144 * 4;
constexpr size_t W_PG = W_S;
constexpr size_t W_R1 = W_C, W_G = W_C, W_V = W_G + (size_t)MTOK * DFF * 2, W_V_END = W_V + (size_t)MTOK * DFF * 2, W_R2 = W_C;
static_assert(W_S_END <= 268435456 && W_V_END <= 268435456, "workspace map exceeds 256 MiB");
static_assert(W_SB_END <= W_V && W_PU_END <= W_V, "side buffers / up partials overlap H");
static_assert(W_PART + (size_t)12 * 256 * 1024 * 4 <= W_MIX && W_PART + (size_t)12 * 256 * 1024 * 4 <= W_V, "r1 / partials overlap mix or v");

constexpr int LDS_TOTAL = 147456;
struct P { const float* in[N_IN]; float* out; unsigned char* ws; };

__device__ __forceinline__ float bf2f(unsigned short b) { return __uint_as_float(((unsigned)b) << 16); }
__device__ __forceinline__ float bflo(unsigned u) { return __uint_as_float(u << 16); }
__device__ __forceinline__ float bfhi(unsigned u) { return __uint_as_float(u & 0xffff0000u); }
__device__ __forceinline__ unsigned short f2bf(float f) { return (unsigned short)(cvt_pk_bf16(f, 0.f) & 0xffffu); }
__device__ __forceinline__ float sigm(float x) { return __builtin_amdgcn_rcpf(1.f + __expf(-x)); }
__device__ __forceinline__ float gelu_tanh(float x) { return x * sigm(1.5957691216057308f * (x + 0.044715f * x * x * x)); }
typedef float f32x2 __attribute__((ext_vector_type(2)));
__device__ __forceinline__ f32x2 gelu_pk2(f32x2 x) {
    const f32x2 t = x * ((x * x) * (-0.10294324f) + (-2.3022082f));
    f32x2 e; e.x = __builtin_amdgcn_exp2f(t.x); e.y = __builtin_amdgcn_exp2f(t.y);
    const f32x2 d = e + 1.0f; f32x2 r; r.x = __builtin_amdgcn_rcpf(d.x); r.y = __builtin_amdgcn_rcpf(d.y);
    return x * r;
}
__device__ __forceinline__ float wave_sum(float v) {
#pragma unroll
    for (int o = 1; o < 64; o <<= 1) v += __shfl_xor(v, o);
    return v;
}
#define LDS_WAIT() asm volatile("s_waitcnt lgkmcnt(0)" ::: "memory")
#define REPEAT(N) for (int rep_ = 0; rep_ < (N); ++rep_)
#define TIMED(N) const unsigned long long tq0_##N = (PROBE_PHASE == (N)) ? __builtin_amdgcn_s_memrealtime() : 0ull;
#define TIMED_END(N) if (PROBE_PHASE == (N)) { const unsigned long long tq1 = __builtin_amdgcn_s_memrealtime(); while (__builtin_amdgcn_s_memrealtime() - tq1 < tq1 - tq0_##N) __builtin_amdgcn_s_sleep(4); }

struct EpiProj {
    static constexpr bool PERM = true, AFTER_DRAIN = false;
    bf16_t* O; const float* bias; bf16_t* UT;
    __device__ __forceinline__ void operator()(const f32x4 (&acc)[2][2][4][2], const Unit& u, int wr, int wc, int fr, int fq) const {
        const int row0 = u.pm * 256 + wr * 64 + fr, col0 = u.pn * 256 + wc * 32 + 8 * fq;
        if (u.pn == 4 || u.pn == 5) {
#pragma unroll
            for (int bj = 0; bj < 2; ++bj) { const int col = col0 + bj * 128; const f32x4 b0 = *(const f32x4*)(bias + col), b1 = *(const f32x4*)(bias + col + 4); const int cu = col - C_US, g = cu >> 4, hh = cu & 15;
#pragma unroll
                for (int ai = 0; ai < 2; ++ai)
#pragma unroll
                    for (int m = 0; m < 4; ++m) { const int row = row0 + ai * 128 + m * 16; const f32x4 v0 = acc[ai][bj][m][0] + b0, v1 = acc[ai][bj][m][1] + b1; u32x4 w;
                        w.x = cvt_pk_bf16(v0[0], v0[1]); w.y = cvt_pk_bf16(v0[2], v0[3]); w.z = cvt_pk_bf16(v1[0], v1[1]); w.w = cvt_pk_bf16(v1[2], v1[3]);
                        size_t o; if (row < MP) { const int b = row / TT, t = row - b * TT; o = ((size_t)(b * NG + g) * TT + t) * 16 + hh; } else o = (size_t)MP * DSSM + ((size_t)(row - MP) * NG + g) * 16 + hh;
                        *(u32x4*)(UT + o) = w; } }
            return; }
#pragma unroll
        for (int bj = 0; bj < 2; ++bj) { const int col = col0 + bj * 128; const f32x4 b0 = *(const f32x4*)(bias + col), b1 = *(const f32x4*)(bias + col + 4);
#pragma unroll
            for (int ai = 0; ai < 2; ++ai)
#pragma unroll
                for (int m = 0; m < 4; ++m) { const f32x4 v0 = acc[ai][bj][m][0] + b0, v1 = acc[ai][bj][m][1] + b1; u32x4 w;
                    w.x = cvt_pk_bf16(v0[0], v0[1]); w.y = cvt_pk_bf16(v0[2], v0[3]); w.z = cvt_pk_bf16(v1[0], v1[1]); w.w = cvt_pk_bf16(v1[2], v1[3]);
                    *(u32x4*)(O + (size_t)(row0 + ai * 128 + m * 16) * DIN + col) = w; } }
    }
};
struct EpiGlu {
    static constexpr bool PERM = true, AFTER_DRAIN = false;
    bf16_t* mix; const bf16_t* m2; const float* carry; const bf16_t* proj; const float* bias;
    __device__ __forceinline__ void operator()(const f32x4 (&acc)[2][2][4][2], const Unit& u, int wr, int wc, int fr, int fq) const {
        const int row0 = u.pm * 256 + wr * 64 + fr, j = u.pn * 128 + wc * 32 + 8 * fq;
        const f32x4 bv0 = *(const f32x4*)(bias + j), bv1 = *(const f32x4*)(bias + j + 4), bg0 = *(const f32x4*)(bias + 1024 + j), bg1 = *(const f32x4*)(bias + 1024 + j + 4);
#pragma unroll
        for (int ai = 0; ai < 2; ++ai)
#pragma unroll
            for (int mp = 0; mp < 2; ++mp) { u32x4 gbw[2], mw[2], m2w[2]; f32x4 cv0[2], cv1[2];
#pragma unroll
                for (int mm = 0; mm < 2; ++mm) { const int rowi = row0 + ai * 128 + (2 * mp + mm) * 16; const size_t row = (size_t)rowi; int cidx = 0;
                    if (rowi < MP) { const int b = rowi / TT, t = rowi - b * TT; int kc = t >> 8; kc = kc > 7 ? 7 : kc; cidx = (b * 8 + kc) * 1024; }
                    cv0[mm] = *(const f32x4*)(carry + cidx + j); cv1[mm] = *(const f32x4*)(carry + cidx + j + 4);
                    gbw[mm] = *(const u32x4*)(proj + row * DIN + C_GB + j); mw[mm] = *(const u32x4*)(mix + row * 1024 + j); m2w[mm] = *(const u32x4*)(m2 + row * 1024 + j); }
#pragma unroll
                for (int mm = 0; mm < 2; ++mm) { const int m = 2 * mp + mm; const size_t row = (size_t)(row0 + ai * 128 + m * 16);
                    const f32x4 val0 = acc[ai][0][m][0] + bv0, val1 = acc[ai][0][m][1] + bv1, gate0 = acc[ai][1][m][0] + bg0, gate1 = acc[ai][1][m][1] + bg1;
                    const float o0 = bflo(mw[mm].x) + bflo(m2w[mm].x) * cv0[mm][0] + sigm(bflo(gbw[mm].x)) * val0[0] * sigm(gate0[0]), o1 = bfhi(mw[mm].x) + bfhi(m2w[mm].x) * cv0[mm][1] + sigm(bfhi(gbw[mm].x)) * val0[1] * sigm(gate0[1]);
                    const float o2 = bflo(mw[mm].y) + bflo(m2w[mm].y) * cv0[mm][2] + sigm(bflo(gbw[mm].y)) * val0[2] * sigm(gate0[2]), o3 = bfhi(mw[mm].y) + bfhi(m2w[mm].y) * cv0[mm][3] + sigm(bfhi(gbw[mm].y)) * val0[3] * sigm(gate0[3]);
                    const float o4 = bflo(mw[mm].z) + bflo(m2w[mm].z) * cv1[mm][0] + sigm(bflo(gbw[mm].z)) * val1[0] * sigm(gate1[0]), o5 = bfhi(mw[mm].z) + bfhi(m2w[mm].z) * cv1[mm][1] + sigm(bfhi(gbw[mm].z)) * val1[1] * sigm(gate1[1]);
                    const float o6 = bflo(mw[mm].w) + bflo(m2w[mm].w) * cv1[mm][2] + sigm(bflo(gbw[mm].w)) * val1[2] * sigm(gate1[2]), o7 = bfhi(mw[mm].w) + bfhi(m2w[mm].w) * cv1[mm][3] + sigm(bfhi(gbw[mm].w)) * val1[3] * sigm(gate1[3]);
                    u32x4 w; w.x = cvt_pk_bf16(o0, o1); w.y = cvt_pk_bf16(o2, o3); w.z = cvt_pk_bf16(o4, o5); w.w = cvt_pk_bf16(o6, o7); *(u32x4*)(mix + row * 1024 + j) = w; } }
    }
};
struct EpiRes {
    static constexpr bool PERM = true, AFTER_DRAIN = false;
    bf16_t* R; const bf16_t* X; const float* bias; float* part;
    __device__ __forceinline__ void operator()(const f32x4 (&acc)[2][2][4][2], const Unit& u, int wr, int wc, int fr, int fq) const {
        const int row0 = u.pm * 256 + wr * 64 + fr, col0 = u.pn * 256 + wc * 32 + 8 * fq;
        if (u.ks >= 0) { float* pp = part + ((size_t)u.ks * 256 - 16384) * 1024;
#pragma unroll
            for (int bj = 0; bj < 2; ++bj)
#pragma unroll
                for (int n = 0; n < 2; ++n)
#pragma unroll
                    for (int ai = 0; ai < 2; ++ai)
#pragma unroll
                        for (int m = 0; m < 4; ++m) *(f32x4*)(pp + (size_t)(row0 + ai * 128 + m * 16) * 1024 + col0 + bj * 128 + n * 4) = acc[ai][bj][m][n];
            return; }
#pragma unroll
        for (int bj = 0; bj < 2; ++bj) { const int col = col0 + bj * 128; const f32x4 b0 = *(const f32x4*)(bias + col), b1 = *(const f32x4*)(bias + col + 4);
            u32x4 xw[2][4];
#pragma unroll
            for (int ai = 0; ai < 2; ++ai)
#pragma unroll
                for (int m = 0; m < 4; ++m) xw[ai][m] = *(const u32x4*)(X + (size_t)(row0 + ai * 128 + m * 16) * 1024 + col);
#pragma unroll
            for (int ai = 0; ai < 2; ++ai)
#pragma unroll
                for (int m = 0; m < 4; ++m) { const size_t off = (size_t)(row0 + ai * 128 + m * 16) * 1024 + col; const u32x4 x = xw[ai][m];
                    f32x4 v0 = acc[ai][bj][m][0] + b0, v1 = acc[ai][bj][m][1] + b1;
                    v0[0] += ALPHA * bflo(x.x); v0[1] += ALPHA * bfhi(x.x); v0[2] += ALPHA * bflo(x.y); v0[3] += ALPHA * bfhi(x.y);
                    v1[0] += ALPHA * bflo(x.z); v1[1] += ALPHA * bfhi(x.z); v1[2] += ALPHA * bflo(x.w); v1[3] += ALPHA * bfhi(x.w);
                    u32x4 w; w.x = cvt_pk_bf16(v0[0], v0[1]); w.y = cvt_pk_bf16(v0[2], v0[3]); w.z = cvt_pk_bf16(v1[0], v1[1]); w.w = cvt_pk_bf16(v1[2], v1[3]); *(u32x4*)(R + off) = w; } }
    }
};
__device__ __forceinline__ float rot1(float x) { return __int_as_float(__builtin_amdgcn_update_dpp(0, __float_as_int(x), 0x121, 0xf, 0xf, false)); }
__device__ __forceinline__ float rot2(float x) { return __int_as_float(__builtin_amdgcn_update_dpp(0, __float_as_int(x), 0x122, 0xf, 0xf, false)); }
struct EpiUp {
    static constexpr bool PERM = true, AFTER_DRAIN = false;
    bf16_t* H; const float* bias; float* out; const float* cw; const float* cb; const float* cache; float* sbg; float* sbv;
    __device__ __forceinline__ void operator()(const f32x4 (&acc)[2][2][4][2], const Unit& u, int wr, int wc, int fr, int fq) const {
        const int c0 = u.pn * 128 + wc * 32 + 8 * fq;
        f32x4 bg[2], bv[2], w0[2], w1[2], w2[2], cbv[2];
#pragma unroll
        for (int n = 0; n < 2; ++n) { const int ch = c0 + 4 * n; bg[n] = *(const f32x4*)(bias + ch); bv[n] = *(const f32x4*)(bias + DFF + ch);
            w0[n] = *(const f32x4*)(cw + ch); w1[n] = *(const f32x4*)(cw + DFF + ch); w2[n] = *(const f32x4*)(cw + 2 * DFF + ch); cbv[n] = *(const f32x4*)(cb + ch); }
#pragma unroll
        for (int ai = 0; ai < 2; ++ai) { const int blk = u.pm * 4 + ai * 2 + wr, r0 = blk * 64;
            f32x4 gp1[2], gp2[2];
#pragma unroll
            for (int n = 0; n < 2; ++n) { gp1[n] = (f32x4){0.f, 0.f, 0.f, 0.f}; gp2[n] = (f32x4){0.f, 0.f, 0.f, 0.f}; }
#pragma unroll
            for (int m = 0; m < 4; ++m) { const int row = r0 + 16 * m + fr; const int b = row / TT, t = row - b * TT; float h[8];
#pragma unroll
                for (int n = 0; n < 2; ++n) { const int ch = c0 + 4 * n; const f32x4 g = acc[ai][0][m][n] + bg[n], v = acc[ai][1][m][n] + bv[n];
                    f32x4 a1, a2; a1[0] = rot1(g[0]); a1[1] = rot1(g[1]); a1[2] = rot1(g[2]); a1[3] = rot1(g[3]); a2[0] = rot2(g[0]); a2[1] = rot2(g[1]); a2[2] = rot2(g[2]); a2[3] = rot2(g[3]);
                    f32x4 g1 = (fr >= 1) ? a1 : gp1[n], g2 = (fr >= 2) ? a2 : gp2[n];
                    if (t == 0) g1 = (f32x4){0.f, 0.f, 0.f, 0.f}; if (t <= 1) g2 = (f32x4){0.f, 0.f, 0.f, 0.f};
                    if (t >= TT - 2) *(f32x4*)(out + O_PCF + ((size_t)b * 2 + (t - (TT - 2))) * DFF + ch) = g;
                    if (m == 0 && fr < 2) { *(f32x4*)(sbg + ((size_t)blk * 4 + fr) * DFF + ch) = g; *(f32x4*)(sbv + ((size_t)blk * 2 + fr) * DFF + ch) = v; }
                    if (m == 3 && fr >= 14) *(f32x4*)(sbg + ((size_t)blk * 4 + fr - 12) * DFF + ch) = g;
                    const f32x4 y = cbv[n] + w0[n] * g2 + w1[n] * g1 + w2[n] * g;
                    { const f32x2 ga_ = gelu_pk2((f32x2){y[0], y[1]}) * (f32x2){v[0], v[1]}, gb_ = gelu_pk2((f32x2){y[2], y[3]}) * (f32x2){v[2], v[3]}; h[4 * n] = ga_.x; h[4 * n + 1] = ga_.y; h[4 * n + 2] = gb_.x; h[4 * n + 3] = gb_.y; }
                    gp1[n] = a1; gp2[n] = a2; }
                u32x4 w; w.x = cvt_pk_bf16(h[0], h[1]); w.y = cvt_pk_bf16(h[2], h[3]); w.z = cvt_pk_bf16(h[4], h[5]); w.w = cvt_pk_bf16(h[6], h[7]); *(u32x4*)(H + (size_t)row * DFF + c0) = w; } }
    }
};
struct EpiRaw {
    static constexpr bool PERM = false, AFTER_DRAIN = false;
    float* pu; int ld;
    __device__ __forceinline__ void operator()(const f32x4 (&acc)[2][2][4][2], const Unit& u, int wr, int wc, int fr, int fq) const {
        float* pp = pu + (size_t)u.ks * 256 * ld + (size_t)(wr * 64 + fr) * ld + u.pn * 256 + wc * 32 + 4 * fq;
#pragma unroll
        for (int ai = 0; ai < 2; ++ai)
#pragma unroll
            for (int m = 0; m < 4; ++m)
#pragma unroll
                for (int bj = 0; bj < 2; ++bj)
#pragma unroll
                    for (int n = 0; n < 2; ++n) *(f32x4*)(pp + (size_t)(ai * 128 + m * 16) * ld + bj * 128 + n * 16) = acc[ai][bj][m][n];
    }
};
template <class Epi> __device__ __forceinline__ void run_gemm(LAS unsigned char* lds, int vc, const bf16_t* A, const bf16_t* Bt, int N, int K, const Epi& E) {
    pg8::Gemm g; g.A = A; g.Bt = Bt; g.M = MTOK; g.N = N; g.K = K;
    pg8::StaticOrder S; S.init(MTOK, N, K, (int)gridDim.x, vc);
    pg8::gemm_phase<Epi, pg8::StaticOrder, false>(lds, g, S, E, nullptr);
}

template <class Epi> __device__ __forceinline__ void run_gemm_split(LAS unsigned char* lds, int vc, const bf16_t* A, const bf16_t* Bt, int N, int K, int nsplit, const Epi& E) {
    pg8::Gemm g; g.A = A; g.Bt = Bt; g.M = MTOK; g.N = N; g.K = K;
    pg8::SplitOrder S; S.init(N, K, nsplit, (int)gridDim.x, vc);
    pg8::gemm_phase<Epi, pg8::SplitOrder, false>(lds, g, S, E, nullptr);
}

template <class Epi> __device__ __forceinline__ void run_gemm_main64(LAS unsigned char* lds, int vc, const bf16_t* A, const bf16_t* Bt, int N, int K, const Epi& E) {
    pg8::Gemm g; g.A = A; g.Bt = Bt; g.M = 16384; g.N = N; g.K = K;
    pg8::StaticOrder S; S.init(16384, N, K, (int)gridDim.x, vc);
    pg8::gemm_phase<Epi, pg8::StaticOrder, false>(lds, g, S, E, nullptr);
}
__device__ __forceinline__ void run_gemm_tail(LAS unsigned char* lds, int vc, const bf16_t* A, const bf16_t* Bt, int N, int K, int nsplit, float* pu) {
    pg8::Gemm g; g.A = A; g.Bt = Bt; g.M = MTOK; g.N = N; g.K = K;
    pg8::TailOrder S; S.init(N, K, nsplit, (int)gridDim.x, vc);
    EpiRaw E; E.pu = pu; E.ld = N;
    pg8::gemm_phase<EpiRaw, pg8::TailOrder, false>(lds, g, S, E, nullptr);
}

__device__ __forceinline__ void transpose_item(const float* W, int N, bf16_t* WT, int K, int k0, int srcn0, int dstn0, LAS float* scr, int lane) {
    float tv[32];
#pragma unroll
    for (int i = 0; i < 32; ++i) tv[i] = W[(size_t)(k0 + 2 * i + (lane >> 5)) * N + srcn0 + (lane & 31)];
#pragma unroll
    for (int i = 0; i < 32; ++i) scr[(2 * i + (lane >> 5)) * 33 + (lane & 31)] = tv[i];
    LDS_WAIT();
    const int c = lane & 7;
#pragma unroll
    for (int j = 0; j < 4; ++j) { const int n = (lane >> 3) + 8 * j; const LAS float* s = scr + (8 * c) * 33 + n;
        u32x4 o; o.x = cvt_pk_bf16(s[0 * 33], s[1 * 33]); o.y = cvt_pk_bf16(s[2 * 33], s[3 * 33]); o.z = cvt_pk_bf16(s[4 * 33], s[5 * 33]); o.w = cvt_pk_bf16(s[6 * 33], s[7 * 33]);
        *(u32x4*)(WT + (size_t)(dstn0 + n) * K + k0 + 8 * c) = o; }
    LDS_WAIT();
}
__device__ __forceinline__ const float* src_row(const P& p, int r) {
    if (r < MP) { const int b = r / TT, t = r - b * TT; return t < 16 ? p.in[I_META] + (size_t)t * DM : p.in[I_XP] + ((size_t)b * 2048 + (t - 16)) * DM; }
    return p.in[I_XS] + (size_t)(r - MP) * DM;
}
template <bool OUT_BF16> __device__ __forceinline__ void ln_row(const float* xrow, const float* g, const float* bta, void* orow, int lane, int nsplit = 0, const bf16_t* xres = nullptr, const float* rbias = nullptr) {
    f32x4 v[4]; float s = 0.f;
#pragma unroll
    for (int j = 0; j < 4; ++j) { v[j] = *(const f32x4*)(xrow + 4 * lane + 256 * j);
        if (nsplit > 0) { for (int k = 1; k < nsplit; ++k) v[j] += *(const f32x4*)(xrow + (size_t)k * 256 * 1024 + 4 * lane + 256 * j);
            const u32x2 xw = *(const u32x2*)(xres + 4 * lane + 256 * j); const f32x4 bv = *(const f32x4*)(rbias + 4 * lane + 256 * j);
            v[j][0] += ALPHA * bflo(xw.x) + bv[0]; v[j][1] += ALPHA * bfhi(xw.x) + bv[1]; v[j][2] += ALPHA * bflo(xw.y) + bv[2]; v[j][3] += ALPHA * bfhi(xw.y) + bv[3]; }
        s += (v[j][0] + v[j][1]) + (v[j][2] + v[j][3]); }
    const float mean = wave_sum(s) * (1.f / DM); float s2 = 0.f;
#pragma unroll
    for (int j = 0; j < 4; ++j) { v[j] = v[j] - mean; s2 += (v[j][0] * v[j][0] + v[j][1] * v[j][1]) + (v[j][2] * v[j][2] + v[j][3] * v[j][3]); }
    const float rstd = 1.f / sqrtf(wave_sum(s2) * (1.f / DM) + LN_EPS);
#pragma unroll
    for (int j = 0; j < 4; ++j) { const f32x4 gg = *(const f32x4*)(g + 4 * lane + 256 * j), bb = *(const f32x4*)(bta + 4 * lane + 256 * j);
        const f32x4 o = (v[j] * rstd) * gg + bb;
        if (OUT_BF16) { u32x2 w; w.x = cvt_pk_bf16(o[0], o[1]); w.y = cvt_pk_bf16(o[2], o[3]); *(u32x2*)((bf16_t*)orow + 4 * lane + 256 * j) = w; }
        else *(f32x4*)((float*)orow + 4 * lane + 256 * j) = o; }
}
template <bool OUT_BF16> __device__ __forceinline__ void ln_rows2(const float* xa, const float* xb, const float* g, const float* bta, void* oa, void* ob, int lane, bool vb) {
    f32x4 va[4], vbv[4]; float sa = 0.f, sb = 0.f;
#pragma unroll
    for (int j = 0; j < 4; ++j) { va[j] = *(const f32x4*)(xa + 4 * lane + 256 * j); vbv[j] = *(const f32x4*)(xb + 4 * lane + 256 * j); }
#pragma unroll
    for (int j = 0; j < 4; ++j) { sa += (va[j][0] + va[j][1]) + (va[j][2] + va[j][3]); sb += (vbv[j][0] + vbv[j][1]) + (vbv[j][2] + vbv[j][3]); }
#pragma unroll
    for (int o = 1; o < 64; o <<= 1) { sa += __shfl_xor(sa, o); sb += __shfl_xor(sb, o); }
    const float ma = sa * (1.f / DM), mb = sb * (1.f / DM); float qa = 0.f, qb = 0.f;
#pragma unroll
    for (int j = 0; j < 4; ++j) { va[j] = va[j] - ma; vbv[j] = vbv[j] - mb; qa += (va[j][0] * va[j][0] + va[j][1] * va[j][1]) + (va[j][2] * va[j][2] + va[j][3] * va[j][3]);
        qb += (vbv[j][0] * vbv[j][0] + vbv[j][1] * vbv[j][1]) + (vbv[j][2] * vbv[j][2] + vbv[j][3] * vbv[j][3]); }
#pragma unroll
    for (int o = 1; o < 64; o <<= 1) { qa += __shfl_xor(qa, o); qb += __shfl_xor(qb, o); }
    const float ra = 1.f / sqrtf(qa * (1.f / DM) + LN_EPS), rb = 1.f / sqrtf(qb * (1.f / DM) + LN_EPS);
#pragma unroll
    for (int j = 0; j < 4; ++j) { const f32x4 gg = *(const f32x4*)(g + 4 * lane + 256 * j), bb = *(const f32x4*)(bta + 4 * lane + 256 * j);
        const f32x4 o1 = (va[j] * ra) * gg + bb, o2 = (vbv[j] * rb) * gg + bb;
        if (OUT_BF16) { u32x2 w; w.x = cvt_pk_bf16(o1[0], o1[1]); w.y = cvt_pk_bf16(o1[2], o1[3]); *(u32x2*)((bf16_t*)oa + 4 * lane + 256 * j) = w;
            if (vb) { w.x = cvt_pk_bf16(o2[0], o2[1]); w.y = cvt_pk_bf16(o2[2], o2[3]); *(u32x2*)((bf16_t*)ob + 4 * lane + 256 * j) = w; } }
        else { *(f32x4*)((float*)oa + 4 * lane + 256 * j) = o1; if (vb) *(f32x4*)((float*)ob + 4 * lane + 256 * j) = o2; } }
}
template <bool OUT_BF16> __device__ __forceinline__ void ln_rows2_bf(const bf16_t* xa, const bf16_t* xb, const float* g, const float* bta, void* oa, void* ob, int lane, bool vb) {
    float va[16], vq[16]; float sa = 0.f, sb = 0.f;
    { u32x4 ra[2], rb[2];
#pragma unroll
      for (int j = 0; j < 2; ++j) { ra[j] = *(const u32x4*)(xa + 8 * lane + 512 * j); rb[j] = *(const u32x4*)(xb + 8 * lane + 512 * j); }
#pragma unroll
      for (int j = 0; j < 2; ++j) { va[8 * j] = bflo(ra[j].x); va[8 * j + 1] = bfhi(ra[j].x); va[8 * j + 2] = bflo(ra[j].y); va[8 * j + 3] = bfhi(ra[j].y); va[8 * j + 4] = bflo(ra[j].z); va[8 * j + 5] = bfhi(ra[j].z); va[8 * j + 6] = bflo(ra[j].w); va[8 * j + 7] = bfhi(ra[j].w);
          vq[8 * j] = bflo(rb[j].x); vq[8 * j + 1] = bfhi(rb[j].x); vq[8 * j + 2] = bflo(rb[j].y); vq[8 * j + 3] = bfhi(rb[j].y); vq[8 * j + 4] = bflo(rb[j].z); vq[8 * j + 5] = bfhi(rb[j].z); vq[8 * j + 6] = bflo(rb[j].w); vq[8 * j + 7] = bfhi(rb[j].w); } }
#pragma unroll
    for (int e = 0; e < 16; ++e) { sa += va[e]; sb += vq[e]; }
#pragma unroll
    for (int o = 1; o < 64; o <<= 1) { sa += __shfl_xor(sa, o); sb += __shfl_xor(sb, o); }
    const float ma = sa * (1.f / DM), mb = sb * (1.f / DM); float qa = 0.f, qb = 0.f;
#pragma unroll
    for (int e = 0; e < 16; ++e) { va[e] -= ma; vq[e] -= mb; qa += va[e] * va[e]; qb += vq[e] * vq[e]; }
#pragma unroll
    for (int o = 1; o < 64; o <<= 1) { qa += __shfl_xor(qa, o); qb += __shfl_xor(qb, o); }
    const float ra_ = 1.f / sqrtf(qa * (1.f / DM) + LN_EPS), rb_ = 1.f / sqrtf(qb * (1.f / DM) + LN_EPS);
#pragma unroll
    for (int j = 0; j < 2; ++j) { const int c = 8 * lane + 512 * j; const f32x4 g0 = *(const f32x4*)(g + c), g1 = *(const f32x4*)(g + c + 4), b0 = *(const f32x4*)(bta + c), b1 = *(const f32x4*)(bta + c + 4);
        float o1[8], o2[8];
#pragma unroll
        for (int e = 0; e < 4; ++e) { o1[e] = va[8 * j + e] * ra_ * g0[e] + b0[e]; o1[4 + e] = va[8 * j + 4 + e] * ra_ * g1[e] + b1[e]; o2[e] = vq[8 * j + e] * rb_ * g0[e] + b0[e]; o2[4 + e] = vq[8 * j + 4 + e] * rb_ * g1[e] + b1[e]; }
        if (OUT_BF16) { u32x4 w; w.x = cvt_pk_bf16(o1[0], o1[1]); w.y = cvt_pk_bf16(o1[2], o1[3]); w.z = cvt_pk_bf16(o1[4], o1[5]); w.w = cvt_pk_bf16(o1[6], o1[7]); *(u32x4*)((bf16_t*)oa + c) = w;
            if (vb) { w.x = cvt_pk_bf16(o2[0], o2[1]); w.y = cvt_pk_bf16(o2[2], o2[3]); w.z = cvt_pk_bf16(o2[4], o2[5]); w.w = cvt_pk_bf16(o2[6], o2[7]); *(u32x4*)((bf16_t*)ob + c) = w; } }
        else { *(f32x4*)((float*)oa + c) = (f32x4){o1[0], o1[1], o1[2], o1[3]}; *(f32x4*)((float*)oa + c + 4) = (f32x4){o1[4], o1[5], o1[6], o1[7]};
            if (vb) { *(f32x4*)((float*)ob + c) = (f32x4){o2[0], o2[1], o2[2], o2[3]}; *(f32x4*)((float*)ob + c + 4) = (f32x4){o2[4], o2[5], o2[6], o2[7]}; } } }
}
__device__ __forceinline__ void s5_precompute(const P& p, LAS unsigned char* lds, int g) {
    LAS float* apr = (LAS float*)lds;
    LAS float* api = apr + 17 * 64;
    LAS float* bbr = api + 17 * 64;
    LAS float* bbi = bbr + 1024;
    LAS float* cr = bbi + 1024;
    LAS float* ci = cr + 1024;
    LAS float* Kl = ci + 1024;
    int tid_ = threadIdx.x; asm volatile("" : "+v"(tid_)); const int tid = tid_;
    if (tid < 64) { const int pp = tid;
        const float dt = expf(p.in[I_SLDT][g]); const float lre = p.in[I_SLRE][g * 64 + pp], lim = p.in[I_SLIM][g * 64 + pp];
        const float mag = expf(lre * dt); const float ang = lim * dt; const float abr = mag * cosf(ang), abi = mag * sinf(ang);
        const float den = lre * lre + lim * lim, nr = abr - 1.0f, ni = abi; const float fre = (nr * lre + ni * lim) / den, fim = (ni * lre - nr * lim) / den;
        float pr = 1.f, pi = 0.f;
        for (int j = 0; j <= 16; ++j) { apr[j * 64 + pp] = pr; api[j * 64 + pp] = pi; const float nr2 = pr * abr - pi * abi, ni2 = pr * abi + pi * abr; pr = nr2; pi = ni2; }
        float* a1 = (float*)(p.ws + W_A1); float* a16 = (float*)(p.ws + W_A16); float* bbar = (float*)(p.ws + W_BBAR);
        a1[(g * 64 + pp) * 2] = abr; a1[(g * 64 + pp) * 2 + 1] = abi; a16[(g * 64 + pp) * 2] = apr[16 * 64 + pp]; a16[(g * 64 + pp) * 2 + 1] = api[16 * 64 + pp];
        for (int c = 0; c < 16; ++c) { const float br = p.in[I_SBRE][(g * 64 + pp) * 16 + c], bi = p.in[I_SBIM][(g * 64 + pp) * 16 + c];
            const float xr = fre * br - fim * bi, xi = fre * bi + fim * br; bbr[pp * 16 + c] = xr; bbi[pp * 16 + c] = xi;
            bbar[((g * 64 + pp) * 16 + c) * 2] = xr; bbar[((g * 64 + pp) * 16 + c) * 2 + 1] = xi; }
    }
    for (int i = tid; i < 1024; i += 512) { cr[i] = p.in[I_SCRE][g * 1024 + i]; ci[i] = p.in[I_SCIM][g * 1024 + i]; }
    __syncthreads();
    { const int j = tid >> 5, c1 = (tid >> 1) & 15, c0 = 8 * (tid & 1); float acc8[8];
#pragma unroll
      for (int e = 0; e < 8; ++e) acc8[e] = 0.f;
      for (int pp = 0; pp < 64; ++pp) { const float xr = cr[c1 * 64 + pp], xi = ci[c1 * 64 + pp], ar = apr[j * 64 + pp], ai = api[j * 64 + pp]; const float car = xr * ar - xi * ai, cai = xr * ai + xi * ar;
          const f32x4 r0 = *(const LAS f32x4*)(bbr + pp * 16 + c0), r1 = *(const LAS f32x4*)(bbr + pp * 16 + c0 + 4), i0 = *(const LAS f32x4*)(bbi + pp * 16 + c0), i1 = *(const LAS f32x4*)(bbi + pp * 16 + c0 + 4);
          acc8[0] += car * r0[0] - cai * i0[0]; acc8[1] += car * r0[1] - cai * i0[1]; acc8[2] += car * r0[2] - cai * i0[2]; acc8[3] += car * r0[3] - cai * i0[3];
          acc8[4] += car * r1[0] - cai * i1[0]; acc8[5] += car * r1[1] - cai * i1[1]; acc8[6] += car * r1[2] - cai * i1[2]; acc8[7] += car * r1[3] - cai * i1[3]; }
#pragma unroll
      for (int e = 0; e < 8; ++e) { float v = acc8[e]; if (j == 0 && c1 == c0 + e) v += p.in[I_SD][g * 16 + c1]; Kl[(j * 16 + c1) * 16 + c0 + e] = v; } }
    __syncthreads();
    bf16_t* W1 = (bf16_t*)(p.ws + W_W1) + (size_t)g * 128 * 256; bf16_t* W2 = (bf16_t*)(p.ws + W_W2) + (size_t)g * 256 * 384;
    for (int i = tid; i < 128 * 32; i += 512) { const int n = i >> 5, ch = i & 31, s = ch >> 1, c0 = 8 * (ch & 1), pp = n & 63; const bool im = n >= 64; float v[8];
        const float ar = apr[(15 - s) * 64 + pp], ai = api[(15 - s) * 64 + pp];
#pragma unroll
        for (int e = 0; e < 8; ++e) { const float xr = bbr[pp * 16 + c0 + e], xi = bbi[pp * 16 + c0 + e]; v[e] = im ? (ar * xi + ai * xr) : (ar * xr - ai * xi); }
        u32x4 o; o.x = cvt_pk_bf16(v[0], v[1]); o.y = cvt_pk_bf16(v[2], v[3]); o.z = cvt_pk_bf16(v[4], v[5]); o.w = cvt_pk_bf16(v[6], v[7]);
        *(u32x4*)(W1 + (size_t)n * 256 + 8 * ch) = o; }
    for (int i = tid; i < 256 * 48; i += 512) { const int n = i / 48, ch = i - n * 48, t = n >> 4, c1 = n & 15; float v[8];
        if (ch < 32) { const int s = ch >> 1, c0 = 8 * (ch & 1);
#pragma unroll
            for (int e = 0; e < 8; ++e) v[e] = (s <= t) ? Kl[((t - s) * 16 + c1) * 16 + c0 + e] : 0.f; }
        else { const bool im = ch >= 40; const int p0 = 8 * (ch - (im ? 40 : 32));
#pragma unroll
            for (int e = 0; e < 8; ++e) { const int pp = p0 + e; const float ar = apr[(t + 1) * 64 + pp], ai = api[(t + 1) * 64 + pp], xr = cr[c1 * 64 + pp], xi = ci[c1 * 64 + pp];
                v[e] = im ? -(xr * ai + xi * ar) : (xr * ar - xi * ai); } }
        u32x4 o; o.x = cvt_pk_bf16(v[0], v[1]); o.y = cvt_pk_bf16(v[2], v[3]); o.z = cvt_pk_bf16(v[4], v[5]); o.w = cvt_pk_bf16(v[6], v[7]);
        *(u32x4*)(W2 + (size_t)n * 384 + 8 * ch) = o; }
    __syncthreads();
}
template <int CLS> __device__ __forceinline__ void transposes(const P& p, LAS float* scr, int lane, int gw, int NGW) {
    constexpr int I_UP = 16 * 192, I_DN = 48 * 32, I_IN = 16 * 112, I_GL = 8 * 64, I_OU = 16 * 32, I_LR = 16 * 8;
    constexpr int NITEMS = CLS == 0 ? I_IN + I_LR : I_UP + I_DN + I_GL + I_OU;
    for (int it = gw; it < NITEMS; it += NGW) { int r = it;
        if (CLS == 0) {
            if (r < I_IN) { const int kb = r / 112, nb = r % 112; transpose_item(p.in[I_WIN], DIN, (bf16_t*)(p.ws + W_WTIN), 1024, 64 * kb, 32 * nb, 32 * nb, scr, lane); continue; } r -= I_IN;
            { const int which = r >> 6, blk = (r >> 3) & 7, kb = (r >> 2) & 1, nb = r & 3;
              transpose_item(p.in[which ? I_WI : I_WR] + blk * 16384, 128, (bf16_t*)(p.ws + (which ? W_WTI : W_WTR)) + blk * 16384, 128, 64 * kb, 32 * nb, 32 * nb, scr, lane); }
        } else {
            if (r < I_UP) { const int kb = r / 192, nb = r % 192, d0 = 32 * nb, s0 = ((d0 >> 7) & 1) * DFF + (d0 >> 8) * 128 + (d0 & 127);
                transpose_item(p.in[I_WUP], 6144, (bf16_t*)(p.ws + W_WTUP), 1024, 64 * kb, s0, d0, scr, lane); continue; } r -= I_UP;
            if (r < I_DN) { const int kb = r / 32, nb = r % 32; transpose_item(p.in[I_WDOWN], 1024, (bf16_t*)(p.ws + W_WTDOWN), 3072, 64 * kb, 32 * nb, 32 * nb, scr, lane); continue; } r -= I_DN;
            if (r < I_GL) { const int kb = r / 64, nb = r % 64, d0 = 32 * nb, s0 = ((d0 >> 7) & 1) * 1024 + (d0 >> 8) * 128 + (d0 & 127);
                transpose_item(p.in[I_WGLU], 2048, (bf16_t*)(p.ws + W_WTGLU), 512, 64 * kb, s0, d0, scr, lane); continue; } r -= I_GL;
            { const int kb = r / 32, nb = r % 32; transpose_item(p.in[I_WOUT], 1024, (bf16_t*)(p.ws + W_WTOUT), 1024, 64 * kb, 32 * nb, 32 * nb, scr, lane); }
        }
    }
}
__device__ __forceinline__ void phase0(const P& p, LAS unsigned char* lds) {
    int tid_ = threadIdx.x; asm volatile("" : "+v"(tid_)); const int tid = tid_, lane = tid & 63, wid = tid >> 6;
    REPEAT(REP_P0A) for (int g = blockIdx.x; g < NG; g += gridDim.x) s5_precompute(p, lds, g);
    LAS float* scr = (LAS float*)(lds + wid * 8704);
    const int gw = blockIdx.x * 8 + wid, NGW = gridDim.x * 8;
    { const int skip = ((int)gridDim.x >= 64) ? NG : 0;
      if ((int)blockIdx.x >= skip) REPEAT(REP_P0B) transposes<0>(p, scr, lane, ((int)blockIdx.x - skip) * 8 + wid, ((int)gridDim.x - skip) * 8); }
    { const int skip = ((int)gridDim.x >= 64) ? NG : 0;
      if ((int)blockIdx.x >= skip) { const int gw2 = ((int)blockIdx.x - skip) * 8 + wid, NGW2 = ((int)gridDim.x - skip) * 8;
        REPEAT(REP_P0C) for (int r = gw2; r < MTOK; r += 2 * NGW2) { const int r2 = r + NGW2; const bool vb = r2 < MTOK; const int rb = vb ? r2 : r;
          ln_rows2<true>(src_row(p, r), src_row(p, rb), p.in[I_EG], p.in[I_EB], (bf16_t*)(p.ws + W_XN) + (size_t)r * DM, (bf16_t*)(p.ws + W_XN) + (size_t)rb * DM, lane, vb); } } }
}

template <int MODE> __device__ __forceinline__ void lru_unit(const P& p, LAS unsigned char* lds, int b, int kc, int nb) {
    int tid_ = threadIdx.x; asm volatile("" : "+v"(tid_)); const int tid = tid_, lane = tid & 63, wid = tid >> 6, q = lane >> 4, n = lane & 15;
    int mt0, nmt, rowbase;
    if (MODE == 2) { mt0 = kc; nmt = 1; rowbase = MP; } else { mt0 = (NCHUNK * kc) >> 3; nmt = ((NCHUNK * (kc + 1)) >> 3) - mt0; rowbase = b * TT; }
    const int t0 = 16 * mt0, ntok = 16 * nmt;
    const bf16_t* proj = (const bf16_t*)(p.ws + W_PROJ);
    LAS bf16_t* xcs = (LAS bf16_t*)lds;
    LAS bf16_t* gas = (LAS bf16_t*)(lds + 73984);
    if (MODE == 2) {
        for (int it = tid; it < ntok * 16; it += 512) { const int i = it >> 4, cg8 = it & 15, c0 = nb * 128 + cg8 * 8; float a[8];
            { const f32x4 b0 = *(const f32x4*)(p.in[I_CLB] + c0), b1 = *(const f32x4*)(p.in[I_CLB] + c0 + 4); a[0] = b0[0]; a[1] = b0[1]; a[2] = b0[2]; a[3] = b0[3]; a[4] = b1[0]; a[5] = b1[1]; a[6] = b1[2]; a[7] = b1[3]; }
#pragma unroll
            for (int j = 0; j < 4; ++j) { const f32x4 w0 = *(const f32x4*)(p.in[I_CLW] + j * 1024 + c0), w1 = *(const f32x4*)(p.in[I_CLW] + j * 1024 + c0 + 4); float x[8];
                if (j < 3) { const float* cp = p.in[I_CCL] + ((size_t)(t0 + i) * 3 + j) * 1024 + c0; const f32x4 x0 = *(const f32x4*)cp, x1 = *(const f32x4*)(cp + 4);
                    x[0] = x0[0]; x[1] = x0[1]; x[2] = x0[2]; x[3] = x0[3]; x[4] = x1[0]; x[5] = x1[1]; x[6] = x1[2]; x[7] = x1[3]; }
                else { const u32x4 xv = *(const u32x4*)(proj + (size_t)(rowbase + t0 + i) * DIN + c0);
                    x[0] = bflo(xv.x); x[1] = bfhi(xv.x); x[2] = bflo(xv.y); x[3] = bfhi(xv.y); x[4] = bflo(xv.z); x[5] = bfhi(xv.z); x[6] = bflo(xv.w); x[7] = bfhi(xv.w); }
                a[0] += w0[0] * x[0]; a[1] += w0[1] * x[1]; a[2] += w0[2] * x[2]; a[3] += w0[3] * x[3]; a[4] += w1[0] * x[4]; a[5] += w1[1] * x[5]; a[6] += w1[2] * x[6]; a[7] += w1[3] * x[7]; }
            u32x4 o; o.x = cvt_pk_bf16(a[0], a[1]); o.y = cvt_pk_bf16(a[2], a[3]); o.z = cvt_pk_bf16(a[4], a[5]); o.w = cvt_pk_bf16(a[6], a[7]);
            *(LAS u32x4*)(xcs + i * 136 + cg8 * 8) = o;
            *(LAS u32x4*)(gas + i * 128 + cg8 * 8) = *(const u32x4*)(proj + (size_t)(rowbase + t0 + i) * DIN + C_GA + c0); }
    } else {
        const int cg8 = tid & 15, tr = tid >> 4, c0 = nb * 128 + cg8 * 8; float w[4][8], bs[8];
        { const f32x4 b0 = *(const f32x4*)(p.in[I_CLB] + c0), b1 = *(const f32x4*)(p.in[I_CLB] + c0 + 4); bs[0] = b0[0]; bs[1] = b0[1]; bs[2] = b0[2]; bs[3] = b0[3]; bs[4] = b1[0]; bs[5] = b1[1]; bs[6] = b1[2]; bs[7] = b1[3]; }
#pragma unroll
        for (int j = 0; j < 4; ++j) { const f32x4 w0 = *(const f32x4*)(p.in[I_CLW] + j * 1024 + c0), w1 = *(const f32x4*)(p.in[I_CLW] + j * 1024 + c0 + 4);
            w[j][0] = w0[0]; w[j][1] = w0[1]; w[j][2] = w0[2]; w[j][3] = w0[3]; w[j][4] = w1[0]; w[j][5] = w1[1]; w[j][6] = w1[2]; w[j][7] = w1[3]; }
        const int i0 = tr * 9; int i1 = i0 + 9; if (i1 > ntok) i1 = ntok;
        u32x4 xr[12], gr[9];
#pragma unroll
        for (int k = 0; k < 12; ++k) { const int i = i0 - 3 + k, t = t0 + i; xr[k] = (u32x4){0u, 0u, 0u, 0u}; if (t >= 0 && i < i1) xr[k] = *(const u32x4*)(proj + (size_t)(rowbase + t) * DIN + c0); }
#pragma unroll
        for (int k = 0; k < 9; ++k) { gr[k] = (u32x4){0u, 0u, 0u, 0u}; if (i0 + k < i1) gr[k] = *(const u32x4*)(proj + (size_t)(rowbase + t0 + i0 + k) * DIN + C_GA + c0); }
#pragma unroll
        for (int k = 0; k < 9; ++k) { if (i0 + k < i1) { float a[8];
#pragma unroll
            for (int e = 0; e < 8; ++e) a[e] = bs[e];
#pragma unroll
            for (int j = 0; j < 4; ++j) { const u32x4 xv = xr[k + j];
                a[0] += w[j][0] * bflo(xv.x); a[1] += w[j][1] * bfhi(xv.x); a[2] += w[j][2] * bflo(xv.y); a[3] += w[j][3] * bfhi(xv.y);
                a[4] += w[j][4] * bflo(xv.z); a[5] += w[j][5] * bfhi(xv.z); a[6] += w[j][6] * bflo(xv.w); a[7] += w[j][7] * bfhi(xv.w); }
            u32x4 o; o.x = cvt_pk_bf16(a[0], a[1]); o.y = cvt_pk_bf16(a[2], a[3]); o.z = cvt_pk_bf16(a[4], a[5]); o.w = cvt_pk_bf16(a[6], a[7]);
            *(LAS u32x4*)(xcs + (i0 + k) * 136 + cg8 * 8) = o; *(LAS u32x4*)(gas + (i0 + k) * 128 + cg8 * 8) = gr[k]; } }
    }
    __syncthreads();
    const int c = nb * 128 + wid * 16 + n;
    bf16x8 Br[4], Bi[4];
    { const bf16_t* wr_ = (const bf16_t*)(p.ws + W_WTR) + (size_t)c * 128 + q * 8; const bf16_t* wi_ = (const bf16_t*)(p.ws + W_WTI) + (size_t)c * 128 + q * 8;
#pragma unroll
      for (int kk = 0; kk < 4; ++kk) { Br[kk] = *(const bf16x8*)(wr_ + 32 * kk); Bi[kk] = *(const bf16x8*)(wi_ + 32 * kk); } }
    const float br = p.in[I_BR][c], bi = p.in[I_BI][c]; const float c8 = -8.0f * log1pf(expf(-p.in[I_LAM][c]));
    bf16_t* M1 = (bf16_t*)(p.ws + W_MIX); bf16_t* M2 = (bf16_t*)(p.out + O_YP);
    float h_run = 0.f, A_run = 1.f;
    for (int mt = 0; mt < nmt; ++mt) {
        f32x4 accr = {0.f, 0.f, 0.f, 0.f}, acci = {0.f, 0.f, 0.f, 0.f};
#pragma unroll
        for (int kk = 0; kk < 4; ++kk) { const bf16x8 Af = *(const LAS bf16x8*)(xcs + (16 * mt + n) * 136 + 32 * kk + 8 * q);
            accr = __builtin_amdgcn_mfma_f32_16x16x32_bf16(Af, Br[kk], accr, 0, 0, 0); acci = __builtin_amdgcn_mfma_f32_16x16x32_bf16(Af, Bi[kk], acci, 0, 0, 0); }
        float a[4], bx[4], ga[4];
#pragma unroll
        for (int j = 0; j < 4; ++j) { const int tok = 16 * mt + 4 * q + j; const float xcv = bf2f(xcs[tok * 136 + wid * 16 + n]);
            ga[j] = bf2f(gas[tok * 128 + wid * 16 + n]);
            const float r = sigm(accr[j] + br), ig = sigm(acci[j] + bi), la = c8 * r; a[j] = __expf(la); bx[j] = __builtin_amdgcn_sqrtf(fmaf(-a[j], a[j], 1.0f)) * (ig * xcv); }
        float h[4], Ac[4];
        if (MODE == 2) {
#pragma unroll
            for (int j = 0; j < 4; ++j) { const int s = t0 + 16 * mt + 4 * q + j; h[j] = a[j] * p.in[I_SL][(size_t)s * 1024 + c] + bx[j]; p.out[O_SL + (size_t)s * 1024 + c] = h[j]; Ac[j] = 0.f; }
        } else {
            float Ap[4]; h[0] = bx[0]; Ap[0] = a[0];
#pragma unroll
            for (int j = 1; j < 4; ++j) { h[j] = a[j] * h[j - 1] + bx[j]; Ap[j] = a[j] * Ap[j - 1]; }
            float PA = Ap[3], PH = h[3];
            float tA = __shfl_up(PA, 16), tH = __shfl_up(PH, 16); if (q >= 1) { PH = PA * tH + PH; PA = PA * tA; }
            tA = __shfl_up(PA, 32); tH = __shfl_up(PH, 32); if (q >= 2) { PH = PA * tH + PH; PA = PA * tA; }
            const float h_end = PA * h_run + PH; const float hin_s = __shfl_up(h_end, 16), pae_s = __shfl_up(PA, 16);
            const float h_in = (q == 0) ? h_run : hin_s; const float a_in = A_run * ((q == 0) ? 1.0f : pae_s);
#pragma unroll
            for (int j = 0; j < 4; ++j) { h[j] += Ap[j] * h_in; Ac[j] = Ap[j] * a_in; }
            h_run = __shfl(h_end, 48 + n); A_run *= __shfl(PA, 48 + n);
        }
#pragma unroll
        for (int j = 0; j < 4; ++j) { const size_t row = (size_t)(rowbase + t0 + 16 * mt + 4 * q + j); const float sg = sigm(ga[j]);
            M1[row * 1024 + c] = f2bf(sg * h[j]); M2[row * 1024 + c] = f2bf(sg * Ac[j]); }
    }
    if (MODE == 0 && q == 0) { ((float*)(p.ws + W_LRUA))[(size_t)(b * 8 + kc) * 1024 + c] = A_run; ((float*)(p.ws + W_LRUH))[(size_t)(b * 8 + kc) * 1024 + c] = h_run; }
    __syncthreads();
}

__device__ __forceinline__ void s5_fused(const P& p, LAS unsigned char* lds, int g, int b) {
    int tid_ = threadIdx.x; asm volatile("" : "+v"(tid_)); const int tid = tid_, lane = tid & 63, wid = tid >> 6, n = lane & 15, q = lane >> 4;
    LAS bf16_t* Us = (LAS bf16_t*)lds;
    LAS float* Ssm = (LAS float*)(lds + 68112);
    LAS bf16_t* Hs = (LAS bf16_t*)(lds + 68112);
    const bf16_t* proj = (const bf16_t*)(p.ws + W_PROJ); const bf16x8 zero = {0, 0, 0, 0, 0, 0, 0, 0};
    bf16x8 Bf1[8];
    { const bf16_t* W = (const bf16_t*)(p.ws + W_W1) + (size_t)g * 128 * 256;
#pragma unroll
      for (int kk = 0; kk < 8; ++kk) Bf1[kk] = *(const bf16x8*)(W + (size_t)(16 * wid + n) * 256 + 32 * kk + 8 * q); }
    TIMED(231) { const bf16_t* ub = (const bf16_t*)(p.out + O_YP) + (size_t)MTOK * 1024 + (size_t)(b * NG + g) * TT * 16;
      u32x4 tv[9];
#pragma unroll
      for (int i = 0; i < 9; ++i) { const int it = tid + 512 * i; tv[i] = (u32x4){0u, 0u, 0u, 0u}; if (it < TT * 2) tv[i] = *(const u32x4*)(ub + (size_t)it * 8); }
#pragma unroll
      for (int i = 0; i < 9; ++i) { const int it = tid + 512 * i; if (it < TT * 2) { const int t = it >> 1; *(LAS u32x4*)(Us + (t >> 4) * 264 + (t & 15) * 16 + 8 * (it & 1)) = tv[i]; } } }
    __syncthreads();
    TIMED_END(231)
    TIMED(232) {
#pragma unroll 1
      for (int rt = 0; rt < 9; ++rt) { const int k = 16 * rt + n; f32x4 acc = {0.f, 0.f, 0.f, 0.f};
#pragma unroll
          for (int kk = 0; kk < 8; ++kk) { const bf16x8 Af = *(const LAS bf16x8*)(Us + k * 264 + 32 * kk + 8 * q);
              acc = __builtin_amdgcn_mfma_f32_16x16x32_bf16(Af, Bf1[kk], acc, 0, 0, 0); }
#pragma unroll
          for (int j = 0; j < 4; ++j) Ssm[(16 * rt + 4 * q + j) * 128 + 16 * wid + n] = acc[j]; } }
    __syncthreads();
    TIMED_END(232)
    bf16x8 Bw[2][12];
    { const bf16_t* W = (const bf16_t*)(p.ws + W_W2) + (size_t)g * 256 * 384;
#pragma unroll
      for (int i = 0; i < 2; ++i)
#pragma unroll
          for (int kk = 0; kk < 12; ++kk) Bw[i][kk] = *(const bf16x8*)(W + (size_t)(16 * (2 * wid + i) + n) * 384 + 32 * kk + 8 * q); }
    TIMED(233) if (wid == 0) { const float* a16 = (const float*)(p.ws + W_A16) + (g * 64 + lane) * 2; const float ar = a16[0], ai = a16[1]; float hr = 0.f, hi = 0.f;
#pragma unroll 1
        for (int kb = 0; kb < 132; kb += 4) { float sr[4], si[4];
#pragma unroll
            for (int u = 0; u < 4; ++u) { sr[u] = Ssm[(kb + u) * 128 + lane]; si[u] = Ssm[(kb + u) * 128 + 64 + lane]; }
            LDS_WAIT();
#pragma unroll
            for (int u = 0; u < 4; ++u) { const int k = kb + u; if (k < NCHUNK) { Hs[k * 136 + lane] = f2bf(hr); Hs[k * 136 + 64 + lane] = f2bf(hi);
                const float nr = ar * hr - ai * hi + sr[u], ni = ar * hi + ai * hr + si[u]; hr = nr; hi = ni; } } }
        p.out[O_PSR + ((size_t)b * NG + g) * 64 + lane] = hr; p.out[O_PSI + ((size_t)b * NG + g) * 64 + lane] = hi; }
    __syncthreads();
    TIMED_END(233)
    TIMED(234)
    {
#pragma unroll 1
      for (int rt = 0; rt < 9; ++rt) { const int k = 16 * rt + n; f32x4 acc0 = {0.f, 0.f, 0.f, 0.f}, acc1 = {0.f, 0.f, 0.f, 0.f};
#pragma unroll
          for (int kk = 0; kk < 8; ++kk) { const bf16x8 af = *(const LAS bf16x8*)(Us + k * 264 + 32 * kk + 8 * q);
              acc0 = __builtin_amdgcn_mfma_f32_16x16x32_bf16(af, Bw[0][kk], acc0, 0, 0, 0); acc1 = __builtin_amdgcn_mfma_f32_16x16x32_bf16(af, Bw[1][kk], acc1, 0, 0, 0); }
#pragma unroll
          for (int kk = 8; kk < 12; ++kk) { const bf16x8 af = *(const LAS bf16x8*)(Hs + k * 136 + 32 * (kk - 8) + 8 * q);
              acc0 = __builtin_amdgcn_mfma_f32_16x16x32_bf16(af, Bw[0][kk], acc0, 0, 0, 0); acc1 = __builtin_amdgcn_mfma_f32_16x16x32_bf16(af, Bw[1][kk], acc1, 0, 0, 0); }
          bf16_t* Y = (bf16_t*)(p.ws + W_YSG) + (size_t)(b * TT + 16 * (16 * rt + 4 * q) + 2 * wid) * DSSM + 16 * g + n;
#pragma unroll
          for (int j = 0; j < 4; ++j) { if (16 * rt + 4 * q + j < NCHUNK) { Y[(size_t)j * 16 * DSSM] = f2bf(gelu_tanh(acc0[j])); Y[(size_t)j * 16 * DSSM + DSSM] = f2bf(gelu_tanh(acc1[j])); } } } }
    TIMED_END(234)
}
__device__ __forceinline__ void s5_sample(const P& p, int s, int g, int lane) {
    const bf16_t* up = (const bf16_t*)(p.out + O_YP) + (size_t)MTOK * 1024 + (size_t)MP * DSSM + ((size_t)s * NG + g) * 16;
    const u32x4 u0 = *(const u32x4*)up, u1 = *(const u32x4*)(up + 8); float u[16];
    u[0] = bflo(u0.x); u[1] = bfhi(u0.x); u[2] = bflo(u0.y); u[3] = bfhi(u0.y); u[4] = bflo(u0.z); u[5] = bfhi(u0.z); u[6] = bflo(u0.w); u[7] = bfhi(u0.w);
    u[8] = bflo(u1.x); u[9] = bfhi(u1.x); u[10] = bflo(u1.y); u[11] = bfhi(u1.y); u[12] = bflo(u1.z); u[13] = bfhi(u1.z); u[14] = bflo(u1.w); u[15] = bfhi(u1.w);
    const float* a1 = (const float*)(p.ws + W_A1) + (g * 64 + lane) * 2; const float ar = a1[0], ai = a1[1];
    const float* bb = (const float*)(p.ws + W_BBAR) + (size_t)(g * 64 + lane) * 32; float bur = 0.f, bui = 0.f;
#pragma unroll
    for (int c = 0; c < 16; ++c) { bur += bb[2 * c] * u[c]; bui += bb[2 * c + 1] * u[c]; }
    const size_t si = ((size_t)s * NG + g) * 64 + lane; const float h0r = p.in[I_SSR][si], h0i = p.in[I_SSI][si];
    const float hr = ar * h0r - ai * h0i + bur, hi = ar * h0i + ai * h0r + bui;
    p.out[O_SSR + si] = hr; p.out[O_SSI + si] = hi;
    float v16[16];
#pragma unroll
    for (int c1 = 0; c1 < 16; ++c1) v16[c1] = p.in[I_SCRE][(g * 16 + c1) * 64 + lane] * hr - p.in[I_SCIM][(g * 16 + c1) * 64 + lane] * hi;
    float v8[8], v4[4], v2[2], v1;
    { const bool hi32 = (lane & 32) != 0;
#pragma unroll
      for (int i = 0; i < 8; ++i) { const float keep = hi32 ? v16[i + 8] : v16[i], send = hi32 ? v16[i] : v16[i + 8]; v8[i] = keep + __shfl_xor(send, 32); } }
    { const bool hb = (lane & 16) != 0;
#pragma unroll
      for (int i = 0; i < 4; ++i) { const float keep = hb ? v8[i + 4] : v8[i], send = hb ? v8[i] : v8[i + 4]; v4[i] = keep + __shfl_xor(send, 16); } }
    { const bool hb = (lane & 8) != 0;
#pragma unroll
      for (int i = 0; i < 2; ++i) { const float keep = hb ? v4[i + 2] : v4[i], send = hb ? v4[i] : v4[i + 2]; v2[i] = keep + __shfl_xor(send, 8); } }
    { const bool hb = (lane & 4) != 0; const float keep = hb ? v2[1] : v2[0], send = hb ? v2[0] : v2[1]; v1 = keep + __shfl_xor(send, 4); }
    v1 += __shfl_xor(v1, 1); v1 += __shfl_xor(v1, 2);
    const int c1 = ((lane >> 5) & 1) * 8 + ((lane >> 4) & 1) * 4 + ((lane >> 3) & 1) * 2 + ((lane >> 2) & 1);
    if ((lane & 3) == 0) { const float uc = bf2f(up[c1]); const float yv = v1 + p.in[I_SD][g * 16 + c1] * uc;
        ((bf16_t*)(p.ws + W_YSG))[(size_t)(MP + s) * DSSM + 16 * g + c1] = f2bf(gelu_tanh(yv)); }
}
__device__ __forceinline__ void phase2a(const P& p, LAS unsigned char* lds) {
    TIMED(22) for (int u = blockIdx.x; u < 512; u += gridDim.x) lru_unit<0>(p, lds, (u >> 3) & 7, u >> 6, u & 7); TIMED_END(22)
    TIMED(23) for (int it = blockIdx.x; it < NG * NBATCH; it += gridDim.x) s5_fused(p, lds, it & 31, it >> 5); TIMED_END(23)
}
__device__ __forceinline__ void phase2b(const P& p, LAS unsigned char* lds) {
    int tid_ = threadIdx.x; asm volatile("" : "+v"(tid_)); const int tid = tid_, lane = tid & 63, wid = tid >> 6;
    const size_t gt = (size_t)blockIdx.x * 512 + tid, GT = (size_t)gridDim.x * 512;
    for (size_t i = gt; i < (size_t)NBATCH * 1024; i += GT) { const int b = (int)(i >> 10), c = (int)(i & 1023); float h = 0.f;
        const float* A = (const float*)(p.ws + W_LRUA); const float* Hh = (const float*)(p.ws + W_LRUH); float* Cc = (float*)(p.ws + W_LRUC);
        for (int kc = 0; kc < 8; ++kc) { const size_t o = (size_t)(b * 8 + kc) * 1024 + c; Cc[o] = h; h = A[o] * h + Hh[o]; }
        p.out[O_PL + i] = h; }
    for (int u = (int)gridDim.x - 1 - (int)blockIdx.x; u < 64; u += gridDim.x) lru_unit<2>(p, lds, 0, u >> 3, u & 7);
    for (int it = blockIdx.x * 8 + wid; it < NSAMP * NG; it += gridDim.x * 8) s5_sample(p, it >> 5, it & 31, lane);
    const bf16_t* proj = (const bf16_t*)(p.ws + W_PROJ);
    for (size_t i = gt; i < (size_t)NBATCH * 3 * 1024; i += GT) { const int c = (int)(i & 1023), j = (int)((i >> 10) % 3), b = (int)(i / 3072);
        p.out[O_PCL + i] = bf2f(proj[(size_t)(b * TT + TT - 3 + j) * DIN + c]); }
    for (size_t i = gt; i < (size_t)NSAMP * 3 * 1024; i += GT) { const int c = (int)(i & 1023), j = (int)((i >> 10) % 3), s = (int)(i / 3072);
        p.out[O_SCL + i] = (j < 2) ? p.in[I_CCL][((size_t)s * 3 + j + 1) * 1024 + c] : bf2f(proj[(size_t)(MP + s) * DIN + c]); }
    for (size_t i = gt; i < (size_t)NSAMP * DFF; i += GT) { const int ch = (int)(i % DFF), s = (int)(i / DFF);
        p.out[O_SCF + ((size_t)s * 2) * DFF + ch] = p.in[I_CCF][((size_t)s * 2 + 1) * DFF + ch]; }
}
__device__ __forceinline__ void phase_glutail(const P& p) {
    const size_t gt = (size_t)blockIdx.x * 512 + threadIdx.x, GT = (size_t)gridDim.x * 512;
    const float* pg = (const float*)(p.ws + W_PG); const float* bias = p.in[I_BGLU]; const bf16_t* proj = (const bf16_t*)(p.ws + W_PROJ);
    bf16_t* mix = (bf16_t*)(p.ws + W_MIX); const bf16_t* m2 = (const bf16_t*)(p.out + O_YP); const float* carry = (const float*)(p.ws + W_LRUC);
    for (size_t it = gt; it < (size_t)256 * 256; it += GT) { const int rl = (int)(it >> 8), j = (int)(it & 255) * 4, rowi = 16384 + rl; const size_t row = (size_t)rowi; const int col = 256 * (j >> 7) + (j & 127);
        f32x4 val = *(const f32x4*)(bias + j), gate = *(const f32x4*)(bias + 1024 + j);
#pragma unroll
        for (int ks = 0; ks < 2; ++ks) { val += *(const f32x4*)(pg + (size_t)ks * 256 * 2048 + (size_t)rl * 2048 + col); gate += *(const f32x4*)(pg + (size_t)ks * 256 * 2048 + (size_t)rl * 2048 + col + 128); }
        int cidx = 0; if (rowi < MP) { const int b = rowi / TT, t = rowi - b * TT; int kc = t >> 8; kc = kc > 7 ? 7 : kc; cidx = (b * 8 + kc) * 1024; }
        const f32x4 cv = *(const f32x4*)(carry + cidx + j); const u32x2 gbw = *(const u32x2*)(proj + row * DIN + C_GB + j), mw = *(const u32x2*)(mix + row * 1024 + j), m2w = *(const u32x2*)(m2 + row * 1024 + j);
        const float o0 = bflo(mw.x) + bflo(m2w.x) * cv[0] + sigm(bflo(gbw.x)) * val[0] * sigm(gate[0]), o1 = bfhi(mw.x) + bfhi(m2w.x) * cv[1] + sigm(bfhi(gbw.x)) * val[1] * sigm(gate[1]);
        const float o2 = bflo(mw.y) + bflo(m2w.y) * cv[2] + sigm(bflo(gbw.y)) * val[2] * sigm(gate[2]), o3 = bfhi(mw.y) + bfhi(m2w.y) * cv[3] + sigm(bfhi(gbw.y)) * val[3] * sigm(gate[3]);
        u32x2 w; w.x = cvt_pk_bf16(o0, o1); w.y = cvt_pk_bf16(o2, o3); *(u32x2*)(mix + row * 1024 + j) = w; }
}
__device__ __forceinline__ void phase_ln1(const P& p) {
    const int lane = threadIdx.x & 63, wid = threadIdx.x >> 6; const int gw = blockIdx.x * 8 + wid, NGW = gridDim.x * 8;
    const bf16_t* R = (const bf16_t*)(p.ws + W_R1); bf16_t* X = (bf16_t*)(p.ws + W_XN);
    for (int r = gw; r < 16384; r += 2 * NGW) { const int r2 = r + NGW; const bool vb = r2 < 16384; const int rb = vb ? r2 : r;
        ln_rows2_bf<true>(R + (size_t)r * DM, R + (size_t)rb * DM, p.in[I_L1G], p.in[I_L1B], X + (size_t)r * DM, X + (size_t)rb * DM, lane, vb); }
    for (int r = 16384 + gw; r < MTOK; r += NGW) { bf16_t* xr = X + (size_t)r * DM;
        ln_row<true>((const float*)(p.ws + W_PART) + (size_t)(r - 16384) * DM, p.in[I_L1G], p.in[I_L1B], xr, lane, 4, xr, p.in[I_BOUT]); }
}
__device__ __forceinline__ void phase_ffnfix(const P& p) {
    const size_t gt = (size_t)blockIdx.x * 512 + threadIdx.x, GT = (size_t)gridDim.x * 512;
    const float* sbg = (const float*)(p.ws + W_SBG); const float* sbv = (const float*)(p.ws + W_SBV); bf16_t* H = (bf16_t*)(p.ws + W_V);
    for (size_t it = gt; it < (size_t)256 * 2 * 384; it += GT) { const int cg8 = (int)(it % 384), rr = (int)((it / 384) & 1), blk = (int)(it / 768), ch = cg8 * 8, row = blk * 64 + rr; const int t = row % TT;
        float o[8];
#pragma unroll
        for (int hh = 0; hh < 2; ++hh) { const int c = ch + 4 * hh; const f32x4 z = {0.f, 0.f, 0.f, 0.f};
            const f32x4 g0 = *(const f32x4*)(sbg + ((size_t)blk * 4 + rr) * DFF + c), v = *(const f32x4*)(sbv + ((size_t)blk * 2 + rr) * DFF + c);
            f32x4 g1, g2;
            if (rr == 0) { g1 = (blk > 0 && t >= 1) ? *(const f32x4*)(sbg + ((size_t)(blk - 1) * 4 + 3) * DFF + c) : z; g2 = (blk > 0 && t >= 2) ? *(const f32x4*)(sbg + ((size_t)(blk - 1) * 4 + 2) * DFF + c) : z; }
            else { g1 = (t >= 1) ? *(const f32x4*)(sbg + ((size_t)blk * 4) * DFF + c) : z; g2 = (blk > 0 && t >= 2) ? *(const f32x4*)(sbg + ((size_t)(blk - 1) * 4 + 3) * DFF + c) : z; }
            const f32x4 w0 = *(const f32x4*)(p.in[I_FCW] + c), w1 = *(const f32x4*)(p.in[I_FCW] + DFF + c), w2 = *(const f32x4*)(p.in[I_FCW] + 2 * DFF + c), cbv = *(const f32x4*)(p.in[I_FCB] + c);
            const f32x4 y = cbv + w0 * g2 + w1 * g1 + w2 * g0;
            o[4 * hh] = gelu_tanh(y[0]) * v[0]; o[4 * hh + 1] = gelu_tanh(y[1]) * v[1]; o[4 * hh + 2] = gelu_tanh(y[2]) * v[2]; o[4 * hh + 3] = gelu_tanh(y[3]) * v[3]; }
        u32x4 w; w.x = cvt_pk_bf16(o[0], o[1]); w.y = cvt_pk_bf16(o[2], o[3]); w.z = cvt_pk_bf16(o[4], o[5]); w.w = cvt_pk_bf16(o[6], o[7]);
        *(u32x4*)(H + (size_t)row * DFF + ch) = w; }
}
__device__ __forceinline__ f32x4 up_tail_sum(const float* pu, const float* bias, int rl, int col, int bcol) {
    f32x4 v = *(const f32x4*)(bias + bcol);
#pragma unroll
    for (int ks = 0; ks < 4; ++ks) v += *(const f32x4*)(pu + (size_t)ks * 256 * 6144 + (size_t)rl * 6144 + col);
    return v;
}
__device__ __forceinline__ void phase_ffntail(const P& p) {
    const size_t gt = (size_t)blockIdx.x * 512 + threadIdx.x, GT = (size_t)gridDim.x * 512;
    const float* pu = (const float*)(p.ws + W_PU); const float* sbg = (const float*)(p.ws + W_SBG); bf16_t* H = (bf16_t*)(p.ws + W_V); const float* bias = p.in[I_BUP];
    for (size_t it = gt; it < (size_t)256 * 768; it += GT) { const int rl = (int)(it / 768), ch = (int)(it - (size_t)rl * 768) * 4, row = 16384 + rl; const int colg = 256 * (ch >> 7) + (ch & 127);
        const f32x4 g0 = up_tail_sum(pu, bias, rl, colg, ch), v = up_tail_sum(pu, bias, rl, colg + 128, DFF + ch); f32x4 g1, g2;
        if (row >= MP) { const int s_ = row - MP; g2 = *(const f32x4*)(p.in[I_CCF] + ((size_t)s_ * 2) * DFF + ch); g1 = *(const f32x4*)(p.in[I_CCF] + ((size_t)s_ * 2 + 1) * DFF + ch);
            *(f32x4*)(p.out + O_SCF + ((size_t)s_ * 2 + 1) * DFF + ch) = g0; }
        else {
            g1 = (rl >= 1) ? up_tail_sum(pu, bias, rl - 1, colg, ch) : *(const f32x4*)(sbg + ((size_t)255 * 4 + 3) * DFF + ch);
            g2 = (rl >= 2) ? up_tail_sum(pu, bias, rl - 2, colg, ch) : *(const f32x4*)(sbg + ((size_t)255 * 4 + 2 + rl) * DFF + ch);
            const int t = row - 7 * TT; if (t >= TT - 2) *(f32x4*)(p.out + O_PCF + ((size_t)7 * 2 + (t - (TT - 2))) * DFF + ch) = g0; }
        const f32x4 w0 = *(const f32x4*)(p.in[I_FCW] + ch), w1 = *(const f32x4*)(p.in[I_FCW] + DFF + ch), w2 = *(const f32x4*)(p.in[I_FCW] + 2 * DFF + ch), cbv = *(const f32x4*)(p.in[I_FCB] + ch);
        const f32x4 y = cbv + w0 * g2 + w1 * g1 + w2 * g0;
        u32x2 w; w.x = cvt_pk_bf16(gelu_tanh(y[0]) * v[0], gelu_tanh(y[1]) * v[1]); w.y = cvt_pk_bf16(gelu_tanh(y[2]) * v[2], gelu_tanh(y[3]) * v[3]);
        *(u32x2*)(H + (size_t)row * DFF + ch) = w; }
}
__device__ __forceinline__ float* y_row(const P& p, int r) {
    if (r >= MP) return p.out + O_YS + (size_t)(r - MP) * DM;
    const int b = r / TT, t = r - b * TT; return t < 16 ? nullptr : p.out + O_YP + ((size_t)b * 2048 + (t - 16)) * DM;
}
__device__ __forceinline__ void phase_ln2(const P& p) {
    const int lane = threadIdx.x & 63, wid = threadIdx.x >> 6; const int gw = blockIdx.x * 8 + wid, NGW = gridDim.x * 8;
    const bf16_t* R = (const bf16_t*)(p.ws + W_R2);
    for (int r = gw; r < 16384; r += 2 * NGW) { const int r2 = r + NGW; float* oa = y_row(p, r); float* ob = (r2 < 16384) ? y_row(p, r2) : nullptr;
        if (oa && ob) ln_rows2_bf<false>(R + (size_t)r * DM, R + (size_t)r2 * DM, p.in[I_L2G], p.in[I_L2B], oa, ob, lane, true);
        else if (oa) ln_rows2_bf<false>(R + (size_t)r * DM, R + (size_t)r * DM, p.in[I_L2G], p.in[I_L2B], oa, oa, lane, false);
        else if (ob) ln_rows2_bf<false>(R + (size_t)r2 * DM, R + (size_t)r2 * DM, p.in[I_L2G], p.in[I_L2B], ob, ob, lane, false); }
    for (int r = 16384 + gw; r < MTOK; r += NGW) { float* o = y_row(p, r);
        if (o) ln_row<false>((const float*)(p.ws + W_PART) + (size_t)(r - 16384) * DM, p.in[I_L2G], p.in[I_L2B], o, lane, 12, (const bf16_t*)(p.ws + W_XN) + (size_t)r * DM, p.in[I_BDOWN]); }
}

__global__ __launch_bounds__(512, 2) void hawk_fwd(P p) {
    extern __shared__ __attribute__((aligned(16))) unsigned char shm[];
    LAS unsigned char* lds = (LAS unsigned char*)shm;
    cg::grid_group grid = cg::this_grid();
    volatile LAS unsigned* xst = (volatile LAS unsigned*)(lds + LDS_TOTAL - 16);
    if (threadIdx.x < 4) xst[threadIdx.x] = 0u;
    __syncthreads();
    XcdBarrier xb = xcd_barrier_post((unsigned*)(p.ws + W_BAR), xst);
    if (threadIdx.x == 0) xst[2] = xb_add((unsigned*)(p.ws + W_BAR) + XCD_BAR_WORDS + 64 * xb.x, 1u);
#define GSYNC() xcd_barrier(xb)
    if (p.ws == nullptr) grid.sync();
    TIMED(0) REPEAT(REP_P0) { phase0(p, lds); GSYNC(); } TIMED_END(0)
    if (threadIdx.x == 0) { unsigned* bar = (unsigned*)(p.ws + W_BAR); bool ok = (gridDim.x % 8u) == 0u;
        for (unsigned j = 0; j < 16; ++j) { const unsigned cnt = xb_ld(&bar[XB_XCNT(j)]); if (cnt != (j < 8 ? gridDim.x / 8u : 0u)) ok = false; }
        xst[3] = ok ? (xst[2] * 8u + xb.x) : blockIdx.x; }
    __syncthreads();
    const int vc = (int)xst[3];
    TIMED(1) REPEAT(REP_P1) { EpiProj E; E.O = (bf16_t*)(p.ws + W_PROJ); E.bias = p.in[I_BIN]; E.UT = (bf16_t*)(p.out + O_YP) + (size_t)MTOK * 1024; run_gemm(lds, vc, (const bf16_t*)(p.ws + W_XN), (const bf16_t*)(p.ws + W_WTIN), DIN, 1024, E);
        { const int G = (int)gridDim.x, nun = (MTOK / 256) * (DIN / 256), rem = nun % G; const int c = vc;
          if (c >= rem) transposes<1>(p, (LAS float*)(lds + (threadIdx.x >> 6) * 8704), threadIdx.x & 63, (c - rem) * 8 + (int)(threadIdx.x >> 6), (G - rem) * 8); }
        GSYNC(); } TIMED_END(1)
    TIMED(20) REPEAT(REP_P2A) { phase2a(p, lds); GSYNC(); } TIMED_END(20)
    TIMED(21) REPEAT(REP_P2B) { phase2b(p, lds); GSYNC(); } TIMED_END(21)
    TIMED(3) { EpiGlu E; E.mix = (bf16_t*)(p.ws + W_MIX); E.m2 = (const bf16_t*)(p.out + O_YP); E.carry = (const float*)(p.ws + W_LRUC); E.proj = (const bf16_t*)(p.ws + W_PROJ); E.bias = p.in[I_BGLU]; run_gemm_main64(lds, vc, (const bf16_t*)(p.ws + W_YSG), (const bf16_t*)(p.ws + W_WTGLU), 2048, 512, E);
        run_gemm_tail(lds, vc, (const bf16_t*)(p.ws + W_YSG), (const bf16_t*)(p.ws + W_WTGLU), 2048, 512, 2, (float*)(p.ws + W_PG)); GSYNC();
        phase_glutail(p); GSYNC(); } TIMED_END(3)
    TIMED(4) REPEAT(REP_P4) { EpiRes E; E.R = (bf16_t*)(p.ws + W_R1); E.X = (const bf16_t*)(p.ws + W_XN); E.bias = p.in[I_BOUT]; E.part = (float*)(p.ws + W_PART); run_gemm_split(lds, vc, (const bf16_t*)(p.ws + W_MIX), (const bf16_t*)(p.ws + W_WTOUT), 1024, 1024, 4, E); GSYNC(); } TIMED_END(4)
    TIMED(5) REPEAT(REP_P5) { phase_ln1(p); GSYNC(); } TIMED_END(5)
    TIMED(6) REPEAT(REP_P6) { EpiUp E; E.H = (bf16_t*)(p.ws + W_V); E.bias = p.in[I_BUP]; E.out = p.out; E.cw = p.in[I_FCW]; E.cb = p.in[I_FCB]; E.cache = p.in[I_CCF]; E.sbg = (float*)(p.ws + W_SBG); E.sbv = (float*)(p.ws + W_SBV); run_gemm_main64(lds, vc, (const bf16_t*)(p.ws + W_XN), (const bf16_t*)(p.ws + W_WTUP), 6144, 1024, E);
        run_gemm_tail(lds, vc, (const bf16_t*)(p.ws + W_XN), (const bf16_t*)(p.ws + W_WTUP), 6144, 1024, 4, (float*)(p.ws + W_PU)); GSYNC(); } TIMED_END(6)
    TIMED(7) phase_ffnfix(p); phase_ffntail(p);
    GSYNC(); TIMED_END(7)
    TIMED(8) REPEAT(REP_P8) { EpiRes E; E.R = (bf16_t*)(p.ws + W_R2); E.X = (const bf16_t*)(p.ws + W_XN); E.bias = p.in[I_BDOWN]; E.part = (float*)(p.ws + W_PART); run_gemm_split(lds, vc, (const bf16_t*)(p.ws + W_V), (const bf16_t*)(p.ws + W_WTDOWN), 1024, 3072, 12, E); GSYNC(); } TIMED_END(8)
    TIMED(9) REPEAT(REP_P9) phase_ln2(p); TIMED_END(9)
}

extern "C" void kernel_launch(void* const* d_in, const int* in_sizes, int n_in, void* d_out, int out_size, void* d_ws, size_t ws_size, hipStream_t stream) {
    constexpr int LDS_BYTES = LDS_TOTAL;
    static int grid = 0;
    if (grid == 0) {
        if (n_in != N_IN || (size_t)out_size != O_END || ws_size < 268435456ull) { fprintf(stderr, "kernel_launch: unexpected shapes (n_in %d out %d ws %zu)\n", n_in, out_size, ws_size); grid = -1; return; }
        int dev = 0, cus = 0, per_cu = 0;
        if (hipGetDevice(&dev) != hipSuccess || hipDeviceGetAttribute(&cus, hipDeviceAttributeMultiprocessorCount, dev) != hipSuccess) { grid = -1; return; }
        if (hipFuncSetAttribute((const void*)hawk_fwd, hipFuncAttributeMaxDynamicSharedMemorySize, LDS_BYTES) != hipSuccess) { fprintf(stderr, "kernel_launch: hipFuncSetAttribute failed\n"); grid = -1; return; }
        if (hipOccupancyMaxActiveBlocksPerMultiprocessor(&per_cu, (const void*)hawk_fwd, 512, LDS_BYTES) != hipSuccess || per_cu < 1) { fprintf(stderr, "kernel_launch: occupancy query failed (%d)\n", per_cu); grid = -1; (void)hipGetLastError(); return; }
        grid = cus * per_cu;
    }
    if (grid < 0) return;
    if (hipMemsetAsync((char*)d_ws + W_BAR, 0, (XCD_BAR_WORDS + 64 * 16) * 4, stream) != hipSuccess) { fprintf(stderr, "kernel_launch: memset failed\n"); return; }
    P p{};
    for (int i = 0; i < N_IN; ++i) p.in[i] = (const float*)d_in[i];
    p.out = (float*)d_out; p.ws = (unsigned char*)d_ws;
    void* args[] = {&p};
    hipError_t e = hipLaunchCooperativeKernel((const void*)hawk_fwd, dim3(grid), dim3(512), args, LDS_BYTES, stream);
    if (e != hipSuccess) fprintf(stderr, "cooperative launch failed: %s (grid %d)\n", hipGetErrorString(e), grid);
}
```
